# Optimizing an MI355X kernel written in HIP

```python
import jax, jax.numpy as jnp
from jax import lax
import numpy as np

D_MODEL = 1024
BATCH = 8
SEQ = 8192
DEPTH = 2

POOL_WINDOWS = (2, 4, 8, 16)
POOL_GROUPS = 4
WIDTH_A = D_MODEL // 2
POOL_GROUP_DIM = WIDTH_A // POOL_GROUPS
CHUNK = 128
SGU_HEADS = 4
WIDTH_B = D_MODEL // 2
SGU_HEAD_DIM = WIDTH_B // SGU_HEADS
WIDTH_C = D_MODEL // 2
CONV_WIDTH = 3
N_BRANCHES = 3
W_IN_COLS = WIDTH_A + 2 * WIDTH_B + 3 * WIDTH_C + N_BRANCHES * D_MODEL
D_FF = 2816
EPS = 1e-6

kernel_name = "hybrid_pool_sgu_shortconv_gated_block"


def rmsnorm(x, g):
    xf = x.astype(jnp.float32)
    y = xf * lax.rsqrt(jnp.mean(xf * xf, axis=-1, keepdims=True) + EPS)
    return (y * g.astype(jnp.float32)).astype(x.dtype)


def causal_dwconv3(z, w):
    s = z.shape[1]
    zp = jnp.pad(z, ((0, 0), (CONV_WIDTH - 1, 0), (0, 0)))
    return zp[:, :s] * w[0] + zp[:, 1:s + 1] * w[1] + zp[:, 2:s + 2] * w[2]


def multiscale_pool(a):
    bsz, s = a.shape[0], a.shape[1]
    af = a.astype(jnp.float32)
    cs = jnp.cumsum(af, axis=1)
    cs_pad = jnp.pad(cs, ((0, 0), (1, 0), (0, 0), (0, 0)))
    t = jnp.arange(s, dtype=jnp.float32)
    outs = []
    for g, w in enumerate(POOL_WINDOWS):
        upper = cs[:, :, g]
        lower = jnp.concatenate(
            [jnp.zeros((bsz, w - 1, a.shape[3]), jnp.float32), cs_pad[:, :s - w + 1, g]], axis=1)
        cnt = jnp.minimum(t + 1.0, float(w))[None, :, None]
        outs.append((upper - lower) / cnt - af[:, :, g])
    return jnp.stack(outs, axis=2).astype(a.dtype)


def setup_inputs(seed: int = 0) -> dict:
    key = jax.random.key(seed)
    k = jax.random.split(key, 20)
    n = jax.random.normal
    f32 = jnp.float32
    L = DEPTH
    tri = jnp.tril(jnp.ones((CHUNK, CHUNK), f32))
    row_scale = (jnp.arange(CHUNK, dtype=f32) + 1.0) ** -0.5
    w_spatial = n(k[5], (L, SGU_HEADS, CHUNK, CHUNK), f32) * tri * row_scale[:, None]
    return {
        "x": n(k[0], (BATCH, SEQ, D_MODEL), f32),
        "g_mix": 1.0 + 0.02 * n(k[1], (L, D_MODEL), f32),
        "w_in": n(k[2], (L, D_MODEL, W_IN_COLS), f32) * D_MODEL ** -0.5,
        "w_pool": n(k[3], (L, POOL_GROUPS, POOL_GROUP_DIM, POOL_GROUP_DIM), f32) * POOL_GROUP_DIM ** -0.5,
        "pool_scale": 1.0 + 0.1 * n(k[4], (L, WIDTH_A), f32),
        "g_sgu": 1.0 + 0.02 * n(k[6], (L, WIDTH_B), f32),
        "w_spatial": w_spatial,
        "b_spatial": 1.0 + 0.01 * n(k[7], (L, SGU_HEADS, CHUNK), f32),
        "conv_c": n(k[8], (L, CONV_WIDTH, WIDTH_C), f32) * CONV_WIDTH ** -0.5,
        "w_branch_a": n(k[9], (L, WIDTH_A, D_MODEL), f32) * WIDTH_A ** -0.5,
        "w_branch_b": n(k[10], (L, WIDTH_B, D_MODEL), f32) * WIDTH_B ** -0.5,
        "w_branch_c": n(k[11], (L, WIDTH_C, D_MODEL), f32) * WIDTH_C ** -0.5,
        "w_o": n(k[12], (L, D_MODEL, D_MODEL), f32) * D_MODEL ** -0.5,
        "g_ffn": 1.0 + 0.02 * n(k[13], (L, D_MODEL), f32),
        "w_up": n(k[14], (L, D_MODEL, 2 * D_FF), f32) * D_MODEL ** -0.5,
        "conv_ffn": n(k[15], (L, CONV_WIDTH, 2 * D_FF), f32) * CONV_WIDTH ** -0.5,
        "conv_ffn_b": 0.01 * n(k[16], (L, 2 * D_FF), f32),
        "w_down": n(k[17], (L, D_FF, D_MODEL), f32) * D_FF ** -0.5,
        "g_final": 1.0 + 0.02 * n(k[18], (D_MODEL,), f32),
    }


def reference(x, g_mix, w_in, w_pool, pool_scale, g_sgu, w_spatial, b_spatial, conv_c,
              w_branch_a, w_branch_b, w_branch_c, w_o, g_ffn, w_up, conv_ffn, conv_ffn_b,
              w_down, g_final):
    bsz, s, _ = x.shape
    n_chunks = s // CHUNK
    splits = np.cumsum([WIDTH_A, 2 * WIDTH_B, WIDTH_C, WIDTH_C, WIDTH_C, D_MODEL, D_MODEL]).tolist()
    for l in range(DEPTH):
        h = rmsnorm(x, g_mix[l])
        p = h @ w_in[l]
        a, uv, c_b, c_c, c_x, ga, gb, gc = jnp.split(p, splits, axis=-1)

        a = a.reshape(bsz, s, POOL_GROUPS, POOL_GROUP_DIM)
        pa = multiscale_pool(a)
        ya = jnp.einsum("bsgd,gde->bsge", pa, w_pool[l]).reshape(bsz, s, WIDTH_A) * pool_scale[l]

        uv = jax.nn.gelu(uv)
        u, v = jnp.split(uv, 2, axis=-1)
        v = rmsnorm(v, g_sgu[l])
        v = v.reshape(bsz, n_chunks, CHUNK, SGU_HEADS, SGU_HEAD_DIM)
        ws = jnp.tril(w_spatial[l])
        sv = jnp.einsum("gts,bcsgd->bctgd", ws, v) + b_spatial[l].T[None, None, :, :, None]
        yb = u * sv.reshape(bsz, s, WIDTH_B)

        yc = c_b * causal_dwconv3(c_c * c_x, conv_c[l])

        merged = (jax.nn.sigmoid(ga) * (ya @ w_branch_a[l])
                  + jax.nn.sigmoid(gb) * (yb @ w_branch_b[l])
                  + jax.nn.sigmoid(gc) * (yc @ w_branch_c[l]))
        x = x + merged @ w_o[l]

        h = rmsnorm(x, g_ffn[l])
        up = causal_dwconv3(h @ w_up[l], conv_ffn[l]) + conv_ffn_b[l]
        gate, val = jnp.split(up, 2, axis=-1)
        x = x + (jax.nn.silu(gate) * val) @ w_down[l]
    return rmsnorm(x, g_final)
```

```cpp
#include <hip/hip_runtime.h>
#include <hip/hip_cooperative_groups.h>
#include <cstdio>
namespace cg = cooperative_groups;
namespace pg8 {
#define PG8_LAS __attribute__((address_space(3)))
typedef unsigned short bf16_t;
typedef short bf16x8 __attribute__((ext_vector_type(8)));
typedef float f32x4 __attribute__((ext_vector_type(4)));
typedef unsigned u32x4 __attribute__((ext_vector_type(4)));
constexpr int BM = 256, BK = 64, HALF = 128, HTB = HALF * BK * 2  , STAGE_BYTES = 8 * HTB, NXCD = 8, WGM = 8;

__host__ __device__ __forceinline__ int lds_byte(int r, int c) { const int st = (r >> 4) * 2 + (c >> 5), rr = r & 15, cc = c & 31, ob = rr * 64 + cc * 2; return st * 1024 + (ob ^ (((ob >> 9) & 1) << 5)); }
__host__ __device__ __forceinline__ void stage_rc(int b, int& R, int& C) { const int st = b / 1024, sb = b % 1024, swz = sb ^ (((sb >> 9) & 1) << 5); R = (st >> 1) * 16 + swz / 64; C = (st & 1) * 32 + (swz % 64) / 2; }
__host__ __device__ __forceinline__ int perm32(int rho) { const int n = rho >> 4, i = rho & 15; return 8 * (i >> 2) + 4 * n + (i & 3); }

struct Unit { int pm, pn; };
struct Gemm { const bf16_t* A; const bf16_t* Bt; int M, N, K; };

struct StaticOrder {
    int nM, nN, nwg, G, c;
    __host__ __device__ void init(int M, int N, int G_, int c_) { nM = M / BM; nN = N / BM; nwg = nM * nN; G = G_; c = c_; }
    __host__ __device__ bool next(int i, Unit& u) const {
        const long L = (long)i * G + c; if (L >= nwg) return false;
        int wgid = (int)L; { const int q = nwg / NXCD, r = nwg % NXCD, xcd = wgid % NXCD, off = wgid / NXCD; wgid = (xcd < r ? xcd * (q + 1) : r * (q + 1) + (xcd - r) * q) + off; }
        const int nig = WGM * nN, gid = wgid / nig, fm = gid * WGM, gsz = (nM - fm) < WGM ? (nM - fm) : WGM;
        u.pm = fm + ((wgid % nig) % gsz); u.pn = (wgid % nig) / gsz; return true;
    }
    __device__ __forceinline__ void a_ready(const Unit&) const {}
    __device__ __forceinline__ void done(const Unit&) const {}
};
__device__ __forceinline__ unsigned cvt_pk_bf16(float lo, float hi) { unsigned r; asm volatile("v_cvt_pk_bf16_f32 %0, %1, %2" : "=v"(r) : "v"(lo), "v"(hi)); return r; }

template <class Epi, class Sched, bool STAMP = false>
__device__ __forceinline__ void gemm_phase(PG8_LAS unsigned char* lds, const Gemm g, const Sched& S, const Epi& E, unsigned long long* stamps) {
    int tid_ = threadIdx.x; asm volatile("" : "+v"(tid_));
    const int tid = tid_, wid = __builtin_amdgcn_readfirstlane(tid >> 6), lane = tid & 63, wr = wid >> 2, wc = wid & 3, fr = lane & 15, fq = lane >> 4;
    const int K = g.K, nt = K / BK;
    int ts_lo = 0, ts_hi = 0, nts = 0; const unsigned long long rt_entry = STAMP ? (unsigned long long)wall_clock64() : 0ull;
#define PG8_STAMP() do { if (STAMP && wid == 0 && nts < 64) { const unsigned long long _c = (unsigned long long)clock64(); \
        ts_lo = (lane == nts) ? (int)(unsigned)_c : ts_lo; ts_hi = (lane == nts) ? (int)(unsigned)(_c >> 32) : ts_hi; ++nts; } } while (0)
    PG8_STAMP();
    unsigned voffA[2], voffB[2];
#pragma unroll
    for (int i = 0; i < 2; ++i) { int R, C; stage_rc(tid * 16 + i * 8192, R, C); const int Rb = Epi::PERM ? ((R & ~31) + perm32(R & 31)) : R;
        voffA[i] = (unsigned)(R * K + C) * 2u; voffB[i] = (unsigned)(Rb * K + C) * 2u; }
    const size_t kstep = (size_t)(BK * 2);
    const size_t hstep = (size_t)HALF * K * 2;
    const size_t tstep = 2 * hstep;
    const unsigned ldsw = (unsigned)wid * 1024u;
    const int aoff = lds_byte(wr * 64 + fr, fq * 8), boff = lds_byte(wc * 32 + fr, fq * 8);
#define PG8_SA(b, h) (((b) * 2 + (h)) * HTB)
#define PG8_SB(b, h) ((4 + (b) * 2 + (h)) * HTB)
#define PG8_STAGE(bufoff, gbase, voff) do { _Pragma("unroll") for (int _i = 0; _i < 2; ++_i) \
        __builtin_amdgcn_global_load_lds((const unsigned*)((const char*)(gbase) + (voff)[_i]), (PG8_LAS unsigned*)(lds + (bufoff) + ldsw + _i * 8192), 16, 0, 0); } while (0)
#define PG8_LDA(dst, b, h) do { _Pragma("unroll") for (int m = 0; m < 4; ++m) _Pragma("unroll") for (int k = 0; k < 2; ++k) dst[m][k] = *(const PG8_LAS bf16x8*)(lds + PG8_SA(b, h) + aoff + m * 2048 + k * 1024); } while (0)
#define PG8_LDB(dst, b, h) do { _Pragma("unroll") for (int n = 0; n < 2; ++n) _Pragma("unroll") for (int k = 0; k < 2; ++k) dst[n][k] = *(const PG8_LAS bf16x8*)(lds + PG8_SB(b, h) + boff + n * 2048 + k * 1024); } while (0)
#define PG8_MMA(ai, bj, At, Bt) do { __builtin_amdgcn_s_setprio(1); _Pragma("unroll") for (int m = 0; m < 4; ++m) _Pragma("unroll") for (int n = 0; n < 2; ++n) _Pragma("unroll") for (int k = 0; k < 2; ++k) \
        acc[ai][bj][m][n] = __builtin_amdgcn_mfma_f32_16x16x32_bf16(Bt[n][k], At[m][k], acc[ai][bj][m][n], 0, 0, 0); __builtin_amdgcn_s_setprio(0); } while (0)
#define PG8_WAIT_V(n) asm volatile("s_waitcnt vmcnt(" #n ")" ::: "memory")
#define PG8_WAIT_L(n) asm volatile("s_waitcnt lgkmcnt(" #n ")" ::: "memory")
#define PG8_BAR __builtin_amdgcn_s_barrier()
#define PG8_SCHED __builtin_amdgcn_sched_barrier(0)
    Unit cur, nxt; int ui = 0;
    if (!S.next(0, cur)) return;
    f32x4 acc[2][2][4][2];
#pragma unroll
    for (int a = 0; a < 2; ++a)
#pragma unroll
        for (int b = 0; b < 2; ++b)
#pragma unroll
            for (int m = 0; m < 4; ++m)
#pragma unroll
                for (int n = 0; n < 2; ++n) acc[a][b][m][n] = (f32x4){0.f, 0.f, 0.f, 0.f};
    bf16x8 At[4][2], B0[2][2], B1[2][2];
    const char* cA = (const char*)g.A + (size_t)cur.pm * tstep; const char* cB = (const char*)g.Bt + (size_t)cur.pn * tstep;
    S.a_ready(cur);
    PG8_STAGE(PG8_SB(0, 0), cB, voffB); PG8_STAGE(PG8_SA(0, 0), cA, voffA); PG8_STAGE(PG8_SB(0, 1), cB + hstep, voffB); PG8_STAGE(PG8_SA(0, 1), cA + hstep, voffA);
    if (wr == 1) PG8_BAR;
    PG8_WAIT_V(4); PG8_BAR;
    PG8_STAGE(PG8_SB(1, 0), cB + kstep, voffB); PG8_STAGE(PG8_SA(1, 0), cA + kstep, voffA); PG8_STAGE(PG8_SB(1, 1), cB + hstep + kstep, voffB);
    PG8_WAIT_V(6); PG8_BAR;
    PG8_STAMP();
    for (;;) {
        const bool has_next = S.next(ui + 1, nxt);
        const char* nA = has_next ? (const char*)g.A + (size_t)nxt.pm * tstep : cA; const char* nB = has_next ? (const char*)g.Bt + (size_t)nxt.pn * tstep : cB;
        for (int t = 0; t < nt; t += 2) {
            if constexpr (Epi::MIDK) { if (t == 8 || t == 16) E.mid(acc, cur, t, wr, wc, fr, fq); }
            const bool last = (t == nt - 2);
            const char* a1 = cA + (size_t)(t + 1) * kstep;
            const char* a2 = last ? nA : cA + (size_t)(t + 2) * kstep; const char* b2 = last ? nB : cB + (size_t)(t + 2) * kstep;
            const char* a3 = a2 + kstep; const char* b3 = b2 + kstep;
            if (last && has_next) S.a_ready(nxt);
            PG8_LDB(B0, 0, 0); PG8_SCHED; PG8_LDA(At, 0, 0); PG8_STAGE(PG8_SA(1, 1), a1 + hstep, voffA);
            PG8_WAIT_L(8); PG8_BAR; PG8_WAIT_L(0); PG8_MMA(0, 0, At, B0); PG8_BAR; PG8_SCHED;
            PG8_LDB(B1, 0, 1); PG8_STAGE(PG8_SB(0, 0), b2, voffB);
            PG8_BAR; PG8_WAIT_L(0); PG8_MMA(0, 1, At, B1); PG8_BAR;
            PG8_LDA(At, 0, 1); PG8_STAGE(PG8_SA(0, 0), a2, voffA);
            PG8_BAR; PG8_WAIT_L(0); PG8_MMA(1, 0, At, B0); PG8_BAR; PG8_SCHED;
            PG8_STAGE(PG8_SB(0, 1), b2 + hstep, voffB);
            PG8_WAIT_V(6); PG8_BAR; PG8_MMA(1, 1, At, B1); PG8_BAR;
            PG8_LDB(B0, 1, 0); PG8_SCHED; PG8_LDA(At, 1, 0); PG8_STAGE(PG8_SA(0, 1), a2 + hstep, voffA);
            PG8_WAIT_L(8); PG8_BAR; PG8_WAIT_L(0); PG8_MMA(0, 0, At, B0); PG8_BAR; PG8_SCHED;
            PG8_LDB(B1, 1, 1); PG8_STAGE(PG8_SB(1, 0), b3, voffB);
            PG8_BAR; PG8_WAIT_L(0); PG8_MMA(0, 1, At, B1); PG8_BAR;
            PG8_LDA(At, 1, 1); PG8_STAGE(PG8_SA(1, 0), a3, voffA);
            PG8_BAR; PG8_WAIT_L(0); PG8_MMA(1, 0, At, B0); PG8_BAR; PG8_SCHED;
            PG8_STAGE(PG8_SB(1, 1), b3 + hstep, voffB);
            PG8_WAIT_V(6); PG8_BAR; PG8_MMA(1, 1, At, B1); PG8_BAR;
        }
        PG8_STAMP();
        if constexpr (!Epi::AFTER_DRAIN) { E(acc, cur, wr, wc, fr, fq); S.done(cur); }
        PG8_STAMP();
        if (!has_next) break;
#pragma unroll
        for (int a = 0; a < 2; ++a)
#pragma unroll
            for (int b = 0; b < 2; ++b)
#pragma unroll
                for (int m = 0; m < 4; ++m)
#pragma unroll
                    for (int n = 0; n < 2; ++n) acc[a][b][m][n] = (f32x4){0.f, 0.f, 0.f, 0.f};
        cur = nxt; cA = nA; cB = nB; ++ui;
    }
    PG8_WAIT_V(0);
    if (wr == 0) PG8_BAR;
    PG8_BAR;
    if constexpr (Epi::AFTER_DRAIN) { E.fused(acc, cur, wr, wc, fr, fq, lds, wid, lane); S.done(cur); }
    PG8_STAMP();
    if (STAMP && wid == 0) { stamps[lane] = lane < nts ? (((unsigned long long)(unsigned)ts_hi << 32) | (unsigned)ts_lo) : 0ull;
        if (lane == 62) stamps[62] = rt_entry; if (lane == 63) stamps[63] = (unsigned long long)wall_clock64(); }
#undef PG8_STAMP
#undef PG8_SA
#undef PG8_SB
#undef PG8_STAGE
#undef PG8_LDA
#undef PG8_LDB
#undef PG8_MMA
#undef PG8_WAIT_V
#undef PG8_WAIT_L
#undef PG8_BAR
#undef PG8_SCHED
}
}
typedef pg8::bf16_t bf16_t;
typedef pg8::f32x4 f32x4;
typedef pg8::u32x4 u32x4;
typedef pg8::bf16x8 bf16x8;
typedef unsigned u32x2 __attribute__((ext_vector_type(2)));
#define LAS __attribute__((address_space(3)))
constexpr int MTOK = 65536, DM = 1024, NIN = 6144, DFF = 2816, NUP = 5632, SEQ = 8192, NBR = 1536, NPA = 3072;
constexpr int MH = MTOK / 2;
constexpr float EPS = 1e-6f;
constexpr size_t WS_WIN = 0;
constexpr size_t WS_WBR = WS_WIN + (size_t)NIN * DM * 2;
constexpr size_t WS_WO = WS_WBR + (size_t)DM * NBR * 2;
constexpr size_t WS_WUP = WS_WO + (size_t)DM * DM * 2;
constexpr size_t WS_WDN = WS_WUP + (size_t)NUP * DM * 2;
constexpr size_t WS_SSQ = WS_WDN + (size_t)DM * DFF * 2;
constexpr size_t WS_XB = WS_SSQ + (size_t)MTOK * 16 * 4;
constexpr size_t WS_B1 = WS_XB + (size_t)MTOK * NBR * 2;
constexpr size_t WS_B2 = WS_B1 + (size_t)MTOK * NPA * 2;
constexpr size_t WS_END = WS_B2 + (size_t)MTOK * NPA * 2;

__device__ __forceinline__ int otid() { int t = threadIdx.x; asm volatile("" : "+v"(t)); return t; }
__device__ __forceinline__ int obid() { int b = blockIdx.x; asm volatile("" : "+s"(b)); return b; }
struct Params {
    const float* in[19];
    float* out; unsigned char* ws;
};

__device__ __forceinline__ float bflo(unsigned w) { return __uint_as_float(w << 16); }
__device__ __forceinline__ float bfhi(unsigned w) { return __uint_as_float(w & 0xffff0000u); }
__device__ __forceinline__ unsigned pk(float a, float b) { return pg8::cvt_pk_bf16(a, b); }
__device__ __forceinline__ float fast_rcp(float x) { return __builtin_amdgcn_rcpf(x); }
__device__ __forceinline__ float sigmoid_f(float x) { x = fminf(fmaxf(x, -30.f), 30.f); return fast_rcp(1.0f + __expf(-x)); }
__device__ __forceinline__ float gelu_tanh_f(float x) {
    const float z2 = 1.5957691216f * (x + 0.044715f * x * x * x);
    return x * fast_rcp(1.0f + __expf(-z2));
}
__device__ __forceinline__ float silu_f(float x) { return x * fast_rcp(1.0f + __expf(-x)); }
__device__ __forceinline__ float row_rstd(const float* ssq, int r) {
    const f32x4* p = (const f32x4*)(ssq + (size_t)r * 16);
    const f32x4 a = p[0], b = p[1], c = p[2], d = p[3];
    const float s = ((a[0] + a[1]) + (a[2] + a[3])) + ((b[0] + b[1]) + (b[2] + b[3])) + ((c[0] + c[1]) + (c[2] + c[3])) + ((d[0] + d[1]) + (d[2] + d[3]));
    return rsqrtf(s * (1.0f / 1024.0f) + EPS);
}

struct EpiIn {
    static constexpr bool PERM = true, AFTER_DRAIN = false, MIDK = false;
    bf16_t* PA; bf16_t* G; const float* ssq;
    __device__ __forceinline__ void operator()(const f32x4 (&acc)[2][2][4][2], const pg8::Unit& u, int wr, int wc, int fr, int fq) const {
        const int colt = u.pn * 256;
        const int act = (colt >= NPA) ? 2 : ((colt >= 512 && colt < 1536) ? 1 : 0);
        bf16_t* base = (colt >= NPA) ? G : PA;
        const int col0 = (colt >= NPA ? colt - NPA : colt) + wc * 32 + 8 * fq;
        const int row0 = u.pm * 256 + wr * 64 + fr;
#pragma unroll
        for (int ai = 0; ai < 2; ++ai)
#pragma unroll
            for (int m = 0; m < 4; ++m) {
                const int r = row0 + ai * 128 + m * 16;
                const float rs = row_rstd(ssq, r);
                bf16_t* rowp = base + (size_t)r * NPA + col0;
#pragma unroll
                for (int bj = 0; bj < 2; ++bj) {
                    float v[8];
#pragma unroll
                    for (int j = 0; j < 4; ++j) { v[j] = acc[ai][bj][m][0][j] * rs; v[4 + j] = acc[ai][bj][m][1][j] * rs; }
                    if (act == 1) {
#pragma unroll
                        for (int j = 0; j < 8; ++j) v[j] = gelu_tanh_f(v[j]);
                    } else if (act == 2) {
#pragma unroll
                        for (int j = 0; j < 8; ++j) v[j] = sigmoid_f(v[j]);
                    }
                    u32x4 w; w.x = pk(v[0], v[1]); w.y = pk(v[2], v[3]); w.z = pk(v[4], v[5]); w.w = pk(v[6], v[7]);
                    *(u32x4*)(rowp + bj * 128) = w;
                }
            }
    }
};
struct EpiBr {
    static constexpr bool PERM = true, AFTER_DRAIN = false, MIDK = true;
    const bf16_t* G; bf16_t* out;
    __device__ __forceinline__ void mid(f32x4 (&acc)[2][2][4][2], const pg8::Unit& u, int t, int wr, int wc, int fr, int fq) const {
        const int seg = (t == 8) ? 0 : 1024;
        int col0 = u.pn * 256 + wc * 32 + 8 * fq + seg;
        int row0 = u.pm * 256 + wr * 64 + fr;
        asm volatile("" : "+v"(col0), "+v"(row0));
#pragma unroll
        for (int ai = 0; ai < 2; ++ai)
#pragma unroll
            for (int m = 0; m < 4; ++m) {
                const bf16_t* rowp = G + (size_t)(row0 + ai * 128 + m * 16) * NPA + col0;
#pragma unroll
                for (int bj = 0; bj < 2; ++bj) {
                    const u32x4 nu = *(const u32x4*)(rowp + bj * 128), de = *(const u32x4*)(rowp + bj * 128 + 1024);
                    const unsigned nw[4] = {nu.x, nu.y, nu.z, nu.w}, dw[4] = {de.x, de.y, de.z, de.w};
#pragma unroll
                    for (int q = 0; q < 4; ++q) {
                        const float r0 = bflo(nw[q]) * fast_rcp(bflo(dw[q])), r1 = bfhi(nw[q]) * fast_rcp(bfhi(dw[q]));
                        acc[ai][bj][m][q >> 1][(q & 1) * 2] *= r0; acc[ai][bj][m][q >> 1][(q & 1) * 2 + 1] *= r1;
                    }
                }
                if (m & 1) asm volatile("" ::: "memory");
            }
    }
    __device__ __forceinline__ void operator()(const f32x4 (&acc)[2][2][4][2], const pg8::Unit& u, int wr, int wc, int fr, int fq) const {
        const int col0 = u.pn * 256 + wc * 32 + 8 * fq;
        const int row0 = u.pm * 256 + wr * 64 + fr;
#pragma unroll
        for (int ai = 0; ai < 2; ++ai)
#pragma unroll
            for (int m = 0; m < 4; ++m) {
                const int r = row0 + ai * 128 + m * 16;
                const bf16_t* gp = G + (size_t)r * NPA + 2048 + col0;
                bf16_t* op = out + (size_t)r * DM + col0;
#pragma unroll
                for (int bj = 0; bj < 2; ++bj) {
                    const u32x4 s = *(const u32x4*)(gp + bj * 128);
                    const f32x4 a0 = acc[ai][bj][m][0], a1 = acc[ai][bj][m][1];
                    u32x4 w;
                    w.x = pk(a0[0] * bflo(s.x), a0[1] * bfhi(s.x)); w.y = pk(a0[2] * bflo(s.y), a0[3] * bfhi(s.y));
                    w.z = pk(a1[0] * bflo(s.z), a1[1] * bfhi(s.z)); w.w = pk(a1[2] * bflo(s.w), a1[3] * bfhi(s.w));
                    *(u32x4*)(op + bj * 128) = w;
                }
            }
    }
};
struct EpiRes {
    static constexpr bool PERM = true, AFTER_DRAIN = false, MIDK = false;
    const float* base; float* out; bf16_t* xb; float* ssq; int row_off;
    __device__ __forceinline__ void operator()(const f32x4 (&acc)[2][2][4][2], const pg8::Unit& u, int wr, int wc, int fr, int fq) const {
        const int col0 = u.pn * 256 + wc * 32 + 8 * fq;
        const int row0 = row_off + u.pm * 256 + wr * 64 + fr;
#pragma unroll
        for (int ai = 0; ai < 2; ++ai)
#pragma unroll
            for (int m = 0; m < 4; ++m) {
                const int r = row0 + ai * 128 + m * 16;
                const size_t off = (size_t)r * DM + col0;
                float sq = 0.f;
#pragma unroll
                for (int bj = 0; bj < 2; ++bj) {
                    const f32x4 b0 = *(const f32x4*)(base + off + bj * 128), b1 = *(const f32x4*)(base + off + bj * 128 + 4);
                    const f32x4 o0 = b0 + acc[ai][bj][m][0], o1 = b1 + acc[ai][bj][m][1];
                    *(f32x4*)(out + off + bj * 128) = o0; *(f32x4*)(out + off + bj * 128 + 4) = o1;
                    u32x4 w; w.x = pk(o0[0], o0[1]); w.y = pk(o0[2], o0[3]); w.z = pk(o1[0], o1[1]); w.w = pk(o1[2], o1[3]);
                    *(u32x4*)(xb + off + bj * 128) = w;
                    sq += (o0[0] * o0[0] + o0[1] * o0[1]) + (o0[2] * o0[2] + o0[3] * o0[3]) + (o1[0] * o1[0] + o1[1] * o1[1]) + (o1[2] * o1[2] + o1[3] * o1[3]);
                }
                sq += __shfl_xor(sq, 16); sq += __shfl_xor(sq, 32);
                if (fq == 0) ssq[(size_t)r * 16 + u.pn * 4 + wc] = sq;
                asm volatile("" ::: "memory");
            }
    }
};
struct EpiUp {
    static constexpr bool PERM = true, AFTER_DRAIN = false, MIDK = false;
    bf16_t* out; const float* ssq; int row_off;
    __device__ __forceinline__ void operator()(const f32x4 (&acc)[2][2][4][2], const pg8::Unit& u, int wr, int wc, int fr, int fq) const {
        const int col0 = u.pn * 256 + wc * 32 + 8 * fq;
        const int row0 = u.pm * 256 + wr * 64 + fr;
#pragma unroll
        for (int ai = 0; ai < 2; ++ai)
#pragma unroll
            for (int m = 0; m < 4; ++m) {
                const int r = row0 + ai * 128 + m * 16;
                const float rs = row_rstd(ssq, row_off + r);
                bf16_t* rowp = out + (size_t)r * NUP + col0;
#pragma unroll
                for (int bj = 0; bj < 2; ++bj) {
                    const f32x4 a0 = acc[ai][bj][m][0] * rs, a1 = acc[ai][bj][m][1] * rs;
                    u32x4 w; w.x = pk(a0[0], a0[1]); w.y = pk(a0[2], a0[3]); w.z = pk(a1[0], a1[1]); w.w = pk(a1[2], a1[3]);
                    *(u32x4*)(rowp + bj * 128) = w;
                }
            }
    }
};

__device__ __forceinline__ void transpose_tile(const float* __restrict__ W, int N, const float* __restrict__ g, bf16_t* __restrict__ Wt, int ldt, int koff, int k0, int n0, float* tile, int tid) {
    {
        const int kk = tid >> 4, nn = (tid & 15) * 4;
#pragma unroll
        for (int h = 0; h < 2; ++h) {
            const int k = kk + h * 32;
            f32x4 v = *(const f32x4*)(W + (size_t)(k0 + k) * N + n0 + nn);
            const float s = g ? g[k0 + k] : 1.0f;
            tile[k * 65 + nn + 0] = v[0] * s; tile[k * 65 + nn + 1] = v[1] * s; tile[k * 65 + nn + 2] = v[2] * s; tile[k * 65 + nn + 3] = v[3] * s;
        }
    }
    __syncthreads();
    {
        const int n = tid >> 3, kq = (tid & 7) * 8;
        float v[8];
#pragma unroll
        for (int j = 0; j < 8; ++j) v[j] = tile[(kq + j) * 65 + n];
        u32x4 w; w.x = pk(v[0], v[1]); w.y = pk(v[2], v[3]); w.z = pk(v[4], v[5]); w.w = pk(v[6], v[7]);
        *(u32x4*)(Wt + (size_t)(n0 + n) * ldt + koff + k0 + kq) = w;
    }
    __syncthreads();
}

__device__ __forceinline__ void prep_phase(const Params& p, int l, float* ldsf) {
    unsigned char* ws = p.ws;
    bf16_t* wt_in = (bf16_t*)(ws + WS_WIN); bf16_t* wt_br = (bf16_t*)(ws + WS_WBR); bf16_t* wt_o = (bf16_t*)(ws + WS_WO);
    bf16_t* wt_up = (bf16_t*)(ws + WS_WUP); bf16_t* wt_dn = (bf16_t*)(ws + WS_WDN);
    const float* g_mix = p.in[1] + (size_t)l * DM; const float* w_in = p.in[2] + (size_t)l * DM * NIN;
    const float* w_pool = p.in[3] + (size_t)l * 4 * 128 * 128; const float* pscale = p.in[4] + (size_t)l * 512;
    const float* w_ba = p.in[9] + (size_t)l * 512 * DM; const float* w_bb = p.in[10] + (size_t)l * 512 * DM; const float* w_bc = p.in[11] + (size_t)l * 512 * DM;
    const float* w_o = p.in[12] + (size_t)l * DM * DM; const float* g_ffn = p.in[13] + (size_t)l * DM;
    const float* w_up = p.in[14] + (size_t)l * DM * NUP; const float* w_dn = p.in[17] + (size_t)l * DFF * DM;
    const int tid = otid(), bid = obid();
    constexpr int T0 = 16 * 96, T1 = T0 + 128, T2 = T1 + 128, T3 = T2 + 256, T4 = T3 + 16 * 88, T5 = T4 + 44 * 16;
    for (int i = bid; i < T5; i += gridDim.x) {
        if (i < T0) { const int kt = i & 15, nt = i >> 4; transpose_tile(w_in, NIN, g_mix, wt_in, DM, 0, kt * 64, nt * 64, ldsf, tid); }
        else if (i < T1) { const int j = i - T0, kt = j & 7, nt = j >> 3; transpose_tile(w_bb, DM, nullptr, wt_br, NBR, 512, kt * 64, nt * 64, ldsf, tid); }
        else if (i < T2) { const int j = i - T1, kt = j & 7, nt = j >> 3; transpose_tile(w_bc, DM, nullptr, wt_br, NBR, 1024, kt * 64, nt * 64, ldsf, tid); }
        else if (i < T3) { const int j = i - T2, kt = j & 15, nt = j >> 4; transpose_tile(w_o, DM, nullptr, wt_o, DM, 0, kt * 64, nt * 64, ldsf, tid); }
        else if (i < T4) { const int j = i - T3, kt = j & 15, nt = j >> 4; transpose_tile(w_up, NUP, g_ffn, wt_up, DM, 0, kt * 64, nt * 64, ldsf, tid); }
        else { const int j = i - T4, kt = j % 44, nt = j / 44; transpose_tile(w_dn, DM, nullptr, wt_dn, DFF, 0, kt * 64, nt * 64, ldsf, tid); }
    }
    {
        float* wpT = ldsf;
        float* wa = ldsf + 128 * 128;
        for (int it = (int)gridDim.x - 1 - bid; it < 64; it += gridDim.x) {
            const int g = it >> 4, n0 = (it & 15) * 64;
            for (int q = tid; q < 128 * 32; q += 512) {
                const int d = q >> 5, e4 = (q & 31) * 4;
                const f32x4 v = *(const f32x4*)(w_pool + ((size_t)g * 128 + d) * 128 + e4);
                const f32x4 s = *(const f32x4*)(pscale + g * 128 + e4);
                wpT[(e4 + 0) * 128 + d] = v[0] * s[0]; wpT[(e4 + 1) * 128 + d] = v[1] * s[1]; wpT[(e4 + 2) * 128 + d] = v[2] * s[2]; wpT[(e4 + 3) * 128 + d] = v[3] * s[3];
            }
            for (int q = tid; q < 128 * 16; q += 512) {
                const int e = q >> 4, c4 = (q & 15) * 4;
                *(f32x4*)(wa + e * 64 + c4) = *(const f32x4*)(w_ba + (size_t)(g * 128 + e) * DM + n0 + c4);
            }
            __syncthreads();
            const int d = tid & 127, ns = tid >> 7;
            float acc[16];
#pragma unroll
            for (int i = 0; i < 16; ++i) acc[i] = 0.f;
            for (int e = 0; e < 128; ++e) {
                const float w = wpT[e * 128 + d];
                const f32x4* wr4 = (const f32x4*)(wa + e * 64 + ns * 16);
#pragma unroll
                for (int c = 0; c < 4; ++c) { const f32x4 b = wr4[c]; acc[c * 4 + 0] += w * b[0]; acc[c * 4 + 1] += w * b[1]; acc[c * 4 + 2] += w * b[2]; acc[c * 4 + 3] += w * b[3]; }
            }
#pragma unroll
            for (int i = 0; i < 16; ++i) wt_br[(size_t)(n0 + ns * 16 + i) * NBR + g * 128 + d] = (bf16_t)(pk(acc[i], 0.f) & 0xffffu);
            __syncthreads();
        }
    }
    if (l == 0) {
        const float* x = p.in[0]; bf16_t* xb = (bf16_t*)(ws + WS_XB); float* ssq = (float*)(ws + WS_SSQ);
        const int lane = tid & 63, wave = tid >> 6;
        for (int r = bid * 8 + wave; r < MTOK; r += gridDim.x * 8) {
            float sq = 0.f;
#pragma unroll
            for (int i = 0; i < 4; ++i) {
                const f32x4 v = *(const f32x4*)(x + (size_t)r * DM + i * 256 + lane * 4);
                sq += (v[0] * v[0] + v[1] * v[1]) + (v[2] * v[2] + v[3] * v[3]);
                u32x2 w; w.x = pk(v[0], v[1]); w.y = pk(v[2], v[3]);
                *(u32x2*)(xb + (size_t)r * DM + i * 256 + lane * 4) = w;
            }
#pragma unroll
            for (int o = 32; o >= 1; o >>= 1) sq += __shfl_xor(sq, o);
            if (lane < 16) ssq[(size_t)r * 16 + lane] = (lane == 0) ? sq : 0.f;
        }
    }
}
__device__ __forceinline__ void ld8(const bf16_t* p, float (&v)[8]) {
    const u32x4 w = *(const u32x4*)p;
    v[0] = bflo(w.x); v[1] = bfhi(w.x); v[2] = bflo(w.y); v[3] = bfhi(w.y); v[4] = bflo(w.z); v[5] = bfhi(w.z); v[6] = bflo(w.w); v[7] = bfhi(w.w);
}
__device__ __forceinline__ void st8(bf16_t* p, const float (&v)[8]) {
    u32x4 w; w.x = pk(v[0], v[1]); w.y = pk(v[2], v[3]); w.z = pk(v[4], v[5]); w.w = pk(v[6], v[7]);
    *(u32x4*)p = w;
}
constexpr int VT_PITCH = 136;
__device__ __forceinline__ void mixer_phase(const Params& p, int l, unsigned char* lds) {
    const bf16_t* PA = (const bf16_t*)(p.ws + WS_B1);
    bf16_t* Y = (bf16_t*)(p.ws + WS_XB);
    const float* g_sgu = p.in[5] + (size_t)l * 512;
    const float* w_sp = p.in[6] + (size_t)l * 4 * 128 * 128;
    const float* b_sp = p.in[7] + (size_t)l * 4 * 128;
    const float* conv_c = p.in[8] + (size_t)l * 3 * 512;
    float* rs = (float*)lds;
    bf16_t* vT = (bf16_t*)(lds + 1024);
    const int tid = otid(), lane = tid & 63, wave = tid >> 6, fr = lane & 15, fq = lane >> 4;
    for (int item = obid(); item < MTOK / 128; item += gridDim.x) {
        const int t0 = item * 128, pos0 = t0 & (SEQ - 1);
        {
            const int row = tid >> 2, q = tid & 3;
            const bf16_t* vp = PA + (size_t)(t0 + row) * NPA + 1024 + q * 128;
            float sq = 0.f;
#pragma unroll
            for (int i = 0; i < 16; ++i) { float v[8]; ld8(vp + i * 8, v);
#pragma unroll
                for (int j = 0; j < 8; ++j) sq += v[j] * v[j]; }
            sq += __shfl_xor(sq, 1); sq += __shfl_xor(sq, 2);
            if (q == 0) rs[row] = rsqrtf(sq * (1.0f / 512.0f) + EPS);
        }
        {
            const int c8 = (tid & 63) * 8, r0 = (tid >> 6) * 16;
            {
                const int w = 2 << (c8 >> 7);
                const bf16_t* ap = PA + (size_t)t0 * NPA + c8;
                bf16_t* yp = Y + (size_t)t0 * NBR + c8;
                float s[8];
#pragma unroll
                for (int j = 0; j < 8; ++j) s[j] = 0.f;
                for (int k = 1; k < w; ++k) { const int rr = r0 - k; if (pos0 + rr >= 0) { float v[8]; ld8(ap + (ptrdiff_t)rr * NPA, v);
#pragma unroll
                        for (int j = 0; j < 8; ++j) s[j] += v[j]; } }
                for (int i = 0; i < 16; ++i) {
                    const int rr = r0 + i; float v[8]; ld8(ap + (ptrdiff_t)rr * NPA, v);
                    const int pos = pos0 + rr; const float inv = 1.0f / (float)(pos + 1 < w ? pos + 1 : w);
                    float o[8];
#pragma unroll
                    for (int j = 0; j < 8; ++j) { s[j] += v[j]; o[j] = s[j] * inv - v[j]; }
                    st8(yp + (size_t)rr * NBR, o);
                    const int ro = rr - w + 1;
                    if (pos0 + ro >= 0) { float q[8]; ld8(ap + (ptrdiff_t)ro * NPA, q);
#pragma unroll
                        for (int j = 0; j < 8; ++j) s[j] -= q[j]; }
                }
            }
            {
                const bf16_t* bp = PA + (size_t)t0 * NPA + 1536 + c8;
                bf16_t* yp = Y + (size_t)t0 * NBR + 1024 + c8;
                float w0[8], w1[8], w2[8], z1[8], z2[8];
#pragma unroll
                for (int j = 0; j < 8; ++j) { w0[j] = conv_c[c8 + j]; w1[j] = conv_c[512 + c8 + j]; w2[j] = conv_c[1024 + c8 + j]; z1[j] = 0.f; z2[j] = 0.f; }
                if (pos0 + r0 - 2 >= 0) { float a[8], b[8]; ld8(bp + (ptrdiff_t)(r0 - 2) * NPA + 512, a); ld8(bp + (ptrdiff_t)(r0 - 2) * NPA + 1024, b);
#pragma unroll
                    for (int j = 0; j < 8; ++j) z2[j] = a[j] * b[j]; }
                if (pos0 + r0 - 1 >= 0) { float a[8], b[8]; ld8(bp + (ptrdiff_t)(r0 - 1) * NPA + 512, a); ld8(bp + (ptrdiff_t)(r0 - 1) * NPA + 1024, b);
#pragma unroll
                    for (int j = 0; j < 8; ++j) z1[j] = a[j] * b[j]; }
                for (int i = 0; i < 16; ++i) {
                    const int rr = r0 + i; float cb[8], a[8], b[8], o[8];
                    ld8(bp + (size_t)rr * NPA, cb); ld8(bp + (size_t)rr * NPA + 512, a); ld8(bp + (size_t)rr * NPA + 1024, b);
#pragma unroll
                    for (int j = 0; j < 8; ++j) { const float z = a[j] * b[j]; o[j] = cb[j] * (w0[j] * z2[j] + w1[j] * z1[j] + w2[j] * z); z2[j] = z1[j]; z1[j] = z; }
                    st8(yp + (size_t)rr * NBR, o);
                }
            }
        }
        for (int g = 0; g < 4; ++g) {
            __syncthreads();
            {
                const int s = tid >> 2, dq = (tid & 3) * 32;
                const bf16_t* vp = PA + (size_t)(t0 + s) * NPA + 1024 + g * 128 + dq;
#pragma unroll
                for (int i = 0; i < 4; ++i) {
                    const u32x4 w = *(const u32x4*)(vp + i * 8);
                    const unsigned ww[4] = {w.x, w.y, w.z, w.w};
#pragma unroll
                    for (int q = 0; q < 4; ++q) { vT[(dq + i * 8 + q * 2) * VT_PITCH + s] = (bf16_t)(ww[q] & 0xffffu); vT[(dq + i * 8 + q * 2 + 1) * VT_PITCH + s] = (bf16_t)(ww[q] >> 16); }
                }
            }
            __syncthreads();
            f32x4 acc[8];
#pragma unroll
            for (int n = 0; n < 8; ++n) acc[n] = (f32x4){0.f, 0.f, 0.f, 0.f};
            const int t = wave * 16 + fr;
            const int nk = (wave >> 1) + 1;
            for (int k = 0; k < nk; ++k) {
                const int s0 = k * 32 + fq * 8;
                const float* wp = w_sp + ((size_t)g * 128 + t) * 128 + s0;
                const f32x4 wa = *(const f32x4*)wp, wb = *(const f32x4*)(wp + 4);
                const f32x4 ra = *(const f32x4*)(rs + s0), rb = *(const f32x4*)(rs + s0 + 4);
                float a[8];
#pragma unroll
                for (int j = 0; j < 4; ++j) { a[j] = (s0 + j <= t) ? wa[j] * ra[j] : 0.f; a[4 + j] = (s0 + 4 + j <= t) ? wb[j] * rb[j] : 0.f; }
                union { u32x4 u; bf16x8 h; } af; af.u.x = pk(a[0], a[1]); af.u.y = pk(a[2], a[3]); af.u.z = pk(a[4], a[5]); af.u.w = pk(a[6], a[7]);
#pragma unroll
                for (int n = 0; n < 8; ++n) {
                    const bf16x8 bfrag = *(const bf16x8*)(vT + (n * 16 + fr) * VT_PITCH + s0);
                    acc[n] = __builtin_amdgcn_mfma_f32_16x16x32_bf16(bfrag, af.h, acc[n], 0, 0, 0);
                }
            }
            const float bias = b_sp[g * 128 + t];
            const bf16_t* up = PA + (size_t)(t0 + t) * NPA + 512 + g * 128 + 4 * fq;
            bf16_t* yp = Y + (size_t)(t0 + t) * NBR + 512 + g * 128 + 4 * fq;
#pragma unroll
            for (int n = 0; n < 8; ++n) {
                const u32x2 uu = *(const u32x2*)(up + n * 16);
                const f32x4 gs = *(const f32x4*)(g_sgu + g * 128 + n * 16 + 4 * fq);
                const float o0 = bflo(uu.x) * (acc[n][0] * gs[0] + bias), o1 = bfhi(uu.x) * (acc[n][1] * gs[1] + bias);
                const float o2 = bflo(uu.y) * (acc[n][2] * gs[2] + bias), o3 = bfhi(uu.y) * (acc[n][3] * gs[3] + bias);
                u32x2 w; w.x = pk(o0, o1); w.y = pk(o2, o3);
                *(u32x2*)(yp + n * 16) = w;
            }
        }
        __syncthreads();
    }
}

__device__ __forceinline__ void convact_phase(const Params& p, int l, int h) {
    const bf16_t* up = (const bf16_t*)(p.ws + WS_B1);
    bf16_t* act = (bf16_t*)(p.ws + WS_B2);
    const float* cw = p.in[15] + (size_t)l * 3 * NUP; const float* cb = p.in[16] + (size_t)l * NUP;
    constexpr int RB = 32, NCG = DFF / 8, NU = (MH / RB) * NCG;
    for (int u = obid() * 512 + otid(); u < NU; u += gridDim.x * 512) {
        const int rb = u / NCG, c8 = (u - rb * NCG) * 8, r0 = rb * RB;
        const int pos0 = r0 & (SEQ - 1);
        float wg[3][8], wv[3][8], bg[8], bv[8], g1[8], g2[8], v1[8], v2[8];
#pragma unroll
        for (int j = 0; j < 8; ++j) {
#pragma unroll
            for (int i = 0; i < 3; ++i) { wg[i][j] = cw[i * NUP + c8 + j]; wv[i][j] = cw[i * NUP + DFF + c8 + j]; }
            bg[j] = cb[c8 + j]; bv[j] = cb[DFF + c8 + j]; g1[j] = g2[j] = v1[j] = v2[j] = 0.f;
        }
        const bf16_t* bp = up + (size_t)r0 * NUP + c8;
        if (pos0 >= 2) { ld8(bp - 2 * (ptrdiff_t)NUP, g2); ld8(bp - 2 * (ptrdiff_t)NUP + DFF, v2); ld8(bp - (ptrdiff_t)NUP, g1); ld8(bp - (ptrdiff_t)NUP + DFF, v1); }
        for (int i = 0; i < RB; ++i) {
            float g0[8], v0[8], o[8];
            ld8(bp + (size_t)i * NUP, g0); ld8(bp + (size_t)i * NUP + DFF, v0);
#pragma unroll
            for (int j = 0; j < 8; ++j) {
                const float gg = wg[0][j] * g2[j] + wg[1][j] * g1[j] + wg[2][j] * g0[j] + bg[j];
                const float vv = wv[0][j] * v2[j] + wv[1][j] * v1[j] + wv[2][j] * v0[j] + bv[j];
                o[j] = silu_f(gg) * vv; g2[j] = g1[j]; g1[j] = g0[j]; v2[j] = v1[j]; v1[j] = v0[j];
            }
            st8(act + (size_t)(r0 + i) * DFF + c8, o);
        }
    }
}

__device__ __forceinline__ void final_norm_phase(const Params& p) {
    const float* gf = p.in[18]; const float* ssq = (const float*)(p.ws + WS_SSQ); float* out = p.out;
    const int tid = otid(), lane = tid & 63, wave = tid >> 6;
    for (int r = obid() * 8 + wave; r < MTOK; r += gridDim.x * 8) {
        const float rs = row_rstd(ssq, r);
#pragma unroll
        for (int i = 0; i < 4; ++i) {
            float* q = out + (size_t)r * DM + i * 256 + lane * 4;
            const f32x4 v = *(const f32x4*)q; const f32x4 g = *(const f32x4*)(gf + i * 256 + lane * 4);
            *(f32x4*)q = v * rs * g;
        }
    }
}

template <class Epi> __device__ __forceinline__ void run_gemm(unsigned char* lds, const bf16_t* A, const bf16_t* Bt, int M, int N, int K, const Epi& E) {
    pg8::Gemm g{A, Bt, M, N, K}; pg8::StaticOrder S; S.init(M, N, (int)gridDim.x, obid());
    pg8::gemm_phase<Epi, pg8::StaticOrder, false>((PG8_LAS unsigned char*)lds, g, S, E, nullptr);
}

__global__ void __launch_bounds__(512, 2) fwd_megakernel(Params p) {
    extern __shared__ __attribute__((aligned(16))) unsigned char lds[];
    cg::grid_group grid = cg::this_grid();
    unsigned char* ws = p.ws;
    bf16_t* wt_in = (bf16_t*)(ws + WS_WIN); bf16_t* wt_br = (bf16_t*)(ws + WS_WBR); bf16_t* wt_o = (bf16_t*)(ws + WS_WO);
    bf16_t* wt_up = (bf16_t*)(ws + WS_WUP); bf16_t* wt_dn = (bf16_t*)(ws + WS_WDN);
    float* ssq = (float*)(ws + WS_SSQ); bf16_t* xb = (bf16_t*)(ws + WS_XB); bf16_t* b1 = (bf16_t*)(ws + WS_B1); bf16_t* b2 = (bf16_t*)(ws + WS_B2);
    for (int l = 0; l < 2; ++l) {
        prep_phase(p, l, (float*)lds);
        grid.sync();
        { EpiIn E{b1, b2, ssq}; run_gemm(lds, xb, wt_in, MTOK, NIN, DM, E); }
        grid.sync();
        mixer_phase(p, l, lds);
        grid.sync();
        { EpiBr E{b2, b1}; run_gemm(lds, xb  , wt_br, MTOK, DM, NBR, E); }
        grid.sync();
        { EpiRes E{l == 0 ? p.in[0] : p.out, p.out, xb, ssq, 0}; run_gemm(lds, b1, wt_o, MTOK, DM, DM, E); }
        grid.sync();
        for (int h = 0; h < 2; ++h) {
            { EpiUp E{b1, ssq, h * MH}; run_gemm(lds, xb + (size_t)h * MH * DM, wt_up, MH, NUP, DM, E); }
            grid.sync();
            convact_phase(p, l, h);
            grid.sync();
            { EpiRes E{p.out, p.out, xb, ssq, h * MH}; run_gemm(lds, b2, wt_dn, MH, DM, DFF, E); }
        }
        grid.sync();
    }
    final_norm_phase(p);
}

extern "C" void kernel_launch(void* const* d_in, const int* in_sizes, int n_in, void* d_out, int out_size, void* d_ws, size_t ws_size, hipStream_t stream) {
    constexpr size_t kLds = pg8::STAGE_BYTES;
    static int grid_blocks = 0;
    if (!grid_blocks) {
        int dev = 0, cus = 0, per_cu = 0;
        (void)hipGetDevice(&dev);
        (void)hipDeviceGetAttribute(&cus, hipDeviceAttributeMultiprocessorCount, dev);
        (void)hipFuncSetAttribute((const void*)fwd_megakernel, hipFuncAttributeMaxDynamicSharedMemorySize, (int)kLds);
        (void)hipOccupancyMaxActiveBlocksPerMultiprocessor(&per_cu, (const void*)fwd_megakernel, 512, kLds);
        if (per_cu < 1) per_cu = 1;
        grid_blocks = cus;
        if (ws_size < WS_END || n_in != 19 || out_size != MTOK * DM) { fprintf(stderr, "kernel_launch: unexpected sizes: ws %zu (need %zu), n_in %d, out %d\n", ws_size, (size_t)WS_END, n_in, out_size); }
    }
    Params p{};
    for (int i = 0; i < 19; ++i) p.in[i] = (const float*)d_in[i];
    p.out = (float*)d_out; p.ws = (unsigned char*)d_ws;
    void* args[] = {&p};
    hipError_t e = hipLaunchCooperativeKernel((void*)fwd_megakernel, dim3(grid_blocks), dim3(512), args, kLds, stream);
    if (e != hipSuccess) fprintf(stderr, "cooperative launch failed: %s (grid %d)\n", hipGetErrorString(e), grid_blocks);
}
```

```cpp
#include <hip/hip_runtime.h>
#include <hip/hip_cooperative_groups.h>
#include <cstdio>
namespace cg = cooperative_groups;
namespace pg8 {
#define PG8_LAS __attribute__((address_space(3)))
typedef unsigned short bf16_t;
typedef short bf16x8 __attribute__((ext_vector_type(8)));
typedef float f32x4 __attribute__((ext_vector_type(4)));
typedef unsigned u32x4 __attribute__((ext_vector_type(4)));
constexpr int BM = 256, BK = 64, HALF = 128, HTB = HALF * BK * 2  , STAGE_BYTES = 8 * HTB, NXCD = 8, WGM = 8;

__host__ __device__ __forceinline__ int lds_byte(int r, int c) { const int st = (r >> 4) * 2 + (c >> 5), rr = r & 15, cc = c & 31, ob = rr * 64 + cc * 2; return st * 1024 + (ob ^ (((ob >> 9) & 1) << 5)); }
__host__ __device__ __forceinline__ void stage_rc(int b, int& R, int& C) { const int st = b / 1024, sb = b % 1024, swz = sb ^ (((sb >> 9) & 1) << 5); R = (st >> 1) * 16 + swz / 64; C = (st & 1) * 32 + (swz % 64) / 2; }
__host__ __device__ __forceinline__ int perm32(int rho) { const int n = rho >> 4, i = rho & 15; return 8 * (i >> 2) + 4 * n + (i & 3); }

struct Unit { int pm, pn; };
struct Gemm { const bf16_t* A; const bf16_t* Bt; int M, N, K; };

struct StaticOrder {
    int nM, nN, nwg, G, c;
    __host__ __device__ void init(int M, int N, int G_, int c_) { nM = M / BM; nN = N / BM; nwg = nM * nN; G = G_; c = c_; }
    __host__ __device__ bool next(int i, Unit& u) const {
        const long L = (long)i * G + c; if (L >= nwg) return false;
        int wgid = (int)L; { const int q = nwg / NXCD, r = nwg % NXCD, xcd = wgid % NXCD, off = wgid / NXCD; wgid = (xcd < r ? xcd * (q + 1) : r * (q + 1) + (xcd - r) * q) + off; }
        const int nig = WGM * nN, gid = wgid / nig, fm = gid * WGM, gsz = (nM - fm) < WGM ? (nM - fm) : WGM;
        u.pm = fm + ((wgid % nig) % gsz); u.pn = (wgid % nig) / gsz; return true;
    }
    __device__ __forceinline__ void a_ready(const Unit&) const {}
    __device__ __forceinline__ void done(const Unit&) const {}
};
__device__ __forceinline__ unsigned cvt_pk_bf16(float lo, float hi) { unsigned r; asm volatile("v_cvt_pk_bf16_f32 %0, %1, %2" : "=v"(r) : "v"(lo), "v"(hi)); return r; }

template <class Epi, class Sched, bool STAMP = false>
__device__ __forceinline__ void gemm_phase(PG8_LAS unsigned char* lds, const Gemm g, const Sched& S, const Epi& E, unsigned long long* stamps) {
    int tid_ = threadIdx.x; asm volatile("" : "+v"(tid_));
    const int tid = tid_, wid = __builtin_amdgcn_readfirstlane(tid >> 6), lane = tid & 63, wr = wid >> 2, wc = wid & 3, fr = lane & 15, fq = lane >> 4;
    const int K = g.K, nt = K / BK;
    int ts_lo = 0, ts_hi = 0, nts = 0; const unsigned long long rt_entry = STAMP ? (unsigned long long)wall_clock64() : 0ull;
#define PG8_STAMP() do { if (STAMP && wid == 0 && nts < 64) { const unsigned long long _c = (unsigned long long)clock64(); \
        ts_lo = (lane == nts) ? (int)(unsigned)_c : ts_lo; ts_hi = (lane == nts) ? (int)(unsigned)(_c >> 32) : ts_hi; ++nts; } } while (0)
    PG8_STAMP();
    unsigned voffA[2], voffB[2];
#pragma unroll
    for (int i = 0; i < 2; ++i) { int R, C; stage_rc(tid * 16 + i * 8192, R, C); const int Rb = Epi::PERM ? ((R & ~31) + perm32(R & 31)) : R;
        voffA[i] = (unsigned)(R * K + C) * 2u; voffB[i] = (unsigned)(Rb * K + C) * 2u; }
    const size_t kstep = (size_t)(BK * 2);
    const size_t hstep = (size_t)HALF * K * 2;
    const size_t tstep = 2 * hstep;
    const unsigned ldsw = (unsigned)wid * 1024u;
    const int aoff = lds_byte(wr * 64 + fr, fq * 8), boff = lds_byte(wc * 32 + fr, fq * 8);
#define PG8_SA(b, h) (((b) * 2 + (h)) * HTB)
#define PG8_SB(b, h) ((4 + (b) * 2 + (h)) * HTB)
#define PG8_STAGE(bufoff, gbase, voff) do { _Pragma("unroll") for (int _i = 0; _i < 2; ++_i) \
        __builtin_amdgcn_global_load_lds((const unsigned*)((const char*)(gbase) + (voff)[_i]), (PG8_LAS unsigned*)(lds + (bufoff) + ldsw + _i * 8192), 16, 0, 0); } while (0)
#define PG8_LDA(dst, b, h) do { _Pragma("unroll") for (int m = 0; m < 4; ++m) _Pragma("unroll") for (int k = 0; k < 2; ++k) dst[m][k] = *(const PG8_LAS bf16x8*)(lds + PG8_SA(b, h) + aoff + m * 2048 + k * 1024); } while (0)
#define PG8_LDB(dst, b, h) do { _Pragma("unroll") for (int n = 0; n < 2; ++n) _Pragma("unroll") for (int k = 0; k < 2; ++k) dst[n][k] = *(const PG8_LAS bf16x8*)(lds + PG8_SB(b, h) + boff + n * 2048 + k * 1024); } while (0)
#define PG8_MMA(ai, bj, At, Bt) do { __builtin_amdgcn_s_setprio(1); _Pragma("unroll") for (int m = 0; m < 4; ++m) _Pragma("unroll") for (int n = 0; n < 2; ++n) _Pragma("unroll") for (int k = 0; k < 2; ++k) \
        acc[ai][bj][m][n] = __builtin_amdgcn_mfma_f32_16x16x32_bf16(Bt[n][k], At[m][k], acc[ai][bj][m][n], 0, 0, 0); __builtin_amdgcn_s_setprio(0); } while (0)
#define PG8_WAIT_V(n) asm volatile("s_waitcnt vmcnt(" #n ")" ::: "memory")
#define PG8_WAIT_L(n) asm volatile("s_waitcnt lgkmcnt(" #n ")" ::: "memory")
#define PG8_BAR __builtin_amdgcn_s_barrier()
#define PG8_SCHED __builtin_amdgcn_sched_barrier(0)
    Unit cur, nxt; int ui = 0;
    if (!S.next(0, cur)) return;
    f32x4 acc[2][2][4][2];
#pragma unroll
    for (int a = 0; a < 2; ++a)
#pragma unroll
        for (int b = 0; b < 2; ++b)
#pragma unroll
            for (int m = 0; m < 4; ++m)
#pragma unroll
                for (int n = 0; n < 2; ++n) acc[a][b][m][n] = (f32x4){0.f, 0.f, 0.f, 0.f};
    bf16x8 At[4][2], B0[2][2], B1[2][2];
    const char* cA = (const char*)g.A + (size_t)cur.pm * tstep; const char* cB = (const char*)g.Bt + (size_t)cur.pn * tstep;
    S.a_ready(cur);
    PG8_STAGE(PG8_SB(0, 0), cB, voffB); PG8_STAGE(PG8_SA(0, 0), cA, voffA); PG8_STAGE(PG8_SB(0, 1), cB + hstep, voffB); PG8_STAGE(PG8_SA(0, 1), cA + hstep, voffA);
    if (wr == 1) PG8_BAR;
    PG8_WAIT_V(4); PG8_BAR;
    PG8_STAGE(PG8_SB(1, 0), cB + kstep, voffB); PG8_STAGE(PG8_SA(1, 0), cA + kstep, voffA); PG8_STAGE(PG8_SB(1, 1), cB + hstep + kstep, voffB);
    PG8_WAIT_V(6); PG8_BAR;
    PG8_STAMP();
    for (;;) {
        const bool has_next = S.next(ui + 1, nxt);
        const char* nA = has_next ? (const char*)g.A + (size_t)nxt.pm * tstep : cA; const char* nB = has_next ? (const char*)g.Bt + (size_t)nxt.pn * tstep : cB;
        for (int t = 0; t < nt; t += 2) {
            if constexpr (Epi::MIDK) { if (t == 8 || t == 16) E.mid(acc, cur, t, wr, wc, fr, fq); }
            const bool last = (t == nt - 2);
            const char* a1 = cA + (size_t)(t + 1) * kstep;
            const char* a2 = last ? nA : cA + (size_t)(t + 2) * kstep; const char* b2 = last ? nB : cB + (size_t)(t + 2) * kstep;
            const char* a3 = a2 + kstep; const char* b3 = b2 + kstep;
            if (last && has_next) S.a_ready(nxt);
            PG8_LDB(B0, 0, 0); PG8_SCHED; PG8_LDA(At, 0, 0); PG8_STAGE(PG8_SA(1, 1), a1 + hstep, voffA);
            PG8_WAIT_L(8); PG8_BAR; PG8_WAIT_L(0); PG8_MMA(0, 0, At, B0); PG8_BAR; PG8_SCHED;
            PG8_LDB(B1, 0, 1); PG8_STAGE(PG8_SB(0, 0), b2, voffB);
            PG8_BAR; PG8_WAIT_L(0); PG8_MMA(0, 1, At, B1); PG8_BAR;
            PG8_LDA(At, 0, 1); PG8_STAGE(PG8_SA(0, 0), a2, voffA);
            PG8_BAR; PG8_WAIT_L(0); PG8_MMA(1, 0, At, B0); PG8_BAR; PG8_SCHED;
            PG8_STAGE(PG8_SB(0, 1), b2 + hstep, voffB);
            PG8_WAIT_V(6); PG8_BAR; PG8_MMA(1, 1, At, B1); PG8_BAR;
            PG8_LDB(B0, 1, 0); PG8_SCHED; PG8_LDA(At, 1, 0); PG8_STAGE(PG8_SA(0, 1), a2 + hstep, voffA);
            PG8_WAIT_L(8); PG8_BAR; PG8_WAIT_L(0); PG8_MMA(0, 0, At, B0); PG8_BAR; PG8_SCHED;
            PG8_LDB(B1, 1, 1); PG8_STAGE(PG8_SB(1, 0), b3, voffB);
            PG8_BAR; PG8_WAIT_L(0); PG8_MMA(0, 1, At, B1); PG8_BAR;
            PG8_LDA(At, 1, 1); PG8_STAGE(PG8_SA(1, 0), a3, voffA);
            PG8_BAR; PG8_WAIT_L(0); PG8_MMA(1, 0, At, B0); PG8_BAR; PG8_SCHED;
            PG8_STAGE(PG8_SB(1, 1), b3 + hstep, voffB);
            PG8_WAIT_V(6); PG8_BAR; PG8_MMA(1, 1, At, B1); PG8_BAR;
        }
        PG8_STAMP();
        if constexpr (!Epi::AFTER_DRAIN) { E(acc, cur, wr, wc, fr, fq); S.done(cur); }
        PG8_STAMP();
        if (!has_next) break;
#pragma unroll
        for (int a = 0; a < 2; ++a)
#pragma unroll
            for (int b = 0; b < 2; ++b)
#pragma unroll
                for (int m = 0; m < 4; ++m)
#pragma unroll
                    for (int n = 0; n < 2; ++n) acc[a][b][m][n] = (f32x4){0.f, 0.f, 0.f, 0.f};
        cur = nxt; cA = nA; cB = nB; ++ui;
    }
    PG8_WAIT_V(0);
    if (wr == 0) PG8_BAR;
    PG8_BAR;
    if constexpr (Epi::AFTER_DRAIN) { E.fused(acc, cur, wr, wc, fr, fq, lds, wid, lane); S.done(cur); }
    PG8_STAMP();
    if (STAMP && wid == 0) { stamps[lane] = lane < nts ? (((unsigned long long)(unsigned)ts_hi << 32) | (unsigned)ts_lo) : 0ull;
        if (lane == 62) stamps[62] = rt_entry; if (lane == 63) stamps[63] = (unsigned long long)wall_clock64(); }
#undef PG8_STAMP
#undef PG8_SA
#undef PG8_SB
#undef PG8_STAGE
#undef PG8_LDA
#undef PG8_LDB
#undef PG8_MMA
#undef PG8_WAIT_V
#undef PG8_WAIT_L
#undef PG8_BAR
#undef PG8_SCHED
}
}
typedef pg8::bf16_t bf16_t;
typedef pg8::f32x4 f32x4;
typedef pg8::u32x4 u32x4;
typedef pg8::bf16x8 bf16x8;
typedef unsigned u32x2 __attribute__((ext_vector_type(2)));
#define LAS __attribute__((address_space(3)))
constexpr int MTOK = 65536, DM = 1024, NIN = 6144, DFF = 2816, NUP = 5632, SEQ = 8192, NBR = 1536, NPA = 3072;
constexpr int MH = MTOK / 2;
constexpr float EPS = 1e-6f;
constexpr size_t WS_WIN = 0;
constexpr size_t WS_WBR = WS_WIN + (size_t)NIN * DM * 2;
constexpr size_t WS_WO = WS_WBR + (size_t)DM * NBR * 2;
constexpr size_t WS_WUP = WS_WO + (size_t)DM * DM * 2;
constexpr size_t WS_WDN = WS_WUP + (size_t)NUP * DM * 2;
constexpr size_t WS_SSQ = WS_WDN + (size_t)DM * DFF * 2;
constexpr size_t WS_XB = WS_SSQ + (size_t)MTOK * 16 * 4;
constexpr size_t WS_B1 = WS_XB + (size_t)MTOK * NBR * 2;
constexpr size_t WS_B2 = WS_B1 + (size_t)MTOK * NPA * 2;
constexpr size_t WS_END = WS_B2 + (size_t)MTOK * NPA * 2;

__device__ __forceinline__ int otid() { int t = threadIdx.x; asm volatile("" : "+v"(t)); return t; }
__device__ __forceinline__ int obid() { int b = blockIdx.x; asm volatile("" : "+s"(b)); return b; }
struct Params {
    const float* in[19];
    float* out; unsigned char* ws;
};

__device__ __forceinline__ float bflo(unsigned w) { return __uint_as_float(w << 16); }
__device__ __forceinline__ float bfhi(unsigned w) { return __uint_as_float(w & 0xffff0000u); }
__device__ __forceinline__ unsigned pk(float a, float b) { return pg8::cvt_pk_bf16(a, b); }
__device__ __forceinline__ float fast_rcp(float x) { return __builtin_amdgcn_rcpf(x); }
__device__ __forceinline__ float sigmoid_f(float x) { x = fminf(fmaxf(x, -30.f), 30.f); return fast_rcp(1.0f + __expf(-x)); }
__device__ __forceinline__ float gelu_tanh_f(float x) {
    const float z2 = 1.5957691216f * (x + 0.044715f * x * x * x);
    return x * fast_rcp(1.0f + __expf(-z2));
}
__device__ __forceinline__ float silu_f(float x) { return x * fast_rcp(1.0f + __expf(-x)); }
__device__ __forceinline__ float row_rstd(const float* ssq, int r) {
    const f32x4* p = (const f32x4*)(ssq + (size_t)r * 16);
    const f32x4 a = p[0], b = p[1], c = p[2], d = p[3];
    const float s = ((a[0] + a[1]) + (a[2] + a[3])) + ((b[0] + b[1]) + (b[2] + b[3])) + ((c[0] + c[1]) + (c[2] + c[3])) + ((d[0] + d[1]) + (d[2] + d[3]));
    return rsqrtf(s * (1.0f / 1024.0f) + EPS);
}

__device__ __forceinline__ void rows_rstd8(const float* ssq, int row0, int fq, float (&rs)[8]) {
    f32x4 v[8];
#pragma unroll
    for (int i = 0; i < 8; ++i) v[i] = *(const f32x4*)(ssq + (size_t)(row0 + (i >> 2) * 128 + (i & 3) * 16) * 16 + fq * 4);
#pragma unroll
    for (int i = 0; i < 8; ++i) {
        float s = (v[i][0] + v[i][1]) + (v[i][2] + v[i][3]);
        s += __shfl_xor(s, 16); s += __shfl_xor(s, 32);
        rs[i] = rsqrtf(s * (1.0f / 1024.0f) + EPS);
    }
}
struct EpiIn {
    static constexpr bool PERM = true, AFTER_DRAIN = false, MIDK = false;
    bf16_t* PA; bf16_t* G; const float* ssq;
    __device__ __forceinline__ void operator()(const f32x4 (&acc)[2][2][4][2], const pg8::Unit& u, int wr, int wc, int fr, int fq) const {
        const int colt = u.pn * 256;
        const int act = (colt >= NPA) ? 2 : ((colt >= 512 && colt < 1536) ? 1 : 0);
        bf16_t* base = (colt >= NPA) ? G : PA;
        const int col0 = (colt >= NPA ? colt - NPA : colt) + wc * 32 + 8 * fq;
        const int row0 = u.pm * 256 + wr * 64 + fr;
        float rs8[8]; rows_rstd8(ssq, row0, fq, rs8);
#pragma unroll
        for (int ai = 0; ai < 2; ++ai)
#pragma unroll
            for (int m = 0; m < 4; ++m) {
                const int r = row0 + ai * 128 + m * 16;
                const float rs = rs8[ai * 4 + m];
                bf16_t* rowp = base + (size_t)r * NPA + col0;
#pragma unroll
                for (int bj = 0; bj < 2; ++bj) {
                    float v[8];
#pragma unroll
                    for (int j = 0; j < 4; ++j) { v[j] = acc[ai][bj][m][0][j] * rs; v[4 + j] = acc[ai][bj][m][1][j] * rs; }
                    if (act == 1) {
#pragma unroll
                        for (int j = 0; j < 8; ++j) v[j] = gelu_tanh_f(v[j]);
                    } else if (act == 2) {
#pragma unroll
                        for (int j = 0; j < 8; ++j) v[j] = sigmoid_f(v[j]);
                    }
                    u32x4 w; w.x = pk(v[0], v[1]); w.y = pk(v[2], v[3]); w.z = pk(v[4], v[5]); w.w = pk(v[6], v[7]);
                    *(u32x4*)(rowp + bj * 128) = w;
                }
            }
    }
};
struct EpiBr {
    static constexpr bool PERM = true, AFTER_DRAIN = false, MIDK = true;
    const bf16_t* G; bf16_t* out;
    __device__ __forceinline__ void mid(f32x4 (&acc)[2][2][4][2], const pg8::Unit& u, int t, int wr, int wc, int fr, int fq) const {
        const int seg = (t == 8) ? 0 : 1024;
        int col0 = u.pn * 256 + wc * 32 + 8 * fq + seg;
        int row0 = u.pm * 256 + wr * 64 + fr;
        asm volatile("" : "+v"(col0), "+v"(row0));
#pragma unroll
        for (int ai = 0; ai < 2; ++ai)
#pragma unroll
            for (int m = 0; m < 4; ++m) {
                const bf16_t* rowp = G + (size_t)(row0 + ai * 128 + m * 16) * NPA + col0;
#pragma unroll
                for (int bj = 0; bj < 2; ++bj) {
                    const u32x4 nu = *(const u32x4*)(rowp + bj * 128), de = *(const u32x4*)(rowp + bj * 128 + 1024);
                    const unsigned nw[4] = {nu.x, nu.y, nu.z, nu.w}, dw[4] = {de.x, de.y, de.z, de.w};
#pragma unroll
                    for (int q = 0; q < 4; ++q) {
                        const float r0 = bflo(nw[q]) * fast_rcp(bflo(dw[q])), r1 = bfhi(nw[q]) * fast_rcp(bfhi(dw[q]));
                        acc[ai][bj][m][q >> 1][(q & 1) * 2] *= r0; acc[ai][bj][m][q >> 1][(q & 1) * 2 + 1] *= r1;
                    }
                }
                if (m & 1) asm volatile("" ::: "memory");
            }
    }
    __device__ __forceinline__ void operator()(const f32x4 (&acc)[2][2][4][2], const pg8::Unit& u, int wr, int wc, int fr, int fq) const {
        const int col0 = u.pn * 256 + wc * 32 + 8 * fq;
        const int row0 = u.pm * 256 + wr * 64 + fr;
        u32x4 sg[2][4][2];
#pragma unroll
        for (int ai = 0; ai < 2; ++ai)
#pragma unroll
            for (int m = 0; m < 4; ++m)
#pragma unroll
                for (int bj = 0; bj < 2; ++bj) sg[ai][m][bj] = *(const u32x4*)(G + (size_t)(row0 + ai * 128 + m * 16) * NPA + 2048 + col0 + bj * 128);
#pragma unroll
        for (int ai = 0; ai < 2; ++ai)
#pragma unroll
            for (int m = 0; m < 4; ++m) {
                const int r = row0 + ai * 128 + m * 16;
                bf16_t* op = out + (size_t)r * DM + col0;
#pragma unroll
                for (int bj = 0; bj < 2; ++bj) {
                    const u32x4 s = sg[ai][m][bj];
                    const f32x4 a0 = acc[ai][bj][m][0], a1 = acc[ai][bj][m][1];
                    u32x4 w;
                    w.x = pk(a0[0] * bflo(s.x), a0[1] * bfhi(s.x)); w.y = pk(a0[2] * bflo(s.y), a0[3] * bfhi(s.y));
                    w.z = pk(a1[0] * bflo(s.z), a1[1] * bfhi(s.z)); w.w = pk(a1[2] * bflo(s.w), a1[3] * bfhi(s.w));
                    *(u32x4*)(op + bj * 128) = w;
                }
            }
    }
};
struct EpiRes {
    static constexpr bool PERM = true, AFTER_DRAIN = false, MIDK = false;
    const float* base; float* out; bf16_t* xb; float* ssq; int row_off;
    __device__ __forceinline__ void operator()(const f32x4 (&acc)[2][2][4][2], const pg8::Unit& u, int wr, int wc, int fr, int fq) const {
        const int col0 = u.pn * 256 + wc * 32 + 8 * fq;
        const int row0 = row_off + u.pm * 256 + wr * 64 + fr;
#pragma unroll
        for (int ai = 0; ai < 2; ++ai) {
            f32x4 bb[4][2][2];
#pragma unroll
            for (int m = 0; m < 4; ++m)
#pragma unroll
                for (int bj = 0; bj < 2; ++bj) { const float* bp = base + (size_t)(row0 + ai * 128 + m * 16) * DM + col0 + bj * 128; bb[m][bj][0] = *(const f32x4*)bp; bb[m][bj][1] = *(const f32x4*)(bp + 4); }
            asm volatile("" ::: "memory");
#pragma unroll
            for (int m = 0; m < 4; ++m) {
                const int r = row0 + ai * 128 + m * 16;
                const size_t off = (size_t)r * DM + col0;
                float sq = 0.f;
#pragma unroll
                for (int bj = 0; bj < 2; ++bj) {
                    const f32x4 b0 = bb[m][bj][0], b1 = bb[m][bj][1];
                    const f32x4 o0 = b0 + acc[ai][bj][m][0], o1 = b1 + acc[ai][bj][m][1];
                    *(f32x4*)(out + off + bj * 128) = o0; *(f32x4*)(out + off + bj * 128 + 4) = o1;
                    u32x4 w; w.x = pk(o0[0], o0[1]); w.y = pk(o0[2], o0[3]); w.z = pk(o1[0], o1[1]); w.w = pk(o1[2], o1[3]);
                    *(u32x4*)(xb + off + bj * 128) = w;
                    sq += (o0[0] * o0[0] + o0[1] * o0[1]) + (o0[2] * o0[2] + o0[3] * o0[3]) + (o1[0] * o1[0] + o1[1] * o1[1]) + (o1[2] * o1[2] + o1[3] * o1[3]);
                }
                sq += __shfl_xor(sq, 16); sq += __shfl_xor(sq, 32);
                if (fq == 0) ssq[(size_t)r * 16 + u.pn * 4 + wc] = sq;
            }
            asm volatile("" ::: "memory");
        }
    }
};
struct EpiUp {
    static constexpr bool PERM = true, AFTER_DRAIN = false, MIDK = false;
    bf16_t* out; const float* ssq; int row_off;
    __device__ __forceinline__ void operator()(const f32x4 (&acc)[2][2][4][2], const pg8::Unit& u, int wr, int wc, int fr, int fq) const {
        const int col0 = u.pn * 256 + wc * 32 + 8 * fq;
        const int row0 = u.pm * 256 + wr * 64 + fr;
        float rs8[8]; rows_rstd8(ssq, row_off + row0, fq, rs8);
#pragma unroll
        for (int ai = 0; ai < 2; ++ai)
#pragma unroll
            for (int m = 0; m < 4; ++m) {
                const int r = row0 + ai * 128 + m * 16;
                const float rs = rs8[ai * 4 + m];
                bf16_t* rowp = out + (size_t)r * NUP + col0;
#pragma unroll
                for (int bj = 0; bj < 2; ++bj) {
                    const f32x4 a0 = acc[ai][bj][m][0] * rs, a1 = acc[ai][bj][m][1] * rs;
                    u32x4 w; w.x = pk(a0[0], a0[1]); w.y = pk(a0[2], a0[3]); w.z = pk(a1[0], a1[1]); w.w = pk(a1[2], a1[3]);
                    *(u32x4*)(rowp + bj * 128) = w;
                }
            }
    }
};

__device__ __forceinline__ void transpose_tile(const float* __restrict__ W, int N, const float* __restrict__ g, bf16_t* __restrict__ Wt, int ldt, int koff, int k0, int n0, float* tile, int tid) {
    {
        const int kk = tid >> 4, nn = (tid & 15) * 4;
#pragma unroll
        for (int h = 0; h < 2; ++h) {
            const int k = kk + h * 32;
            f32x4 v = *(const f32x4*)(W + (size_t)(k0 + k) * N + n0 + nn);
            const float s = g ? g[k0 + k] : 1.0f;
            tile[k * 65 + nn + 0] = v[0] * s; tile[k * 65 + nn + 1] = v[1] * s; tile[k * 65 + nn + 2] = v[2] * s; tile[k * 65 + nn + 3] = v[3] * s;
        }
    }
    __syncthreads();
    {
        const int n = tid >> 3, kq = (tid & 7) * 8;
        float v[8];
#pragma unroll
        for (int j = 0; j < 8; ++j) v[j] = tile[(kq + j) * 65 + n];
        u32x4 w; w.x = pk(v[0], v[1]); w.y = pk(v[2], v[3]); w.z = pk(v[4], v[5]); w.w = pk(v[6], v[7]);
        *(u32x4*)(Wt + (size_t)(n0 + n) * ldt + koff + k0 + kq) = w;
    }
    __syncthreads();
}

__device__ __forceinline__ void prep_phase(const Params& p, int l, float* ldsf) {
    unsigned char* ws = p.ws;
    bf16_t* wt_in = (bf16_t*)(ws + WS_WIN); bf16_t* wt_br = (bf16_t*)(ws + WS_WBR); bf16_t* wt_o = (bf16_t*)(ws + WS_WO);
    bf16_t* wt_up = (bf16_t*)(ws + WS_WUP); bf16_t* wt_dn = (bf16_t*)(ws + WS_WDN);
    const float* g_mix = p.in[1] + (size_t)l * DM; const float* w_in = p.in[2] + (size_t)l * DM * NIN;
    const float* w_pool = p.in[3] + (size_t)l * 4 * 128 * 128; const float* pscale = p.in[4] + (size_t)l * 512;
    const float* w_ba = p.in[9] + (size_t)l * 512 * DM; const float* w_bb = p.in[10] + (size_t)l * 512 * DM; const float* w_bc = p.in[11] + (size_t)l * 512 * DM;
    const float* w_o = p.in[12] + (size_t)l * DM * DM; const float* g_ffn = p.in[13] + (size_t)l * DM;
    const float* w_up = p.in[14] + (size_t)l * DM * NUP; const float* w_dn = p.in[17] + (size_t)l * DFF * DM;
    const int tid = otid(), bid = obid();
    constexpr int T0 = 16 * 96, T1 = T0 + 128, T2 = T1 + 128, T3 = T2 + 256, T4 = T3 + 16 * 88, T5 = T4 + 44 * 16;
    for (int i = bid; i < T5; i += gridDim.x) {
        if (i < T0) { const int kt = i & 15, nt = i >> 4; transpose_tile(w_in, NIN, g_mix, wt_in, DM, 0, kt * 64, nt * 64, ldsf, tid); }
        else if (i < T1) { const int j = i - T0, kt = j & 7, nt = j >> 3; transpose_tile(w_bb, DM, nullptr, wt_br, NBR, 512, kt * 64, nt * 64, ldsf, tid); }
        else if (i < T2) { const int j = i - T1, kt = j & 7, nt = j >> 3; transpose_tile(w_bc, DM, nullptr, wt_br, NBR, 1024, kt * 64, nt * 64, ldsf, tid); }
        else if (i < T3) { const int j = i - T2, kt = j & 15, nt = j >> 4; transpose_tile(w_o, DM, nullptr, wt_o, DM, 0, kt * 64, nt * 64, ldsf, tid); }
        else if (i < T4) { const int j = i - T3, kt = j & 15, nt = j >> 4; transpose_tile(w_up, NUP, g_ffn, wt_up, DM, 0, kt * 64, nt * 64, ldsf, tid); }
        else { const int j = i - T4, kt = j % 44, nt = j / 44; transpose_tile(w_dn, DM, nullptr, wt_dn, DFF, 0, kt * 64, nt * 64, ldsf, tid); }
    }
    {
        float* wpT = ldsf;
        float* wa = ldsf + 128 * 128;
        for (int it = (int)gridDim.x - 1 - bid; it < 64; it += gridDim.x) {
            const int g = it >> 4, n0 = (it & 15) * 64;
            for (int q = tid; q < 128 * 32; q += 512) {
                const int d = q >> 5, e4 = (q & 31) * 4;
                const f32x4 v = *(const f32x4*)(w_pool + ((size_t)g * 128 + d) * 128 + e4);
                const f32x4 s = *(const f32x4*)(pscale + g * 128 + e4);
                wpT[(e4 + 0) * 128 + d] = v[0] * s[0]; wpT[(e4 + 1) * 128 + d] = v[1] * s[1]; wpT[(e4 + 2) * 128 + d] = v[2] * s[2]; wpT[(e4 + 3) * 128 + d] = v[3] * s[3];
            }
            for (int q = tid; q < 128 * 16; q += 512) {
                const int e = q >> 4, c4 = (q & 15) * 4;
                *(f32x4*)(wa + e * 64 + c4) = *(const f32x4*)(w_ba + (size_t)(g * 128 + e) * DM + n0 + c4);
            }
            __syncthreads();
            const int d = tid & 127, ns = tid >> 7;
            float acc[16];
#pragma unroll
            for (int i = 0; i < 16; ++i) acc[i] = 0.f;
            for (int e = 0; e < 128; ++e) {
                const float w = wpT[e * 128 + d];
                const f32x4* wr4 = (const f32x4*)(wa + e * 64 + ns * 16);
#pragma unroll
                for (int c = 0; c < 4; ++c) { const f32x4 b = wr4[c]; acc[c * 4 + 0] += w * b[0]; acc[c * 4 + 1] += w * b[1]; acc[c * 4 + 2] += w * b[2]; acc[c * 4 + 3] += w * b[3]; }
            }
#pragma unroll
            for (int i = 0; i < 16; ++i) wt_br[(size_t)(n0 + ns * 16 + i) * NBR + g * 128 + d] = (bf16_t)(pk(acc[i], 0.f) & 0xffffu);
            __syncthreads();
        }
    }
    if (l == 0) {
        const float* x = p.in[0]; bf16_t* xb = (bf16_t*)(ws + WS_XB); float* ssq = (float*)(ws + WS_SSQ);
        const int lane = tid & 63, wave = tid >> 6;
        for (int r = bid * 8 + wave; r < MTOK; r += gridDim.x * 8) {
            float sq = 0.f;
#pragma unroll
            for (int i = 0; i < 4; ++i) {
                const f32x4 v = *(const f32x4*)(x + (size_t)r * DM + i * 256 + lane * 4);
                sq += (v[0] * v[0] + v[1] * v[1]) + (v[2] * v[2] + v[3] * v[3]);
                u32x2 w; w.x = pk(v[0], v[1]); w.y = pk(v[2], v[3]);
                *(u32x2*)(xb + (size_t)r * DM + i * 256 + lane * 4) = w;
            }
#pragma unroll
            for (int o = 32; o >= 1; o >>= 1) sq += __shfl_xor(sq, o);
            if (lane < 16) ssq[(size_t)r * 16 + lane] = (lane == 0) ? sq : 0.f;
        }
    }
}
__device__ __forceinline__ void ld8(const bf16_t* p, float (&v)[8]) {
    const u32x4 w = *(const u32x4*)p;
    v[0] = bflo(w.x); v[1] = bfhi(w.x); v[2] = bflo(w.y); v[3] = bfhi(w.y); v[4] = bflo(w.z); v[5] = bfhi(w.z); v[6] = bflo(w.w); v[7] = bfhi(w.w);
}
__device__ __forceinline__ void st8(bf16_t* p, const float (&v)[8]) {
    u32x4 w; w.x = pk(v[0], v[1]); w.y = pk(v[2], v[3]); w.z = pk(v[4], v[5]); w.w = pk(v[6], v[7]);
    *(u32x4*)p = w;
}
constexpr int VT_PITCH = 136;
__device__ __forceinline__ void mixer_phase(const Params& p, int l, unsigned char* lds) {
    const bf16_t* PA = (const bf16_t*)(p.ws + WS_B1);
    bf16_t* Y = (bf16_t*)(p.ws + WS_XB);
    const float* g_sgu = p.in[5] + (size_t)l * 512;
    const float* w_sp = p.in[6] + (size_t)l * 4 * 128 * 128;
    const float* b_sp = p.in[7] + (size_t)l * 4 * 128;
    const float* conv_c = p.in[8] + (size_t)l * 3 * 512;
    float* rs = (float*)lds;
    bf16_t* vT = (bf16_t*)(lds + 1024);
    const int tid = otid(), lane = tid & 63, wave = tid >> 6, fr = lane & 15, fq = lane >> 4;
    for (int item = obid(); item < MTOK / 128; item += gridDim.x) {
        const int t0 = item * 128, pos0 = t0 & (SEQ - 1);
        {
            const int row = tid >> 2, q = tid & 3;
            const bf16_t* vp = PA + (size_t)(t0 + row) * NPA + 1024 + q * 128;
            float sq = 0.f;
#pragma unroll
            for (int i = 0; i < 16; ++i) { float v[8]; ld8(vp + i * 8, v);
#pragma unroll
                for (int j = 0; j < 8; ++j) sq += v[j] * v[j]; }
            sq += __shfl_xor(sq, 1); sq += __shfl_xor(sq, 2);
            if (q == 0) rs[row] = rsqrtf(sq * (1.0f / 512.0f) + EPS);
        }
        {
            const int c8 = (tid & 63) * 8, r0 = (tid >> 6) * 16;
            {
                const int w = 2 << (c8 >> 7);
                const bf16_t* ap = PA + (size_t)t0 * NPA + c8;
                bf16_t* yp = Y + (size_t)t0 * NBR + c8;
                float s[8];
#pragma unroll
                for (int j = 0; j < 8; ++j) s[j] = 0.f;
                for (int k = 1; k < w; ++k) { const int rr = r0 - k; if (pos0 + rr >= 0) { float v[8]; ld8(ap + (ptrdiff_t)rr * NPA, v);
#pragma unroll
                        for (int j = 0; j < 8; ++j) s[j] += v[j]; } }
                for (int i = 0; i < 16; ++i) {
                    const int rr = r0 + i; float v[8]; ld8(ap + (ptrdiff_t)rr * NPA, v);
                    const int pos = pos0 + rr; const float inv = 1.0f / (float)(pos + 1 < w ? pos + 1 : w);
                    float o[8];
#pragma unroll
                    for (int j = 0; j < 8; ++j) { s[j] += v[j]; o[j] = s[j] * inv - v[j]; }
                    st8(yp + (size_t)rr * NBR, o);
                    const int ro = rr - w + 1;
                    if (pos0 + ro >= 0) { float q[8]; ld8(ap + (ptrdiff_t)ro * NPA, q);
#pragma unroll
                        for (int j = 0; j < 8; ++j) s[j] -= q[j]; }
                }
            }
            {
                const bf16_t* bp = PA + (size_t)t0 * NPA + 1536 + c8;
                bf16_t* yp = Y + (size_t)t0 * NBR + 1024 + c8;
                float w0[8], w1[8], w2[8], z1[8], z2[8];
#pragma unroll
                for (int j = 0; j < 8; ++j) { w0[j] = conv_c[c8 + j]; w1[j] = conv_c[512 + c8 + j]; w2[j] = conv_c[1024 + c8 + j]; z1[j] = 0.f; z2[j] = 0.f; }
                if (pos0 + r0 - 2 >= 0) { float a[8], b[8]; ld8(bp + (ptrdiff_t)(r0 - 2) * NPA + 512, a); ld8(bp + (ptrdiff_t)(r0 - 2) * NPA + 1024, b);
#pragma unroll
                    for (int j = 0; j < 8; ++j) z2[j] = a[j] * b[j]; }
                if (pos0 + r0 - 1 >= 0) { float a[8], b[8]; ld8(bp + (ptrdiff_t)(r0 - 1) * NPA + 512, a); ld8(bp + (ptrdiff_t)(r0 - 1) * NPA + 1024, b);
#pragma unroll
                    for (int j = 0; j < 8; ++j) z1[j] = a[j] * b[j]; }
                for (int i = 0; i < 16; ++i) {
                    const int rr = r0 + i; float cb[8], a[8], b[8], o[8];
                    ld8(bp + (size_t)rr * NPA, cb); ld8(bp + (size_t)rr * NPA + 512, a); ld8(bp + (size_t)rr * NPA + 1024, b);
#pragma unroll
                    for (int j = 0; j < 8; ++j) { const float z = a[j] * b[j]; o[j] = cb[j] * (w0[j] * z2[j] + w1[j] * z1[j] + w2[j] * z); z2[j] = z1[j]; z1[j] = z; }
                    st8(yp + (size_t)rr * NBR, o);
                }
            }
        }
        for (int g = 0; g < 4; ++g) {
            __syncthreads();
            {
                const int s = tid >> 2, dq = (tid & 3) * 32;
                const bf16_t* vp = PA + (size_t)(t0 + s) * NPA + 1024 + g * 128 + dq;
#pragma unroll
                for (int i = 0; i < 4; ++i) {
                    const u32x4 w = *(const u32x4*)(vp + i * 8);
                    const unsigned ww[4] = {w.x, w.y, w.z, w.w};
#pragma unroll
                    for (int q = 0; q < 4; ++q) { vT[(dq + i * 8 + q * 2) * VT_PITCH + s] = (bf16_t)(ww[q] & 0xffffu); vT[(dq + i * 8 + q * 2 + 1) * VT_PITCH + s] = (bf16_t)(ww[q] >> 16); }
                }
            }
            __syncthreads();
            f32x4 acc[8];
#pragma unroll
            for (int n = 0; n < 8; ++n) acc[n] = (f32x4){0.f, 0.f, 0.f, 0.f};
            const int t = wave * 16 + fr;
            const int nk = (wave >> 1) + 1;
            for (int k = 0; k < nk; ++k) {
                const int s0 = k * 32 + fq * 8;
                const float* wp = w_sp + ((size_t)g * 128 + t) * 128 + s0;
                const f32x4 wa = *(const f32x4*)wp, wb = *(const f32x4*)(wp + 4);
                const f32x4 ra = *(const f32x4*)(rs + s0), rb = *(const f32x4*)(rs + s0 + 4);
                float a[8];
#pragma unroll
                for (int j = 0; j < 4; ++j) { a[j] = (s0 + j <= t) ? wa[j] * ra[j] : 0.f; a[4 + j] = (s0 + 4 + j <= t) ? wb[j] * rb[j] : 0.f; }
                union { u32x4 u; bf16x8 h; } af; af.u.x = pk(a[0], a[1]); af.u.y = pk(a[2], a[3]); af.u.z = pk(a[4], a[5]); af.u.w = pk(a[6], a[7]);
#pragma unroll
                for (int n = 0; n < 8; ++n) {
                    const bf16x8 bfrag = *(const bf16x8*)(vT + (n * 16 + fr) * VT_PITCH + s0);
                    acc[n] = __builtin_amdgcn_mfma_f32_16x16x32_bf16(bfrag, af.h, acc[n], 0, 0, 0);
                }
            }
            const float bias = b_sp[g * 128 + t];
            const bf16_t* up = PA + (size_t)(t0 + t) * NPA + 512 + g * 128 + 4 * fq;
            bf16_t* yp = Y + (size_t)(t0 + t) * NBR + 512 + g * 128 + 4 * fq;
#pragma unroll
            for (int n = 0; n < 8; ++n) {
                const u32x2 uu = *(const u32x2*)(up + n * 16);
                const f32x4 gs = *(const f32x4*)(g_sgu + g * 128 + n * 16 + 4 * fq);
                const float o0 = bflo(uu.x) * (acc[n][0] * gs[0] + bias), o1 = bfhi(uu.x) * (acc[n][1] * gs[1] + bias);
                const float o2 = bflo(uu.y) * (acc[n][2] * gs[2] + bias), o3 = bfhi(uu.y) * (acc[n][3] * gs[3] + bias);
                u32x2 w; w.x = pk(o0, o1); w.y = pk(o2, o3);
                *(u32x2*)(yp + n * 16) = w;
            }
        }
        __syncthreads();
    }
}

__device__ __forceinline__ void convact_phase(const Params& p, int l, int h) {
    const bf16_t* up = (const bf16_t*)(p.ws + WS_B1);
    bf16_t* act = (bf16_t*)(p.ws + WS_B2);
    const float* cw = p.in[15] + (size_t)l * 3 * NUP; const float* cb = p.in[16] + (size_t)l * NUP;
    constexpr int RB = 32, NCG = DFF / 8, NU = (MH / RB) * NCG;
    for (int u = obid() * 512 + otid(); u < NU; u += gridDim.x * 512) {
        const int rb = u / NCG, c8 = (u - rb * NCG) * 8, r0 = rb * RB;
        const int pos0 = r0 & (SEQ - 1);
        float wg[3][8], wv[3][8], bg[8], bv[8], g1[8], g2[8], v1[8], v2[8];
#pragma unroll
        for (int j = 0; j < 8; ++j) {
#pragma unroll
            for (int i = 0; i < 3; ++i) { wg[i][j] = cw[i * NUP + c8 + j]; wv[i][j] = cw[i * NUP + DFF + c8 + j]; }
            bg[j] = cb[c8 + j]; bv[j] = cb[DFF + c8 + j]; g1[j] = g2[j] = v1[j] = v2[j] = 0.f;
        }
        const bf16_t* bp = up + (size_t)r0 * NUP + c8;
        if (pos0 >= 2) { ld8(bp - 2 * (ptrdiff_t)NUP, g2); ld8(bp - 2 * (ptrdiff_t)NUP + DFF, v2); ld8(bp - (ptrdiff_t)NUP, g1); ld8(bp - (ptrdiff_t)NUP + DFF, v1); }
        for (int i = 0; i < RB; ++i) {
            float g0[8], v0[8], o[8];
            ld8(bp + (size_t)i * NUP, g0); ld8(bp + (size_t)i * NUP + DFF, v0);
#pragma unroll
            for (int j = 0; j < 8; ++j) {
                const float gg = wg[0][j] * g2[j] + wg[1][j] * g1[j] + wg[2][j] * g0[j] + bg[j];
                const float vv = wv[0][j] * v2[j] + wv[1][j] * v1[j] + wv[2][j] * v0[j] + bv[j];
                o[j] = silu_f(gg) * vv; g2[j] = g1[j]; g1[j] = g0[j]; v2[j] = v1[j]; v1[j] = v0[j];
            }
            st8(act + (size_t)(r0 + i) * DFF + c8, o);
        }
    }
}

__device__ __forceinline__ void final_norm_phase(const Params& p) {
    const float* gf = p.in[18]; const float* ssq = (const float*)(p.ws + WS_SSQ); float* out = p.out;
    const int tid = otid(), lane = tid & 63, wave = tid >> 6;
    for (int r = obid() * 8 + wave; r < MTOK; r += gridDim.x * 8) {
        const float rs = row_rstd(ssq, r);
#pragma unroll
        for (int i = 0; i < 4; ++i) {
            float* q = out + (size_t)r * DM + i * 256 + lane * 4;
            const f32x4 v = *(const f32x4*)q; const f32x4 g = *(const f32x4*)(gf + i * 256 + lane * 4);
            *(f32x4*)q = v * rs * g;
        }
    }
}

template <class Epi> __device__ __forceinline__ void run_gemm(unsigned char* lds, const bf16_t* A, const bf16_t* Bt, int M, int N, int K, const Epi& E) {
    pg8::Gemm g{A, Bt, M, N, K}; pg8::StaticOrder S; S.init(M, N, (int)gridDim.x, obid());
    pg8::gemm_phase<Epi, pg8::StaticOrder, false>((PG8_LAS unsigned char*)lds, g, S, E, nullptr);
}

__global__ void __launch_bounds__(512, 2) fwd_megakernel(Params p) {
    extern __shared__ __attribute__((aligned(16))) unsigned char lds[];
    cg::grid_group grid = cg::this_grid();
    unsigned char* ws = p.ws;
    bf16_t* wt_in = (bf16_t*)(ws + WS_WIN); bf16_t* wt_br = (bf16_t*)(ws + WS_WBR); bf16_t* wt_o = (bf16_t*)(ws + WS_WO);
    bf16_t* wt_up = (bf16_t*)(ws + WS_WUP); bf16_t* wt_dn = (bf16_t*)(ws + WS_WDN);
    float* ssq = (float*)(ws + WS_SSQ); bf16_t* xb = (bf16_t*)(ws + WS_XB); bf16_t* b1 = (bf16_t*)(ws + WS_B1); bf16_t* b2 = (bf16_t*)(ws + WS_B2);
    for (int l = 0; l < 2; ++l) {
        prep_phase(p, l, (float*)lds);
        grid.sync();
        { EpiIn E{b1, b2, ssq}; run_gemm(lds, xb, wt_in, MTOK, NIN, DM, E); }
        grid.sync();
        mixer_phase(p, l, lds);
        grid.sync();
        { EpiBr E{b2, b1}; run_gemm(lds, xb  , wt_br, MTOK, DM, NBR, E); }
        grid.sync();
        { EpiRes E{l == 0 ? p.in[0] : p.out, p.out, xb, ssq, 0}; run_gemm(lds, b1, wt_o, MTOK, DM, DM, E); }
        grid.sync();
        for (int h = 0; h < 2; ++h) {
            { EpiUp E{b1, ssq, h * MH}; run_gemm(lds, xb + (size_t)h * MH * DM, wt_up, MH, NUP, DM, E); }
            grid.sync();
            convact_phase(p, l, h);
            grid.sync();
            { EpiRes E{p.out, p.out, xb, ssq, h * MH}; run_gemm(lds, b2, wt_dn, MH, DM, DFF, E); }
        }
        grid.sync();
    }
    final_norm_phase(p);
}

extern "C" void kernel_launch(void* const* d_in, const int* in_sizes, int n_in, void* d_out, int out_size, void* d_ws, size_t ws_size, hipStream_t stream) {
    constexpr size_t kLds = pg8::STAGE_BYTES;
    static int grid_blocks = 0;
    if (!grid_blocks) {
        int dev = 0, cus = 0, per_cu = 0;
        (void)hipGetDevice(&dev);
        (void)hipDeviceGetAttribute(&cus, hipDeviceAttributeMultiprocessorCount, dev);
        (void)hipFuncSetAttribute((const void*)fwd_megakernel, hipFuncAttributeMaxDynamicSharedMemorySize, (int)kLds);
        (void)hipOccupancyMaxActiveBlocksPerMultiprocessor(&per_cu, (const void*)fwd_megakernel, 512, kLds);
        if (per_cu < 1) per_cu = 1;
        grid_blocks = cus;
        if (ws_size < WS_END || n_in != 19 || out_size != MTOK * DM) { fprintf(stderr, "kernel_launch: unexpected sizes: ws %zu (need %zu), n_in %d, out %d\n", ws_size, (size_t)WS_END, n_in, out_size); }
    }
    Params p{};
    for (int i = 0; i < 19; ++i) p.in[i] = (const float*)d_in[i];
    p.out = (float*)d_out; p.ws = (unsigned char*)d_ws;
    void* args[] = {&p};
    hipError_t e = hipLaunchCooperativeKernel((void*)fwd_megakernel, dim3(grid_blocks), dim3(512), args, kLds, stream);
    if (e != hipSuccess) fprintf(stderr, "cooperative launch failed: %s (grid %d)\n", hipGetErrorString(e), grid_blocks);
}
```

```cpp
#include <hip/hip_runtime.h>
#include <hip/hip_cooperative_groups.h>
#include <cstdio>
namespace cg = cooperative_groups;
namespace pg8 {
#define PG8_LAS __attribute__((address_space(3)))
typedef unsigned short bf16_t;
typedef short bf16x8 __attribute__((ext_vector_type(8)));
typedef float f32x4 __attribute__((ext_vector_type(4)));
typedef unsigned u32x4 __attribute__((ext_vector_type(4)));
constexpr int BM = 256, BK = 64, HALF = 128, HTB = HALF * BK * 2  , STAGE_BYTES = 8 * HTB, NXCD = 8, WGM = 8;

__host__ __device__ __forceinline__ int lds_byte(int r, int c) { const int st = (r >> 4) * 2 + (c >> 5), rr = r & 15, cc = c & 31, ob = rr * 64 + cc * 2; return st * 1024 + (ob ^ (((ob >> 9) & 1) << 5)); }
__host__ __device__ __forceinline__ void stage_rc(int b, int& R, int& C) { const int st = b / 1024, sb = b % 1024, swz = sb ^ (((sb >> 9) & 1) << 5); R = (st >> 1) * 16 + swz / 64; C = (st & 1) * 32 + (swz % 64) / 2; }
__host__ __device__ __forceinline__ int perm32(int rho) { const int n = rho >> 4, i = rho & 15; return 8 * (i >> 2) + 4 * n + (i & 3); }

struct Unit { int pm, pn; };
struct Gemm { const bf16_t* A; const bf16_t* Bt; int M, N, K; };

struct StaticOrder {
    int nM, nN, nwg, G, c;
    __host__ __device__ void init(int M, int N, int G_, int c_) { nM = M / BM; nN = N / BM; nwg = nM * nN; G = G_; c = c_; }
    __host__ __device__ bool next(int i, Unit& u) const {
        const long L = (long)i * G + c; if (L >= nwg) return false;
        int wgid = (int)L; { const int q = nwg / NXCD, r = nwg % NXCD, xcd = wgid % NXCD, off = wgid / NXCD; wgid = (xcd < r ? xcd * (q + 1) : r * (q + 1) + (xcd - r) * q) + off; }
        const int nig = WGM * nN, gid = wgid / nig, fm = gid * WGM, gsz = (nM - fm) < WGM ? (nM - fm) : WGM;
        u.pm = fm + ((wgid % nig) % gsz); u.pn = (wgid % nig) / gsz; return true;
    }
    __device__ __forceinline__ void a_ready(const Unit&) const {}
    __device__ __forceinline__ void done(const Unit&) const {}
};
__device__ __forceinline__ unsigned cvt_pk_bf16(float lo, float hi) { unsigned r; asm volatile("v_cvt_pk_bf16_f32 %0, %1, %2" : "=v"(r) : "v"(lo), "v"(hi)); return r; }

template <class Epi, class Sched, bool STAMP = false>
__device__ __forceinline__ void gemm_phase(PG8_LAS unsigned char* lds, const Gemm g, const Sched& S, const Epi& E, unsigned long long* stamps) {
    int tid_ = threadIdx.x; asm volatile("" : "+v"(tid_));
    const int tid = tid_, wid = __builtin_amdgcn_readfirstlane(tid >> 6), lane = tid & 63, wr = wid >> 2, wc = wid & 3, fr = lane & 15, fq = lane >> 4;
    const int K = g.K, nt = K / BK;
    int ts_lo = 0, ts_hi = 0, nts = 0; const unsigned long long rt_entry = STAMP ? (unsigned long long)wall_clock64() : 0ull;
#define PG8_STAMP() do { if (STAMP && wid == 0 && nts < 64) { const unsigned long long _c = (unsigned long long)clock64(); \
        ts_lo = (lane == nts) ? (int)(unsigned)_c : ts_lo; ts_hi = (lane == nts) ? (int)(unsigned)(_c >> 32) : ts_hi; ++nts; } } while (0)
    PG8_STAMP();
    unsigned voffA[2], voffB[2];
#pragma unroll
    for (int i = 0; i < 2; ++i) { int R, C; stage_rc(tid * 16 + i * 8192, R, C); const int Rb = Epi::PERM ? ((R & ~31) + perm32(R & 31)) : R;
        voffA[i] = (unsigned)(R * K + C) * 2u; voffB[i] = (unsigned)(Rb * K + C) * 2u; }
    const size_t kstep = (size_t)(BK * 2);
    const size_t hstep = (size_t)HALF * K * 2;
    const size_t tstep = 2 * hstep;
    const unsigned ldsw = (unsigned)wid * 1024u;
    const int aoff = lds_byte(wr * 64 + fr, fq * 8), boff = lds_byte(wc * 32 + fr, fq * 8);
#define PG8_SA(b, h) (((b) * 2 + (h)) * HTB)
#define PG8_SB(b, h) ((4 + (b) * 2 + (h)) * HTB)
#define PG8_STAGE(bufoff, gbase, voff) do { _Pragma("unroll") for (int _i = 0; _i < 2; ++_i) \
        __builtin_amdgcn_global_load_lds((const unsigned*)((const char*)(gbase) + (voff)[_i]), (PG8_LAS unsigned*)(lds + (bufoff) + ldsw + _i * 8192), 16, 0, 0); } while (0)
#define PG8_LDA(dst, b, h) do { _Pragma("unroll") for (int m = 0; m < 4; ++m) _Pragma("unroll") for (int k = 0; k < 2; ++k) dst[m][k] = *(const PG8_LAS bf16x8*)(lds + PG8_SA(b, h) + aoff + m * 2048 + k * 1024); } while (0)
#define PG8_LDB(dst, b, h) do { _Pragma("unroll") for (int n = 0; n < 2; ++n) _Pragma("unroll") for (int k = 0; k < 2; ++k) dst[n][k] = *(const PG8_LAS bf16x8*)(lds + PG8_SB(b, h) + boff + n * 2048 + k * 1024); } while (0)
#define PG8_MMA(ai, bj, At, Bt) do { __builtin_amdgcn_s_setprio(1); _Pragma("unroll") for (int m = 0; m < 4; ++m) _Pragma("unroll") for (int n = 0; n < 2; ++n) _Pragma("unroll") for (int k = 0; k < 2; ++k) \
        acc[ai][bj][m][n] = __builtin_amdgcn_mfma_f32_16x16x32_bf16(Bt[n][k], At[m][k], acc[ai][bj][m][n], 0, 0, 0); __builtin_amdgcn_s_setprio(0); } while (0)
#define PG8_WAIT_V(n) asm volatile("s_waitcnt vmcnt(" #n ")" ::: "memory")
#define PG8_WAIT_L(n) asm volatile("s_waitcnt lgkmcnt(" #n ")" ::: "memory")
#define PG8_BAR __builtin_amdgcn_s_barrier()
#define PG8_SCHED __builtin_amdgcn_sched_barrier(0)
    Unit cur, nxt; int ui = 0;
    if (!S.next(0, cur)) return;
    f32x4 acc[2][2][4][2];
#pragma unroll
    for (int a = 0; a < 2; ++a)
#pragma unroll
        for (int b = 0; b < 2; ++b)
#pragma unroll
            for (int m = 0; m < 4; ++m)
#pragma unroll
                for (int n = 0; n < 2; ++n) acc[a][b][m][n] = (f32x4){0.f, 0.f, 0.f, 0.f};
    bf16x8 At[4][2], B0[2][2], B1[2][2];
    const char* cA = (const char*)g.A + (size_t)cur.pm * tstep; const char* cB = (const char*)g.Bt + (size_t)cur.pn * tstep;
    S.a_ready(cur);
    PG8_STAGE(PG8_SB(0, 0), cB, voffB); PG8_STAGE(PG8_SA(0, 0), cA, voffA); PG8_STAGE(PG8_SB(0, 1), cB + hstep, voffB); PG8_STAGE(PG8_SA(0, 1), cA + hstep, voffA);
    if (wr == 1) PG8_BAR;
    PG8_WAIT_V(4); PG8_BAR;
    PG8_STAGE(PG8_SB(1, 0), cB + kstep, voffB); PG8_STAGE(PG8_SA(1, 0), cA + kstep, voffA); PG8_STAGE(PG8_SB(1, 1), cB + hstep + kstep, voffB);
    PG8_WAIT_V(6); PG8_BAR;
    PG8_STAMP();
    for (;;) {
        const bool has_next = S.next(ui + 1, nxt);
        const char* nA = has_next ? (const char*)g.A + (size_t)nxt.pm * tstep : cA; const char* nB = has_next ? (const char*)g.Bt + (size_t)nxt.pn * tstep : cB;
        for (int t = 0; t < nt; t += 2) {
            if constexpr (Epi::MIDK) { if (t == 8 || t == 16) E.mid(acc, cur, t, wr, wc, fr, fq); }
            const bool last = (t == nt - 2);
            const char* a1 = cA + (size_t)(t + 1) * kstep;
            const char* a2 = last ? nA : cA + (size_t)(t + 2) * kstep; const char* b2 = last ? nB : cB + (size_t)(t + 2) * kstep;
            const char* a3 = a2 + kstep; const char* b3 = b2 + kstep;
            if (last && has_next) S.a_ready(nxt);
            PG8_LDB(B0, 0, 0); PG8_SCHED; PG8_LDA(At, 0, 0); PG8_STAGE(PG8_SA(1, 1), a1 + hstep, voffA);
            PG8_WAIT_L(8); PG8_BAR; PG8_WAIT_L(0); PG8_MMA(0, 0, At, B0); PG8_BAR; PG8_SCHED;
            PG8_LDB(B1, 0, 1); PG8_STAGE(PG8_SB(0, 0), b2, voffB);
            PG8_BAR; PG8_WAIT_L(0); PG8_MMA(0, 1, At, B1); PG8_BAR;
            PG8_LDA(At, 0, 1); PG8_STAGE(PG8_SA(0, 0), a2, voffA);
            PG8_BAR; PG8_WAIT_L(0); PG8_MMA(1, 0, At, B0); PG8_BAR; PG8_SCHED;
            PG8_STAGE(PG8_SB(0, 1), b2 + hstep, voffB);
            PG8_WAIT_V(6); PG8_BAR; PG8_MMA(1, 1, At, B1); PG8_BAR;
            PG8_LDB(B0, 1, 0); PG8_SCHED; PG8_LDA(At, 1, 0); PG8_STAGE(PG8_SA(0, 1), a2 + hstep, voffA);
            PG8_WAIT_L(8); PG8_BAR; PG8_WAIT_L(0); PG8_MMA(0, 0, At, B0); PG8_BAR; PG8_SCHED;
            PG8_LDB(B1, 1, 1); PG8_STAGE(PG8_SB(1, 0), b3, voffB);
            PG8_BAR; PG8_WAIT_L(0); PG8_MMA(0, 1, At, B1); PG8_BAR;
            PG8_LDA(At, 1, 1); PG8_STAGE(PG8_SA(1, 0), a3, voffA);
            PG8_BAR; PG8_WAIT_L(0); PG8_MMA(1, 0, At, B0); PG8_BAR; PG8_SCHED;
            PG8_STAGE(PG8_SB(1, 1), b3 + hstep, voffB);
            PG8_WAIT_V(6); PG8_BAR; PG8_MMA(1, 1, At, B1); PG8_BAR;
        }
        PG8_STAMP();
        if constexpr (!Epi::AFTER_DRAIN) { E(acc, cur, wr, wc, fr, fq); S.done(cur); }
        PG8_STAMP();
        if (!has_next) break;
#pragma unroll
        for (int a = 0; a < 2; ++a)
#pragma unroll
            for (int b = 0; b < 2; ++b)
#pragma unroll
                for (int m = 0; m < 4; ++m)
#pragma unroll
                    for (int n = 0; n < 2; ++n) acc[a][b][m][n] = (f32x4){0.f, 0.f, 0.f, 0.f};
        cur = nxt; cA = nA; cB = nB; ++ui;
    }
    PG8_WAIT_V(0);
    if (wr == 0) PG8_BAR;
    PG8_BAR;
    if constexpr (Epi::AFTER_DRAIN) { E.fused(acc, cur, wr, wc, fr, fq, lds, wid, lane); S.done(cur); }
    PG8_STAMP();
    if (STAMP && wid == 0) { stamps[lane] = lane < nts ? (((unsigned long long)(unsigned)ts_hi << 32) | (unsigned)ts_lo) : 0ull;
        if (lane == 62) stamps[62] = rt_entry; if (lane == 63) stamps[63] = (unsigned long long)wall_clock64(); }
#undef PG8_STAMP
#undef PG8_SA
#undef PG8_SB
#undef PG8_STAGE
#undef PG8_LDA
#undef PG8_LDB
#undef PG8_MMA
#undef PG8_WAIT_V
#undef PG8_WAIT_L
#undef PG8_BAR
#undef PG8_SCHED
}
}
typedef pg8::bf16_t bf16_t;
typedef pg8::f32x4 f32x4;
typedef pg8::u32x4 u32x4;
typedef pg8::bf16x8 bf16x8;
typedef unsigned u32x2 __attribute__((ext_vector_type(2)));
#define LAS __attribute__((address_space(3)))
constexpr int MTOK = 65536, DM = 1024, NIN = 6144, DFF = 2816, NUP = 5632, SEQ = 8192, NBR = 1536, NPA = 3072;
constexpr int MH = MTOK / 2;
constexpr float EPS = 1e-6f;
constexpr size_t WS_WIN = 0;
constexpr size_t WS_WBR = WS_WIN + (size_t)NIN * DM * 2;
constexpr size_t WS_WO = WS_WBR + (size_t)DM * NBR * 2;
constexpr size_t WS_WUP = WS_WO + (size_t)DM * DM * 2;
constexpr size_t WS_WDN = WS_WUP + (size_t)NUP * DM * 2;
constexpr size_t WS_SSQ = WS_WDN + (size_t)DM * DFF * 2;
constexpr size_t WS_XB = WS_SSQ + (size_t)MTOK * 16 * 4;
constexpr size_t WS_B1 = WS_XB + (size_t)MTOK * NBR * 2;
constexpr size_t WS_B2 = WS_B1 + (size_t)MTOK * NPA * 2;
constexpr size_t WS_END = WS_B2 + (size_t)MTOK * NPA * 2;

__device__ __forceinline__ int otid() { int t = threadIdx.x; asm volatile("" : "+v"(t)); return t; }
__device__ __forceinline__ int obid() { int b = blockIdx.x; asm volatile("" : "+s"(b)); return b; }
struct Params {
    const float* in[19];
    float* out; unsigned char* ws;
};

__device__ __forceinline__ void st_nt16(void* p, u32x4 w) { __builtin_nontemporal_store(w, (u32x4*)p); }
__device__ __forceinline__ float bflo(unsigned w) { return __uint_as_float(w << 16); }
__device__ __forceinline__ float bfhi(unsigned w) { return __uint_as_float(w & 0xffff0000u); }
__device__ __forceinline__ unsigned pk(float a, float b) { return pg8::cvt_pk_bf16(a, b); }
__device__ __forceinline__ float fast_rcp(float x) { return __builtin_amdgcn_rcpf(x); }
__device__ __forceinline__ float gate_t(float x) { return 1.0f + __builtin_amdgcn_exp2f(fminf(x * -1.44269504f, 43.28f)); }
__device__ __forceinline__ float gelu_tanh_f(float x) {
    const float z2 = 1.5957691216f * (x + 0.044715f * x * x * x);
    return x * fast_rcp(1.0f + __expf(-z2));
}
__device__ __forceinline__ float silu_f(float x) { return x * fast_rcp(1.0f + __expf(-x)); }
__device__ __forceinline__ float row_rstd(const float* ssq, int r) {
    const f32x4* p = (const f32x4*)(ssq + (size_t)r * 16);
    const f32x4 a = p[0], b = p[1], c = p[2], d = p[3];
    const float s = ((a[0] + a[1]) + (a[2] + a[3])) + ((b[0] + b[1]) + (b[2] + b[3])) + ((c[0] + c[1]) + (c[2] + c[3])) + ((d[0] + d[1]) + (d[2] + d[3]));
    return rsqrtf(s * (1.0f / 1024.0f) + EPS);
}

__device__ __forceinline__ void rows_rstd8(const float* ssq, int row0, int fq, float (&rs)[8]) {
    f32x4 v[8];
#pragma unroll
    for (int i = 0; i < 8; ++i) v[i] = *(const f32x4*)(ssq + (size_t)(row0 + (i >> 2) * 128 + (i & 3) * 16) * 16 + fq * 4);
#pragma unroll
    for (int i = 0; i < 8; ++i) {
        float s = (v[i][0] + v[i][1]) + (v[i][2] + v[i][3]);
        s += __shfl_xor(s, 16); s += __shfl_xor(s, 32);
        rs[i] = rsqrtf(s * (1.0f / 1024.0f) + EPS);
    }
}
struct EpiIn {
    static constexpr bool PERM = true, AFTER_DRAIN = false, MIDK = false;
    bf16_t* PA; bf16_t* G; const float* ssq;
    __device__ __forceinline__ void operator()(const f32x4 (&acc)[2][2][4][2], const pg8::Unit& u, int wr, int wc, int fr, int fq) const {
        const int colt = u.pn * 256;
        const int act = (colt >= NPA) ? 2 : ((colt >= 512 && colt < 1536) ? 1 : 0);
        bf16_t* base = (colt >= NPA) ? G : PA;
        const int col0 = (colt >= NPA ? colt - NPA : colt) + wc * 32 + 8 * fq;
        const int row0 = u.pm * 256 + wr * 64 + fr;
        float rs8[8]; rows_rstd8(ssq, row0, fq, rs8);
#pragma unroll
        for (int ai = 0; ai < 2; ++ai)
#pragma unroll
            for (int m = 0; m < 4; ++m) {
                const int r = row0 + ai * 128 + m * 16;
                const float rs = rs8[ai * 4 + m];
                bf16_t* rowp = base + (size_t)r * NPA + col0;
#pragma unroll
                for (int bj = 0; bj < 2; ++bj) {
                    float v[8];
#pragma unroll
                    for (int j = 0; j < 4; ++j) { v[j] = acc[ai][bj][m][0][j] * rs; v[4 + j] = acc[ai][bj][m][1][j] * rs; }
                    if (act == 1) {
#pragma unroll
                        for (int j = 0; j < 8; ++j) v[j] = gelu_tanh_f(v[j]);
                    } else if (act == 2) {
#pragma unroll
                        for (int j = 0; j < 8; ++j) v[j] = gate_t(v[j]);
                    }
                    u32x4 w; w.x = pk(v[0], v[1]); w.y = pk(v[2], v[3]); w.z = pk(v[4], v[5]); w.w = pk(v[6], v[7]);
                    st_nt16(rowp + bj * 128, w);
                }
            }
    }
};
struct EpiBr {
    static constexpr bool PERM = true, AFTER_DRAIN = false, MIDK = true;
    const bf16_t* G; bf16_t* out;
    __device__ __forceinline__ void mid(f32x4 (&acc)[2][2][4][2], const pg8::Unit& u, int t, int wr, int wc, int fr, int fq) const {
        const int seg = (t == 8) ? 0 : 1024;
        int col0 = u.pn * 256 + wc * 32 + 8 * fq + seg;
        int row0 = u.pm * 256 + wr * 64 + fr;
        asm volatile("" : "+v"(col0), "+v"(row0));
#pragma unroll
        for (int ai = 0; ai < 2; ++ai)
#pragma unroll
            for (int m = 0; m < 4; ++m) {
                const bf16_t* rowp = G + (size_t)(row0 + ai * 128 + m * 16) * NPA + col0;
#pragma unroll
                for (int bj = 0; bj < 2; ++bj) {
                    const u32x4 nu = *(const u32x4*)(rowp + bj * 128), de = *(const u32x4*)(rowp + bj * 128 + 1024);
                    const unsigned nw[4] = {nu.x, nu.y, nu.z, nu.w}, dw[4] = {de.x, de.y, de.z, de.w};
#pragma unroll
                    for (int q = 0; q < 4; ++q) {
                        const float r0 = bflo(dw[q]) * fast_rcp(bflo(nw[q])), r1 = bfhi(dw[q]) * fast_rcp(bfhi(nw[q]));
                        acc[ai][bj][m][q >> 1][(q & 1) * 2] *= r0; acc[ai][bj][m][q >> 1][(q & 1) * 2 + 1] *= r1;
                    }
                }
                if (m & 1) asm volatile("" ::: "memory");
            }
    }
    __device__ __forceinline__ void operator()(const f32x4 (&acc)[2][2][4][2], const pg8::Unit& u, int wr, int wc, int fr, int fq) const {
        const int col0 = u.pn * 256 + wc * 32 + 8 * fq;
        const int row0 = u.pm * 256 + wr * 64 + fr;
        u32x4 sg[2][4][2];
#pragma unroll
        for (int ai = 0; ai < 2; ++ai)
#pragma unroll
            for (int m = 0; m < 4; ++m)
#pragma unroll
                for (int bj = 0; bj < 2; ++bj) sg[ai][m][bj] = *(const u32x4*)(G + (size_t)(row0 + ai * 128 + m * 16) * NPA + 2048 + col0 + bj * 128);
#pragma unroll
        for (int ai = 0; ai < 2; ++ai)
#pragma unroll
            for (int m = 0; m < 4; ++m) {
                const int r = row0 + ai * 128 + m * 16;
                bf16_t* op = out + (size_t)r * DM + col0;
#pragma unroll
                for (int bj = 0; bj < 2; ++bj) {
                    const u32x4 s = sg[ai][m][bj];
                    const f32x4 a0 = acc[ai][bj][m][0], a1 = acc[ai][bj][m][1];
                    u32x4 w;
                    w.x = pk(a0[0] * fast_rcp(bflo(s.x)), a0[1] * fast_rcp(bfhi(s.x))); w.y = pk(a0[2] * fast_rcp(bflo(s.y)), a0[3] * fast_rcp(bfhi(s.y)));
                    w.z = pk(a1[0] * fast_rcp(bflo(s.z)), a1[1] * fast_rcp(bfhi(s.z))); w.w = pk(a1[2] * fast_rcp(bflo(s.w)), a1[3] * fast_rcp(bfhi(s.w)));
                    *(u32x4*)(op + bj * 128) = w;
                }
            }
    }
};
struct EpiRes {
    static constexpr bool PERM = true, AFTER_DRAIN = false, MIDK = false;
    const float* base; float* out; bf16_t* xb; float* ssq; int row_off;
    __device__ __forceinline__ void operator()(const f32x4 (&acc)[2][2][4][2], const pg8::Unit& u, int wr, int wc, int fr, int fq) const {
        const int col0 = u.pn * 256 + wc * 32 + 8 * fq;
        const int row0 = row_off + u.pm * 256 + wr * 64 + fr;
#pragma unroll
        for (int ai = 0; ai < 2; ++ai) {
            f32x4 bb[4][2][2];
#pragma unroll
            for (int m = 0; m < 4; ++m)
#pragma unroll
                for (int bj = 0; bj < 2; ++bj) { const float* bp = base + (size_t)(row0 + ai * 128 + m * 16) * DM + col0 + bj * 128; bb[m][bj][0] = *(const f32x4*)bp; bb[m][bj][1] = *(const f32x4*)(bp + 4); }
            asm volatile("" ::: "memory");
#pragma unroll
            for (int m = 0; m < 4; ++m) {
                const int r = row0 + ai * 128 + m * 16;
                const size_t off = (size_t)r * DM + col0;
                float sq = 0.f;
#pragma unroll
                for (int bj = 0; bj < 2; ++bj) {
                    const f32x4 b0 = bb[m][bj][0], b1 = bb[m][bj][1];
                    const f32x4 o0 = b0 + acc[ai][bj][m][0], o1 = b1 + acc[ai][bj][m][1];
                    *(f32x4*)(out + off + bj * 128) = o0; *(f32x4*)(out + off + bj * 128 + 4) = o1;
                    u32x4 w; w.x = pk(o0[0], o0[1]); w.y = pk(o0[2], o0[3]); w.z = pk(o1[0], o1[1]); w.w = pk(o1[2], o1[3]);
                    *(u32x4*)(xb + off + bj * 128) = w;
                    sq += (o0[0] * o0[0] + o0[1] * o0[1]) + (o0[2] * o0[2] + o0[3] * o0[3]) + (o1[0] * o1[0] + o1[1] * o1[1]) + (o1[2] * o1[2] + o1[3] * o1[3]);
                }
                sq += __shfl_xor(sq, 16); sq += __shfl_xor(sq, 32);
                if (fq == 0) ssq[(size_t)r * 16 + u.pn * 4 + wc] = sq;
            }
            asm volatile("" ::: "memory");
        }
    }
};
__device__ __forceinline__ float dpp_ror1(float x) { return __int_as_float(__builtin_amdgcn_update_dpp(0, __float_as_int(x), 0x121, 0xf, 0xf, false)); }
__device__ __forceinline__ float dpp_ror2(float x) { return __int_as_float(__builtin_amdgcn_update_dpp(0, __float_as_int(x), 0x122, 0xf, 0xf, false)); }
__device__ __forceinline__ float dpp_shr1(float old, float x) { return __int_as_float(__builtin_amdgcn_update_dpp(__float_as_int(old), __float_as_int(x), 0x111, 0xf, 0xf, false)); }
__device__ __forceinline__ float dpp_shr2(float old, float x) { return __int_as_float(__builtin_amdgcn_update_dpp(__float_as_int(old), __float_as_int(x), 0x112, 0xf, 0xf, false)); }
struct EpiUp {
    static constexpr bool PERM = true, AFTER_DRAIN = false, MIDK = false;
    bf16_t* act; bf16_t* zs; const float* ssq; const float* cw; const float* cb;
    __device__ __forceinline__ void operator()(const f32x4 (&acc)[2][2][4][2], const pg8::Unit& u, int wr, int wc, int fr, int fq) const {
        const int c0 = u.pn * 128 + wc * 32 + 8 * fq;
        const int row0 = u.pm * 256 + wr * 64 + fr;
        float rs8[8]; rows_rstd8(ssq, row0, fq, rs8);
        u32x2 keep[2][4];
#pragma unroll
        for (int n = 0; n < 2; ++n) {
            const int c = c0 + 4 * n;
            const f32x4 gw0 = *(const f32x4*)(cw + c), gw1 = *(const f32x4*)(cw + NUP + c), gw2 = *(const f32x4*)(cw + 2 * NUP + c), gb = *(const f32x4*)(cb + c);
            const f32x4 vw0 = *(const f32x4*)(cw + DFF + c), vw1 = *(const f32x4*)(cw + NUP + DFF + c), vw2 = *(const f32x4*)(cw + 2 * NUP + DFF + c), vb = *(const f32x4*)(cb + DFF + c);
#pragma unroll
            for (int ai = 0; ai < 2; ++ai) {
                f32x4 pg = {0.f, 0.f, 0.f, 0.f}, pv = {0.f, 0.f, 0.f, 0.f};
                const int blk = u.pm * 4 + ai * 2 + wr;
#pragma unroll
                for (int m = 0; m < 4; ++m) {
                    const float rs = rs8[ai * 4 + m];
                    const f32x4 zg = acc[ai][0][m][n] * rs, zv = acc[ai][1][m][n] * rs;
                    float o[4];
#pragma unroll
                    for (int j = 0; j < 4; ++j) {
                        const float g1 = dpp_shr1(dpp_ror1(pg[j]), zg[j]), g2 = dpp_shr2(dpp_ror2(pg[j]), zg[j]);
                        const float v1 = dpp_shr1(dpp_ror1(pv[j]), zv[j]), v2 = dpp_shr2(dpp_ror2(pv[j]), zv[j]);
                        const float gg = gw2[j] * zg[j] + gw1[j] * g1 + gw0[j] * g2 + gb[j];
                        const float vv = vw2[j] * zv[j] + vw1[j] * v1 + vw0[j] * v2 + vb[j];
                        o[j] = silu_f(gg) * vv;
                    }
                    u32x2 w; w.x = pk(o[0], o[1]); w.y = pk(o[2], o[3]);
                    const int r = row0 + ai * 128 + m * 16;
                    if (n == 0) keep[ai][m] = w;
                    else if (!(m == 0 && fr < 2)) { u32x4 ww; ww.x = keep[ai][m].x; ww.y = keep[ai][m].y; ww.z = w.x; ww.w = w.y; st_nt16(act + (size_t)r * DFF + c0, ww); }
                    if (m == 0 && fr < 2) {
                        bf16_t* zp = zs + ((size_t)blk * 4 + 2 + fr) * NUP + c;
                        u32x2 a; a.x = pk(zg[0], zg[1]); a.y = pk(zg[2], zg[3]); *(u32x2*)zp = a;
                        u32x2 d; d.x = pk(zv[0], zv[1]); d.y = pk(zv[2], zv[3]); *(u32x2*)(zp + DFF) = d;
                    }
                    if (m == 3 && fr >= 14) {
                        bf16_t* zp = zs + ((size_t)blk * 4 + (fr - 14)) * NUP + c;
                        u32x2 a; a.x = pk(zg[0], zg[1]); a.y = pk(zg[2], zg[3]); *(u32x2*)zp = a;
                        u32x2 d; d.x = pk(zv[0], zv[1]); d.y = pk(zv[2], zv[3]); *(u32x2*)(zp + DFF) = d;
                    }
                    pg = zg; pv = zv;
                }
            }
        }
    }
};

__device__ __forceinline__ void transpose_tile(const float* __restrict__ W, int N, const float* __restrict__ g, bf16_t* __restrict__ Wt, int ldt, int koff, int k0, int n0, int nd0, float* tile, int tid) {
    {
        const int kk = tid >> 4, nn = (tid & 15) * 4;
#pragma unroll
        for (int h = 0; h < 2; ++h) {
            const int k = kk + h * 32;
            f32x4 v = *(const f32x4*)(W + (size_t)(k0 + k) * N + n0 + nn);
            const float s = g ? g[k0 + k] : 1.0f;
            tile[k * 65 + nn + 0] = v[0] * s; tile[k * 65 + nn + 1] = v[1] * s; tile[k * 65 + nn + 2] = v[2] * s; tile[k * 65 + nn + 3] = v[3] * s;
        }
    }
    __syncthreads();
    {
        const int n = tid >> 3, kq = (tid & 7) * 8;
        float v[8];
#pragma unroll
        for (int j = 0; j < 8; ++j) v[j] = tile[(kq + j) * 65 + n];
        u32x4 w; w.x = pk(v[0], v[1]); w.y = pk(v[2], v[3]); w.z = pk(v[4], v[5]); w.w = pk(v[6], v[7]);
        *(u32x4*)(Wt + (size_t)(nd0 + n) * ldt + koff + k0 + kq) = w;
    }
    __syncthreads();
}

__device__ __forceinline__ void prep_phase(const Params& p, int l, float* ldsf) {
    unsigned char* ws = p.ws;
    bf16_t* wt_in = (bf16_t*)(ws + WS_WIN); bf16_t* wt_br = (bf16_t*)(ws + WS_WBR); bf16_t* wt_o = (bf16_t*)(ws + WS_WO);
    bf16_t* wt_up = (bf16_t*)(ws + WS_WUP); bf16_t* wt_dn = (bf16_t*)(ws + WS_WDN);
    const float* g_mix = p.in[1] + (size_t)l * DM; const float* w_in = p.in[2] + (size_t)l * DM * NIN;
    const float* w_pool = p.in[3] + (size_t)l * 4 * 128 * 128; const float* pscale = p.in[4] + (size_t)l * 512;
    const float* w_ba = p.in[9] + (size_t)l * 512 * DM; const float* w_bb = p.in[10] + (size_t)l * 512 * DM; const float* w_bc = p.in[11] + (size_t)l * 512 * DM;
    const float* w_o = p.in[12] + (size_t)l * DM * DM; const float* g_ffn = p.in[13] + (size_t)l * DM;
    const float* w_up = p.in[14] + (size_t)l * DM * NUP; const float* w_dn = p.in[17] + (size_t)l * DFF * DM;
    const int tid = otid(), bid = obid();
    constexpr int T0 = 16 * 96, T1 = T0 + 128, T2 = T1 + 128, T3 = T2 + 256, T4 = T3 + 16 * 88, T5 = T4 + 44 * 16;
    for (int i = bid; i < T5; i += gridDim.x) {
        if (i < T0) { const int kt = i & 15, nt = i >> 4; transpose_tile(w_in, NIN, g_mix, wt_in, DM, 0, kt * 64, nt * 64, nt * 64, ldsf, tid); }
        else if (i < T1) { const int j = i - T0, kt = j & 7, nt = j >> 3; transpose_tile(w_bb, DM, nullptr, wt_br, NBR, 512, kt * 64, nt * 64, nt * 64, ldsf, tid); }
        else if (i < T2) { const int j = i - T1, kt = j & 7, nt = j >> 3; transpose_tile(w_bc, DM, nullptr, wt_br, NBR, 1024, kt * 64, nt * 64, nt * 64, ldsf, tid); }
        else if (i < T3) { const int j = i - T2, kt = j & 15, nt = j >> 4; transpose_tile(w_o, DM, nullptr, wt_o, DM, 0, kt * 64, nt * 64, nt * 64, ldsf, tid); }
        else if (i < T4) { const int j = i - T3, kt = j & 15, nt = j >> 4; const int n0 = nt * 64, bj = n0 / DFF, q0 = n0 - bj * DFF; transpose_tile(w_up, NUP, g_ffn, wt_up, DM, 0, kt * 64, n0, (q0 >> 7) * 256 + bj * 128 + (q0 & 127), ldsf, tid);   }
        else { const int j = i - T4, kt = j % 44, nt = j / 44; transpose_tile(w_dn, DM, nullptr, wt_dn, DFF, 0, kt * 64, nt * 64, nt * 64, ldsf, tid); }
    }
    {
        float* wpT = ldsf;
        float* wa = ldsf + 128 * 128;
        for (int it = (int)gridDim.x - 1 - bid; it < 64; it += gridDim.x) {
            const int g = it >> 4, n0 = (it & 15) * 64;
            for (int q = tid; q < 128 * 32; q += 512) {
                const int d = q >> 5, e4 = (q & 31) * 4;
                const f32x4 v = *(const f32x4*)(w_pool + ((size_t)g * 128 + d) * 128 + e4);
                const f32x4 s = *(const f32x4*)(pscale + g * 128 + e4);
                wpT[(e4 + 0) * 128 + d] = v[0] * s[0]; wpT[(e4 + 1) * 128 + d] = v[1] * s[1]; wpT[(e4 + 2) * 128 + d] = v[2] * s[2]; wpT[(e4 + 3) * 128 + d] = v[3] * s[3];
            }
            for (int q = tid; q < 128 * 16; q += 512) {
                const int e = q >> 4, c4 = (q & 15) * 4;
                *(f32x4*)(wa + e * 64 + c4) = *(const f32x4*)(w_ba + (size_t)(g * 128 + e) * DM + n0 + c4);
            }
            __syncthreads();
            const int d = tid & 127, ns = tid >> 7;
            float acc[16];
#pragma unroll
            for (int i = 0; i < 16; ++i) acc[i] = 0.f;
            for (int e = 0; e < 128; ++e) {
                const float w = wpT[e * 128 + d];
                const f32x4* wr4 = (const f32x4*)(wa + e * 64 + ns * 16);
#pragma unroll
                for (int c = 0; c < 4; ++c) { const f32x4 b = wr4[c]; acc[c * 4 + 0] += w * b[0]; acc[c * 4 + 1] += w * b[1]; acc[c * 4 + 2] += w * b[2]; acc[c * 4 + 3] += w * b[3]; }
            }
#pragma unroll
            for (int i = 0; i < 16; ++i) wt_br[(size_t)(n0 + ns * 16 + i) * NBR + g * 128 + d] = (bf16_t)(pk(acc[i], 0.f) & 0xffffu);
            __syncthreads();
        }
    }
    if (l == 0) {
        const float* x = p.in[0]; bf16_t* xb = (bf16_t*)(ws + WS_XB); float* ssq = (float*)(ws + WS_SSQ);
        const int lane = tid & 63, wave = tid >> 6;
        for (int r = bid * 8 + wave; r < MTOK; r += gridDim.x * 8) {
            float sq = 0.f;
#pragma unroll
            for (int i = 0; i < 4; ++i) {
                const f32x4 v = *(const f32x4*)(x + (size_t)r * DM + i * 256 + lane * 4);
                sq += (v[0] * v[0] + v[1] * v[1]) + (v[2] * v[2] + v[3] * v[3]);
                u32x2 w; w.x = pk(v[0], v[1]); w.y = pk(v[2], v[3]);
                *(u32x2*)(xb + (size_t)r * DM + i * 256 + lane * 4) = w;
            }
#pragma unroll
            for (int o = 32; o >= 1; o >>= 1) sq += __shfl_xor(sq, o);
            if (lane < 16) ssq[(size_t)r * 16 + lane] = (lane == 0) ? sq : 0.f;
        }
    }
}
__device__ __forceinline__ void ld8(const bf16_t* p, float (&v)[8]) {
    const u32x4 w = *(const u32x4*)p;
    v[0] = bflo(w.x); v[1] = bfhi(w.x); v[2] = bflo(w.y); v[3] = bfhi(w.y); v[4] = bflo(w.z); v[5] = bfhi(w.z); v[6] = bflo(w.w); v[7] = bfhi(w.w);
}
__device__ __forceinline__ void st8(bf16_t* p, const float (&v)[8]) {
    u32x4 w; w.x = pk(v[0], v[1]); w.y = pk(v[2], v[3]); w.z = pk(v[4], v[5]); w.w = pk(v[6], v[7]);
    *(u32x4*)p = w;
}
constexpr int VT_PITCH = 136;
__device__ __forceinline__ void mixer_phase(const Params& p, int l, unsigned char* lds) {
    const bf16_t* PA = (const bf16_t*)(p.ws + WS_B1);
    bf16_t* Y = (bf16_t*)(p.ws + WS_XB);
    const float* g_sgu = p.in[5] + (size_t)l * 512;
    const float* w_sp = p.in[6] + (size_t)l * 4 * 128 * 128;
    const float* b_sp = p.in[7] + (size_t)l * 4 * 128;
    const float* conv_c = p.in[8] + (size_t)l * 3 * 512;
    float* rs = (float*)lds;
    bf16_t* vT = (bf16_t*)(lds + 1024);
    const int tid = otid(), lane = tid & 63, wave = tid >> 6, fr = lane & 15, fq = lane >> 4;
    for (int item = obid(); item < MTOK / 128; item += gridDim.x) {
        const int t0 = item * 128, pos0 = t0 & (SEQ - 1);
        {
            const int row = tid >> 2, q = tid & 3;
            const bf16_t* vp = PA + (size_t)(t0 + row) * NPA + 1024 + q * 128;
            float sq = 0.f;
#pragma unroll
            for (int i = 0; i < 16; ++i) { float v[8]; ld8(vp + i * 8, v);
#pragma unroll
                for (int j = 0; j < 8; ++j) sq += v[j] * v[j]; }
            sq += __shfl_xor(sq, 1); sq += __shfl_xor(sq, 2);
            if (q == 0) rs[row] = rsqrtf(sq * (1.0f / 512.0f) + EPS);
        }
        {
            const int c8 = (tid & 63) * 8, r0 = (tid >> 6) * 16;
            {
                const int w = 2 << (c8 >> 7);
                const bf16_t* ap = PA + (size_t)t0 * NPA + c8;
                bf16_t* yp = Y + (size_t)t0 * NBR + c8;
                float s[8];
#pragma unroll
                for (int j = 0; j < 8; ++j) s[j] = 0.f;
                for (int k = 1; k < w; ++k) { const int rr = r0 - k; if (pos0 + rr >= 0) { float v[8]; ld8(ap + (ptrdiff_t)rr * NPA, v);
#pragma unroll
                        for (int j = 0; j < 8; ++j) s[j] += v[j]; } }
                for (int i = 0; i < 16; ++i) {
                    const int rr = r0 + i; float v[8]; ld8(ap + (ptrdiff_t)rr * NPA, v);
                    const int pos = pos0 + rr; const float inv = 1.0f / (float)(pos + 1 < w ? pos + 1 : w);
                    float o[8];
#pragma unroll
                    for (int j = 0; j < 8; ++j) { s[j] += v[j]; o[j] = s[j] * inv - v[j]; }
                    st8(yp + (size_t)rr * NBR, o);
                    const int ro = rr - w + 1;
                    if (pos0 + ro >= 0) { float q[8]; ld8(ap + (ptrdiff_t)ro * NPA, q);
#pragma unroll
                        for (int j = 0; j < 8; ++j) s[j] -= q[j]; }
                }
            }
            {
                const bf16_t* bp = PA + (size_t)t0 * NPA + 1536 + c8;
                bf16_t* yp = Y + (size_t)t0 * NBR + 1024 + c8;
                float w0[8], w1[8], w2[8], z1[8], z2[8];
#pragma unroll
                for (int j = 0; j < 8; ++j) { w0[j] = conv_c[c8 + j]; w1[j] = conv_c[512 + c8 + j]; w2[j] = conv_c[1024 + c8 + j]; z1[j] = 0.f; z2[j] = 0.f; }
                if (pos0 + r0 - 2 >= 0) { float a[8], b[8]; ld8(bp + (ptrdiff_t)(r0 - 2) * NPA + 512, a); ld8(bp + (ptrdiff_t)(r0 - 2) * NPA + 1024, b);
#pragma unroll
                    for (int j = 0; j < 8; ++j) z2[j] = a[j] * b[j]; }
                if (pos0 + r0 - 1 >= 0) { float a[8], b[8]; ld8(bp + (ptrdiff_t)(r0 - 1) * NPA + 512, a); ld8(bp + (ptrdiff_t)(r0 - 1) * NPA + 1024, b);
#pragma unroll
                    for (int j = 0; j < 8; ++j) z1[j] = a[j] * b[j]; }
                for (int i = 0; i < 16; ++i) {
                    const int rr = r0 + i; float cb[8], a[8], b[8], o[8];
                    ld8(bp + (size_t)rr * NPA, cb); ld8(bp + (size_t)rr * NPA + 512, a); ld8(bp + (size_t)rr * NPA + 1024, b);
#pragma unroll
                    for (int j = 0; j < 8; ++j) { const float z = a[j] * b[j]; o[j] = cb[j] * (w0[j] * z2[j] + w1[j] * z1[j] + w2[j] * z); z2[j] = z1[j]; z1[j] = z; }
                    st8(yp + (size_t)rr * NBR, o);
                }
            }
        }
        for (int g = 0; g < 4; ++g) {
            __syncthreads();
            {
                const int s = tid >> 2, dq = (tid & 3) * 32;
                const bf16_t* vp = PA + (size_t)(t0 + s) * NPA + 1024 + g * 128 + dq;
#pragma unroll
                for (int i = 0; i < 4; ++i) {
                    const u32x4 w = *(const u32x4*)(vp + i * 8);
                    const unsigned ww[4] = {w.x, w.y, w.z, w.w};
#pragma unroll
                    for (int q = 0; q < 4; ++q) { vT[(dq + i * 8 + q * 2) * VT_PITCH + s] = (bf16_t)(ww[q] & 0xffffu); vT[(dq + i * 8 + q * 2 + 1) * VT_PITCH + s] = (bf16_t)(ww[q] >> 16); }
                }
            }
            __syncthreads();
            f32x4 acc[8];
#pragma unroll
            for (int n = 0; n < 8; ++n) acc[n] = (f32x4){0.f, 0.f, 0.f, 0.f};
            const int t = wave * 16 + fr;
            const int nk = (wave >> 1) + 1;
            for (int k = 0; k < nk; ++k) {
                const int s0 = k * 32 + fq * 8;
                const float* wp = w_sp + ((size_t)g * 128 + t) * 128 + s0;
                const f32x4 wa = *(const f32x4*)wp, wb = *(const f32x4*)(wp + 4);
                const f32x4 ra = *(const f32x4*)(rs + s0), rb = *(const f32x4*)(rs + s0 + 4);
                float a[8];
#pragma unroll
                for (int j = 0; j < 4; ++j) { a[j] = (s0 + j <= t) ? wa[j] * ra[j] : 0.f; a[4 + j] = (s0 + 4 + j <= t) ? wb[j] * rb[j] : 0.f; }
                union { u32x4 u; bf16x8 h; } af; af.u.x = pk(a[0], a[1]); af.u.y = pk(a[2], a[3]); af.u.z = pk(a[4], a[5]); af.u.w = pk(a[6], a[7]);
#pragma unroll
                for (int n = 0; n < 8; ++n) {
                    const bf16x8 bfrag = *(const bf16x8*)(vT + (n * 16 + fr) * VT_PITCH + s0);
                    acc[n] = __builtin_amdgcn_mfma_f32_16x16x32_bf16(bfrag, af.h, acc[n], 0, 0, 0);
                }
            }
            const float bias = b_sp[g * 128 + t];
            const bf16_t* up = PA + (size_t)(t0 + t) * NPA + 512 + g * 128 + 4 * fq;
            bf16_t* yp = Y + (size_t)(t0 + t) * NBR + 512 + g * 128 + 4 * fq;
#pragma unroll
            for (int n = 0; n < 8; ++n) {
                const u32x2 uu = *(const u32x2*)(up + n * 16);
                const f32x4 gs = *(const f32x4*)(g_sgu + g * 128 + n * 16 + 4 * fq);
                const float o0 = bflo(uu.x) * (acc[n][0] * gs[0] + bias), o1 = bfhi(uu.x) * (acc[n][1] * gs[1] + bias);
                const float o2 = bflo(uu.y) * (acc[n][2] * gs[2] + bias), o3 = bfhi(uu.y) * (acc[n][3] * gs[3] + bias);
                u32x2 w; w.x = pk(o0, o1); w.y = pk(o2, o3);
                *(u32x2*)(yp + n * 16) = w;
            }
        }
        __syncthreads();
    }
}

__device__ __forceinline__ void ffn_fixup_phase(const Params& p, int l) {
    const bf16_t* zs = (const bf16_t*)(p.ws + WS_B2);
    bf16_t* act = (bf16_t*)(p.ws + WS_B1);
    const float* cw = p.in[15] + (size_t)l * 3 * NUP; const float* cb = p.in[16] + (size_t)l * NUP;
    constexpr int NCG = DFF / 8, NU = (MTOK / 64) * NCG;
    for (int u = obid() * 512 + otid(); u < NU; u += gridDim.x * 512) {
        const int blk = u / NCG, c8 = (u - blk * NCG) * 8;
        const bool first = ((blk * 64) & (SEQ - 1)) == 0;
        float g2[8], g1[8], ga[8], gb2[8], v2[8], v1[8], va[8], vb2[8];
#pragma unroll
        for (int j = 0; j < 8; ++j) { g2[j] = g1[j] = v2[j] = v1[j] = 0.f; }
        const bf16_t* own = zs + (size_t)blk * 4 * NUP + c8;
        if (!first) { const bf16_t* prv = own - 4 * (ptrdiff_t)NUP; ld8(prv, g2); ld8(prv + NUP, g1); ld8(prv + DFF, v2); ld8(prv + NUP + DFF, v1); }
        ld8(own + 2 * NUP, ga); ld8(own + 3 * NUP, gb2); ld8(own + 2 * NUP + DFF, va); ld8(own + 3 * NUP + DFF, vb2);
        float o0[8], o1[8];
#pragma unroll
        for (int j = 0; j < 8; ++j) {
            const float w0 = cw[c8 + j], w1 = cw[NUP + c8 + j], w2 = cw[2 * NUP + c8 + j], bb = cb[c8 + j];
            const float x0 = cw[DFF + c8 + j], x1 = cw[NUP + DFF + c8 + j], x2 = cw[2 * NUP + DFF + c8 + j], xb_ = cb[DFF + c8 + j];
            const float gg0 = w0 * g2[j] + w1 * g1[j] + w2 * ga[j] + bb, vv0 = x0 * v2[j] + x1 * v1[j] + x2 * va[j] + xb_;
            const float gg1 = w0 * g1[j] + w1 * ga[j] + w2 * gb2[j] + bb, vv1 = x0 * v1[j] + x1 * va[j] + x2 * vb2[j] + xb_;
            o0[j] = silu_f(gg0) * vv0; o1[j] = silu_f(gg1) * vv1;
        }
        st8(act + (size_t)(blk * 64) * DFF + c8, o0); st8(act + (size_t)(blk * 64 + 1) * DFF + c8, o1);
    }
}

__device__ __forceinline__ void final_norm_phase(const Params& p) {
    const float* gf = p.in[18]; const float* ssq = (const float*)(p.ws + WS_SSQ); float* out = p.out;
    const int tid = otid(), lane = tid & 63, wave = tid >> 6;
    for (int r = obid() * 8 + wave; r < MTOK; r += gridDim.x * 8) {
        const float rs = row_rstd(ssq, r);
#pragma unroll
        for (int i = 0; i < 4; ++i) {
            float* q = out + (size_t)r * DM + i * 256 + lane * 4;
            const f32x4 v = *(const f32x4*)q; const f32x4 g = *(const f32x4*)(gf + i * 256 + lane * 4);
            *(f32x4*)q = v * rs * g;
        }
    }
}

template <class Epi> __device__ __forceinline__ void run_gemm(unsigned char* lds, const bf16_t* A, const bf16_t* Bt, int M, int N, int K, const Epi& E, int stagger_step = 0) {
    pg8::Gemm g{A, Bt, M, N, K}; pg8::StaticOrder S; S.init(M, N, (int)gridDim.x, obid());
    if (stagger_step) {
        const unsigned long long t0 = wall_clock64(), d = (unsigned long long)(((obid() >> 3) & 7) * stagger_step);
        while (wall_clock64() - t0 < d) __builtin_amdgcn_s_sleep(16);
    }
    pg8::gemm_phase<Epi, pg8::StaticOrder, false>((PG8_LAS unsigned char*)lds, g, S, E, nullptr);
}

__global__ void __launch_bounds__(512, 2) fwd_megakernel(Params p) {
    extern __shared__ __attribute__((aligned(16))) unsigned char lds[];
    cg::grid_group grid = cg::this_grid();
    unsigned char* ws = p.ws;
    bf16_t* wt_in = (bf16_t*)(ws + WS_WIN); bf16_t* wt_br = (bf16_t*)(ws + WS_WBR); bf16_t* wt_o = (bf16_t*)(ws + WS_WO);
    bf16_t* wt_up = (bf16_t*)(ws + WS_WUP); bf16_t* wt_dn = (bf16_t*)(ws + WS_WDN);
    float* ssq = (float*)(ws + WS_SSQ); bf16_t* xb = (bf16_t*)(ws + WS_XB); bf16_t* b1 = (bf16_t*)(ws + WS_B1); bf16_t* b2 = (bf16_t*)(ws + WS_B2);
    for (int l = 0; l < 2; ++l) {
        prep_phase(p, l, (float*)lds);
        grid.sync();
        { EpiIn E{b1, b2, ssq}; run_gemm(lds, xb, wt_in, MTOK, NIN, DM, E); }
        grid.sync();
        mixer_phase(p, l, lds);
        grid.sync();
        { EpiBr E{b2, b1}; run_gemm(lds, xb  , wt_br, MTOK, DM, NBR, E); }
        grid.sync();
        { EpiRes E{l == 0 ? p.in[0] : p.out, p.out, xb, ssq, 0}; run_gemm(lds, b1, wt_o, MTOK, DM, DM, E); }
        grid.sync();
        { EpiUp E{b1, b2, ssq, p.in[15] + (size_t)l * 3 * NUP, p.in[16] + (size_t)l * NUP}; run_gemm(lds, xb, wt_up, MTOK, NUP, DM, E); }
        grid.sync();
        ffn_fixup_phase(p, l);
        grid.sync();
        { EpiRes E{p.out, p.out, xb, ssq, 0}; run_gemm(lds, b1, wt_dn, MTOK, DM, DFF, E); }
        grid.sync();
    }
    final_norm_phase(p);
}

extern "C" void kernel_launch(void* const* d_in, const int* in_sizes, int n_in, void* d_out, int out_size, void* d_ws, size_t ws_size, hipStream_t stream) {
    constexpr size_t kLds = pg8::STAGE_BYTES;
    static int grid_blocks = 0;
    if (!grid_blocks) {
        int dev = 0, cus = 0, per_cu = 0;
        (void)hipGetDevice(&dev);
        (void)hipDeviceGetAttribute(&cus, hipDeviceAttributeMultiprocessorCount, dev);
        (void)hipFuncSetAttribute((const void*)fwd_megakernel, hipFuncAttributeMaxDynamicSharedMemorySize, (int)kLds);
        (void)hipOccupancyMaxActiveBlocksPerMultiprocessor(&per_cu, (const void*)fwd_megakernel, 512, kLds);
        if (per_cu < 1) per_cu = 1;
        grid_blocks = cus;
        if (ws_size < WS_END || n_in != 19 || out_size != MTOK * DM) { fprintf(stderr, "kernel_launch: unexpected sizes: ws %zu (need %zu), n_in %d, out %d\n", ws_size, (size_t)WS_END, n_in, out_size); }
    }
    Params p{};
    for (int i = 0; i < 19; ++i) p.in[i] = (const float*)d_in[i];
    p.out = (float*)d_out; p.ws = (unsigned char*)d_ws;
    void* args[] = {&p};
    hipError_t e = hipLaunchCooperativeKernel((void*)fwd_megakernel, dim3(grid_blocks), dim3(512), args, kLds, stream);
    if (e != hipSuccess) fprintf(stderr, "cooperative launch failed: %s (grid %d)\n", hipGetErrorString(e), grid_blocks);
}
```

```cpp
#include <hip/hip_runtime.h>
#include <hip/hip_cooperative_groups.h>
#include <cstdio>
namespace cg = cooperative_groups;
namespace pg8 {
#define PG8_LAS __attribute__((address_space(3)))
typedef unsigned short bf16_t;
typedef short bf16x8 __attribute__((ext_vector_type(8)));
typedef float f32x4 __attribute__((ext_vector_type(4)));
typedef unsigned u32x4 __attribute__((ext_vector_type(4)));
constexpr int BM = 256, BK = 64, HALF = 128, HTB = HALF * BK * 2  , STAGE_BYTES = 8 * HTB, NXCD = 8, WGM = 8;

__host__ __device__ __forceinline__ int lds_byte(int r, int c) { const int st = (r >> 4) * 2 + (c >> 5), rr = r & 15, cc = c & 31, ob = rr * 64 + cc * 2; return st * 1024 + (ob ^ (((ob >> 9) & 1) << 5)); }
__host__ __device__ __forceinline__ void stage_rc(int b, int& R, int& C) { const int st = b / 1024, sb = b % 1024, swz = sb ^ (((sb >> 9) & 1) << 5); R = (st >> 1) * 16 + swz / 64; C = (st & 1) * 32 + (swz % 64) / 2; }
__host__ __device__ __forceinline__ int perm32(int rho) { const int n = rho >> 4, i = rho & 15; return 8 * (i >> 2) + 4 * n + (i & 3); }

struct Unit { int pm, pn; };
struct Gemm { const bf16_t* A; const bf16_t* Bt; int M, N, K; };

struct StaticOrder {
    int nM, nN, nwg, G, c;
    __host__ __device__ void init(int M, int N, int G_, int c_) { nM = M / BM; nN = N / BM; nwg = nM * nN; G = G_; c = c_; }
    __host__ __device__ bool next(int i, Unit& u) const {
        const long L = (long)i * G + c; if (L >= nwg) return false;
        int wgid = (int)L; { const int q = nwg / NXCD, r = nwg % NXCD, xcd = wgid % NXCD, off = wgid / NXCD; wgid = (xcd < r ? xcd * (q + 1) : r * (q + 1) + (xcd - r) * q) + off; }
        const int nig = WGM * nN, gid = wgid / nig, fm = gid * WGM, gsz = (nM - fm) < WGM ? (nM - fm) : WGM;
        u.pm = fm + ((wgid % nig) % gsz); u.pn = (wgid % nig) / gsz; return true;
    }
    __device__ __forceinline__ void a_ready(const Unit&) const {}
    __device__ __forceinline__ void done(const Unit&) const {}
};
__device__ __forceinline__ unsigned cvt_pk_bf16(float lo, float hi) { unsigned r; asm volatile("v_cvt_pk_bf16_f32 %0, %1, %2" : "=v"(r) : "v"(lo), "v"(hi)); return r; }

template <class Epi, class Sched, bool STAMP = false>
__device__ __forceinline__ void gemm_phase(PG8_LAS unsigned char* lds, const Gemm g, const Sched& S, const Epi& E, unsigned long long* stamps) {
    int tid_ = threadIdx.x; asm volatile("" : "+v"(tid_));
    const int tid = tid_, wid = __builtin_amdgcn_readfirstlane(tid >> 6), lane = tid & 63, wr = wid >> 2, wc = wid & 3, fr = lane & 15, fq = lane >> 4;
    const int K = g.K, nt = K / BK;
    int ts_lo = 0, ts_hi = 0, nts = 0; const unsigned long long rt_entry = STAMP ? (unsigned long long)wall_clock64() : 0ull;
#define PG8_STAMP() do { if (STAMP && wid == 0 && nts < 64) { const unsigned long long _c = (unsigned long long)clock64(); \
        ts_lo = (lane == nts) ? (int)(unsigned)_c : ts_lo; ts_hi = (lane == nts) ? (int)(unsigned)(_c >> 32) : ts_hi; ++nts; } } while (0)
    PG8_STAMP();
    unsigned voffA[2], voffB[2];
#pragma unroll
    for (int i = 0; i < 2; ++i) { int R, C; stage_rc(tid * 16 + i * 8192, R, C); const int Rb = Epi::PERM ? ((R & ~31) + perm32(R & 31)) : R;
        voffA[i] = (unsigned)(R * K + C) * 2u; voffB[i] = (unsigned)(Rb * K + C) * 2u; }
    const size_t kstep = (size_t)(BK * 2);
    const size_t hstep = (size_t)HALF * K * 2;
    const size_t tstep = 2 * hstep;
    const unsigned ldsw = (unsigned)wid * 1024u;
    const int aoff = lds_byte(wr * 64 + fr, fq * 8), boff = lds_byte(wc * 32 + fr, fq * 8);
#define PG8_SA(b, h) (((b) * 2 + (h)) * HTB)
#define PG8_SB(b, h) ((4 + (b) * 2 + (h)) * HTB)
#define PG8_STAGE(bufoff, gbase, voff) do { _Pragma("unroll") for (int _i = 0; _i < 2; ++_i) \
        __builtin_amdgcn_global_load_lds((const unsigned*)((const char*)(gbase) + (voff)[_i]), (PG8_LAS unsigned*)(lds + (bufoff) + ldsw + _i * 8192), 16, 0, 0); } while (0)
#define PG8_LDA(dst, b, h) do { _Pragma("unroll") for (int m = 0; m < 4; ++m) _Pragma("unroll") for (int k = 0; k < 2; ++k) dst[m][k] = *(const PG8_LAS bf16x8*)(lds + PG8_SA(b, h) + aoff + m * 2048 + k * 1024); } while (0)
#define PG8_LDB(dst, b, h) do { _Pragma("unroll") for (int n = 0; n < 2; ++n) _Pragma("unroll") for (int k = 0; k < 2; ++k) dst[n][k] = *(const PG8_LAS bf16x8*)(lds + PG8_SB(b, h) + boff + n * 2048 + k * 1024); } while (0)
#define PG8_MMA(ai, bj, At, Bt) do { __builtin_amdgcn_s_setprio(1); _Pragma("unroll") for (int m = 0; m < 4; ++m) _Pragma("unroll") for (int n = 0; n < 2; ++n) _Pragma("unroll") for (int k = 0; k < 2; ++k) \
        acc[ai][bj][m][n] = __builtin_amdgcn_mfma_f32_16x16x32_bf16(Bt[n][k], At[m][k], acc[ai][bj][m][n], 0, 0, 0); __builtin_amdgcn_s_setprio(0); } while (0)
#define PG8_WAIT_V(n) asm volatile("s_waitcnt vmcnt(" #n ")" ::: "memory")
#define PG8_WAIT_L(n) asm volatile("s_waitcnt lgkmcnt(" #n ")" ::: "memory")
#define PG8_BAR __builtin_amdgcn_s_barrier()
#define PG8_SCHED __builtin_amdgcn_sched_barrier(0)
    Unit cur, nxt; int ui = 0;
    if (!S.next(0, cur)) return;
    f32x4 acc[2][2][4][2];
#pragma unroll
    for (int a = 0; a < 2; ++a)
#pragma unroll
        for (int b = 0; b < 2; ++b)
#pragma unroll
            for (int m = 0; m < 4; ++m)
#pragma unroll
                for (int n = 0; n < 2; ++n) acc[a][b][m][n] = (f32x4){0.f, 0.f, 0.f, 0.f};
    bf16x8 At[4][2], B0[2][2], B1[2][2];
    const char* cA = (const char*)g.A + (size_t)cur.pm * tstep; const char* cB = (const char*)g.Bt + (size_t)cur.pn * tstep;
    S.a_ready(cur);
    PG8_STAGE(PG8_SB(0, 0), cB, voffB); PG8_STAGE(PG8_SA(0, 0), cA, voffA); PG8_STAGE(PG8_SB(0, 1), cB + hstep, voffB); PG8_STAGE(PG8_SA(0, 1), cA + hstep, voffA);
    if (wr == 1) PG8_BAR;
    PG8_WAIT_V(4); PG8_BAR;
    PG8_STAGE(PG8_SB(1, 0), cB + kstep, voffB); PG8_STAGE(PG8_SA(1, 0), cA + kstep, voffA); PG8_STAGE(PG8_SB(1, 1), cB + hstep + kstep, voffB);
    PG8_WAIT_V(6); PG8_BAR;
    PG8_STAMP();
    for (;;) {
        const bool has_next = S.next(ui + 1, nxt);
        const char* nA = has_next ? (const char*)g.A + (size_t)nxt.pm * tstep : cA; const char* nB = has_next ? (const char*)g.Bt + (size_t)nxt.pn * tstep : cB;
        for (int t = 0; t < nt; t += 2) {
            if constexpr (Epi::MIDK) { if (t == 8 || t == 16) E.mid(acc, cur, t, wr, wc, fr, fq); }
            const bool last = (t == nt - 2);
            const char* a1 = cA + (size_t)(t + 1) * kstep;
            const char* a2 = last ? nA : cA + (size_t)(t + 2) * kstep; const char* b2 = last ? nB : cB + (size_t)(t + 2) * kstep;
            const char* a3 = a2 + kstep; const char* b3 = b2 + kstep;
            if (last && has_next) S.a_ready(nxt);
            PG8_LDB(B0, 0, 0); PG8_SCHED; PG8_LDA(At, 0, 0); PG8_STAGE(PG8_SA(1, 1), a1 + hstep, voffA);
            PG8_WAIT_L(8); PG8_BAR; PG8_WAIT_L(0); PG8_MMA(0, 0, At, B0); PG8_BAR; PG8_SCHED;
            PG8_LDB(B1, 0, 1); PG8_STAGE(PG8_SB(0, 0), b2, voffB);
            PG8_BAR; PG8_WAIT_L(0); PG8_MMA(0, 1, At, B1); PG8_BAR;
            PG8_LDA(At, 0, 1); PG8_STAGE(PG8_SA(0, 0), a2, voffA);
            PG8_BAR; PG8_WAIT_L(0); PG8_MMA(1, 0, At, B0); PG8_BAR; PG8_SCHED;
            PG8_STAGE(PG8_SB(0, 1), b2 + hstep, voffB);
            PG8_WAIT_V(6); PG8_BAR; PG8_MMA(1, 1, At, B1); PG8_BAR;
            PG8_LDB(B0, 1, 0); PG8_SCHED; PG8_LDA(At, 1, 0); PG8_STAGE(PG8_SA(0, 1), a2 + hstep, voffA);
            PG8_WAIT_L(8); PG8_BAR; PG8_WAIT_L(0); PG8_MMA(0, 0, At, B0); PG8_BAR; PG8_SCHED;
            PG8_LDB(B1, 1, 1); PG8_STAGE(PG8_SB(1, 0), b3, voffB);
            PG8_BAR; PG8_WAIT_L(0); PG8_MMA(0, 1, At, B1); PG8_BAR;
            PG8_LDA(At, 1, 1); PG8_STAGE(PG8_SA(1, 0), a3, voffA);
            PG8_BAR; PG8_WAIT_L(0); PG8_MMA(1, 0, At, B0); PG8_BAR; PG8_SCHED;
            PG8_STAGE(PG8_SB(1, 1), b3 + hstep, voffB);
            PG8_WAIT_V(6); PG8_BAR; PG8_MMA(1, 1, At, B1); PG8_BAR;
        }
        PG8_STAMP();
        if constexpr (!Epi::AFTER_DRAIN) { E(acc, cur, wr, wc, fr, fq); S.done(cur); }
        PG8_STAMP();
        if (!has_next) break;
#pragma unroll
        for (int a = 0; a < 2; ++a)
#pragma unroll
            for (int b = 0; b < 2; ++b)
#pragma unroll
                for (int m = 0; m < 4; ++m)
#pragma unroll
                    for (int n = 0; n < 2; ++n) acc[a][b][m][n] = (f32x4){0.f, 0.f, 0.f, 0.f};
        cur = nxt; cA = nA; cB = nB; ++ui;
    }
    PG8_WAIT_V(0);
    if (wr == 0) PG8_BAR;
    PG8_BAR;
    if constexpr (Epi::AFTER_DRAIN) { E.fused(acc, cur, wr, wc, fr, fq, lds, wid, lane); S.done(cur); }
    PG8_STAMP();
    if (STAMP && wid == 0) { stamps[lane] = lane < nts ? (((unsigned long long)(unsigned)ts_hi << 32) | (unsigned)ts_lo) : 0ull;
        if (lane == 62) stamps[62] = rt_entry; if (lane == 63) stamps[63] = (unsigned long long)wall_clock64(); }
#undef PG8_STAMP
#undef PG8_SA
#undef PG8_SB
#undef PG8_STAGE
#undef PG8_LDA
#undef PG8_LDB
#undef PG8_MMA
#undef PG8_WAIT_V
#undef PG8_WAIT_L
#undef PG8_BAR
#undef PG8_SCHED
}
}
typedef pg8::bf16_t bf16_t;
typedef pg8::f32x4 f32x4;
typedef pg8::u32x4 u32x4;
typedef pg8::bf16x8 bf16x8;
typedef unsigned u32x2 __attribute__((ext_vector_type(2)));
#define LAS __attribute__((address_space(3)))
constexpr int MTOK = 65536, DM = 1024, NIN = 6144, DFF = 2816, NUP = 5632, SEQ = 8192, NBR = 1536, NPA = 3072;
constexpr int MH = MTOK / 2;
constexpr float EPS = 1e-6f;
constexpr size_t WS_WIN = 0;
constexpr size_t WS_WBR = WS_WIN + (size_t)NIN * DM * 2;
constexpr size_t WS_WO = WS_WBR + (size_t)DM * NBR * 2;
constexpr size_t WS_WUP = WS_WO + (size_t)DM * DM * 2;
constexpr size_t WS_WDN = WS_WUP + (size_t)NUP * DM * 2;
constexpr size_t WS_SSQ = WS_WDN + (size_t)DM * DFF * 2;
constexpr size_t WS_XB = WS_SSQ + (size_t)MTOK * 16 * 4;
constexpr size_t WS_B1 = WS_XB + (size_t)MTOK * NBR * 2;
constexpr size_t WS_B2 = WS_B1 + (size_t)MTOK * NPA * 2;
constexpr size_t WS_END = WS_B2 + (size_t)MTOK * NPA * 2;

__device__ __forceinline__ int otid() { int t = threadIdx.x; asm volatile("" : "+v"(t)); return t; }
__device__ __forceinline__ int obid() { int b = blockIdx.x; asm volatile("" : "+s"(b)); return b; }
struct Params {
    const float* in[19];
    float* out; unsigned char* ws;
};

__device__ __forceinline__ void st_nt16(void* p, u32x4 w) { __builtin_nontemporal_store(w, (u32x4*)p); }
__device__ __forceinline__ float bflo(unsigned w) { return __uint_as_float(w << 16); }
__device__ __forceinline__ float bfhi(unsigned w) { return __uint_as_float(w & 0xffff0000u); }
__device__ __forceinline__ unsigned pk(float a, float b) { return pg8::cvt_pk_bf16(a, b); }
__device__ __forceinline__ float fast_rcp(float x) { return __builtin_amdgcn_rcpf(x); }
__device__ __forceinline__ float gate_t(float x) { return 1.0f + __builtin_amdgcn_exp2f(fminf(x * -1.44269504f, 43.28f)); }
__device__ __forceinline__ float gelu_tanh_f(float x) {
    const float z2 = 1.5957691216f * (x + 0.044715f * x * x * x);
    return x * fast_rcp(1.0f + __expf(-z2));
}
__device__ __forceinline__ float silu_f(float x) { return x * fast_rcp(1.0f + __expf(-x)); }
__device__ __forceinline__ float row_rstd(const float* ssq, int r) {
    const f32x4* p = (const f32x4*)(ssq + (size_t)r * 16);
    const f32x4 a = p[0], b = p[1], c = p[2], d = p[3];
    const float s = ((a[0] + a[1]) + (a[2] + a[3])) + ((b[0] + b[1]) + (b[2] + b[3])) + ((c[0] + c[1]) + (c[2] + c[3])) + ((d[0] + d[1]) + (d[2] + d[3]));
    return rsqrtf(s * (1.0f / 1024.0f) + EPS);
}

__device__ __forceinline__ void rows_rstd8(const float* ssq, int row0, int fq, float (&rs)[8]) {
    f32x4 v[8];
#pragma unroll
    for (int i = 0; i < 8; ++i) v[i] = *(const f32x4*)(ssq + (size_t)(row0 + (i >> 2) * 128 + (i & 3) * 16) * 16 + fq * 4);
#pragma unroll
    for (int i = 0; i < 8; ++i) {
        float s = (v[i][0] + v[i][1]) + (v[i][2] + v[i][3]);
        s += __shfl_xor(s, 16); s += __shfl_xor(s, 32);
        rs[i] = rsqrtf(s * (1.0f / 1024.0f) + EPS);
    }
}
struct EpiIn {
    static constexpr bool PERM = true, AFTER_DRAIN = false, MIDK = false;
    bf16_t* PA; bf16_t* G; const float* ssq;
    __device__ __forceinline__ void operator()(const f32x4 (&acc)[2][2][4][2], const pg8::Unit& u, int wr, int wc, int fr, int fq) const {
        const int colt = u.pn * 256;
        const int act = (colt >= NPA) ? 2 : ((colt >= 512 && colt < 1536) ? 1 : 0);
        bf16_t* base = (colt >= NPA) ? G : PA;
        const int col0 = (colt >= NPA ? colt - NPA : colt) + wc * 32 + 8 * fq;
        const int row0 = u.pm * 256 + wr * 64 + fr;
        float rs8[8]; rows_rstd8(ssq, row0, fq, rs8);
#pragma unroll
        for (int ai = 0; ai < 2; ++ai)
#pragma unroll
            for (int m = 0; m < 4; ++m) {
                const int r = row0 + ai * 128 + m * 16;
                const float rs = rs8[ai * 4 + m];
                bf16_t* rowp = base + (size_t)r * NPA + col0;
#pragma unroll
                for (int bj = 0; bj < 2; ++bj) {
                    float v[8];
#pragma unroll
                    for (int j = 0; j < 4; ++j) { v[j] = acc[ai][bj][m][0][j] * rs; v[4 + j] = acc[ai][bj][m][1][j] * rs; }
                    if (act == 1) {
#pragma unroll
                        for (int j = 0; j < 8; ++j) v[j] = gelu_tanh_f(v[j]);
                    } else if (act == 2) {
#pragma unroll
                        for (int j = 0; j < 8; ++j) v[j] = gate_t(v[j]);
                    }
                    u32x4 w; w.x = pk(v[0], v[1]); w.y = pk(v[2], v[3]); w.z = pk(v[4], v[5]); w.w = pk(v[6], v[7]);
                    st_nt16(rowp + bj * 128, w);
                }
            }
    }
};
struct EpiBr {
    static constexpr bool PERM = true, AFTER_DRAIN = false, MIDK = true;
    const bf16_t* G; bf16_t* out;
    __device__ __forceinline__ void mid(f32x4 (&acc)[2][2][4][2], const pg8::Unit& u, int t, int wr, int wc, int fr, int fq) const {
        const int seg = (t == 8) ? 0 : 1024;
        int col0 = u.pn * 256 + wc * 32 + 8 * fq + seg;
        int row0 = u.pm * 256 + wr * 64 + fr;
        asm volatile("" : "+v"(col0), "+v"(row0));
#pragma unroll
        for (int ai = 0; ai < 2; ++ai)
#pragma unroll
            for (int m = 0; m < 4; ++m) {
                const bf16_t* rowp = G + (size_t)(row0 + ai * 128 + m * 16) * NPA + col0;
#pragma unroll
                for (int bj = 0; bj < 2; ++bj) {
                    const u32x4 nu = *(const u32x4*)(rowp + bj * 128), de = *(const u32x4*)(rowp + bj * 128 + 1024);
                    const unsigned nw[4] = {nu.x, nu.y, nu.z, nu.w}, dw[4] = {de.x, de.y, de.z, de.w};
#pragma unroll
                    for (int q = 0; q < 4; ++q) {
                        const float r0 = bflo(dw[q]) * fast_rcp(bflo(nw[q])), r1 = bfhi(dw[q]) * fast_rcp(bfhi(nw[q]));
                        acc[ai][bj][m][q >> 1][(q & 1) * 2] *= r0; acc[ai][bj][m][q >> 1][(q & 1) * 2 + 1] *= r1;
                    }
                }
                if (m & 1) asm volatile("" ::: "memory");
            }
    }
    __device__ __forceinline__ void operator()(const f32x4 (&acc)[2][2][4][2], const pg8::Unit& u, int wr, int wc, int fr, int fq) const {
        const int col0 = u.pn * 256 + wc * 32 + 8 * fq;
        const int row0 = u.pm * 256 + wr * 64 + fr;
        u32x4 sg[2][4][2];
#pragma unroll
        for (int ai = 0; ai < 2; ++ai)
#pragma unroll
            for (int m = 0; m < 4; ++m)
#pragma unroll
                for (int bj = 0; bj < 2; ++bj) sg[ai][m][bj] = *(const u32x4*)(G + (size_t)(row0 + ai * 128 + m * 16) * NPA + 2048 + col0 + bj * 128);
#pragma unroll
        for (int ai = 0; ai < 2; ++ai)
#pragma unroll
            for (int m = 0; m < 4; ++m) {
                const int r = row0 + ai * 128 + m * 16;
                bf16_t* op = out + (size_t)r * DM + col0;
#pragma unroll
                for (int bj = 0; bj < 2; ++bj) {
                    const u32x4 s = sg[ai][m][bj];
                    const f32x4 a0 = acc[ai][bj][m][0], a1 = acc[ai][bj][m][1];
                    u32x4 w;
                    w.x = pk(a0[0] * fast_rcp(bflo(s.x)), a0[1] * fast_rcp(bfhi(s.x))); w.y = pk(a0[2] * fast_rcp(bflo(s.y)), a0[3] * fast_rcp(bfhi(s.y)));
                    w.z = pk(a1[0] * fast_rcp(bflo(s.z)), a1[1] * fast_rcp(bfhi(s.z))); w.w = pk(a1[2] * fast_rcp(bflo(s.w)), a1[3] * fast_rcp(bfhi(s.w)));
                    *(u32x4*)(op + bj * 128) = w;
                }
            }
    }
};
struct EpiRes {
    static constexpr bool PERM = true, AFTER_DRAIN = false, MIDK = false;
    bf16_t* xb; float* ssq;
    __device__ __forceinline__ void operator()(const f32x4 (&acc)[2][2][4][2], const pg8::Unit& u, int wr, int wc, int fr, int fq) const {
        const int col0 = u.pn * 256 + wc * 32 + 8 * fq;
        const int row0 = u.pm * 256 + wr * 64 + fr;
#pragma unroll
        for (int ai = 0; ai < 2; ++ai) {
            u32x4 bb[4][2];
#pragma unroll
            for (int m = 0; m < 4; ++m)
#pragma unroll
                for (int bj = 0; bj < 2; ++bj) bb[m][bj] = *(const u32x4*)(xb + (size_t)(row0 + ai * 128 + m * 16) * DM + col0 + bj * 128);
            asm volatile("" ::: "memory");
#pragma unroll
            for (int m = 0; m < 4; ++m) {
                const int r = row0 + ai * 128 + m * 16;
                float sq = 0.f;
#pragma unroll
                for (int bj = 0; bj < 2; ++bj) {
                    const u32x4 s = bb[m][bj];
                    const f32x4 a0 = acc[ai][bj][m][0], a1 = acc[ai][bj][m][1];
                    const float o0 = bflo(s.x) + a0[0], o1 = bfhi(s.x) + a0[1], o2 = bflo(s.y) + a0[2], o3 = bfhi(s.y) + a0[3];
                    const float o4 = bflo(s.z) + a1[0], o5 = bfhi(s.z) + a1[1], o6 = bflo(s.w) + a1[2], o7 = bfhi(s.w) + a1[3];
                    u32x4 w; w.x = pk(o0, o1); w.y = pk(o2, o3); w.z = pk(o4, o5); w.w = pk(o6, o7);
                    *(u32x4*)(xb + (size_t)r * DM + col0 + bj * 128) = w;
                    sq += (o0 * o0 + o1 * o1) + (o2 * o2 + o3 * o3) + (o4 * o4 + o5 * o5) + (o6 * o6 + o7 * o7);
                }
                sq += __shfl_xor(sq, 16); sq += __shfl_xor(sq, 32);
                if (fq == 0) ssq[(size_t)r * 16 + u.pn * 4 + wc] = sq;
            }
            asm volatile("" ::: "memory");
        }
    }
};
__device__ __forceinline__ float dpp_ror1(float x) { return __int_as_float(__builtin_amdgcn_update_dpp(0, __float_as_int(x), 0x121, 0xf, 0xf, false)); }
__device__ __forceinline__ float dpp_ror2(float x) { return __int_as_float(__builtin_amdgcn_update_dpp(0, __float_as_int(x), 0x122, 0xf, 0xf, false)); }
__device__ __forceinline__ float dpp_shr1(float old, float x) { return __int_as_float(__builtin_amdgcn_update_dpp(__float_as_int(old), __float_as_int(x), 0x111, 0xf, 0xf, false)); }
__device__ __forceinline__ float dpp_shr2(float old, float x) { return __int_as_float(__builtin_amdgcn_update_dpp(__float_as_int(old), __float_as_int(x), 0x112, 0xf, 0xf, false)); }
struct EpiUp {
    static constexpr bool PERM = true, AFTER_DRAIN = false, MIDK = false;
    bf16_t* act; bf16_t* zs; const float* ssq; const float* cw; const float* cb;
    __device__ __forceinline__ void operator()(const f32x4 (&acc)[2][2][4][2], const pg8::Unit& u, int wr, int wc, int fr, int fq) const {
        const int c0 = u.pn * 128 + wc * 32 + 8 * fq;
        const int row0 = u.pm * 256 + wr * 64 + fr;
        float rs8[8]; rows_rstd8(ssq, row0, fq, rs8);
        u32x2 keep[2][4];
#pragma unroll
        for (int n = 0; n < 2; ++n) {
            const int c = c0 + 4 * n;
            const f32x4 gw0 = *(const f32x4*)(cw + c), gw1 = *(const f32x4*)(cw + NUP + c), gw2 = *(const f32x4*)(cw + 2 * NUP + c), gb = *(const f32x4*)(cb + c);
            const f32x4 vw0 = *(const f32x4*)(cw + DFF + c), vw1 = *(const f32x4*)(cw + NUP + DFF + c), vw2 = *(const f32x4*)(cw + 2 * NUP + DFF + c), vb = *(const f32x4*)(cb + DFF + c);
#pragma unroll
            for (int ai = 0; ai < 2; ++ai) {
                f32x4 pg = {0.f, 0.f, 0.f, 0.f}, pv = {0.f, 0.f, 0.f, 0.f};
                const int blk = u.pm * 4 + ai * 2 + wr;
#pragma unroll
                for (int m = 0; m < 4; ++m) {
                    const float rs = rs8[ai * 4 + m];
                    const f32x4 zg = acc[ai][0][m][n] * rs, zv = acc[ai][1][m][n] * rs;
                    float o[4];
#pragma unroll
                    for (int j = 0; j < 4; ++j) {
                        const float g1 = dpp_shr1(dpp_ror1(pg[j]), zg[j]), g2 = dpp_shr2(dpp_ror2(pg[j]), zg[j]);
                        const float v1 = dpp_shr1(dpp_ror1(pv[j]), zv[j]), v2 = dpp_shr2(dpp_ror2(pv[j]), zv[j]);
                        const float gg = gw2[j] * zg[j] + gw1[j] * g1 + gw0[j] * g2 + gb[j];
                        const float vv = vw2[j] * zv[j] + vw1[j] * v1 + vw0[j] * v2 + vb[j];
                        o[j] = silu_f(gg) * vv;
                    }
                    u32x2 w; w.x = pk(o[0], o[1]); w.y = pk(o[2], o[3]);
                    const int r = row0 + ai * 128 + m * 16;
                    if (n == 0) keep[ai][m] = w;
                    else if (!(m == 0 && fr < 2)) { u32x4 ww; ww.x = keep[ai][m].x; ww.y = keep[ai][m].y; ww.z = w.x; ww.w = w.y; st_nt16(act + (size_t)r * DFF + c0, ww); }
                    if (m == 0 && fr < 2) {
                        bf16_t* zp = zs + ((size_t)blk * 4 + 2 + fr) * NUP + c;
                        u32x2 a; a.x = pk(zg[0], zg[1]); a.y = pk(zg[2], zg[3]); *(u32x2*)zp = a;
                        u32x2 d; d.x = pk(zv[0], zv[1]); d.y = pk(zv[2], zv[3]); *(u32x2*)(zp + DFF) = d;
                    }
                    if (m == 3 && fr >= 14) {
                        bf16_t* zp = zs + ((size_t)blk * 4 + (fr - 14)) * NUP + c;
                        u32x2 a; a.x = pk(zg[0], zg[1]); a.y = pk(zg[2], zg[3]); *(u32x2*)zp = a;
                        u32x2 d; d.x = pk(zv[0], zv[1]); d.y = pk(zv[2], zv[3]); *(u32x2*)(zp + DFF) = d;
                    }
                    pg = zg; pv = zv;
                }
            }
        }
    }
};

__device__ __forceinline__ void transpose_tile(const float* __restrict__ W, int N, const float* __restrict__ g, bf16_t* __restrict__ Wt, int ldt, int koff, int k0, int n0, int nd0, float* tile, int tid) {
    {
        const int kk = tid >> 4, nn = (tid & 15) * 4;
#pragma unroll
        for (int h = 0; h < 2; ++h) {
            const int k = kk + h * 32;
            f32x4 v = *(const f32x4*)(W + (size_t)(k0 + k) * N + n0 + nn);
            const float s = g ? g[k0 + k] : 1.0f;
            tile[k * 65 + nn + 0] = v[0] * s; tile[k * 65 + nn + 1] = v[1] * s; tile[k * 65 + nn + 2] = v[2] * s; tile[k * 65 + nn + 3] = v[3] * s;
        }
    }
    __syncthreads();
    {
        const int n = tid >> 3, kq = (tid & 7) * 8;
        float v[8];
#pragma unroll
        for (int j = 0; j < 8; ++j) v[j] = tile[(kq + j) * 65 + n];
        u32x4 w; w.x = pk(v[0], v[1]); w.y = pk(v[2], v[3]); w.z = pk(v[4], v[5]); w.w = pk(v[6], v[7]);
        *(u32x4*)(Wt + (size_t)(nd0 + n) * ldt + koff + k0 + kq) = w;
    }
    __syncthreads();
}

__device__ __forceinline__ void prep_phase(const Params& p, int l, float* ldsf) {
    unsigned char* ws = p.ws;
    bf16_t* wt_in = (bf16_t*)(ws + WS_WIN); bf16_t* wt_br = (bf16_t*)(ws + WS_WBR); bf16_t* wt_o = (bf16_t*)(ws + WS_WO);
    bf16_t* wt_up = (bf16_t*)(ws + WS_WUP); bf16_t* wt_dn = (bf16_t*)(ws + WS_WDN);
    const float* g_mix = p.in[1] + (size_t)l * DM; const float* w_in = p.in[2] + (size_t)l * DM * NIN;
    const float* w_pool = p.in[3] + (size_t)l * 4 * 128 * 128; const float* pscale = p.in[4] + (size_t)l * 512;
    const float* w_ba = p.in[9] + (size_t)l * 512 * DM; const float* w_bb = p.in[10] + (size_t)l * 512 * DM; const float* w_bc = p.in[11] + (size_t)l * 512 * DM;
    const float* w_o = p.in[12] + (size_t)l * DM * DM; const float* g_ffn = p.in[13] + (size_t)l * DM;
    const float* w_up = p.in[14] + (size_t)l * DM * NUP; const float* w_dn = p.in[17] + (size_t)l * DFF * DM;
    const int tid = otid(), bid = obid();
    constexpr int T0 = 16 * 96, T1 = T0 + 128, T2 = T1 + 128, T3 = T2 + 256, T4 = T3 + 16 * 88, T5 = T4 + 44 * 16;
    for (int i = bid; i < T5; i += gridDim.x) {
        if (i < T0) { const int kt = i & 15, nt = i >> 4; transpose_tile(w_in, NIN, g_mix, wt_in, DM, 0, kt * 64, nt * 64, nt * 64, ldsf, tid); }
        else if (i < T1) { const int j = i - T0, kt = j & 7, nt = j >> 3; transpose_tile(w_bb, DM, nullptr, wt_br, NBR, 512, kt * 64, nt * 64, nt * 64, ldsf, tid); }
        else if (i < T2) { const int j = i - T1, kt = j & 7, nt = j >> 3; transpose_tile(w_bc, DM, nullptr, wt_br, NBR, 1024, kt * 64, nt * 64, nt * 64, ldsf, tid); }
        else if (i < T3) { const int j = i - T2, kt = j & 15, nt = j >> 4; transpose_tile(w_o, DM, nullptr, wt_o, DM, 0, kt * 64, nt * 64, nt * 64, ldsf, tid); }
        else if (i < T4) { const int j = i - T3, kt = j & 15, nt = j >> 4; const int n0 = nt * 64, bj = n0 / DFF, q0 = n0 - bj * DFF; transpose_tile(w_up, NUP, g_ffn, wt_up, DM, 0, kt * 64, n0, (q0 >> 7) * 256 + bj * 128 + (q0 & 127), ldsf, tid);   }
        else { const int j = i - T4, kt = j % 44, nt = j / 44; transpose_tile(w_dn, DM, nullptr, wt_dn, DFF, 0, kt * 64, nt * 64, nt * 64, ldsf, tid); }
    }
    {
        float* wpT = ldsf;
        float* wa = ldsf + 128 * 128;
        for (int it = (int)gridDim.x - 1 - bid; it < 64; it += gridDim.x) {
            const int g = it >> 4, n0 = (it & 15) * 64;
            for (int q = tid; q < 128 * 32; q += 512) {
                const int d = q >> 5, e4 = (q & 31) * 4;
                const f32x4 v = *(const f32x4*)(w_pool + ((size_t)g * 128 + d) * 128 + e4);
                const f32x4 s = *(const f32x4*)(pscale + g * 128 + e4);
                wpT[(e4 + 0) * 128 + d] = v[0] * s[0]; wpT[(e4 + 1) * 128 + d] = v[1] * s[1]; wpT[(e4 + 2) * 128 + d] = v[2] * s[2]; wpT[(e4 + 3) * 128 + d] = v[3] * s[3];
            }
            for (int q = tid; q < 128 * 16; q += 512) {
                const int e = q >> 4, c4 = (q & 15) * 4;
                *(f32x4*)(wa + e * 64 + c4) = *(const f32x4*)(w_ba + (size_t)(g * 128 + e) * DM + n0 + c4);
            }
            __syncthreads();
            const int d = tid & 127, ns = tid >> 7;
            float acc[16];
#pragma unroll
            for (int i = 0; i < 16; ++i) acc[i] = 0.f;
            for (int e = 0; e < 128; ++e) {
                const float w = wpT[e * 128 + d];
                const f32x4* wr4 = (const f32x4*)(wa + e * 64 + ns * 16);
#pragma unroll
                for (int c = 0; c < 4; ++c) { const f32x4 b = wr4[c]; acc[c * 4 + 0] += w * b[0]; acc[c * 4 + 1] += w * b[1]; acc[c * 4 + 2] += w * b[2]; acc[c * 4 + 3] += w * b[3]; }
            }
#pragma unroll
            for (int i = 0; i < 16; ++i) wt_br[(size_t)(n0 + ns * 16 + i) * NBR + g * 128 + d] = (bf16_t)(pk(acc[i], 0.f) & 0xffffu);
            __syncthreads();
        }
    }
    if (l == 0) {
        const float* x = p.in[0]; bf16_t* xb = (bf16_t*)(ws + WS_XB); float* ssq = (float*)(ws + WS_SSQ);
        const int lane = tid & 63, wave = tid >> 6;
        for (int r = bid * 8 + wave; r < MTOK; r += gridDim.x * 8) {
            float sq = 0.f;
#pragma unroll
            for (int i = 0; i < 4; ++i) {
                const f32x4 v = *(const f32x4*)(x + (size_t)r * DM + i * 256 + lane * 4);
                sq += (v[0] * v[0] + v[1] * v[1]) + (v[2] * v[2] + v[3] * v[3]);
                u32x2 w; w.x = pk(v[0], v[1]); w.y = pk(v[2], v[3]);
                *(u32x2*)(xb + (size_t)r * DM + i * 256 + lane * 4) = w;
            }
#pragma unroll
            for (int o = 32; o >= 1; o >>= 1) sq += __shfl_xor(sq, o);
            if (lane < 16) ssq[(size_t)r * 16 + lane] = (lane == 0) ? sq : 0.f;
        }
    }
}
__device__ __forceinline__ void ld8(const bf16_t* p, float (&v)[8]) {
    const u32x4 w = *(const u32x4*)p;
    v[0] = bflo(w.x); v[1] = bfhi(w.x); v[2] = bflo(w.y); v[3] = bfhi(w.y); v[4] = bflo(w.z); v[5] = bfhi(w.z); v[6] = bflo(w.w); v[7] = bfhi(w.w);
}
__device__ __forceinline__ void st8(bf16_t* p, const float (&v)[8]) {
    u32x4 w; w.x = pk(v[0], v[1]); w.y = pk(v[2], v[3]); w.z = pk(v[4], v[5]); w.w = pk(v[6], v[7]);
    *(u32x4*)p = w;
}
constexpr int VT_PITCH = 136;
__device__ __forceinline__ void mixer_phase(const Params& p, int l, unsigned char* lds) {
    const bf16_t* PA = (const bf16_t*)(p.ws + WS_B1);
    bf16_t* Y = (bf16_t*)p.out;
    const float* g_sgu = p.in[5] + (size_t)l * 512;
    const float* w_sp = p.in[6] + (size_t)l * 4 * 128 * 128;
    const float* b_sp = p.in[7] + (size_t)l * 4 * 128;
    const float* conv_c = p.in[8] + (size_t)l * 3 * 512;
    float* rs = (float*)lds;
    bf16_t* vT = (bf16_t*)(lds + 1024);
    const int tid = otid(), lane = tid & 63, wave = tid >> 6, fr = lane & 15, fq = lane >> 4;
    for (int item = obid(); item < MTOK / 128; item += gridDim.x) {
        const int t0 = item * 128, pos0 = t0 & (SEQ - 1);
        {
            const int row = tid >> 2, q = tid & 3;
            const bf16_t* vp = PA + (size_t)(t0 + row) * NPA + 1024 + q * 128;
            float sq = 0.f;
#pragma unroll
            for (int i = 0; i < 16; ++i) { float v[8]; ld8(vp + i * 8, v);
#pragma unroll
                for (int j = 0; j < 8; ++j) sq += v[j] * v[j]; }
            sq += __shfl_xor(sq, 1); sq += __shfl_xor(sq, 2);
            if (q == 0) rs[row] = rsqrtf(sq * (1.0f / 512.0f) + EPS);
        }
        {
            const int c8 = (tid & 63) * 8, r0 = (tid >> 6) * 16;
            {
                const int w = 2 << (c8 >> 7);
                const bf16_t* ap = PA + (size_t)t0 * NPA + c8;
                bf16_t* yp = Y + (size_t)t0 * NBR + c8;
                float s[8];
#pragma unroll
                for (int j = 0; j < 8; ++j) s[j] = 0.f;
                for (int k = 1; k < w; ++k) { const int rr = r0 - k; if (pos0 + rr >= 0) { float v[8]; ld8(ap + (ptrdiff_t)rr * NPA, v);
#pragma unroll
                        for (int j = 0; j < 8; ++j) s[j] += v[j]; } }
                for (int i = 0; i < 16; ++i) {
                    const int rr = r0 + i; float v[8]; ld8(ap + (ptrdiff_t)rr * NPA, v);
                    const int pos = pos0 + rr; const float inv = 1.0f / (float)(pos + 1 < w ? pos + 1 : w);
                    float o[8];
#pragma unroll
                    for (int j = 0; j < 8; ++j) { s[j] += v[j]; o[j] = s[j] * inv - v[j]; }
                    st8(yp + (size_t)rr * NBR, o);
                    const int ro = rr - w + 1;
                    if (pos0 + ro >= 0) { float q[8]; ld8(ap + (ptrdiff_t)ro * NPA, q);
#pragma unroll
                        for (int j = 0; j < 8; ++j) s[j] -= q[j]; }
                }
            }
            {
                const bf16_t* bp = PA + (size_t)t0 * NPA + 1536 + c8;
                bf16_t* yp = Y + (size_t)t0 * NBR + 1024 + c8;
                float w0[8], w1[8], w2[8], z1[8], z2[8];
#pragma unroll
                for (int j = 0; j < 8; ++j) { w0[j] = conv_c[c8 + j]; w1[j] = conv_c[512 + c8 + j]; w2[j] = conv_c[1024 + c8 + j]; z1[j] = 0.f; z2[j] = 0.f; }
                if (pos0 + r0 - 2 >= 0) { float a[8], b[8]; ld8(bp + (ptrdiff_t)(r0 - 2) * NPA + 512, a); ld8(bp + (ptrdiff_t)(r0 - 2) * NPA + 1024, b);
#pragma unroll
                    for (int j = 0; j < 8; ++j) z2[j] = a[j] * b[j]; }
                if (pos0 + r0 - 1 >= 0) { float a[8], b[8]; ld8(bp + (ptrdiff_t)(r0 - 1) * NPA + 512, a); ld8(bp + (ptrdiff_t)(r0 - 1) * NPA + 1024, b);
#pragma unroll
                    for (int j = 0; j < 8; ++j) z1[j] = a[j] * b[j]; }
                for (int i = 0; i < 16; ++i) {
                    const int rr = r0 + i; float cb[8], a[8], b[8], o[8];
                    ld8(bp + (size_t)rr * NPA, cb); ld8(bp + (size_t)rr * NPA + 512, a); ld8(bp + (size_t)rr * NPA + 1024, b);
#pragma unroll
                    for (int j = 0; j < 8; ++j) { const float z = a[j] * b[j]; o[j] = cb[j] * (w0[j] * z2[j] + w1[j] * z1[j] + w2[j] * z); z2[j] = z1[j]; z1[j] = z; }
                    st8(yp + (size_t)rr * NBR, o);
                }
            }
        }
        for (int g = 0; g < 4; ++g) {
            __syncthreads();
            {
                const int s = tid >> 2, dq = (tid & 3) * 32;
                const bf16_t* vp = PA + (size_t)(t0 + s) * NPA + 1024 + g * 128 + dq;
#pragma unroll
                for (int i = 0; i < 4; ++i) {
                    const u32x4 w = *(const u32x4*)(vp + i * 8);
                    const unsigned ww[4] = {w.x, w.y, w.z, w.w};
#pragma unroll
                    for (int q = 0; q < 4; ++q) { vT[(dq + i * 8 + q * 2) * VT_PITCH + s] = (bf16_t)(ww[q] & 0xffffu); vT[(dq + i * 8 + q * 2 + 1) * VT_PITCH + s] = (bf16_t)(ww[q] >> 16); }
                }
            }
            __syncthreads();
            f32x4 acc[8];
#pragma unroll
            for (int n = 0; n < 8; ++n) acc[n] = (f32x4){0.f, 0.f, 0.f, 0.f};
            const int t = wave * 16 + fr;
            const int nk = (wave >> 1) + 1;
            for (int k = 0; k < nk; ++k) {
                const int s0 = k * 32 + fq * 8;
                const float* wp = w_sp + ((size_t)g * 128 + t) * 128 + s0;
                const f32x4 wa = *(const f32x4*)wp, wb = *(const f32x4*)(wp + 4);
                const f32x4 ra = *(const f32x4*)(rs + s0), rb = *(const f32x4*)(rs + s0 + 4);
                float a[8];
#pragma unroll
                for (int j = 0; j < 4; ++j) { a[j] = (s0 + j <= t) ? wa[j] * ra[j] : 0.f; a[4 + j] = (s0 + 4 + j <= t) ? wb[j] * rb[j] : 0.f; }
                union { u32x4 u; bf16x8 h; } af; af.u.x = pk(a[0], a[1]); af.u.y = pk(a[2], a[3]); af.u.z = pk(a[4], a[5]); af.u.w = pk(a[6], a[7]);
#pragma unroll
                for (int n = 0; n < 8; ++n) {
                    const bf16x8 bfrag = *(const bf16x8*)(vT + (n * 16 + fr) * VT_PITCH + s0);
                    acc[n] = __builtin_amdgcn_mfma_f32_16x16x32_bf16(bfrag, af.h, acc[n], 0, 0, 0);
                }
            }
            const float bias = b_sp[g * 128 + t];
            const bf16_t* up = PA + (size_t)(t0 + t) * NPA + 512 + g * 128 + 4 * fq;
            bf16_t* yp = Y + (size_t)(t0 + t) * NBR + 512 + g * 128 + 4 * fq;
#pragma unroll
            for (int n = 0; n < 8; ++n) {
                const u32x2 uu = *(const u32x2*)(up + n * 16);
                const f32x4 gs = *(const f32x4*)(g_sgu + g * 128 + n * 16 + 4 * fq);
                const float o0 = bflo(uu.x) * (acc[n][0] * gs[0] + bias), o1 = bfhi(uu.x) * (acc[n][1] * gs[1] + bias);
                const float o2 = bflo(uu.y) * (acc[n][2] * gs[2] + bias), o3 = bfhi(uu.y) * (acc[n][3] * gs[3] + bias);
                u32x2 w; w.x = pk(o0, o1); w.y = pk(o2, o3);
                *(u32x2*)(yp + n * 16) = w;
            }
        }
        __syncthreads();
    }
}

__device__ __forceinline__ void ffn_fixup_phase(const Params& p, int l) {
    const bf16_t* zs = (const bf16_t*)(p.ws + WS_B2);
    bf16_t* act = (bf16_t*)(p.ws + WS_B1);
    const float* cw = p.in[15] + (size_t)l * 3 * NUP; const float* cb = p.in[16] + (size_t)l * NUP;
    constexpr int NCG = DFF / 8, NU = (MTOK / 64) * NCG;
    for (int u = obid() * 512 + otid(); u < NU; u += gridDim.x * 512) {
        const int blk = u / NCG, c8 = (u - blk * NCG) * 8;
        const bool first = ((blk * 64) & (SEQ - 1)) == 0;
        float g2[8], g1[8], ga[8], gb2[8], v2[8], v1[8], va[8], vb2[8];
#pragma unroll
        for (int j = 0; j < 8; ++j) { g2[j] = g1[j] = v2[j] = v1[j] = 0.f; }
        const bf16_t* own = zs + (size_t)blk * 4 * NUP + c8;
        if (!first) { const bf16_t* prv = own - 4 * (ptrdiff_t)NUP; ld8(prv, g2); ld8(prv + NUP, g1); ld8(prv + DFF, v2); ld8(prv + NUP + DFF, v1); }
        ld8(own + 2 * NUP, ga); ld8(own + 3 * NUP, gb2); ld8(own + 2 * NUP + DFF, va); ld8(own + 3 * NUP + DFF, vb2);
        float o0[8], o1[8];
#pragma unroll
        for (int j = 0; j < 8; ++j) {
            const float w0 = cw[c8 + j], w1 = cw[NUP + c8 + j], w2 = cw[2 * NUP + c8 + j], bb = cb[c8 + j];
            const float x0 = cw[DFF + c8 + j], x1 = cw[NUP + DFF + c8 + j], x2 = cw[2 * NUP + DFF + c8 + j], xb_ = cb[DFF + c8 + j];
            const float gg0 = w0 * g2[j] + w1 * g1[j] + w2 * ga[j] + bb, vv0 = x0 * v2[j] + x1 * v1[j] + x2 * va[j] + xb_;
            const float gg1 = w0 * g1[j] + w1 * ga[j] + w2 * gb2[j] + bb, vv1 = x0 * v1[j] + x1 * va[j] + x2 * vb2[j] + xb_;
            o0[j] = silu_f(gg0) * vv0; o1[j] = silu_f(gg1) * vv1;
        }
        st8(act + (size_t)(blk * 64) * DFF + c8, o0); st8(act + (size_t)(blk * 64 + 1) * DFF + c8, o1);
    }
}

__device__ __forceinline__ void final_norm_phase(const Params& p) {
    const float* gf = p.in[18]; const float* ssq = (const float*)(p.ws + WS_SSQ); const bf16_t* xb = (const bf16_t*)(p.ws + WS_XB); float* out = p.out;
    const int tid = otid(), lane = tid & 63, wave = tid >> 6;
    for (int r = obid() * 8 + wave; r < MTOK; r += gridDim.x * 8) {
        const float rs = row_rstd(ssq, r);
#pragma unroll
        for (int i = 0; i < 2; ++i) {
            const int c = i * 512 + lane * 8;
            float v[8]; ld8(xb + (size_t)r * DM + c, v);
            const f32x4 g0 = *(const f32x4*)(gf + c), g1 = *(const f32x4*)(gf + c + 4);
            f32x4 o0, o1;
#pragma unroll
            for (int j = 0; j < 4; ++j) { o0[j] = v[j] * rs * g0[j]; o1[j] = v[4 + j] * rs * g1[j]; }
            float* q = out + (size_t)r * DM + c;
            __builtin_nontemporal_store(o0, (f32x4*)q); __builtin_nontemporal_store(o1, (f32x4*)(q + 4));
        }
    }
}

template <class Epi> __device__ __forceinline__ void run_gemm(unsigned char* lds, const bf16_t* A, const bf16_t* Bt, int M, int N, int K, const Epi& E, int stagger_step = 0) {
    pg8::Gemm g{A, Bt, M, N, K}; pg8::StaticOrder S; S.init(M, N, (int)gridDim.x, obid());
    if (stagger_step) {
        const unsigned long long t0 = wall_clock64(), d = (unsigned long long)(((obid() >> 3) & 7) * stagger_step);
        while (wall_clock64() - t0 < d) __builtin_amdgcn_s_sleep(16);
    }
    pg8::gemm_phase<Epi, pg8::StaticOrder, false>((PG8_LAS unsigned char*)lds, g, S, E, nullptr);
}

__global__ void __launch_bounds__(512, 2) fwd_megakernel(Params p) {
    extern __shared__ __attribute__((aligned(16))) unsigned char lds[];
    cg::grid_group grid = cg::this_grid();
    unsigned char* ws = p.ws;
    bf16_t* wt_in = (bf16_t*)(ws + WS_WIN); bf16_t* wt_br = (bf16_t*)(ws + WS_WBR); bf16_t* wt_o = (bf16_t*)(ws + WS_WO);
    bf16_t* wt_up = (bf16_t*)(ws + WS_WUP); bf16_t* wt_dn = (bf16_t*)(ws + WS_WDN);
    float* ssq = (float*)(ws + WS_SSQ); bf16_t* xb = (bf16_t*)(ws + WS_XB); bf16_t* b1 = (bf16_t*)(ws + WS_B1); bf16_t* b2 = (bf16_t*)(ws + WS_B2);
    for (int l = 0; l < 2; ++l) {
        prep_phase(p, l, (float*)lds);
        grid.sync();
        { EpiIn E{b1, b2, ssq}; run_gemm(lds, xb, wt_in, MTOK, NIN, DM, E); }
        grid.sync();
        mixer_phase(p, l, lds);
        grid.sync();
        { EpiBr E{b2, b1}; run_gemm(lds, (const bf16_t*)p.out  , wt_br, MTOK, DM, NBR, E); }
        grid.sync();
        { EpiRes E{xb, ssq}; run_gemm(lds, b1, wt_o, MTOK, DM, DM, E); }
        grid.sync();
        { EpiUp E{b1, b2, ssq, p.in[15] + (size_t)l * 3 * NUP, p.in[16] + (size_t)l * NUP}; run_gemm(lds, xb, wt_up, MTOK, NUP, DM, E); }
        grid.sync();
        ffn_fixup_phase(p, l);
        grid.sync();
        { EpiRes E{xb, ssq}; run_gemm(lds, b1, wt_dn, MTOK, DM, DFF, E); }
        grid.sync();
    }
    final_norm_phase(p);
}

extern "C" void kernel_launch(void* const* d_in, const int* in_sizes, int n_in, void* d_out, int out_size, void* d_ws, size_t ws_size, hipStream_t stream) {
    constexpr size_t kLds = pg8::STAGE_BYTES;
    static int grid_blocks = 0;
    if (!grid_blocks) {
        int dev = 0, cus = 0, per_cu = 0;
        (void)hipGetDevice(&dev);
        (void)hipDeviceGetAttribute(&cus, hipDeviceAttributeMultiprocessorCount, dev);
        (void)hipFuncSetAttribute((const void*)fwd_megakernel, hipFuncAttributeMaxDynamicSharedMemorySize, (int)kLds);
        (void)hipOccupancyMaxActiveBlocksPerMultiprocessor(&per_cu, (const void*)fwd_megakernel, 512, kLds);
        if (per_cu < 1) per_cu = 1;
        grid_blocks = cus;
        if (ws_size < WS_END || n_in != 19 || out_size != MTOK * DM) { fprintf(stderr, "kernel_launch: unexpected sizes: ws %zu (need %zu), n_in %d, out %d\n", ws_size, (size_t)WS_END, n_in, out_size); }
    }
    Params p{};
    for (int i = 0; i < 19; ++i) p.in[i] = (const float*)d_in[i];
    p.out = (float*)d_out; p.ws = (unsigned char*)d_ws;
    void* args[] = {&p};
    hipError_t e = hipLaunchCooperativeKernel((void*)fwd_megakernel, dim3(grid_blocks), dim3(512), args, kLds, stream);
    if (e != hipSuccess) fprintf(stderr, "cooperative launch failed: %s (grid %d)\n", hipGetErrorString(e), grid_blocks);
}
```

```cpp
#include <hip/hip_runtime.h>
#include <hip/hip_cooperative_groups.h>
#include <cstdio>
namespace cg = cooperative_groups;
namespace pg8 {
#define PG8_LAS __attribute__((address_space(3)))
typedef unsigned short bf16_t;
typedef short bf16x8 __attribute__((ext_vector_type(8)));
typedef float f32x4 __attribute__((ext_vector_type(4)));
typedef unsigned u32x4 __attribute__((ext_vector_type(4)));
constexpr int BM = 256, BK = 64, HALF = 128, HTB = HALF * BK * 2  , STAGE_BYTES = 8 * HTB, NXCD = 8, WGM = 8;

__host__ __device__ __forceinline__ int lds_byte(int r, int c) { const int st = (r >> 4) * 2 + (c >> 5), rr = r & 15, cc = c & 31, ob = rr * 64 + cc * 2; return st * 1024 + (ob ^ (((ob >> 9) & 1) << 5)); }
__host__ __device__ __forceinline__ void stage_rc(int b, int& R, int& C) { const int st = b / 1024, sb = b % 1024, swz = sb ^ (((sb >> 9) & 1) << 5); R = (st >> 1) * 16 + swz / 64; C = (st & 1) * 32 + (swz % 64) / 2; }
__host__ __device__ __forceinline__ int perm32(int rho) { const int n = rho >> 4, i = rho & 15; return 8 * (i >> 2) + 4 * n + (i & 3); }

struct Unit { int pm, pn; };
struct Gemm { const bf16_t* A; const bf16_t* Bt; int M, N, K; };

struct StaticOrder {
    int nM, nN, nwg, G, c;
    __host__ __device__ void init(int M, int N, int G_, int c_) { nM = M / BM; nN = N / BM; nwg = nM * nN; G = G_; c = c_; }
    __host__ __device__ bool next(int i, Unit& u) const {
        const long L = (long)i * G + c; if (L >= nwg) return false;
        int wgid = (int)L; { const int q = nwg / NXCD, r = nwg % NXCD, xcd = wgid % NXCD, off = wgid / NXCD; wgid = (xcd < r ? xcd * (q + 1) : r * (q + 1) + (xcd - r) * q) + off; }
        const int nig = WGM * nN, gid = wgid / nig, fm = gid * WGM, gsz = (nM - fm) < WGM ? (nM - fm) : WGM;
        u.pm = fm + ((wgid % nig) % gsz); u.pn = (wgid % nig) / gsz; return true;
    }
    __device__ __forceinline__ void a_ready(const Unit&) const {}
    __device__ __forceinline__ void done(const Unit&) const {}
};
__device__ __forceinline__ unsigned cvt_pk_bf16(float lo, float hi) { unsigned r; asm volatile("v_cvt_pk_bf16_f32 %0, %1, %2" : "=v"(r) : "v"(lo), "v"(hi)); return r; }

template <class Epi, class Sched, bool STAMP = false>
__device__ __forceinline__ void gemm_phase(PG8_LAS unsigned char* lds, const Gemm g, const Sched& S, const Epi& E, unsigned long long* stamps) {
    int tid_ = threadIdx.x; asm volatile("" : "+v"(tid_));
    const int tid = tid_, wid = __builtin_amdgcn_readfirstlane(tid >> 6), lane = tid & 63, wr = wid >> 2, wc = wid & 3, fr = lane & 15, fq = lane >> 4;
    const int K = g.K, nt = K / BK;
    int ts_lo = 0, ts_hi = 0, nts = 0; const unsigned long long rt_entry = STAMP ? (unsigned long long)wall_clock64() : 0ull;
#define PG8_STAMP() do { if (STAMP && wid == 0 && nts < 64) { const unsigned long long _c = (unsigned long long)clock64(); \
        ts_lo = (lane == nts) ? (int)(unsigned)_c : ts_lo; ts_hi = (lane == nts) ? (int)(unsigned)(_c >> 32) : ts_hi; ++nts; } } while (0)
    PG8_STAMP();
    unsigned voffA[2], voffB[2];
#pragma unroll
    for (int i = 0; i < 2; ++i) { int R, C; stage_rc(tid * 16 + i * 8192, R, C); const int Rb = Epi::PERM ? ((R & ~31) + perm32(R & 31)) : R;
        voffA[i] = (unsigned)(R * K + C) * 2u; voffB[i] = (unsigned)(Rb * K + C) * 2u; }
    const size_t kstep = (size_t)(BK * 2);
    const size_t hstep = (size_t)HALF * K * 2;
    const size_t tstep = 2 * hstep;
    const unsigned ldsw = (unsigned)wid * 1024u;
    const int aoff = lds_byte(wr * 64 + fr, fq * 8), boff = lds_byte(wc * 32 + fr, fq * 8);
#define PG8_SA(b, h) (((b) * 2 + (h)) * HTB)
#define PG8_SB(b, h) ((4 + (b) * 2 + (h)) * HTB)
#define PG8_STAGE(bufoff, gbase, voff) do { _Pragma("unroll") for (int _i = 0; _i < 2; ++_i) \
        __builtin_amdgcn_global_load_lds((const unsigned*)((const char*)(gbase) + (voff)[_i]), (PG8_LAS unsigned*)(lds + (bufoff) + ldsw + _i * 8192), 16, 0, 0); } while (0)
#define PG8_LDA(dst, b, h) do { _Pragma("unroll") for (int m = 0; m < 4; ++m) _Pragma("unroll") for (int k = 0; k < 2; ++k) dst[m][k] = *(const PG8_LAS bf16x8*)(lds + PG8_SA(b, h) + aoff + m * 2048 + k * 1024); } while (0)
#define PG8_LDB(dst, b, h) do { _Pragma("unroll") for (int n = 0; n < 2; ++n) _Pragma("unroll") for (int k = 0; k < 2; ++k) dst[n][k] = *(const PG8_LAS bf16x8*)(lds + PG8_SB(b, h) + boff + n * 2048 + k * 1024); } while (0)
#define PG8_MMA(ai, bj, At, Bt) do { __builtin_amdgcn_s_setprio(1); _Pragma("unroll") for (int m = 0; m < 4; ++m) _Pragma("unroll") for (int n = 0; n < 2; ++n) _Pragma("unroll") for (int k = 0; k < 2; ++k) \
        acc[ai][bj][m][n] = __builtin_amdgcn_mfma_f32_16x16x32_bf16(Bt[n][k], At[m][k], acc[ai][bj][m][n], 0, 0, 0); __builtin_amdgcn_s_setprio(0); } while (0)
#define PG8_WAIT_V(n) asm volatile("s_waitcnt vmcnt(" #n ")" ::: "memory")
#define PG8_WAIT_L(n) asm volatile("s_waitcnt lgkmcnt(" #n ")" ::: "memory")
#define PG8_BAR __builtin_amdgcn_s_barrier()
#define PG8_SCHED __builtin_amdgcn_sched_barrier(0)
    Unit cur, nxt; int ui = 0;
    if (!S.next(0, cur)) return;
    f32x4 acc[2][2][4][2];
#pragma unroll
    for (int a = 0; a < 2; ++a)
#pragma unroll
        for (int b = 0; b < 2; ++b)
#pragma unroll
            for (int m = 0; m < 4; ++m)
#pragma unroll
                for (int n = 0; n < 2; ++n) acc[a][b][m][n] = (f32x4){0.f, 0.f, 0.f, 0.f};
    bf16x8 At[4][2], B0[2][2], B1[2][2];
    const char* cA = (const char*)g.A + (size_t)cur.pm * tstep; const char* cB = (const char*)g.Bt + (size_t)cur.pn * tstep;
    S.a_ready(cur);
    PG8_STAGE(PG8_SB(0, 0), cB, voffB); PG8_STAGE(PG8_SA(0, 0), cA, voffA); PG8_STAGE(PG8_SB(0, 1), cB + hstep, voffB); PG8_STAGE(PG8_SA(0, 1), cA + hstep, voffA);
    if (wr == 1) PG8_BAR;
    PG8_WAIT_V(4); PG8_BAR;
    PG8_STAGE(PG8_SB(1, 0), cB + kstep, voffB); PG8_STAGE(PG8_SA(1, 0), cA + kstep, voffA); PG8_STAGE(PG8_SB(1, 1), cB + hstep + kstep, voffB);
    PG8_WAIT_V(6); PG8_BAR;
    PG8_STAMP();
    for (;;) {
        const bool has_next = S.next(ui + 1, nxt);
        const char* nA = has_next ? (const char*)g.A + (size_t)nxt.pm * tstep : cA; const char* nB = has_next ? (const char*)g.Bt + (size_t)nxt.pn * tstep : cB;
        for (int t = 0; t < nt; t += 2) {
            if constexpr (Epi::MIDK) { if (t == 8 || t == 16) E.mid(acc, cur, t, wr, wc, fr, fq); }
            const bool last = (t == nt - 2);
            const char* a1 = cA + (size_t)(t + 1) * kstep;
            const char* a2 = last ? nA : cA + (size_t)(t + 2) * kstep; const char* b2 = last ? nB : cB + (size_t)(t + 2) * kstep;
            const char* a3 = a2 + kstep; const char* b3 = b2 + kstep;
            if (last && has_next) S.a_ready(nxt);
            PG8_LDB(B0, 0, 0); PG8_SCHED; PG8_LDA(At, 0, 0); PG8_STAGE(PG8_SA(1, 1), a1 + hstep, voffA);
            PG8_WAIT_L(8); PG8_BAR; PG8_WAIT_L(0); PG8_MMA(0, 0, At, B0); PG8_BAR; PG8_SCHED;
            PG8_LDB(B1, 0, 1); PG8_STAGE(PG8_SB(0, 0), b2, voffB);
            PG8_BAR; PG8_WAIT_L(0); PG8_MMA(0, 1, At, B1); PG8_BAR;
            PG8_LDA(At, 0, 1); PG8_STAGE(PG8_SA(0, 0), a2, voffA);
            PG8_BAR; PG8_WAIT_L(0); PG8_MMA(1, 0, At, B0); PG8_BAR; PG8_SCHED;
            PG8_STAGE(PG8_SB(0, 1), b2 + hstep, voffB);
            PG8_WAIT_V(6); PG8_BAR; PG8_MMA(1, 1, At, B1); PG8_BAR;
            PG8_LDB(B0, 1, 0); PG8_SCHED; PG8_LDA(At, 1, 0); PG8_STAGE(PG8_SA(0, 1), a2 + hstep, voffA);
            PG8_WAIT_L(8); PG8_BAR; PG8_WAIT_L(0); PG8_MMA(0, 0, At, B0); PG8_BAR; PG8_SCHED;
            PG8_LDB(B1, 1, 1); PG8_STAGE(PG8_SB(1, 0), b3, voffB);
            PG8_BAR; PG8_WAIT_L(0); PG8_MMA(0, 1, At, B1); PG8_BAR;
            PG8_LDA(At, 1, 1); PG8_STAGE(PG8_SA(1, 0), a3, voffA);
            PG8_BAR; PG8_WAIT_L(0); PG8_MMA(1, 0, At, B0); PG8_BAR; PG8_SCHED;
            PG8_STAGE(PG8_SB(1, 1), b3 + hstep, voffB);
            PG8_WAIT_V(6); PG8_BAR; PG8_MMA(1, 1, At, B1); PG8_BAR;
        }
        PG8_STAMP();
        if constexpr (!Epi::AFTER_DRAIN) { E(acc, cur, wr, wc, fr, fq); S.done(cur); }
        PG8_STAMP();
        if (!has_next) break;
#pragma unroll
        for (int a = 0; a < 2; ++a)
#pragma unroll
            for (int b = 0; b < 2; ++b)
#pragma unroll
                for (int m = 0; m < 4; ++m)
#pragma unroll
                    for (int n = 0; n < 2; ++n) acc[a][b][m][n] = (f32x4){0.f, 0.f, 0.f, 0.f};
        cur = nxt; cA = nA; cB = nB; ++ui;
    }
    PG8_WAIT_V(0);
    if (wr == 0) PG8_BAR;
    PG8_BAR;
    if constexpr (Epi::AFTER_DRAIN) { E.fused(acc, cur, wr, wc, fr, fq, lds, wid, lane); S.done(cur); }
    PG8_STAMP();
    if (STAMP && wid == 0) { stamps[lane] = lane < nts ? (((unsigned long long)(unsigned)ts_hi << 32) | (unsigned)ts_lo) : 0ull;
        if (lane == 62) stamps[62] = rt_entry; if (lane == 63) stamps[63] = (unsigned long long)wall_clock64(); }
#undef PG8_STAMP
#undef PG8_SA
#undef PG8_SB
#undef PG8_STAGE
#undef PG8_LDA
#undef PG8_LDB
#undef PG8_MMA
#undef PG8_WAIT_V
#undef PG8_WAIT_L
#undef PG8_BAR
#undef PG8_SCHED
}
}
typedef pg8::bf16_t bf16_t;
typedef pg8::f32x4 f32x4;
typedef pg8::u32x4 u32x4;
typedef pg8::bf16x8 bf16x8;
typedef unsigned u32x2 __attribute__((ext_vector_type(2)));
#define LAS __attribute__((address_space(3)))
constexpr int MTOK = 65536, DM = 1024, NIN = 6144, DFF = 2816, NUP = 5632, SEQ = 8192, NBR = 1536, NPA = 3072;
constexpr int MH = MTOK / 2;
constexpr float EPS = 1e-6f;
constexpr size_t WS_WIN = 0;
constexpr size_t WS_WBR = WS_WIN + (size_t)NIN * DM * 2;
constexpr size_t WS_WO = WS_WBR + (size_t)DM * NBR * 2;
constexpr size_t WS_WUP = WS_WO + (size_t)DM * DM * 2;
constexpr size_t WS_WDN = WS_WUP + (size_t)NUP * DM * 2;
constexpr size_t WS_SSQ = WS_WDN + (size_t)DM * DFF * 2;
constexpr size_t WS_XB = WS_SSQ + (size_t)MTOK * 16 * 4;
constexpr size_t WS_B1 = WS_XB + (size_t)MTOK * NBR * 2;
constexpr size_t WS_B2 = WS_B1 + (size_t)MTOK * NPA * 2;
constexpr size_t WS_END = WS_B2 + (size_t)MTOK * NPA * 2;

__device__ __forceinline__ int otid() { int t = threadIdx.x; asm volatile("" : "+v"(t)); return t; }
__device__ __forceinline__ int obid() { int b = blockIdx.x; asm volatile("" : "+s"(b)); return b; }
struct Params {
    const float* in[19];
    float* out; unsigned char* ws;
};

__device__ __forceinline__ void st_nt16(void* p, u32x4 w) { __builtin_nontemporal_store(w, (u32x4*)p); }
__device__ __forceinline__ float bflo(unsigned w) { return __uint_as_float(w << 16); }
__device__ __forceinline__ float bfhi(unsigned w) { return __uint_as_float(w & 0xffff0000u); }
__device__ __forceinline__ unsigned pk(float a, float b) { return pg8::cvt_pk_bf16(a, b); }
__device__ __forceinline__ float fast_rcp(float x) { return __builtin_amdgcn_rcpf(x); }
__device__ __forceinline__ float gate_t(float x) { return 1.0f + __builtin_amdgcn_exp2f(fminf(x * -1.44269504f, 43.28f)); }
__device__ __forceinline__ float gelu_tanh_f(float x) {
    const float z2 = 1.5957691216f * (x + 0.044715f * x * x * x);
    return x * fast_rcp(1.0f + __expf(-z2));
}
__device__ __forceinline__ float silu_f(float x) { return x * fast_rcp(1.0f + __expf(-x)); }
__device__ __forceinline__ float row_rstd(const float* ssq, int r) {
    const f32x4* p = (const f32x4*)(ssq + (size_t)r * 16);
    const f32x4 a = p[0], b = p[1], c = p[2], d = p[3];
    const float s = ((a[0] + a[1]) + (a[2] + a[3])) + ((b[0] + b[1]) + (b[2] + b[3])) + ((c[0] + c[1]) + (c[2] + c[3])) + ((d[0] + d[1]) + (d[2] + d[3]));
    return rsqrtf(s * (1.0f / 1024.0f) + EPS);
}

__device__ __forceinline__ void rows_rstd8(const float* ssq, int row0, int fq, float (&rs)[8]) {
    f32x4 v[8];
#pragma unroll
    for (int i = 0; i < 8; ++i) v[i] = *(const f32x4*)(ssq + (size_t)(row0 + (i >> 2) * 128 + (i & 3) * 16) * 16 + fq * 4);
#pragma unroll
    for (int i = 0; i < 8; ++i) {
        float s = (v[i][0] + v[i][1]) + (v[i][2] + v[i][3]);
        s += __shfl_xor(s, 16); s += __shfl_xor(s, 32);
        rs[i] = rsqrtf(s * (1.0f / 1024.0f) + EPS);
    }
}
struct EpiIn {
    static constexpr bool PERM = true, AFTER_DRAIN = false, MIDK = false;
    bf16_t* PA; bf16_t* G; const float* ssq;
    __device__ __forceinline__ void operator()(const f32x4 (&acc)[2][2][4][2], const pg8::Unit& u, int wr, int wc, int fr, int fq) const {
        const int colt = u.pn * 256;
        const int act = (colt >= NPA) ? 2 : ((colt >= 512 && colt < 1536) ? 1 : 0);
        bf16_t* base = (colt >= NPA) ? G : PA;
        const int col0 = (colt >= NPA ? colt - NPA : colt) + wc * 32 + 8 * fq;
        const int row0 = u.pm * 256 + wr * 64 + fr;
        float rs8[8]; rows_rstd8(ssq, row0, fq, rs8);
#pragma unroll
        for (int ai = 0; ai < 2; ++ai)
#pragma unroll
            for (int m = 0; m < 4; ++m) {
                const int r = row0 + ai * 128 + m * 16;
                const float rs = rs8[ai * 4 + m];
                bf16_t* rowp = base + (size_t)r * NPA + col0;
#pragma unroll
                for (int bj = 0; bj < 2; ++bj) {
                    float v[8];
#pragma unroll
                    for (int j = 0; j < 4; ++j) { v[j] = acc[ai][bj][m][0][j] * rs; v[4 + j] = acc[ai][bj][m][1][j] * rs; }
                    if (act == 1) {
#pragma unroll
                        for (int j = 0; j < 8; ++j) v[j] = gelu_tanh_f(v[j]);
                    } else if (act == 2) {
#pragma unroll
                        for (int j = 0; j < 8; ++j) v[j] = gate_t(v[j]);
                    }
                    u32x4 w; w.x = pk(v[0], v[1]); w.y = pk(v[2], v[3]); w.z = pk(v[4], v[5]); w.w = pk(v[6], v[7]);
                    st_nt16(rowp + bj * 128, w);
                }
            }
    }
};
struct EpiBr {
    static constexpr bool PERM = true, AFTER_DRAIN = false, MIDK = true;
    const bf16_t* G; bf16_t* out;
    __device__ __forceinline__ void mid(f32x4 (&acc)[2][2][4][2], const pg8::Unit& u, int t, int wr, int wc, int fr, int fq) const {
        const int seg = (t == 8) ? 0 : 1024;
        int col0 = u.pn * 256 + wc * 32 + 8 * fq + seg;
        int row0 = u.pm * 256 + wr * 64 + fr;
        asm volatile("" : "+v"(col0), "+v"(row0));
#pragma unroll
        for (int ai = 0; ai < 2; ++ai) {
            u32x4 nu[4][2], de[4][2];
#pragma unroll
            for (int m = 0; m < 4; ++m)
#pragma unroll
                for (int bj = 0; bj < 2; ++bj) {
                    const bf16_t* gp = G + (size_t)(row0 + ai * 128 + m * 16) * NPA + col0 + bj * 128;
                    nu[m][bj] = *(const u32x4*)gp; de[m][bj] = *(const u32x4*)(gp + 1024);
                }
            asm volatile("" ::: "memory");
#pragma unroll
            for (int m = 0; m < 4; ++m)
#pragma unroll
                for (int bj = 0; bj < 2; ++bj) {
                    const unsigned nw[4] = {nu[m][bj].x, nu[m][bj].y, nu[m][bj].z, nu[m][bj].w}, dw[4] = {de[m][bj].x, de[m][bj].y, de[m][bj].z, de[m][bj].w};
#pragma unroll
                    for (int q = 0; q < 4; ++q) {
                        const float r0 = bflo(dw[q]) * fast_rcp(bflo(nw[q])), r1 = bfhi(dw[q]) * fast_rcp(bfhi(nw[q]));
                        acc[ai][bj][m][q >> 1][(q & 1) * 2] *= r0; acc[ai][bj][m][q >> 1][(q & 1) * 2 + 1] *= r1;
                    }
                }
            asm volatile("" ::: "memory");
        }
    }
    __device__ __forceinline__ void operator()(const f32x4 (&acc)[2][2][4][2], const pg8::Unit& u, int wr, int wc, int fr, int fq) const {
        const int col0 = u.pn * 256 + wc * 32 + 8 * fq;
        const int row0 = u.pm * 256 + wr * 64 + fr;
        u32x4 sg[2][4][2];
#pragma unroll
        for (int ai = 0; ai < 2; ++ai)
#pragma unroll
            for (int m = 0; m < 4; ++m)
#pragma unroll
                for (int bj = 0; bj < 2; ++bj) sg[ai][m][bj] = *(const u32x4*)(G + (size_t)(row0 + ai * 128 + m * 16) * NPA + 2048 + col0 + bj * 128);
#pragma unroll
        for (int ai = 0; ai < 2; ++ai)
#pragma unroll
            for (int m = 0; m < 4; ++m) {
                const int r = row0 + ai * 128 + m * 16;
                bf16_t* op = out + (size_t)r * DM + col0;
#pragma unroll
                for (int bj = 0; bj < 2; ++bj) {
                    const u32x4 s = sg[ai][m][bj];
                    const f32x4 a0 = acc[ai][bj][m][0], a1 = acc[ai][bj][m][1];
                    u32x4 w;
                    w.x = pk(a0[0] * fast_rcp(bflo(s.x)), a0[1] * fast_rcp(bfhi(s.x))); w.y = pk(a0[2] * fast_rcp(bflo(s.y)), a0[3] * fast_rcp(bfhi(s.y)));
                    w.z = pk(a1[0] * fast_rcp(bflo(s.z)), a1[1] * fast_rcp(bfhi(s.z))); w.w = pk(a1[2] * fast_rcp(bflo(s.w)), a1[3] * fast_rcp(bfhi(s.w)));
                    *(u32x4*)(op + bj * 128) = w;
                }
            }
    }
};
struct EpiRes {
    static constexpr bool PERM = true, AFTER_DRAIN = false, MIDK = false;
    bf16_t* xb; float* ssq;
    __device__ __forceinline__ void operator()(const f32x4 (&acc)[2][2][4][2], const pg8::Unit& u, int wr, int wc, int fr, int fq) const {
        const int col0 = u.pn * 256 + wc * 32 + 8 * fq;
        const int row0 = u.pm * 256 + wr * 64 + fr;
#pragma unroll
        for (int ai = 0; ai < 2; ++ai) {
            u32x4 bb[4][2];
#pragma unroll
            for (int m = 0; m < 4; ++m)
#pragma unroll
                for (int bj = 0; bj < 2; ++bj) bb[m][bj] = *(const u32x4*)(xb + (size_t)(row0 + ai * 128 + m * 16) * DM + col0 + bj * 128);
            asm volatile("" ::: "memory");
#pragma unroll
            for (int m = 0; m < 4; ++m) {
                const int r = row0 + ai * 128 + m * 16;
                float sq = 0.f;
#pragma unroll
                for (int bj = 0; bj < 2; ++bj) {
                    const u32x4 s = bb[m][bj];
                    const f32x4 a0 = acc[ai][bj][m][0], a1 = acc[ai][bj][m][1];
                    const float o0 = bflo(s.x) + a0[0], o1 = bfhi(s.x) + a0[1], o2 = bflo(s.y) + a0[2], o3 = bfhi(s.y) + a0[3];
                    const float o4 = bflo(s.z) + a1[0], o5 = bfhi(s.z) + a1[1], o6 = bflo(s.w) + a1[2], o7 = bfhi(s.w) + a1[3];
                    u32x4 w; w.x = pk(o0, o1); w.y = pk(o2, o3); w.z = pk(o4, o5); w.w = pk(o6, o7);
                    *(u32x4*)(xb + (size_t)r * DM + col0 + bj * 128) = w;
                    sq += (o0 * o0 + o1 * o1) + (o2 * o2 + o3 * o3) + (o4 * o4 + o5 * o5) + (o6 * o6 + o7 * o7);
                }
                sq += __shfl_xor(sq, 16); sq += __shfl_xor(sq, 32);
                if (fq == 0) ssq[(size_t)r * 16 + u.pn * 4 + wc] = sq;
            }
            asm volatile("" ::: "memory");
        }
    }
};
__device__ __forceinline__ float dpp_ror1(float x) { return __int_as_float(__builtin_amdgcn_update_dpp(0, __float_as_int(x), 0x121, 0xf, 0xf, false)); }
__device__ __forceinline__ float dpp_ror2(float x) { return __int_as_float(__builtin_amdgcn_update_dpp(0, __float_as_int(x), 0x122, 0xf, 0xf, false)); }
__device__ __forceinline__ float dpp_shr1(float old, float x) { return __int_as_float(__builtin_amdgcn_update_dpp(__float_as_int(old), __float_as_int(x), 0x111, 0xf, 0xf, false)); }
__device__ __forceinline__ float dpp_shr2(float old, float x) { return __int_as_float(__builtin_amdgcn_update_dpp(__float_as_int(old), __float_as_int(x), 0x112, 0xf, 0xf, false)); }
struct EpiUp {
    static constexpr bool PERM = true, AFTER_DRAIN = false, MIDK = false;
    bf16_t* act; bf16_t* zs; const float* ssq; const float* cw; const float* cb;
    __device__ __forceinline__ void operator()(const f32x4 (&acc)[2][2][4][2], const pg8::Unit& u, int wr, int wc, int fr, int fq) const {
        const int c0 = u.pn * 128 + wc * 32 + 8 * fq;
        const int row0 = u.pm * 256 + wr * 64 + fr;
        float rs8[8]; rows_rstd8(ssq, row0, fq, rs8);
        u32x2 keep[2][4];
#pragma unroll
        for (int n = 0; n < 2; ++n) {
            const int c = c0 + 4 * n;
            const f32x4 gw0 = *(const f32x4*)(cw + c), gw1 = *(const f32x4*)(cw + NUP + c), gw2 = *(const f32x4*)(cw + 2 * NUP + c), gb = *(const f32x4*)(cb + c);
            const f32x4 vw0 = *(const f32x4*)(cw + DFF + c), vw1 = *(const f32x4*)(cw + NUP + DFF + c), vw2 = *(const f32x4*)(cw + 2 * NUP + DFF + c), vb = *(const f32x4*)(cb + DFF + c);
#pragma unroll
            for (int ai = 0; ai < 2; ++ai) {
                f32x4 pg = {0.f, 0.f, 0.f, 0.f}, pv = {0.f, 0.f, 0.f, 0.f};
                const int blk = u.pm * 4 + ai * 2 + wr;
#pragma unroll
                for (int m = 0; m < 4; ++m) {
                    const float rs = rs8[ai * 4 + m];
                    const f32x4 zg = acc[ai][0][m][n] * rs, zv = acc[ai][1][m][n] * rs;
                    float o[4];
#pragma unroll
                    for (int j = 0; j < 4; ++j) {
                        const float g1 = dpp_shr1(dpp_ror1(pg[j]), zg[j]), g2 = dpp_shr2(dpp_ror2(pg[j]), zg[j]);
                        const float v1 = dpp_shr1(dpp_ror1(pv[j]), zv[j]), v2 = dpp_shr2(dpp_ror2(pv[j]), zv[j]);
                        const float gg = gw2[j] * zg[j] + gw1[j] * g1 + gw0[j] * g2 + gb[j];
                        const float vv = vw2[j] * zv[j] + vw1[j] * v1 + vw0[j] * v2 + vb[j];
                        o[j] = silu_f(gg) * vv;
                    }
                    u32x2 w; w.x = pk(o[0], o[1]); w.y = pk(o[2], o[3]);
                    const int r = row0 + ai * 128 + m * 16;
                    if (n == 0) keep[ai][m] = w;
                    else if (!(m == 0 && fr < 2)) { u32x4 ww; ww.x = keep[ai][m].x; ww.y = keep[ai][m].y; ww.z = w.x; ww.w = w.y; st_nt16(act + (size_t)r * DFF + c0, ww); }
                    if (m == 0 && fr < 2) {
                        bf16_t* zp = zs + ((size_t)blk * 4 + 2 + fr) * NUP + c;
                        u32x2 a; a.x = pk(zg[0], zg[1]); a.y = pk(zg[2], zg[3]); *(u32x2*)zp = a;
                        u32x2 d; d.x = pk(zv[0], zv[1]); d.y = pk(zv[2], zv[3]); *(u32x2*)(zp + DFF) = d;
                    }
                    if (m == 3 && fr >= 14) {
                        bf16_t* zp = zs + ((size_t)blk * 4 + (fr - 14)) * NUP + c;
                        u32x2 a; a.x = pk(zg[0], zg[1]); a.y = pk(zg[2], zg[3]); *(u32x2*)zp = a;
                        u32x2 d; d.x = pk(zv[0], zv[1]); d.y = pk(zv[2], zv[3]); *(u32x2*)(zp + DFF) = d;
                    }
                    pg = zg; pv = zv;
                }
            }
        }
    }
};

__device__ __forceinline__ void transpose_tile(const float* __restrict__ W, int N, const float* __restrict__ g, bf16_t* __restrict__ Wt, int ldt, int koff, int k0, int n0, int nd0, float* tile, int tid) {
    {
        const int kk = tid >> 4, nn = (tid & 15) * 4;
#pragma unroll
        for (int h = 0; h < 2; ++h) {
            const int k = kk + h * 32;
            f32x4 v = *(const f32x4*)(W + (size_t)(k0 + k) * N + n0 + nn);
            const float s = g ? g[k0 + k] : 1.0f;
            tile[k * 65 + nn + 0] = v[0] * s; tile[k * 65 + nn + 1] = v[1] * s; tile[k * 65 + nn + 2] = v[2] * s; tile[k * 65 + nn + 3] = v[3] * s;
        }
    }
    __syncthreads();
    {
        const int n = tid >> 3, kq = (tid & 7) * 8;
        float v[8];
#pragma unroll
        for (int j = 0; j < 8; ++j) v[j] = tile[(kq + j) * 65 + n];
        u32x4 w; w.x = pk(v[0], v[1]); w.y = pk(v[2], v[3]); w.z = pk(v[4], v[5]); w.w = pk(v[6], v[7]);
        *(u32x4*)(Wt + (size_t)(nd0 + n) * ldt + koff + k0 + kq) = w;
    }
    __syncthreads();
}

__device__ __forceinline__ void prep_phase(const Params& p, int l, float* ldsf) {
    unsigned char* ws = p.ws;
    bf16_t* wt_in = (bf16_t*)(ws + WS_WIN); bf16_t* wt_br = (bf16_t*)(ws + WS_WBR); bf16_t* wt_o = (bf16_t*)(ws + WS_WO);
    bf16_t* wt_up = (bf16_t*)(ws + WS_WUP); bf16_t* wt_dn = (bf16_t*)(ws + WS_WDN);
    const float* g_mix = p.in[1] + (size_t)l * DM; const float* w_in = p.in[2] + (size_t)l * DM * NIN;
    const float* w_pool = p.in[3] + (size_t)l * 4 * 128 * 128; const float* pscale = p.in[4] + (size_t)l * 512;
    const float* w_ba = p.in[9] + (size_t)l * 512 * DM; const float* w_bb = p.in[10] + (size_t)l * 512 * DM; const float* w_bc = p.in[11] + (size_t)l * 512 * DM;
    const float* w_o = p.in[12] + (size_t)l * DM * DM; const float* g_ffn = p.in[13] + (size_t)l * DM;
    const float* w_up = p.in[14] + (size_t)l * DM * NUP; const float* w_dn = p.in[17] + (size_t)l * DFF * DM;
    const int tid = otid(), bid = obid();
    constexpr int T0 = 16 * 96, T1 = T0 + 128, T2 = T1 + 128, T3 = T2 + 256, T4 = T3 + 16 * 88, T5 = T4 + 44 * 16;
    for (int i = bid; i < T5; i += gridDim.x) {
        if (i < T0) { const int kt = i & 15, nt = i >> 4; transpose_tile(w_in, NIN, g_mix, wt_in, DM, 0, kt * 64, nt * 64, nt * 64, ldsf, tid); }
        else if (i < T1) { const int j = i - T0, kt = j & 7, nt = j >> 3; transpose_tile(w_bb, DM, nullptr, wt_br, NBR, 512, kt * 64, nt * 64, nt * 64, ldsf, tid); }
        else if (i < T2) { const int j = i - T1, kt = j & 7, nt = j >> 3; transpose_tile(w_bc, DM, nullptr, wt_br, NBR, 1024, kt * 64, nt * 64, nt * 64, ldsf, tid); }
        else if (i < T3) { const int j = i - T2, kt = j & 15, nt = j >> 4; transpose_tile(w_o, DM, nullptr, wt_o, DM, 0, kt * 64, nt * 64, nt * 64, ldsf, tid); }
        else if (i < T4) { const int j = i - T3, kt = j & 15, nt = j >> 4; const int n0 = nt * 64, bj = n0 / DFF, q0 = n0 - bj * DFF; transpose_tile(w_up, NUP, g_ffn, wt_up, DM, 0, kt * 64, n0, (q0 >> 7) * 256 + bj * 128 + (q0 & 127), ldsf, tid);   }
        else { const int j = i - T4, kt = j % 44, nt = j / 44; transpose_tile(w_dn, DM, nullptr, wt_dn, DFF, 0, kt * 64, nt * 64, nt * 64, ldsf, tid); }
    }
    {
        float* wpT = ldsf;
        float* wa = ldsf + 128 * 128;
        for (int it = (int)gridDim.x - 1 - bid; it < 64; it += gridDim.x) {
            const int g = it >> 4, n0 = (it & 15) * 64;
            for (int q = tid; q < 128 * 32; q += 512) {
                const int d = q >> 5, e4 = (q & 31) * 4;
                const f32x4 v = *(const f32x4*)(w_pool + ((size_t)g * 128 + d) * 128 + e4);
                const f32x4 s = *(const f32x4*)(pscale + g * 128 + e4);
                wpT[(e4 + 0) * 128 + d] = v[0] * s[0]; wpT[(e4 + 1) * 128 + d] = v[1] * s[1]; wpT[(e4 + 2) * 128 + d] = v[2] * s[2]; wpT[(e4 + 3) * 128 + d] = v[3] * s[3];
            }
            for (int q = tid; q < 128 * 16; q += 512) {
                const int e = q >> 4, c4 = (q & 15) * 4;
                *(f32x4*)(wa + e * 64 + c4) = *(const f32x4*)(w_ba + (size_t)(g * 128 + e) * DM + n0 + c4);
            }
            __syncthreads();
            const int d = tid & 127, ns = tid >> 7;
            float acc[16];
#pragma unroll
            for (int i = 0; i < 16; ++i) acc[i] = 0.f;
            for (int e = 0; e < 128; ++e) {
                const float w = wpT[e * 128 + d];
                const f32x4* wr4 = (const f32x4*)(wa + e * 64 + ns * 16);
#pragma unroll
                for (int c = 0; c < 4; ++c) { const f32x4 b = wr4[c]; acc[c * 4 + 0] += w * b[0]; acc[c * 4 + 1] += w * b[1]; acc[c * 4 + 2] += w * b[2]; acc[c * 4 + 3] += w * b[3]; }
            }
#pragma unroll
            for (int i = 0; i < 16; ++i) wt_br[(size_t)(n0 + ns * 16 + i) * NBR + g * 128 + d] = (bf16_t)(pk(acc[i], 0.f) & 0xffffu);
            __syncthreads();
        }
    }
    if (l == 0) {
        const float* x = p.in[0]; bf16_t* xb = (bf16_t*)(ws + WS_XB); float* ssq = (float*)(ws + WS_SSQ);
        const int lane = tid & 63, wave = tid >> 6;
        for (int r = bid * 8 + wave; r < MTOK; r += gridDim.x * 8) {
            float sq = 0.f;
#pragma unroll
            for (int i = 0; i < 4; ++i) {
                const f32x4 v = *(const f32x4*)(x + (size_t)r * DM + i * 256 + lane * 4);
                sq += (v[0] * v[0] + v[1] * v[1]) + (v[2] * v[2] + v[3] * v[3]);
                u32x2 w; w.x = pk(v[0], v[1]); w.y = pk(v[2], v[3]);
                *(u32x2*)(xb + (size_t)r * DM + i * 256 + lane * 4) = w;
            }
#pragma unroll
            for (int o = 32; o >= 1; o >>= 1) sq += __shfl_xor(sq, o);
            if (lane < 16) ssq[(size_t)r * 16 + lane] = (lane == 0) ? sq : 0.f;
        }
    }
}
__device__ __forceinline__ void ld8(const bf16_t* p, float (&v)[8]) {
    const u32x4 w = *(const u32x4*)p;
    v[0] = bflo(w.x); v[1] = bfhi(w.x); v[2] = bflo(w.y); v[3] = bfhi(w.y); v[4] = bflo(w.z); v[5] = bfhi(w.z); v[6] = bflo(w.w); v[7] = bfhi(w.w);
}
__device__ __forceinline__ void st8(bf16_t* p, const float (&v)[8]) {
    u32x4 w; w.x = pk(v[0], v[1]); w.y = pk(v[2], v[3]); w.z = pk(v[4], v[5]); w.w = pk(v[6], v[7]);
    *(u32x4*)p = w;
}
constexpr int VT_PITCH = 136;
__device__ __forceinline__ void mixer_phase(const Params& p, int l, unsigned char* lds) {
    const bf16_t* PA = (const bf16_t*)(p.ws + WS_B1);
    bf16_t* Y = (bf16_t*)p.out;
    const float* g_sgu = p.in[5] + (size_t)l * 512;
    const float* w_sp = p.in[6] + (size_t)l * 4 * 128 * 128;
    const float* b_sp = p.in[7] + (size_t)l * 4 * 128;
    const float* conv_c = p.in[8] + (size_t)l * 3 * 512;
    float* rs = (float*)lds;
    bf16_t* vT = (bf16_t*)(lds + 1024);
    const int tid = otid(), lane = tid & 63, wave = tid >> 6, fr = lane & 15, fq = lane >> 4;
    for (int item = obid(); item < MTOK / 128; item += gridDim.x) {
        const int t0 = item * 128, pos0 = t0 & (SEQ - 1);
        {
            const int row = tid >> 2, q = tid & 3;
            const bf16_t* vp = PA + (size_t)(t0 + row) * NPA + 1024 + q * 128;
            float sq = 0.f;
#pragma unroll
            for (int i = 0; i < 16; ++i) { float v[8]; ld8(vp + i * 8, v);
#pragma unroll
                for (int j = 0; j < 8; ++j) sq += v[j] * v[j]; }
            sq += __shfl_xor(sq, 1); sq += __shfl_xor(sq, 2);
            if (q == 0) rs[row] = rsqrtf(sq * (1.0f / 512.0f) + EPS);
        }
        {
            const int c8 = (tid & 63) * 8, r0 = (tid >> 6) * 16;
            {
                const int w = 2 << (c8 >> 7);
                const bf16_t* ap = PA + (size_t)t0 * NPA + c8;
                bf16_t* yp = Y + (size_t)t0 * NBR + c8;
                float s[8];
#pragma unroll
                for (int j = 0; j < 8; ++j) s[j] = 0.f;
                for (int k = 1; k < w; ++k) { const int rr = r0 - k; if (pos0 + rr >= 0) { float v[8]; ld8(ap + (ptrdiff_t)rr * NPA, v);
#pragma unroll
                        for (int j = 0; j < 8; ++j) s[j] += v[j]; } }
                for (int i = 0; i < 16; ++i) {
                    const int rr = r0 + i; float v[8]; ld8(ap + (ptrdiff_t)rr * NPA, v);
                    const int pos = pos0 + rr; const float inv = 1.0f / (float)(pos + 1 < w ? pos + 1 : w);
                    float o[8];
#pragma unroll
                    for (int j = 0; j < 8; ++j) { s[j] += v[j]; o[j] = s[j] * inv - v[j]; }
                    st8(yp + (size_t)rr * NBR, o);
                    const int ro = rr - w + 1;
                    if (pos0 + ro >= 0) { float q[8]; ld8(ap + (ptrdiff_t)ro * NPA, q);
#pragma unroll
                        for (int j = 0; j < 8; ++j) s[j] -= q[j]; }
                }
            }
            {
                const bf16_t* bp = PA + (size_t)t0 * NPA + 1536 + c8;
                bf16_t* yp = Y + (size_t)t0 * NBR + 1024 + c8;
                float w0[8], w1[8], w2[8], z1[8], z2[8];
#pragma unroll
                for (int j = 0; j < 8; ++j) { w0[j] = conv_c[c8 + j]; w1[j] = conv_c[512 + c8 + j]; w2[j] = conv_c[1024 + c8 + j]; z1[j] = 0.f; z2[j] = 0.f; }
                if (pos0 + r0 - 2 >= 0) { float a[8], b[8]; ld8(bp + (ptrdiff_t)(r0 - 2) * NPA + 512, a); ld8(bp + (ptrdiff_t)(r0 - 2) * NPA + 1024, b);
#pragma unroll
                    for (int j = 0; j < 8; ++j) z2[j] = a[j] * b[j]; }
                if (pos0 + r0 - 1 >= 0) { float a[8], b[8]; ld8(bp + (ptrdiff_t)(r0 - 1) * NPA + 512, a); ld8(bp + (ptrdiff_t)(r0 - 1) * NPA + 1024, b);
#pragma unroll
                    for (int j = 0; j < 8; ++j) z1[j] = a[j] * b[j]; }
                for (int i = 0; i < 16; ++i) {
                    const int rr = r0 + i; float cb[8], a[8], b[8], o[8];
                    ld8(bp + (size_t)rr * NPA, cb); ld8(bp + (size_t)rr * NPA + 512, a); ld8(bp + (size_t)rr * NPA + 1024, b);
#pragma unroll
                    for (int j = 0; j < 8; ++j) { const float z = a[j] * b[j]; o[j] = cb[j] * (w0[j] * z2[j] + w1[j] * z1[j] + w2[j] * z); z2[j] = z1[j]; z1[j] = z; }
                    st8(yp + (size_t)rr * NBR, o);
                }
            }
        }
        for (int g = 0; g < 4; ++g) {
            __syncthreads();
            {
                const int s = tid >> 2, dq = (tid & 3) * 32;
                const bf16_t* vp = PA + (size_t)(t0 + s) * NPA + 1024 + g * 128 + dq;
#pragma unroll
                for (int i = 0; i < 4; ++i) {
                    const u32x4 w = *(const u32x4*)(vp + i * 8);
                    const unsigned ww[4] = {w.x, w.y, w.z, w.w};
#pragma unroll
                    for (int q = 0; q < 4; ++q) { vT[(dq + i * 8 + q * 2) * VT_PITCH + s] = (bf16_t)(ww[q] & 0xffffu); vT[(dq + i * 8 + q * 2 + 1) * VT_PITCH + s] = (bf16_t)(ww[q] >> 16); }
                }
            }
            __syncthreads();
            f32x4 acc[8];
#pragma unroll
            for (int n = 0; n < 8; ++n) acc[n] = (f32x4){0.f, 0.f, 0.f, 0.f};
            const int t = wave * 16 + fr;
            const int nk = (wave >> 1) + 1;
            for (int k = 0; k < nk; ++k) {
                const int s0 = k * 32 + fq * 8;
                const float* wp = w_sp + ((size_t)g * 128 + t) * 128 + s0;
                const f32x4 wa = *(const f32x4*)wp, wb = *(const f32x4*)(wp + 4);
                const f32x4 ra = *(const f32x4*)(rs + s0), rb = *(const f32x4*)(rs + s0 + 4);
                float a[8];
#pragma unroll
                for (int j = 0; j < 4; ++j) { a[j] = (s0 + j <= t) ? wa[j] * ra[j] : 0.f; a[4 + j] = (s0 + 4 + j <= t) ? wb[j] * rb[j] : 0.f; }
                union { u32x4 u; bf16x8 h; } af; af.u.x = pk(a[0], a[1]); af.u.y = pk(a[2], a[3]); af.u.z = pk(a[4], a[5]); af.u.w = pk(a[6], a[7]);
#pragma unroll
                for (int n = 0; n < 8; ++n) {
                    const bf16x8 bfrag = *(const bf16x8*)(vT + (n * 16 + fr) * VT_PITCH + s0);
                    acc[n] = __builtin_amdgcn_mfma_f32_16x16x32_bf16(bfrag, af.h, acc[n], 0, 0, 0);
                }
            }
            const float bias = b_sp[g * 128 + t];
            const bf16_t* up = PA + (size_t)(t0 + t) * NPA + 512 + g * 128 + 4 * fq;
            bf16_t* yp = Y + (size_t)(t0 + t) * NBR + 512 + g * 128 + 4 * fq;
#pragma unroll
            for (int n = 0; n < 8; ++n) {
                const u32x2 uu = *(const u32x2*)(up + n * 16);
                const f32x4 gs = *(const f32x4*)(g_sgu + g * 128 + n * 16 + 4 * fq);
                const float o0 = bflo(uu.x) * (acc[n][0] * gs[0] + bias), o1 = bfhi(uu.x) * (acc[n][1] * gs[1] + bias);
                const float o2 = bflo(uu.y) * (acc[n][2] * gs[2] + bias), o3 = bfhi(uu.y) * (acc[n][3] * gs[3] + bias);
                u32x2 w; w.x = pk(o0, o1); w.y = pk(o2, o3);
                *(u32x2*)(yp + n * 16) = w;
            }
        }
        __syncthreads();
    }
}

__device__ __forceinline__ void ffn_fixup_phase(const Params& p, int l) {
    const bf16_t* zs = (const bf16_t*)(p.ws + WS_B2);
    bf16_t* act = (bf16_t*)(p.ws + WS_B1);
    const float* cw = p.in[15] + (size_t)l * 3 * NUP; const float* cb = p.in[16] + (size_t)l * NUP;
    constexpr int NCG = DFF / 8, NU = (MTOK / 64) * NCG;
    for (int u = obid() * 512 + otid(); u < NU; u += gridDim.x * 512) {
        const int blk = u / NCG, c8 = (u - blk * NCG) * 8;
        const bool first = ((blk * 64) & (SEQ - 1)) == 0;
        float g2[8], g1[8], ga[8], gb2[8], v2[8], v1[8], va[8], vb2[8];
#pragma unroll
        for (int j = 0; j < 8; ++j) { g2[j] = g1[j] = v2[j] = v1[j] = 0.f; }
        const bf16_t* own = zs + (size_t)blk * 4 * NUP + c8;
        if (!first) { const bf16_t* prv = own - 4 * (ptrdiff_t)NUP; ld8(prv, g2); ld8(prv + NUP, g1); ld8(prv + DFF, v2); ld8(prv + NUP + DFF, v1); }
        ld8(own + 2 * NUP, ga); ld8(own + 3 * NUP, gb2); ld8(own + 2 * NUP + DFF, va); ld8(own + 3 * NUP + DFF, vb2);
        float o0[8], o1[8];
#pragma unroll
        for (int j = 0; j < 8; ++j) {
            const float w0 = cw[c8 + j], w1 = cw[NUP + c8 + j], w2 = cw[2 * NUP + c8 + j], bb = cb[c8 + j];
            const float x0 = cw[DFF + c8 + j], x1 = cw[NUP + DFF + c8 + j], x2 = cw[2 * NUP + DFF + c8 + j], xb_ = cb[DFF + c8 + j];
            const float gg0 = w0 * g2[j] + w1 * g1[j] + w2 * ga[j] + bb, vv0 = x0 * v2[j] + x1 * v1[j] + x2 * va[j] + xb_;
            const float gg1 = w0 * g1[j] + w1 * ga[j] + w2 * gb2[j] + bb, vv1 = x0 * v1[j] + x1 * va[j] + x2 * vb2[j] + xb_;
            o0[j] = silu_f(gg0) * vv0; o1[j] = silu_f(gg1) * vv1;
        }
        st8(act + (size_t)(blk * 64) * DFF + c8, o0); st8(act + (size_t)(blk * 64 + 1) * DFF + c8, o1);
    }
}

__device__ __forceinline__ void final_norm_phase(const Params& p) {
    const float* gf = p.in[18]; const float* ssq = (const float*)(p.ws + WS_SSQ); const bf16_t* xb = (const bf16_t*)(p.ws + WS_XB); float* out = p.out;
    const int tid = otid(), lane = tid & 63, wave = tid >> 6;
    for (int r = obid() * 8 + wave; r < MTOK; r += gridDim.x * 8) {
        const float rs = row_rstd(ssq, r);
#pragma unroll
        for (int i = 0; i < 2; ++i) {
            const int c = i * 512 + lane * 8;
            float v[8]; ld8(xb + (size_t)r * DM + c, v);
            const f32x4 g0 = *(const f32x4*)(gf + c), g1 = *(const f32x4*)(gf + c + 4);
            f32x4 o0, o1;
#pragma unroll
            for (int j = 0; j < 4; ++j) { o0[j] = v[j] * rs * g0[j]; o1[j] = v[4 + j] * rs * g1[j]; }
            float* q = out + (size_t)r * DM + c;
            __builtin_nontemporal_store(o0, (f32x4*)q); __builtin_nontemporal_store(o1, (f32x4*)(q + 4));
        }
    }
}

template <class Epi> __device__ __forceinline__ void run_gemm(unsigned char* lds, const bf16_t* A, const bf16_t* Bt, int M, int N, int K, const Epi& E, int stagger_step = 0) {
    pg8::Gemm g{A, Bt, M, N, K}; pg8::StaticOrder S; S.init(M, N, (int)gridDim.x, obid());
    if (stagger_step) {
        const unsigned long long t0 = wall_clock64(), d = (unsigned long long)(((obid() >> 3) & 7) * stagger_step);
        while (wall_clock64() - t0 < d) __builtin_amdgcn_s_sleep(16);
    }
    pg8::gemm_phase<Epi, pg8::StaticOrder, false>((PG8_LAS unsigned char*)lds, g, S, E, nullptr);
}

__global__ void __launch_bounds__(512, 2) fwd_megakernel(Params p) {
    extern __shared__ __attribute__((aligned(16))) unsigned char lds[];
    cg::grid_group grid = cg::this_grid();
    unsigned char* ws = p.ws;
    bf16_t* wt_in = (bf16_t*)(ws + WS_WIN); bf16_t* wt_br = (bf16_t*)(ws + WS_WBR); bf16_t* wt_o = (bf16_t*)(ws + WS_WO);
    bf16_t* wt_up = (bf16_t*)(ws + WS_WUP); bf16_t* wt_dn = (bf16_t*)(ws + WS_WDN);
    float* ssq = (float*)(ws + WS_SSQ); bf16_t* xb = (bf16_t*)(ws + WS_XB); bf16_t* b1 = (bf16_t*)(ws + WS_B1); bf16_t* b2 = (bf16_t*)(ws + WS_B2);
    for (int l = 0; l < 2; ++l) {
        prep_phase(p, l, (float*)lds);
        grid.sync();
        { EpiIn E{b1, b2, ssq}; run_gemm(lds, xb, wt_in, MTOK, NIN, DM, E); }
        grid.sync();
        mixer_phase(p, l, lds);
        grid.sync();
        { EpiBr E{b2, b1}; run_gemm(lds, (const bf16_t*)p.out  , wt_br, MTOK, DM, NBR, E); }
        grid.sync();
        { EpiRes E{xb, ssq}; run_gemm(lds, b1, wt_o, MTOK, DM, DM, E); }
        grid.sync();
        { EpiUp E{b1, b2, ssq, p.in[15] + (size_t)l * 3 * NUP, p.in[16] + (size_t)l * NUP}; run_gemm(lds, xb, wt_up, MTOK, NUP, DM, E); }
        grid.sync();
        ffn_fixup_phase(p, l);
        grid.sync();
        { EpiRes E{xb, ssq}; run_gemm(lds, b1, wt_dn, MTOK, DM, DFF, E); }
        grid.sync();
    }
    final_norm_phase(p);
}

extern "C" void kernel_launch(void* const* d_in, const int* in_sizes, int n_in, void* d_out, int out_size, void* d_ws, size_t ws_size, hipStream_t stream) {
    constexpr size_t kLds = pg8::STAGE_BYTES;
    static int grid_blocks = 0;
    if (!grid_blocks) {
        int dev = 0, cus = 0, per_cu = 0;
        (void)hipGetDevice(&dev);
        (void)hipDeviceGetAttribute(&cus, hipDeviceAttributeMultiprocessorCount, dev);
        (void)hipFuncSetAttribute((const void*)fwd_megakernel, hipFuncAttributeMaxDynamicSharedMemorySize, (int)kLds);
        (void)hipOccupancyMaxActiveBlocksPerMultiprocessor(&per_cu, (const void*)fwd_megakernel, 512, kLds);
        if (per_cu < 1) per_cu = 1;
        grid_blocks = cus;
        if (ws_size < WS_END || n_in != 19 || out_size != MTOK * DM) { fprintf(stderr, "kernel_launch: unexpected sizes: ws %zu (need %zu), n_in %d, out %d\n", ws_size, (size_t)WS_END, n_in, out_size); }
    }
    Params p{};
    for (int i = 0; i < 19; ++i) p.in[i] = (const float*)d_in[i];
    p.out = (float*)d_out; p.ws = (unsigned char*)d_ws;
    void* args[] = {&p};
    hipError_t e = hipLaunchCooperativeKernel((void*)fwd_megakernel, dim3(grid_blocks), dim3(512), args, kLds, stream);
    if (e != hipSuccess) fprintf(stderr, "cooperative launch failed: %s (grid %d)\n", hipGetErrorString(e), grid_blocks);
}
```

```cpp
#include <hip/hip_runtime.h>
#include <hip/hip_cooperative_groups.h>
#include <cstdio>
namespace cg = cooperative_groups;
namespace pg8 {
#define PG8_LAS __attribute__((address_space(3)))
typedef unsigned short bf16_t;
typedef short bf16x8 __attribute__((ext_vector_type(8)));
typedef float f32x4 __attribute__((ext_vector_type(4)));
typedef unsigned u32x4 __attribute__((ext_vector_type(4)));
constexpr int BM = 256, BK = 64, HALF = 128, HTB = HALF * BK * 2  , STAGE_BYTES = 8 * HTB, NXCD = 8, WGM = 8;

__host__ __device__ __forceinline__ int lds_byte(int r, int c) { const int st = (r >> 4) * 2 + (c >> 5), rr = r & 15, cc = c & 31, ob = rr * 64 + cc * 2; return st * 1024 + (ob ^ (((ob >> 9) & 1) << 5)); }
__host__ __device__ __forceinline__ void stage_rc(int b, int& R, int& C) { const int st = b / 1024, sb = b % 1024, swz = sb ^ (((sb >> 9) & 1) << 5); R = (st >> 1) * 16 + swz / 64; C = (st & 1) * 32 + (swz % 64) / 2; }
__host__ __device__ __forceinline__ int perm32(int rho) { const int n = rho >> 4, i = rho & 15; return 8 * (i >> 2) + 4 * n + (i & 3); }

struct Unit { int pm, pn; };
struct Gemm { const bf16_t* A; const bf16_t* Bt; int M, N, K; };

struct StaticOrder {
    int nM, nN, nwg, G, c;
    __host__ __device__ void init(int M, int N, int G_, int c_) { nM = M / BM; nN = N / BM; nwg = nM * nN; G = G_; c = c_; }
    __host__ __device__ bool next(int i, Unit& u) const {
        const long L = (long)i * G + c; if (L >= nwg) return false;
        int wgid = (int)L; { const int q = nwg / NXCD, r = nwg % NXCD, xcd = wgid % NXCD, off = wgid / NXCD; wgid = (xcd < r ? xcd * (q + 1) : r * (q + 1) + (xcd - r) * q) + off; }
        const int nig = WGM * nN, gid = wgid / nig, fm = gid * WGM, gsz = (nM - fm) < WGM ? (nM - fm) : WGM;
        u.pm = fm + ((wgid % nig) % gsz); u.pn = (wgid % nig) / gsz; return true;
    }
    __device__ __forceinline__ void a_ready(const Unit&) const {}
    __device__ __forceinline__ void done(const Unit&) const {}
};
__device__ __forceinline__ unsigned cvt_pk_bf16(float lo, float hi) { unsigned r; asm volatile("v_cvt_pk_bf16_f32 %0, %1, %2" : "=v"(r) : "v"(lo), "v"(hi)); return r; }

template <class Epi, class Sched, bool STAMP = false>
__device__ __forceinline__ void gemm_phase(PG8_LAS unsigned char* lds, const Gemm g, const Sched& S, const Epi& E, unsigned long long* stamps) {
    int tid_ = threadIdx.x; asm volatile("" : "+v"(tid_));
    const int tid = tid_, wid = __builtin_amdgcn_readfirstlane(tid >> 6), lane = tid & 63, wr = wid >> 2, wc = wid & 3, fr = lane & 15, fq = lane >> 4;
    const int K = g.K, nt = K / BK;
    int ts_lo = 0, ts_hi = 0, nts = 0; const unsigned long long rt_entry = STAMP ? (unsigned long long)wall_clock64() : 0ull;
#define PG8_STAMP() do { if (STAMP && wid == 0 && nts < 64) { const unsigned long long _c = (unsigned long long)clock64(); \
        ts_lo = (lane == nts) ? (int)(unsigned)_c : ts_lo; ts_hi = (lane == nts) ? (int)(unsigned)(_c >> 32) : ts_hi; ++nts; } } while (0)
    PG8_STAMP();
    unsigned voffA[2], voffB[2];
#pragma unroll
    for (int i = 0; i < 2; ++i) { int R, C; stage_rc(tid * 16 + i * 8192, R, C); const int Rb = Epi::PERM ? ((R & ~31) + perm32(R & 31)) : R;
        voffA[i] = (unsigned)(R * K + C) * 2u; voffB[i] = (unsigned)(Rb * K + C) * 2u; }
    const size_t kstep = (size_t)(BK * 2);
    const size_t hstep = (size_t)HALF * K * 2;
    const size_t tstep = 2 * hstep;
    const unsigned ldsw = (unsigned)wid * 1024u;
    const int aoff = lds_byte(wr * 64 + fr, fq * 8), boff = lds_byte(wc * 32 + fr, fq * 8);
#define PG8_SA(b, h) (((b) * 2 + (h)) * HTB)
#define PG8_SB(b, h) ((4 + (b) * 2 + (h)) * HTB)
#define PG8_STAGE(bufoff, gbase, voff) do { _Pragma("unroll") for (int _i = 0; _i < 2; ++_i) \
        __builtin_amdgcn_global_load_lds((const unsigned*)((const char*)(gbase) + (voff)[_i]), (PG8_LAS unsigned*)(lds + (bufoff) + ldsw + _i * 8192), 16, 0, 0); } while (0)
#define PG8_LDA(dst, b, h) do { _Pragma("unroll") for (int m = 0; m < 4; ++m) _Pragma("unroll") for (int k = 0; k < 2; ++k) dst[m][k] = *(const PG8_LAS bf16x8*)(lds + PG8_SA(b, h) + aoff + m * 2048 + k * 1024); } while (0)
#define PG8_LDB(dst, b, h) do { _Pragma("unroll") for (int n = 0; n < 2; ++n) _Pragma("unroll") for (int k = 0; k < 2; ++k) dst[n][k] = *(const PG8_LAS bf16x8*)(lds + PG8_SB(b, h) + boff + n * 2048 + k * 1024); } while (0)
#define PG8_MMA(ai, bj, At, Bt) do { __builtin_amdgcn_s_setprio(1); _Pragma("unroll") for (int m = 0; m < 4; ++m) _Pragma("unroll") for (int n = 0; n < 2; ++n) _Pragma("unroll") for (int k = 0; k < 2; ++k) \
        acc[ai][bj][m][n] = __builtin_amdgcn_mfma_f32_16x16x32_bf16(Bt[n][k], At[m][k], acc[ai][bj][m][n], 0, 0, 0); __builtin_amdgcn_s_setprio(0); } while (0)
#define PG8_WAIT_V(n) asm volatile("s_waitcnt vmcnt(" #n ")" ::: "memory")
#define PG8_WAIT_L(n) asm volatile("s_waitcnt lgkmcnt(" #n ")" ::: "memory")
#define PG8_BAR __builtin_amdgcn_s_barrier()
#define PG8_SCHED __builtin_amdgcn_sched_barrier(0)
    Unit cur, nxt; int ui = 0;
    if (!S.next(0, cur)) return;
    f32x4 acc[2][2][4][2];
#pragma unroll
    for (int a = 0; a < 2; ++a)
#pragma unroll
        for (int b = 0; b < 2; ++b)
#pragma unroll
            for (int m = 0; m < 4; ++m)
#pragma unroll
                for (int n = 0; n < 2; ++n) acc[a][b][m][n] = (f32x4){0.f, 0.f, 0.f, 0.f};
    bf16x8 At[4][2], B0[2][2], B1[2][2];
    const char* cA = (const char*)g.A + (size_t)cur.pm * tstep; const char* cB = (const char*)g.Bt + (size_t)cur.pn * tstep;
    S.a_ready(cur);
    PG8_STAGE(PG8_SB(0, 0), cB, voffB); PG8_STAGE(PG8_SA(0, 0), cA, voffA); PG8_STAGE(PG8_SB(0, 1), cB + hstep, voffB); PG8_STAGE(PG8_SA(0, 1), cA + hstep, voffA);
    if (wr == 1) PG8_BAR;
    PG8_WAIT_V(4); PG8_BAR;
    PG8_STAGE(PG8_SB(1, 0), cB + kstep, voffB); PG8_STAGE(PG8_SA(1, 0), cA + kstep, voffA); PG8_STAGE(PG8_SB(1, 1), cB + hstep + kstep, voffB);
    PG8_WAIT_V(6); PG8_BAR;
    PG8_STAMP();
    for (;;) {
        const bool has_next = S.next(ui + 1, nxt);
        const char* nA = has_next ? (const char*)g.A + (size_t)nxt.pm * tstep : cA; const char* nB = has_next ? (const char*)g.Bt + (size_t)nxt.pn * tstep : cB;
        for (int t = 0; t < nt; t += 2) {
            if constexpr (Epi::MIDK) { if (t == 8 || t == 16) E.mid(acc, cur, t, wr, wc, fr, fq); }
            const bool last = (t == nt - 2);
            const char* a1 = cA + (size_t)(t + 1) * kstep;
            const char* a2 = last ? nA : cA + (size_t)(t + 2) * kstep; const char* b2 = last ? nB : cB + (size_t)(t + 2) * kstep;
            const char* a3 = a2 + kstep; const char* b3 = b2 + kstep;
            if (last && has_next) S.a_ready(nxt);
            PG8_LDB(B0, 0, 0); PG8_SCHED; PG8_LDA(At, 0, 0); PG8_STAGE(PG8_SA(1, 1), a1 + hstep, voffA);
            PG8_WAIT_L(8); PG8_BAR; PG8_WAIT_L(0); PG8_MMA(0, 0, At, B0); PG8_BAR; PG8_SCHED;
            PG8_LDB(B1, 0, 1); PG8_STAGE(PG8_SB(0, 0), b2, voffB);
            PG8_BAR; PG8_WAIT_L(0); PG8_MMA(0, 1, At, B1); PG8_BAR;
            PG8_LDA(At, 0, 1); PG8_STAGE(PG8_SA(0, 0), a2, voffA);
            PG8_BAR; PG8_WAIT_L(0); PG8_MMA(1, 0, At, B0); PG8_BAR; PG8_SCHED;
            PG8_STAGE(PG8_SB(0, 1), b2 + hstep, voffB);
            PG8_WAIT_V(6); PG8_BAR; PG8_MMA(1, 1, At, B1); PG8_BAR;
            PG8_LDB(B0, 1, 0); PG8_SCHED; PG8_LDA(At, 1, 0); PG8_STAGE(PG8_SA(0, 1), a2 + hstep, voffA);
            PG8_WAIT_L(8); PG8_BAR; PG8_WAIT_L(0); PG8_MMA(0, 0, At, B0); PG8_BAR; PG8_SCHED;
            PG8_LDB(B1, 1, 1); PG8_STAGE(PG8_SB(1, 0), b3, voffB);
            PG8_BAR; PG8_WAIT_L(0); PG8_MMA(0, 1, At, B1); PG8_BAR;
            PG8_LDA(At, 1, 1); PG8_STAGE(PG8_SA(1, 0), a3, voffA);
            PG8_BAR; PG8_WAIT_L(0); PG8_MMA(1, 0, At, B0); PG8_BAR; PG8_SCHED;
            PG8_STAGE(PG8_SB(1, 1), b3 + hstep, voffB);
            PG8_WAIT_V(6); PG8_BAR; PG8_MMA(1, 1, At, B1); PG8_BAR;
        }
        PG8_STAMP();
        if constexpr (!Epi::AFTER_DRAIN) { E(acc, cur, wr, wc, fr, fq); S.done(cur); }
        PG8_STAMP();
        if (!has_next) break;
#pragma unroll
        for (int a = 0; a < 2; ++a)
#pragma unroll
            for (int b = 0; b < 2; ++b)
#pragma unroll
                for (int m = 0; m < 4; ++m)
#pragma unroll
                    for (int n = 0; n < 2; ++n) acc[a][b][m][n] = (f32x4){0.f, 0.f, 0.f, 0.f};
        cur = nxt; cA = nA; cB = nB; ++ui;
    }
    PG8_WAIT_V(0);
    if (wr == 0) PG8_BAR;
    PG8_BAR;
    if constexpr (Epi::AFTER_DRAIN) { E.fused(acc, cur, wr, wc, fr, fq, lds, wid, lane); S.done(cur); }
    PG8_STAMP();
    if (STAMP && wid == 0) { stamps[lane] = lane < nts ? (((unsigned long long)(unsigned)ts_hi << 32) | (unsigned)ts_lo) : 0ull;
        if (lane == 62) stamps[62] = rt_entry; if (lane == 63) stamps[63] = (unsigned long long)wall_clock64(); }
#undef PG8_STAMP
#undef PG8_SA
#undef PG8_SB
#undef PG8_STAGE
#undef PG8_LDA
#undef PG8_LDB
#undef PG8_MMA
#undef PG8_WAIT_V
#undef PG8_WAIT_L
#undef PG8_BAR
#undef PG8_SCHED
}
}
typedef pg8::bf16_t bf16_t;
typedef pg8::f32x4 f32x4;
typedef pg8::u32x4 u32x4;
typedef pg8::bf16x8 bf16x8;
typedef unsigned u32x2 __attribute__((ext_vector_type(2)));
#define LAS __attribute__((address_space(3)))
constexpr int MTOK = 65536, DM = 1024, NIN = 6144, DFF = 2816, NUP = 5632, SEQ = 8192, NBR = 1536, NPA = 3072;
constexpr int MH = MTOK / 2;
constexpr float EPS = 1e-6f;
constexpr size_t WS_WIN = 0;
constexpr size_t WS_WBR = WS_WIN + (size_t)NIN * DM * 2;
constexpr size_t WS_WO = WS_WBR + (size_t)DM * NBR * 2;
constexpr size_t WS_WUP = WS_WO + (size_t)DM * DM * 2;
constexpr size_t WS_WDN = WS_WUP + (size_t)NUP * DM * 2;
constexpr size_t WS_SSQ = WS_WDN + (size_t)DM * DFF * 2;
constexpr size_t WS_XB = WS_SSQ + (size_t)MTOK * 16 * 4;
constexpr size_t WS_B1 = WS_XB + (size_t)MTOK * NBR * 2;
constexpr size_t WS_B2 = WS_B1 + (size_t)MTOK * NPA * 2;
constexpr size_t WS_END = WS_B2 + (size_t)MTOK * NPA * 2;

__device__ __forceinline__ int otid() { int t = threadIdx.x; asm volatile("" : "+v"(t)); return t; }
__device__ __forceinline__ int obid() { int b = blockIdx.x; asm volatile("" : "+s"(b)); return b; }
struct Params {
    const float* in[19];
    float* out; unsigned char* ws;
};

__device__ __forceinline__ void st_nt16(void* p, u32x4 w) { __builtin_nontemporal_store(w, (u32x4*)p); }
__device__ __forceinline__ float bflo(unsigned w) { return __uint_as_float(w << 16); }
__device__ __forceinline__ float bfhi(unsigned w) { return __uint_as_float(w & 0xffff0000u); }
__device__ __forceinline__ unsigned pk(float a, float b) { return pg8::cvt_pk_bf16(a, b); }
__device__ __forceinline__ float fast_rcp(float x) { return __builtin_amdgcn_rcpf(x); }
__device__ __forceinline__ float gate_t(float x) { return 1.0f + __builtin_amdgcn_exp2f(fminf(x * -1.44269504f, 43.28f)); }
__device__ __forceinline__ float gelu_tanh_f(float x) {
    const float z2 = 1.5957691216f * (x + 0.044715f * x * x * x);
    return x * fast_rcp(1.0f + __expf(-z2));
}
__device__ __forceinline__ float silu_f(float x) { return x * fast_rcp(1.0f + __expf(-x)); }
__device__ __forceinline__ float row_rstd(const float* ssq, int r) {
    const f32x4* p = (const f32x4*)(ssq + (size_t)r * 16);
    const f32x4 a = p[0], b = p[1], c = p[2], d = p[3];
    const float s = ((a[0] + a[1]) + (a[2] + a[3])) + ((b[0] + b[1]) + (b[2] + b[3])) + ((c[0] + c[1]) + (c[2] + c[3])) + ((d[0] + d[1]) + (d[2] + d[3]));
    return rsqrtf(s * (1.0f / 1024.0f) + EPS);
}

__device__ __forceinline__ void rows_rstd8(const float* ssq, int row0, int fq, float (&rs)[8]) {
    f32x4 v[8];
#pragma unroll
    for (int i = 0; i < 8; ++i) v[i] = *(const f32x4*)(ssq + (size_t)(row0 + (i >> 2) * 128 + (i & 3) * 16) * 16 + fq * 4);
#pragma unroll
    for (int i = 0; i < 8; ++i) {
        float s = (v[i][0] + v[i][1]) + (v[i][2] + v[i][3]);
        s += __shfl_xor(s, 16); s += __shfl_xor(s, 32);
        rs[i] = rsqrtf(s * (1.0f / 1024.0f) + EPS);
    }
}
struct EpiIn {
    static constexpr bool PERM = true, AFTER_DRAIN = false, MIDK = false;
    bf16_t* PA; bf16_t* G; const float* ssq;
    __device__ __forceinline__ void operator()(const f32x4 (&acc)[2][2][4][2], const pg8::Unit& u, int wr, int wc, int fr, int fq) const {
        const int colt = u.pn * 256;
        const int act = (colt >= NPA) ? 2 : ((colt >= 512 && colt < 1536) ? 1 : 0);
        bf16_t* base = (colt >= NPA) ? G : PA;
        const int col0 = (colt >= NPA ? colt - NPA : colt) + wc * 32 + 8 * fq;
        const int row0 = u.pm * 256 + wr * 64 + fr;
        float rs8[8]; rows_rstd8(ssq, row0, fq, rs8);
#pragma unroll
        for (int ai = 0; ai < 2; ++ai)
#pragma unroll
            for (int m = 0; m < 4; ++m) {
                const int r = row0 + ai * 128 + m * 16;
                const float rs = rs8[ai * 4 + m];
                bf16_t* rowp = base + (size_t)r * NPA + col0;
#pragma unroll
                for (int bj = 0; bj < 2; ++bj) {
                    float v[8];
#pragma unroll
                    for (int j = 0; j < 4; ++j) { v[j] = acc[ai][bj][m][0][j] * rs; v[4 + j] = acc[ai][bj][m][1][j] * rs; }
                    if (act == 1) {
#pragma unroll
                        for (int j = 0; j < 8; ++j) v[j] = gelu_tanh_f(v[j]);
                    } else if (act == 2) {
#pragma unroll
                        for (int j = 0; j < 8; ++j) v[j] = gate_t(v[j]);
                    }
                    u32x4 w; w.x = pk(v[0], v[1]); w.y = pk(v[2], v[3]); w.z = pk(v[4], v[5]); w.w = pk(v[6], v[7]);
                    st_nt16(rowp + bj * 128, w);
                }
            }
    }
};
struct EpiBr {
    static constexpr bool PERM = true, AFTER_DRAIN = false, MIDK = true;
    const bf16_t* G; bf16_t* out;
    __device__ __forceinline__ void mid(f32x4 (&acc)[2][2][4][2], const pg8::Unit& u, int t, int wr, int wc, int fr, int fq) const {
        const int seg = (t == 8) ? 0 : 1024;
        int col0 = u.pn * 256 + wc * 32 + 8 * fq + seg;
        int row0 = u.pm * 256 + wr * 64 + fr;
        asm volatile("" : "+v"(col0), "+v"(row0));
#pragma unroll
        for (int ai = 0; ai < 2; ++ai) {
            u32x4 nu[4][2], de[4][2];
#pragma unroll
            for (int m = 0; m < 4; ++m)
#pragma unroll
                for (int bj = 0; bj < 2; ++bj) {
                    const bf16_t* gp = G + (size_t)(row0 + ai * 128 + m * 16) * NPA + col0 + bj * 128;
                    nu[m][bj] = *(const u32x4*)gp; de[m][bj] = *(const u32x4*)(gp + 1024);
                }
            asm volatile("" ::: "memory");
#pragma unroll
            for (int m = 0; m < 4; ++m)
#pragma unroll
                for (int bj = 0; bj < 2; ++bj) {
                    const unsigned nw[4] = {nu[m][bj].x, nu[m][bj].y, nu[m][bj].z, nu[m][bj].w}, dw[4] = {de[m][bj].x, de[m][bj].y, de[m][bj].z, de[m][bj].w};
#pragma unroll
                    for (int q = 0; q < 4; ++q) {
                        const float r0 = bflo(dw[q]) * fast_rcp(bflo(nw[q])), r1 = bfhi(dw[q]) * fast_rcp(bfhi(nw[q]));
                        acc[ai][bj][m][q >> 1][(q & 1) * 2] *= r0; acc[ai][bj][m][q >> 1][(q & 1) * 2 + 1] *= r1;
                    }
                }
            asm volatile("" ::: "memory");
        }
    }
    __device__ __forceinline__ void operator()(const f32x4 (&acc)[2][2][4][2], const pg8::Unit& u, int wr, int wc, int fr, int fq) const {
        const int col0 = u.pn * 256 + wc * 32 + 8 * fq;
        const int row0 = u.pm * 256 + wr * 64 + fr;
        u32x4 sg[2][4][2];
#pragma unroll
        for (int ai = 0; ai < 2; ++ai)
#pragma unroll
            for (int m = 0; m < 4; ++m)
#pragma unroll
                for (int bj = 0; bj < 2; ++bj) sg[ai][m][bj] = *(const u32x4*)(G + (size_t)(row0 + ai * 128 + m * 16) * NPA + 2048 + col0 + bj * 128);
#pragma unroll
        for (int ai = 0; ai < 2; ++ai)
#pragma unroll
            for (int m = 0; m < 4; ++m) {
                const int r = row0 + ai * 128 + m * 16;
                bf16_t* op = out + (size_t)r * DM + col0;
#pragma unroll
                for (int bj = 0; bj < 2; ++bj) {
                    const u32x4 s = sg[ai][m][bj];
                    const f32x4 a0 = acc[ai][bj][m][0], a1 = acc[ai][bj][m][1];
                    u32x4 w;
                    w.x = pk(a0[0] * fast_rcp(bflo(s.x)), a0[1] * fast_rcp(bfhi(s.x))); w.y = pk(a0[2] * fast_rcp(bflo(s.y)), a0[3] * fast_rcp(bfhi(s.y)));
                    w.z = pk(a1[0] * fast_rcp(bflo(s.z)), a1[1] * fast_rcp(bfhi(s.z))); w.w = pk(a1[2] * fast_rcp(bflo(s.w)), a1[3] * fast_rcp(bfhi(s.w)));
                    *(u32x4*)(op + bj * 128) = w;
                }
            }
    }
};
struct EpiRes {
    static constexpr bool PERM = true, AFTER_DRAIN = false, MIDK = false;
    bf16_t* xb; float* ssq;
    __device__ __forceinline__ void operator()(const f32x4 (&acc)[2][2][4][2], const pg8::Unit& u, int wr, int wc, int fr, int fq) const {
        const int col0 = u.pn * 256 + wc * 32 + 8 * fq;
        const int row0 = u.pm * 256 + wr * 64 + fr;
#pragma unroll
        for (int ai = 0; ai < 2; ++ai) {
            u32x4 bb[4][2];
#pragma unroll
            for (int m = 0; m < 4; ++m)
#pragma unroll
                for (int bj = 0; bj < 2; ++bj) bb[m][bj] = *(const u32x4*)(xb + (size_t)(row0 + ai * 128 + m * 16) * DM + col0 + bj * 128);
            asm volatile("" ::: "memory");
#pragma unroll
            for (int m = 0; m < 4; ++m) {
                const int r = row0 + ai * 128 + m * 16;
                float sq = 0.f;
#pragma unroll
                for (int bj = 0; bj < 2; ++bj) {
                    const u32x4 s = bb[m][bj];
                    const f32x4 a0 = acc[ai][bj][m][0], a1 = acc[ai][bj][m][1];
                    const float o0 = bflo(s.x) + a0[0], o1 = bfhi(s.x) + a0[1], o2 = bflo(s.y) + a0[2], o3 = bfhi(s.y) + a0[3];
                    const float o4 = bflo(s.z) + a1[0], o5 = bfhi(s.z) + a1[1], o6 = bflo(s.w) + a1[2], o7 = bfhi(s.w) + a1[3];
                    u32x4 w; w.x = pk(o0, o1); w.y = pk(o2, o3); w.z = pk(o4, o5); w.w = pk(o6, o7);
                    *(u32x4*)(xb + (size_t)r * DM + col0 + bj * 128) = w;
                    sq += (o0 * o0 + o1 * o1) + (o2 * o2 + o3 * o3) + (o4 * o4 + o5 * o5) + (o6 * o6 + o7 * o7);
                }
                sq += __shfl_xor(sq, 16); sq += __shfl_xor(sq, 32);
                if (fq == 0) ssq[(size_t)r * 16 + u.pn * 4 + wc] = sq;
            }
            asm volatile("" ::: "memory");
        }
    }
};
__device__ __forceinline__ float dpp_ror1(float x) { return __int_as_float(__builtin_amdgcn_update_dpp(0, __float_as_int(x), 0x121, 0xf, 0xf, false)); }
__device__ __forceinline__ float dpp_ror2(float x) { return __int_as_float(__builtin_amdgcn_update_dpp(0, __float_as_int(x), 0x122, 0xf, 0xf, false)); }
__device__ __forceinline__ float dpp_shr1(float old, float x) { return __int_as_float(__builtin_amdgcn_update_dpp(__float_as_int(old), __float_as_int(x), 0x111, 0xf, 0xf, false)); }
__device__ __forceinline__ float dpp_shr2(float old, float x) { return __int_as_float(__builtin_amdgcn_update_dpp(__float_as_int(old), __float_as_int(x), 0x112, 0xf, 0xf, false)); }
struct EpiUp {
    static constexpr bool PERM = true, AFTER_DRAIN = false, MIDK = false;
    bf16_t* act; bf16_t* zs; const float* ssq; const float* cw; const float* cb;
    __device__ __forceinline__ void operator()(const f32x4 (&acc)[2][2][4][2], const pg8::Unit& u, int wr, int wc, int fr, int fq) const {
        const int c0 = u.pn * 128 + wc * 32 + 8 * fq;
        const int row0 = u.pm * 256 + wr * 64 + fr;
        float rs8[8]; rows_rstd8(ssq, row0, fq, rs8);
        u32x2 keep[2][4];
#pragma unroll
        for (int n = 0; n < 2; ++n) {
            const int c = c0 + 4 * n;
            const f32x4 gw0 = *(const f32x4*)(cw + c), gw1 = *(const f32x4*)(cw + NUP + c), gw2 = *(const f32x4*)(cw + 2 * NUP + c), gb = *(const f32x4*)(cb + c);
            const f32x4 vw0 = *(const f32x4*)(cw + DFF + c), vw1 = *(const f32x4*)(cw + NUP + DFF + c), vw2 = *(const f32x4*)(cw + 2 * NUP + DFF + c), vb = *(const f32x4*)(cb + DFF + c);
#pragma unroll
            for (int ai = 0; ai < 2; ++ai) {
                f32x4 pg = {0.f, 0.f, 0.f, 0.f}, pv = {0.f, 0.f, 0.f, 0.f};
                const int blk = u.pm * 4 + ai * 2 + wr;
#pragma unroll
                for (int m = 0; m < 4; ++m) {
                    const float rs = rs8[ai * 4 + m];
                    const f32x4 zg = acc[ai][0][m][n] * rs, zv = acc[ai][1][m][n] * rs;
                    float o[4];
#pragma unroll
                    for (int j = 0; j < 4; ++j) {
                        const float g1 = dpp_shr1(dpp_ror1(pg[j]), zg[j]), g2 = dpp_shr2(dpp_ror2(pg[j]), zg[j]);
                        const float v1 = dpp_shr1(dpp_ror1(pv[j]), zv[j]), v2 = dpp_shr2(dpp_ror2(pv[j]), zv[j]);
                        const float gg = gw2[j] * zg[j] + gw1[j] * g1 + gw0[j] * g2 + gb[j];
                        const float vv = vw2[j] * zv[j] + vw1[j] * v1 + vw0[j] * v2 + vb[j];
                        o[j] = silu_f(gg) * vv;
                    }
                    u32x2 w; w.x = pk(o[0], o[1]); w.y = pk(o[2], o[3]);
                    const int r = row0 + ai * 128 + m * 16;
                    if (n == 0) keep[ai][m] = w;
                    else if (!(m == 0 && fr < 2)) { u32x4 ww; ww.x = keep[ai][m].x; ww.y = keep[ai][m].y; ww.z = w.x; ww.w = w.y; st_nt16(act + (size_t)r * DFF + c0, ww); }
                    if (m == 0 && fr < 2) {
                        bf16_t* zp = zs + ((size_t)blk * 4 + 2 + fr) * NUP + c;
                        u32x2 a; a.x = pk(zg[0], zg[1]); a.y = pk(zg[2], zg[3]); *(u32x2*)zp = a;
                        u32x2 d; d.x = pk(zv[0], zv[1]); d.y = pk(zv[2], zv[3]); *(u32x2*)(zp + DFF) = d;
                    }
                    if (m == 3 && fr >= 14) {
                        bf16_t* zp = zs + ((size_t)blk * 4 + (fr - 14)) * NUP + c;
                        u32x2 a; a.x = pk(zg[0], zg[1]); a.y = pk(zg[2], zg[3]); *(u32x2*)zp = a;
                        u32x2 d; d.x = pk(zv[0], zv[1]); d.y = pk(zv[2], zv[3]); *(u32x2*)(zp + DFF) = d;
                    }
                    pg = zg; pv = zv;
                }
            }
        }
    }
};

__device__ __forceinline__ void transpose_tile(const float* __restrict__ W, int N, const float* __restrict__ g, bf16_t* __restrict__ Wt, int ldt, int koff, int k0, int n0, int nd0, float* tile, int tid) {
    {
        const int kk = tid >> 4, nn = (tid & 15) * 4;
#pragma unroll
        for (int h = 0; h < 2; ++h) {
            const int k = kk + h * 32;
            f32x4 v = *(const f32x4*)(W + (size_t)(k0 + k) * N + n0 + nn);
            const float s = g ? g[k0 + k] : 1.0f;
            tile[k * 65 + nn + 0] = v[0] * s; tile[k * 65 + nn + 1] = v[1] * s; tile[k * 65 + nn + 2] = v[2] * s; tile[k * 65 + nn + 3] = v[3] * s;
        }
    }
    __syncthreads();
    {
        const int n = tid >> 3, kq = (tid & 7) * 8;
        float v[8];
#pragma unroll
        for (int j = 0; j < 8; ++j) v[j] = tile[(kq + j) * 65 + n];
        u32x4 w; w.x = pk(v[0], v[1]); w.y = pk(v[2], v[3]); w.z = pk(v[4], v[5]); w.w = pk(v[6], v[7]);
        *(u32x4*)(Wt + (size_t)(nd0 + n) * ldt + koff + k0 + kq) = w;
    }
    __syncthreads();
}

__device__ __forceinline__ void prep_phase(const Params& p, int l, float* ldsf) {
    unsigned char* ws = p.ws;
    bf16_t* wt_in = (bf16_t*)(ws + WS_WIN); bf16_t* wt_br = (bf16_t*)(ws + WS_WBR); bf16_t* wt_o = (bf16_t*)(ws + WS_WO);
    bf16_t* wt_up = (bf16_t*)(ws + WS_WUP); bf16_t* wt_dn = (bf16_t*)(ws + WS_WDN);
    const float* g_mix = p.in[1] + (size_t)l * DM; const float* w_in = p.in[2] + (size_t)l * DM * NIN;
    const float* w_pool = p.in[3] + (size_t)l * 4 * 128 * 128; const float* pscale = p.in[4] + (size_t)l * 512;
    const float* w_ba = p.in[9] + (size_t)l * 512 * DM; const float* w_bb = p.in[10] + (size_t)l * 512 * DM; const float* w_bc = p.in[11] + (size_t)l * 512 * DM;
    const float* w_o = p.in[12] + (size_t)l * DM * DM; const float* g_ffn = p.in[13] + (size_t)l * DM;
    const float* w_up = p.in[14] + (size_t)l * DM * NUP; const float* w_dn = p.in[17] + (size_t)l * DFF * DM;
    const int tid = otid(), bid = obid();
    constexpr int T0 = 16 * 96, T1 = T0 + 128, T2 = T1 + 128, T3 = T2 + 256, T4 = T3 + 16 * 88, T5 = T4 + 44 * 16;
    for (int i = bid; i < T5; i += gridDim.x) {
        if (i < T0) { const int kt = i & 15, nt = i >> 4; transpose_tile(w_in, NIN, g_mix, wt_in, DM, 0, kt * 64, nt * 64, nt * 64, ldsf, tid); }
        else if (i < T1) { const int j = i - T0, kt = j & 7, nt = j >> 3; transpose_tile(w_bb, DM, nullptr, wt_br, NBR, 512, kt * 64, nt * 64, nt * 64, ldsf, tid); }
        else if (i < T2) { const int j = i - T1, kt = j & 7, nt = j >> 3; transpose_tile(w_bc, DM, nullptr, wt_br, NBR, 1024, kt * 64, nt * 64, nt * 64, ldsf, tid); }
        else if (i < T3) { const int j = i - T2, kt = j & 15, nt = j >> 4; transpose_tile(w_o, DM, nullptr, wt_o, DM, 0, kt * 64, nt * 64, nt * 64, ldsf, tid); }
        else if (i < T4) { const int j = i - T3, kt = j & 15, nt = j >> 4; const int n0 = nt * 64, bj = n0 / DFF, q0 = n0 - bj * DFF; transpose_tile(w_up, NUP, g_ffn, wt_up, DM, 0, kt * 64, n0, (q0 >> 7) * 256 + bj * 128 + (q0 & 127), ldsf, tid);   }
        else { const int j = i - T4, kt = j % 44, nt = j / 44; transpose_tile(w_dn, DM, nullptr, wt_dn, DFF, 0, kt * 64, nt * 64, nt * 64, ldsf, tid); }
    }
    {
        float* wpT = ldsf;
        float* wa = ldsf + 128 * 128;
        for (int it = (int)gridDim.x - 1 - bid; it < 64; it += gridDim.x) {
            const int g = it >> 4, n0 = (it & 15) * 64;
            for (int q = tid; q < 128 * 32; q += 512) {
                const int d = q >> 5, e4 = (q & 31) * 4;
                const f32x4 v = *(const f32x4*)(w_pool + ((size_t)g * 128 + d) * 128 + e4);
                const f32x4 s = *(const f32x4*)(pscale + g * 128 + e4);
                wpT[(e4 + 0) * 128 + d] = v[0] * s[0]; wpT[(e4 + 1) * 128 + d] = v[1] * s[1]; wpT[(e4 + 2) * 128 + d] = v[2] * s[2]; wpT[(e4 + 3) * 128 + d] = v[3] * s[3];
            }
            for (int q = tid; q < 128 * 16; q += 512) {
                const int e = q >> 4, c4 = (q & 15) * 4;
                *(f32x4*)(wa + e * 64 + c4) = *(const f32x4*)(w_ba + (size_t)(g * 128 + e) * DM + n0 + c4);
            }
            __syncthreads();
            const int d = tid & 127, ns = tid >> 7;
            float acc[16];
#pragma unroll
            for (int i = 0; i < 16; ++i) acc[i] = 0.f;
            for (int e = 0; e < 128; ++e) {
                const float w = wpT[e * 128 + d];
                const f32x4* wr4 = (const f32x4*)(wa + e * 64 + ns * 16);
#pragma unroll
                for (int c = 0; c < 4; ++c) { const f32x4 b = wr4[c]; acc[c * 4 + 0] += w * b[0]; acc[c * 4 + 1] += w * b[1]; acc[c * 4 + 2] += w * b[2]; acc[c * 4 + 3] += w * b[3]; }
            }
#pragma unroll
            for (int i = 0; i < 16; ++i) wt_br[(size_t)(n0 + ns * 16 + i) * NBR + g * 128 + d] = (bf16_t)(pk(acc[i], 0.f) & 0xffffu);
            __syncthreads();
        }
    }
    if (l == 0) {
        const float* x = p.in[0]; bf16_t* xb = (bf16_t*)(ws + WS_XB); float* ssq = (float*)(ws + WS_SSQ);
        const int lane = tid & 63, wave = tid >> 6;
        for (int r = bid * 8 + wave; r < MTOK; r += gridDim.x * 8) {
            float sq = 0.f;
#pragma unroll
            for (int i = 0; i < 4; ++i) {
                const f32x4 v = *(const f32x4*)(x + (size_t)r * DM + i * 256 + lane * 4);
                sq += (v[0] * v[0] + v[1] * v[1]) + (v[2] * v[2] + v[3] * v[3]);
                u32x2 w; w.x = pk(v[0], v[1]); w.y = pk(v[2], v[3]);
                *(u32x2*)(xb + (size_t)r * DM + i * 256 + lane * 4) = w;
            }
#pragma unroll
            for (int o = 32; o >= 1; o >>= 1) sq += __shfl_xor(sq, o);
            if (lane < 16) ssq[(size_t)r * 16 + lane] = (lane == 0) ? sq : 0.f;
        }
    }
}
__device__ __forceinline__ void ld8(const bf16_t* p, float (&v)[8]) {
    const u32x4 w = *(const u32x4*)p;
    v[0] = bflo(w.x); v[1] = bfhi(w.x); v[2] = bflo(w.y); v[3] = bfhi(w.y); v[4] = bflo(w.z); v[5] = bfhi(w.z); v[6] = bflo(w.w); v[7] = bfhi(w.w);
}
__device__ __forceinline__ void st8(bf16_t* p, const float (&v)[8]) {
    u32x4 w; w.x = pk(v[0], v[1]); w.y = pk(v[2], v[3]); w.z = pk(v[4], v[5]); w.w = pk(v[6], v[7]);
    *(u32x4*)p = w;
}
template <int W> __device__ __forceinline__ void pool_rows(const bf16_t* __restrict__ ap, bf16_t* __restrict__ yp, int r0, int pos0) {
#pragma unroll
    for (int b = 0; b < 4; ++b) {
        const int base = r0 + 4 * b;
        u32x4 h[W + 3];
#pragma unroll
        for (int i = 0; i < W + 3; ++i) { const int rr = base - (W - 1) + i; h[i] = (pos0 + rr >= 0) ? *(const u32x4*)(ap + (ptrdiff_t)rr * NPA) : (u32x4){0u, 0u, 0u, 0u}; }
        float s[8];
#pragma unroll
        for (int j = 0; j < 8; ++j) s[j] = 0.f;
#pragma unroll
        for (int i = 0; i < W - 1; ++i) { const u32x4 q = h[i];
            s[0] += bflo(q.x); s[1] += bfhi(q.x); s[2] += bflo(q.y); s[3] += bfhi(q.y); s[4] += bflo(q.z); s[5] += bfhi(q.z); s[6] += bflo(q.w); s[7] += bfhi(q.w); }
#pragma unroll
        for (int i = 0; i < 4; ++i) {
            const int rr = base + i, pos = pos0 + rr; const float inv = 1.0f / (float)(pos + 1 < W ? pos + 1 : W);
            const u32x4 q = h[W - 1 + i], od = h[i];
            const float v[8] = {bflo(q.x), bfhi(q.x), bflo(q.y), bfhi(q.y), bflo(q.z), bfhi(q.z), bflo(q.w), bfhi(q.w)};
            float o[8];
#pragma unroll
            for (int j = 0; j < 8; ++j) { s[j] += v[j]; o[j] = s[j] * inv - v[j]; }
            st8(yp + (size_t)rr * NBR, o);
            s[0] -= bflo(od.x); s[1] -= bfhi(od.x); s[2] -= bflo(od.y); s[3] -= bfhi(od.y); s[4] -= bflo(od.z); s[5] -= bfhi(od.z); s[6] -= bflo(od.w); s[7] -= bfhi(od.w);
        }
        asm volatile("" ::: "memory");
    }
}
constexpr int VT_PITCH = 136;
__device__ __forceinline__ void mixer_phase(const Params& p, int l, unsigned char* lds) {
    const bf16_t* PA = (const bf16_t*)(p.ws + WS_B1);
    bf16_t* Y = (bf16_t*)p.out;
    const float* g_sgu = p.in[5] + (size_t)l * 512;
    const float* w_sp = p.in[6] + (size_t)l * 4 * 128 * 128;
    const float* b_sp = p.in[7] + (size_t)l * 4 * 128;
    const float* conv_c = p.in[8] + (size_t)l * 3 * 512;
    float* rs = (float*)lds;
    bf16_t* vT = (bf16_t*)(lds + 1024);
    const int tid = otid(), lane = tid & 63, wave = tid >> 6, fr = lane & 15, fq = lane >> 4;
    for (int item = obid(); item < MTOK / 128; item += gridDim.x) {
        const int t0 = item * 128, pos0 = t0 & (SEQ - 1);
        {
            const int row = tid >> 2, q = tid & 3;
            const bf16_t* vp = PA + (size_t)(t0 + row) * NPA + 1024 + q * 128;
            float sq = 0.f;
#pragma unroll
            for (int i = 0; i < 16; ++i) { float v[8]; ld8(vp + i * 8, v);
#pragma unroll
                for (int j = 0; j < 8; ++j) sq += v[j] * v[j]; }
            sq += __shfl_xor(sq, 1); sq += __shfl_xor(sq, 2);
            if (q == 0) rs[row] = rsqrtf(sq * (1.0f / 512.0f) + EPS);
        }
        {
            const int grp = wave & 3;
            const int c8 = (grp * 16 + (lane & 15)) * 8; int r0 = ((wave >> 2) * 4 + (lane >> 4)) * 16;
            asm volatile("" : "+v"(r0));
            {
                const bf16_t* ap = PA + (size_t)t0 * NPA + c8;
                bf16_t* yp = Y + (size_t)t0 * NBR + c8;
                if (grp == 0) pool_rows<2>(ap, yp, r0, pos0); else if (grp == 1) pool_rows<4>(ap, yp, r0, pos0); else if (grp == 2) pool_rows<8>(ap, yp, r0, pos0); else pool_rows<16>(ap, yp, r0, pos0);
            }
            {
                const bf16_t* bp = PA + (size_t)t0 * NPA + 1536 + c8;
                bf16_t* yp = Y + (size_t)t0 * NBR + 1024 + c8;
                float w0[8], w1[8], w2[8], z1[8], z2[8];
#pragma unroll
                for (int j = 0; j < 8; ++j) { w0[j] = conv_c[c8 + j]; w1[j] = conv_c[512 + c8 + j]; w2[j] = conv_c[1024 + c8 + j]; z1[j] = 0.f; z2[j] = 0.f; }
                {
                    const bool h2 = pos0 + r0 - 2 >= 0, h1 = pos0 + r0 - 1 >= 0;
                    const u32x4 zz = {0u, 0u, 0u, 0u};
                    const u32x4 a2 = h2 ? *(const u32x4*)(bp + (ptrdiff_t)(r0 - 2) * NPA + 512) : zz, b2 = h2 ? *(const u32x4*)(bp + (ptrdiff_t)(r0 - 2) * NPA + 1024) : zz;
                    const u32x4 a1 = h1 ? *(const u32x4*)(bp + (ptrdiff_t)(r0 - 1) * NPA + 512) : zz, b1 = h1 ? *(const u32x4*)(bp + (ptrdiff_t)(r0 - 1) * NPA + 1024) : zz;
                    z2[0] = bflo(a2.x) * bflo(b2.x); z2[1] = bfhi(a2.x) * bfhi(b2.x); z2[2] = bflo(a2.y) * bflo(b2.y); z2[3] = bfhi(a2.y) * bfhi(b2.y);
                    z2[4] = bflo(a2.z) * bflo(b2.z); z2[5] = bfhi(a2.z) * bfhi(b2.z); z2[6] = bflo(a2.w) * bflo(b2.w); z2[7] = bfhi(a2.w) * bfhi(b2.w);
                    z1[0] = bflo(a1.x) * bflo(b1.x); z1[1] = bfhi(a1.x) * bfhi(b1.x); z1[2] = bflo(a1.y) * bflo(b1.y); z1[3] = bfhi(a1.y) * bfhi(b1.y);
                    z1[4] = bflo(a1.z) * bflo(b1.z); z1[5] = bfhi(a1.z) * bfhi(b1.z); z1[6] = bflo(a1.w) * bflo(b1.w); z1[7] = bfhi(a1.w) * bfhi(b1.w);
                }
#pragma unroll
                for (int hb = 0; hb < 4; ++hb) {
                    u32x4 qb[4], qc[4], qx[4];
#pragma unroll
                    for (int i = 0; i < 4; ++i) { const bf16_t* rp = bp + (size_t)(r0 + hb * 4 + i) * NPA; qb[i] = *(const u32x4*)rp; qc[i] = *(const u32x4*)(rp + 512); qx[i] = *(const u32x4*)(rp + 1024); }
#pragma unroll
                    for (int i = 0; i < 4; ++i) {
                        const float cb[8] = {bflo(qb[i].x), bfhi(qb[i].x), bflo(qb[i].y), bfhi(qb[i].y), bflo(qb[i].z), bfhi(qb[i].z), bflo(qb[i].w), bfhi(qb[i].w)};
                        const float a[8] = {bflo(qc[i].x), bfhi(qc[i].x), bflo(qc[i].y), bfhi(qc[i].y), bflo(qc[i].z), bfhi(qc[i].z), bflo(qc[i].w), bfhi(qc[i].w)};
                        const float b[8] = {bflo(qx[i].x), bfhi(qx[i].x), bflo(qx[i].y), bfhi(qx[i].y), bflo(qx[i].z), bfhi(qx[i].z), bflo(qx[i].w), bfhi(qx[i].w)};
                        float o[8];
#pragma unroll
                        for (int j = 0; j < 8; ++j) { const float z = a[j] * b[j]; o[j] = cb[j] * (w0[j] * z2[j] + w1[j] * z1[j] + w2[j] * z); z2[j] = z1[j]; z1[j] = z; }
                        st8(yp + (size_t)(r0 + hb * 4 + i) * NBR, o);
                    }
                    asm volatile("" ::: "memory");
                }
            }
        }
        for (int g = 0; g < 4; ++g) {
            __syncthreads();
            {
                const int s = tid >> 2, dq = (tid & 3) * 32;
                const bf16_t* vp = PA + (size_t)(t0 + s) * NPA + 1024 + g * 128 + dq;
#pragma unroll
                for (int i = 0; i < 4; ++i) {
                    const u32x4 w = *(const u32x4*)(vp + i * 8);
                    const unsigned ww[4] = {w.x, w.y, w.z, w.w};
#pragma unroll
                    for (int q = 0; q < 4; ++q) { vT[(dq + i * 8 + q * 2) * VT_PITCH + s] = (bf16_t)(ww[q] & 0xffffu); vT[(dq + i * 8 + q * 2 + 1) * VT_PITCH + s] = (bf16_t)(ww[q] >> 16); }
                }
            }
            __syncthreads();
            f32x4 acc[8];
#pragma unroll
            for (int n = 0; n < 8; ++n) acc[n] = (f32x4){0.f, 0.f, 0.f, 0.f};
            const int t = wave * 16 + fr;
            const int nk = (wave >> 1) + 1;
            for (int k = 0; k < nk; ++k) {
                const int s0 = k * 32 + fq * 8;
                const float* wp = w_sp + ((size_t)g * 128 + t) * 128 + s0;
                const f32x4 wa = *(const f32x4*)wp, wb = *(const f32x4*)(wp + 4);
                const f32x4 ra = *(const f32x4*)(rs + s0), rb = *(const f32x4*)(rs + s0 + 4);
                float a[8];
#pragma unroll
                for (int j = 0; j < 4; ++j) { a[j] = (s0 + j <= t) ? wa[j] * ra[j] : 0.f; a[4 + j] = (s0 + 4 + j <= t) ? wb[j] * rb[j] : 0.f; }
                union { u32x4 u; bf16x8 h; } af; af.u.x = pk(a[0], a[1]); af.u.y = pk(a[2], a[3]); af.u.z = pk(a[4], a[5]); af.u.w = pk(a[6], a[7]);
#pragma unroll
                for (int n = 0; n < 8; ++n) {
                    const bf16x8 bfrag = *(const bf16x8*)(vT + (n * 16 + fr) * VT_PITCH + s0);
                    acc[n] = __builtin_amdgcn_mfma_f32_16x16x32_bf16(bfrag, af.h, acc[n], 0, 0, 0);
                }
            }
            const float bias = b_sp[g * 128 + t];
            const bf16_t* up = PA + (size_t)(t0 + t) * NPA + 512 + g * 128 + 4 * fq;
            bf16_t* yp = Y + (size_t)(t0 + t) * NBR + 512 + g * 128 + 4 * fq;
#pragma unroll
            for (int n = 0; n < 8; ++n) {
                const u32x2 uu = *(const u32x2*)(up + n * 16);
                const f32x4 gs = *(const f32x4*)(g_sgu + g * 128 + n * 16 + 4 * fq);
                const float o0 = bflo(uu.x) * (acc[n][0] * gs[0] + bias), o1 = bfhi(uu.x) * (acc[n][1] * gs[1] + bias);
                const float o2 = bflo(uu.y) * (acc[n][2] * gs[2] + bias), o3 = bfhi(uu.y) * (acc[n][3] * gs[3] + bias);
                u32x2 w; w.x = pk(o0, o1); w.y = pk(o2, o3);
                *(u32x2*)(yp + n * 16) = w;
            }
        }
        __syncthreads();
    }
}

__device__ __forceinline__ void ffn_fixup_phase(const Params& p, int l) {
    const bf16_t* zs = (const bf16_t*)(p.ws + WS_B2);
    bf16_t* act = (bf16_t*)(p.ws + WS_B1);
    const float* cw = p.in[15] + (size_t)l * 3 * NUP; const float* cb = p.in[16] + (size_t)l * NUP;
    constexpr int NCG = DFF / 8, NU = (MTOK / 64) * NCG;
    for (int u = obid() * 512 + otid(); u < NU; u += gridDim.x * 512) {
        const int blk = u / NCG, c8 = (u - blk * NCG) * 8;
        const bool first = ((blk * 64) & (SEQ - 1)) == 0;
        float g2[8], g1[8], ga[8], gb2[8], v2[8], v1[8], va[8], vb2[8];
#pragma unroll
        for (int j = 0; j < 8; ++j) { g2[j] = g1[j] = v2[j] = v1[j] = 0.f; }
        const bf16_t* own = zs + (size_t)blk * 4 * NUP + c8;
        if (!first) { const bf16_t* prv = own - 4 * (ptrdiff_t)NUP; ld8(prv, g2); ld8(prv + NUP, g1); ld8(prv + DFF, v2); ld8(prv + NUP + DFF, v1); }
        ld8(own + 2 * NUP, ga); ld8(own + 3 * NUP, gb2); ld8(own + 2 * NUP + DFF, va); ld8(own + 3 * NUP + DFF, vb2);
        float o0[8], o1[8];
#pragma unroll
        for (int j = 0; j < 8; ++j) {
            const float w0 = cw[c8 + j], w1 = cw[NUP + c8 + j], w2 = cw[2 * NUP + c8 + j], bb = cb[c8 + j];
            const float x0 = cw[DFF + c8 + j], x1 = cw[NUP + DFF + c8 + j], x2 = cw[2 * NUP + DFF + c8 + j], xb_ = cb[DFF + c8 + j];
            const float gg0 = w0 * g2[j] + w1 * g1[j] + w2 * ga[j] + bb, vv0 = x0 * v2[j] + x1 * v1[j] + x2 * va[j] + xb_;
            const float gg1 = w0 * g1[j] + w1 * ga[j] + w2 * gb2[j] + bb, vv1 = x0 * v1[j] + x1 * va[j] + x2 * vb2[j] + xb_;
            o0[j] = silu_f(gg0) * vv0; o1[j] = silu_f(gg1) * vv1;
        }
        st8(act + (size_t)(blk * 64) * DFF + c8, o0); st8(act + (size_t)(blk * 64 + 1) * DFF + c8, o1);
    }
}

__device__ __forceinline__ void final_norm_phase(const Params& p) {
    const float* gf = p.in[18]; const float* ssq = (const float*)(p.ws + WS_SSQ); const bf16_t* xb = (const bf16_t*)(p.ws + WS_XB); float* out = p.out;
    const int tid = otid(), lane = tid & 63, wave = tid >> 6;
    for (int r = obid() * 8 + wave; r < MTOK; r += gridDim.x * 8) {
        const float rs = row_rstd(ssq, r);
#pragma unroll
        for (int i = 0; i < 2; ++i) {
            const int c = i * 512 + lane * 8;
            float v[8]; ld8(xb + (size_t)r * DM + c, v);
            const f32x4 g0 = *(const f32x4*)(gf + c), g1 = *(const f32x4*)(gf + c + 4);
            f32x4 o0, o1;
#pragma unroll
            for (int j = 0; j < 4; ++j) { o0[j] = v[j] * rs * g0[j]; o1[j] = v[4 + j] * rs * g1[j]; }
            float* q = out + (size_t)r * DM + c;
            __builtin_nontemporal_store(o0, (f32x4*)q); __builtin_nontemporal_store(o1, (f32x4*)(q + 4));
        }
    }
}

template <class Epi> __device__ __forceinline__ void run_gemm(unsigned char* lds, const bf16_t* A, const bf16_t* Bt, int M, int N, int K, const Epi& E, int stagger_step = 0) {
    pg8::Gemm g{A, Bt, M, N, K}; pg8::StaticOrder S; S.init(M, N, (int)gridDim.x, obid());
    if (stagger_step) {
        const unsigned long long t0 = wall_clock64(), d = (unsigned long long)(((obid() >> 3) & 7) * stagger_step);
        while (wall_clock64() - t0 < d) __builtin_amdgcn_s_sleep(16);
    }
    pg8::gemm_phase<Epi, pg8::StaticOrder, false>((PG8_LAS unsigned char*)lds, g, S, E, nullptr);
}

__global__ void __launch_bounds__(512, 2) fwd_megakernel(Params p) {
    extern __shared__ __attribute__((aligned(16))) unsigned char lds[];
    cg::grid_group grid = cg::this_grid();
    unsigned char* ws = p.ws;
    bf16_t* wt_in = (bf16_t*)(ws + WS_WIN); bf16_t* wt_br = (bf16_t*)(ws + WS_WBR); bf16_t* wt_o = (bf16_t*)(ws + WS_WO);
    bf16_t* wt_up = (bf16_t*)(ws + WS_WUP); bf16_t* wt_dn = (bf16_t*)(ws + WS_WDN);
    float* ssq = (float*)(ws + WS_SSQ); bf16_t* xb = (bf16_t*)(ws + WS_XB); bf16_t* b1 = (bf16_t*)(ws + WS_B1); bf16_t* b2 = (bf16_t*)(ws + WS_B2);
    for (int l = 0; l < 2; ++l) {
        prep_phase(p, l, (float*)lds);
        grid.sync();
        { EpiIn E{b1, b2, ssq}; run_gemm(lds, xb, wt_in, MTOK, NIN, DM, E); }
        grid.sync();
        mixer_phase(p, l, lds);
        grid.sync();
        { EpiBr E{b2, b1}; run_gemm(lds, (const bf16_t*)p.out  , wt_br, MTOK, DM, NBR, E); }
        grid.sync();
        { EpiRes E{xb, ssq}; run_gemm(lds, b1, wt_o, MTOK, DM, DM, E); }
        grid.sync();
        { EpiUp E{b1, b2, ssq, p.in[15] + (size_t)l * 3 * NUP, p.in[16] + (size_t)l * NUP}; run_gemm(lds, xb, wt_up, MTOK, NUP, DM, E); }
        grid.sync();
        ffn_fixup_phase(p, l);
        grid.sync();
        { EpiRes E{xb, ssq}; run_gemm(lds, b1, wt_dn, MTOK, DM, DFF, E); }
        grid.sync();
    }
    final_norm_phase(p);
}

extern "C" void kernel_launch(void* const* d_in, const int* in_sizes, int n_in, void* d_out, int out_size, void* d_ws, size_t ws_size, hipStream_t stream) {
    constexpr size_t kLds = pg8::STAGE_BYTES;
    static int grid_blocks = 0;
    if (!grid_blocks) {
        int dev = 0, cus = 0, per_cu = 0;
        (void)hipGetDevice(&dev);
        (void)hipDeviceGetAttribute(&cus, hipDeviceAttributeMultiprocessorCount, dev);
        (void)hipFuncSetAttribute((const void*)fwd_megakernel, hipFuncAttributeMaxDynamicSharedMemorySize, (int)kLds);
        (void)hipOccupancyMaxActiveBlocksPerMultiprocessor(&per_cu, (const void*)fwd_megakernel, 512, kLds);
        if (per_cu < 1) per_cu = 1;
        grid_blocks = cus;
        if (ws_size < WS_END || n_in != 19 || out_size != MTOK * DM) { fprintf(stderr, "kernel_launch: unexpected sizes: ws %zu (need %zu), n_in %d, out %d\n", ws_size, (size_t)WS_END, n_in, out_size); }
    }
    Params p{};
    for (int i = 0; i < 19; ++i) p.in[i] = (const float*)d_in[i];
    p.out = (float*)d_out; p.ws = (unsigned char*)d_ws;
    void* args[] = {&p};
    hipError_t e = hipLaunchCooperativeKernel((void*)fwd_megakernel, dim3(grid_blocks), dim3(512), args, kLds, stream);
    if (e != hipSuccess) fprintf(stderr, "cooperative launch failed: %s (grid %d)\n", hipGetErrorString(e), grid_blocks);
}
```

```cpp
#include <hip/hip_runtime.h>
#include <hip/hip_cooperative_groups.h>
#include <cstdio>
namespace cg = cooperative_groups;
namespace pg8 {
#define PG8_LAS __attribute__((address_space(3)))
typedef unsigned short bf16_t;
typedef short bf16x8 __attribute__((ext_vector_type(8)));
typedef float f32x4 __attribute__((ext_vector_type(4)));
typedef unsigned u32x4 __attribute__((ext_vector_type(4)));
constexpr int BM = 256, BK = 64, HALF = 128, HTB = HALF * BK * 2  , STAGE_BYTES = 8 * HTB, NXCD = 8, WGM = 8;

__host__ __device__ __forceinline__ int lds_byte(int r, int c) { const int st = (r >> 4) * 2 + (c >> 5), rr = r & 15, cc = c & 31, ob = rr * 64 + cc * 2; return st * 1024 + (ob ^ (((ob >> 9) & 1) << 5)); }
__host__ __device__ __forceinline__ void stage_rc(int b, int& R, int& C) { const int st = b / 1024, sb = b % 1024, swz = sb ^ (((sb >> 9) & 1) << 5); R = (st >> 1) * 16 + swz / 64; C = (st & 1) * 32 + (swz % 64) / 2; }
__host__ __device__ __forceinline__ int perm32(int rho) { const int n = rho >> 4, i = rho & 15; return 8 * (i >> 2) + 4 * n + (i & 3); }

struct Unit { int pm, pn; };
struct Gemm { const bf16_t* A; const bf16_t* Bt; int M, N, K; };

struct StaticOrder {
    int nM, nN, nwg, G, c;
    __host__ __device__ void init(int M, int N, int G_, int c_) { nM = M / BM; nN = N / BM; nwg = nM * nN; G = G_; c = c_; }
    __host__ __device__ bool next(int i, Unit& u) const {
        const long L = (long)i * G + c; if (L >= nwg) return false;
        int wgid = (int)L; { const int q = nwg / NXCD, r = nwg % NXCD, xcd = wgid % NXCD, off = wgid / NXCD; wgid = (xcd < r ? xcd * (q + 1) : r * (q + 1) + (xcd - r) * q) + off; }
        const int nig = WGM * nN, gid = wgid / nig, fm = gid * WGM, gsz = (nM - fm) < WGM ? (nM - fm) : WGM;
        u.pm = fm + ((wgid % nig) % gsz); u.pn = (wgid % nig) / gsz; return true;
    }
    __device__ __forceinline__ void a_ready(const Unit&) const {}
    __device__ __forceinline__ void done(const Unit&) const {}
};
__device__ __forceinline__ unsigned cvt_pk_bf16(float lo, float hi) { unsigned r; asm volatile("v_cvt_pk_bf16_f32 %0, %1, %2" : "=v"(r) : "v"(lo), "v"(hi)); return r; }

template <class Epi, class Sched, bool STAMP = false>
__device__ __forceinline__ void gemm_phase(PG8_LAS unsigned char* lds, const Gemm g, const Sched& S, const Epi& E, unsigned long long* stamps) {
    int tid_ = threadIdx.x; asm volatile("" : "+v"(tid_));
    const int tid = tid_, wid = __builtin_amdgcn_readfirstlane(tid >> 6), lane = tid & 63, wr = wid >> 2, wc = wid & 3, fr = lane & 15, fq = lane >> 4;
    const int K = g.K, nt = K / BK;
    int ts_lo = 0, ts_hi = 0, nts = 0; const unsigned long long rt_entry = STAMP ? (unsigned long long)wall_clock64() : 0ull;
#define PG8_STAMP() do { if (STAMP && wid == 0 && nts < 64) { const unsigned long long _c = (unsigned long long)clock64(); \
        ts_lo = (lane == nts) ? (int)(unsigned)_c : ts_lo; ts_hi = (lane == nts) ? (int)(unsigned)(_c >> 32) : ts_hi; ++nts; } } while (0)
    PG8_STAMP();
    unsigned voffA[2], voffB[2];
#pragma unroll
    for (int i = 0; i < 2; ++i) { int R, C; stage_rc(tid * 16 + i * 8192, R, C); const int Rb = Epi::PERM ? ((R & ~31) + perm32(R & 31)) : R;
        voffA[i] = (unsigned)(R * K + C) * 2u; voffB[i] = (unsigned)(Rb * K + C) * 2u; }
    const size_t kstep = (size_t)(BK * 2);
    const size_t hstep = (size_t)HALF * K * 2;
    const size_t tstep = 2 * hstep;
    const unsigned ldsw = (unsigned)wid * 1024u;
    const int aoff = lds_byte(wr * 64 + fr, fq * 8), boff = lds_byte(wc * 32 + fr, fq * 8);
#define PG8_SA(b, h) (((b) * 2 + (h)) * HTB)
#define PG8_SB(b, h) ((4 + (b) * 2 + (h)) * HTB)
#define PG8_STAGE(bufoff, gbase, voff) do { _Pragma("unroll") for (int _i = 0; _i < 2; ++_i) \
        __builtin_amdgcn_global_load_lds((const unsigned*)((const char*)(gbase) + (voff)[_i]), (PG8_LAS unsigned*)(lds + (bufoff) + ldsw + _i * 8192), 16, 0, 0); } while (0)
#define PG8_LDA(dst, b, h) do { _Pragma("unroll") for (int m = 0; m < 4; ++m) _Pragma("unroll") for (int k = 0; k < 2; ++k) dst[m][k] = *(const PG8_LAS bf16x8*)(lds + PG8_SA(b, h) + aoff + m * 2048 + k * 1024); } while (0)
#define PG8_LDB(dst, b, h) do { _Pragma("unroll") for (int n = 0; n < 2; ++n) _Pragma("unroll") for (int k = 0; k < 2; ++k) dst[n][k] = *(const PG8_LAS bf16x8*)(lds + PG8_SB(b, h) + boff + n * 2048 + k * 1024); } while (0)
#define PG8_MMA(ai, bj, At, Bt) do { __builtin_amdgcn_s_setprio(1); _Pragma("unroll") for (int m = 0; m < 4; ++m) _Pragma("unroll") for (int n = 0; n < 2; ++n) _Pragma("unroll") for (int k = 0; k < 2; ++k) \
        acc[ai][bj][m][n] = __builtin_amdgcn_mfma_f32_16x16x32_bf16(Bt[n][k], At[m][k], acc[ai][bj][m][n], 0, 0, 0); __builtin_amdgcn_s_setprio(0); } while (0)
#define PG8_WAIT_V(n) asm volatile("s_waitcnt vmcnt(" #n ")" ::: "memory")
#define PG8_WAIT_L(n) asm volatile("s_waitcnt lgkmcnt(" #n ")" ::: "memory")
#define PG8_BAR __builtin_amdgcn_s_barrier()
#define PG8_SCHED __builtin_amdgcn_sched_barrier(0)
    Unit cur, nxt; int ui = 0;
    if (!S.next(0, cur)) return;
    f32x4 acc[2][2][4][2];
#pragma unroll
    for (int a = 0; a < 2; ++a)
#pragma unroll
        for (int b = 0; b < 2; ++b)
#pragma unroll
            for (int m = 0; m < 4; ++m)
#pragma unroll
                for (int n = 0; n < 2; ++n) acc[a][b][m][n] = (f32x4){0.f, 0.f, 0.f, 0.f};
    bf16x8 At[4][2], B0[2][2], B1[2][2];
    const char* cA = (const char*)g.A + (size_t)cur.pm * tstep; const char* cB = (const char*)g.Bt + (size_t)cur.pn * tstep;
    S.a_ready(cur);
    PG8_STAGE(PG8_SB(0, 0), cB, voffB); PG8_STAGE(PG8_SA(0, 0), cA, voffA); PG8_STAGE(PG8_SB(0, 1), cB + hstep, voffB); PG8_STAGE(PG8_SA(0, 1), cA + hstep, voffA);
    if (wr == 1) PG8_BAR;
    PG8_WAIT_V(4); PG8_BAR;
    PG8_STAGE(PG8_SB(1, 0), cB + kstep, voffB); PG8_STAGE(PG8_SA(1, 0), cA + kstep, voffA); PG8_STAGE(PG8_SB(1, 1), cB + hstep + kstep, voffB);
    PG8_WAIT_V(6); PG8_BAR;
    PG8_STAMP();
    for (;;) {
        const bool has_next = S.next(ui + 1, nxt);
        const char* nA = has_next ? (const char*)g.A + (size_t)nxt.pm * tstep : cA; const char* nB = has_next ? (const char*)g.Bt + (size_t)nxt.pn * tstep : cB;
        for (int t = 0; t < nt; t += 2) {
            if constexpr (Epi::MIDK) { if (t == 8 || t == 16) E.mid(acc, cur, t, wr, wc, fr, fq); }
            const bool last = (t == nt - 2);
            const char* a1 = cA + (size_t)(t + 1) * kstep;
            const char* a2 = last ? nA : cA + (size_t)(t + 2) * kstep; const char* b2 = last ? nB : cB + (size_t)(t + 2) * kstep;
            const char* a3 = a2 + kstep; const char* b3 = b2 + kstep;
            if (last && has_next) S.a_ready(nxt);
            PG8_LDB(B0, 0, 0); PG8_SCHED; PG8_LDA(At, 0, 0); PG8_STAGE(PG8_SA(1, 1), a1 + hstep, voffA);
            PG8_WAIT_L(8); PG8_BAR; PG8_WAIT_L(0); PG8_MMA(0, 0, At, B0); PG8_BAR; PG8_SCHED;
            PG8_LDB(B1, 0, 1); PG8_STAGE(PG8_SB(0, 0), b2, voffB);
            PG8_BAR; PG8_WAIT_L(0); PG8_MMA(0, 1, At, B1); PG8_BAR;
            PG8_LDA(At, 0, 1); PG8_STAGE(PG8_SA(0, 0), a2, voffA);
            PG8_BAR; PG8_WAIT_L(0); PG8_MMA(1, 0, At, B0); PG8_BAR; PG8_SCHED;
            PG8_STAGE(PG8_SB(0, 1), b2 + hstep, voffB);
            PG8_WAIT_V(6); PG8_BAR; PG8_MMA(1, 1, At, B1); PG8_BAR;
            PG8_LDB(B0, 1, 0); PG8_SCHED; PG8_LDA(At, 1, 0); PG8_STAGE(PG8_SA(0, 1), a2 + hstep, voffA);
            PG8_WAIT_L(8); PG8_BAR; PG8_WAIT_L(0); PG8_MMA(0, 0, At, B0); PG8_BAR; PG8_SCHED;
            PG8_LDB(B1, 1, 1); PG8_STAGE(PG8_SB(1, 0), b3, voffB);
            PG8_BAR; PG8_WAIT_L(0); PG8_MMA(0, 1, At, B1); PG8_BAR;
            PG8_LDA(At, 1, 1); PG8_STAGE(PG8_SA(1, 0), a3, voffA);
            PG8_BAR; PG8_WAIT_L(0); PG8_MMA(1, 0, At, B0); PG8_BAR; PG8_SCHED;
            PG8_STAGE(PG8_SB(1, 1), b3 + hstep, voffB);
            PG8_WAIT_V(6); PG8_BAR; PG8_MMA(1, 1, At, B1); PG8_BAR;
        }
        PG8_STAMP();
        if constexpr (!Epi::AFTER_DRAIN) { E(acc, cur, wr, wc, fr, fq); S.done(cur); }
        PG8_STAMP();
        if (!has_next) break;
#pragma unroll
        for (int a = 0; a < 2; ++a)
#pragma unroll
            for (int b = 0; b < 2; ++b)
#pragma unroll
                for (int m = 0; m < 4; ++m)
#pragma unroll
                    for (int n = 0; n < 2; ++n) acc[a][b][m][n] = (f32x4){0.f, 0.f, 0.f, 0.f};
        cur = nxt; cA = nA; cB = nB; ++ui;
    }
    PG8_WAIT_V(0);
    if (wr == 0) PG8_BAR;
    PG8_BAR;
    if constexpr (Epi::AFTER_DRAIN) { E.fused(acc, cur, wr, wc, fr, fq, lds, wid, lane); S.done(cur); }
    PG8_STAMP();
    if (STAMP && wid == 0) { stamps[lane] = lane < nts ? (((unsigned long long)(unsigned)ts_hi << 32) | (unsigned)ts_lo) : 0ull;
        if (lane == 62) stamps[62] = rt_entry; if (lane == 63) stamps[63] = (unsigned long long)wall_clock64(); }
#undef PG8_STAMP
#undef PG8_SA
#undef PG8_SB
#undef PG8_STAGE
#undef PG8_LDA
#undef PG8_LDB
#undef PG8_MMA
#undef PG8_WAIT_V
#undef PG8_WAIT_L
#undef PG8_BAR
#undef PG8_SCHED
}
}
typedef pg8::bf16_t bf16_t;
typedef pg8::f32x4 f32x4;
typedef pg8::u32x4 u32x4;
typedef pg8::bf16x8 bf16x8;
typedef unsigned u32x2 __attribute__((ext_vector_type(2)));
#define LAS __attribute__((address_space(3)))
constexpr int MTOK = 65536, DM = 1024, NIN = 6144, DFF = 2816, NUP = 5632, SEQ = 8192, NBR = 1536, NPA = 3072;
constexpr int MH = MTOK / 2;
constexpr float EPS = 1e-6f;
constexpr size_t WS_WIN = 0;
constexpr size_t WS_WBR = WS_WIN + (size_t)NIN * DM * 2;
constexpr size_t WS_WO = WS_WBR + (size_t)DM * NBR * 2;
constexpr size_t WS_WUP = WS_WO + (size_t)DM * DM * 2;
constexpr size_t WS_WDN = WS_WUP + (size_t)NUP * DM * 2;
constexpr size_t WS_SSQ = WS_WDN + (size_t)DM * DFF * 2;
constexpr size_t WS_XB = WS_SSQ + (size_t)MTOK * 16 * 4;
constexpr size_t WS_B1 = WS_XB + (size_t)MTOK * NBR * 2;
constexpr size_t WS_B2 = WS_B1 + (size_t)MTOK * NPA * 2;
constexpr size_t WS_END = WS_B2 + (size_t)MTOK * NPA * 2;

__device__ __forceinline__ int otid() { int t = threadIdx.x; asm volatile("" : "+v"(t)); return t; }
__device__ __forceinline__ int obid() { int b = blockIdx.x; asm volatile("" : "+s"(b)); return b; }
struct Params {
    const float* in[19];
    float* out; unsigned char* ws;
};

__device__ __forceinline__ void st_nt16(void* p, u32x4 w) { __builtin_nontemporal_store(w, (u32x4*)p); }
__device__ __forceinline__ float bflo(unsigned w) { return __uint_as_float(w << 16); }
__device__ __forceinline__ float bfhi(unsigned w) { return __uint_as_float(w & 0xffff0000u); }
__device__ __forceinline__ unsigned pk(float a, float b) { return pg8::cvt_pk_bf16(a, b); }
__device__ __forceinline__ float fast_rcp(float x) { return __builtin_amdgcn_rcpf(x); }
__device__ __forceinline__ float gate_t(float x) { return 1.0f + __builtin_amdgcn_exp2f(fminf(x * -1.44269504f, 43.28f)); }
__device__ __forceinline__ float gelu_tanh_f(float x) {
    const float z2 = 1.5957691216f * (x + 0.044715f * x * x * x);
    return x * fast_rcp(1.0f + __expf(-z2));
}
__device__ __forceinline__ float silu_f(float x) { return x * fast_rcp(1.0f + __expf(-x)); }
__device__ __forceinline__ float row_rstd(const float* ssq, int r) {
    const f32x4* p = (const f32x4*)(ssq + (size_t)r * 16);
    const f32x4 a = p[0], b = p[1], c = p[2], d = p[3];
    const float s = ((a[0] + a[1]) + (a[2] + a[3])) + ((b[0] + b[1]) + (b[2] + b[3])) + ((c[0] + c[1]) + (c[2] + c[3])) + ((d[0] + d[1]) + (d[2] + d[3]));
    return rsqrtf(s * (1.0f / 1024.0f) + EPS);
}

__device__ __forceinline__ void rows_rstd8(const float* ssq, int row0, int fq, float (&rs)[8]) {
    f32x4 v[8];
#pragma unroll
    for (int i = 0; i < 8; ++i) v[i] = *(const f32x4*)(ssq + (size_t)(row0 + (i >> 2) * 128 + (i & 3) * 16) * 16 + fq * 4);
#pragma unroll
    for (int i = 0; i < 8; ++i) {
        float s = (v[i][0] + v[i][1]) + (v[i][2] + v[i][3]);
        s += __shfl_xor(s, 16); s += __shfl_xor(s, 32);
        rs[i] = rsqrtf(s * (1.0f / 1024.0f) + EPS);
    }
}
struct EpiIn {
    static constexpr bool PERM = true, AFTER_DRAIN = false, MIDK = false;
    bf16_t* PA; bf16_t* G; const float* ssq;
    __device__ __forceinline__ void operator()(const f32x4 (&acc)[2][2][4][2], const pg8::Unit& u, int wr, int wc, int fr, int fq) const {
        const int colt = u.pn * 256;
        const int act = (colt >= NPA) ? 2 : ((colt >= 512 && colt < 1536) ? 1 : 0);
        bf16_t* base = (colt >= NPA) ? G : PA;
        const int col0 = (colt >= NPA ? colt - NPA : colt) + wc * 32 + 8 * fq;
        const int row0 = u.pm * 256 + wr * 64 + fr;
        float rs8[8]; rows_rstd8(ssq, row0, fq, rs8);
#pragma unroll
        for (int ai = 0; ai < 2; ++ai)
#pragma unroll
            for (int m = 0; m < 4; ++m) {
                const int r = row0 + ai * 128 + m * 16;
                const float rs = rs8[ai * 4 + m];
                bf16_t* rowp = base + (size_t)r * NPA + col0;
#pragma unroll
                for (int bj = 0; bj < 2; ++bj) {
                    float v[8];
#pragma unroll
                    for (int j = 0; j < 4; ++j) { v[j] = acc[ai][bj][m][0][j] * rs; v[4 + j] = acc[ai][bj][m][1][j] * rs; }
                    if (act == 1) {
#pragma unroll
                        for (int j = 0; j < 8; ++j) v[j] = gelu_tanh_f(v[j]);
                    } else if (act == 2) {
#pragma unroll
                        for (int j = 0; j < 8; ++j) v[j] = gate_t(v[j]);
                    }
                    u32x4 w; w.x = pk(v[0], v[1]); w.y = pk(v[2], v[3]); w.z = pk(v[4], v[5]); w.w = pk(v[6], v[7]);
                    st_nt16(rowp + bj * 128, w);
                }
            }
    }
};
struct EpiBr {
    static constexpr bool PERM = true, AFTER_DRAIN = false, MIDK = true;
    const bf16_t* G; bf16_t* out;
    __device__ __forceinline__ void mid(f32x4 (&acc)[2][2][4][2], const pg8::Unit& u, int t, int wr, int wc, int fr, int fq) const {
        const int seg = (t == 8) ? 0 : 1024;
        int col0 = u.pn * 256 + wc * 32 + 8 * fq + seg;
        int row0 = u.pm * 256 + wr * 64 + fr;
        asm volatile("" : "+v"(col0), "+v"(row0));
#pragma unroll
        for (int ai = 0; ai < 2; ++ai) {
            u32x4 nu[4][2], de[4][2];
#pragma unroll
            for (int m = 0; m < 4; ++m)
#pragma unroll
                for (int bj = 0; bj < 2; ++bj) {
                    const bf16_t* gp = G + (size_t)(row0 + ai * 128 + m * 16) * NPA + col0 + bj * 128;
                    nu[m][bj] = *(const u32x4*)gp; de[m][bj] = *(const u32x4*)(gp + 1024);
                }
            asm volatile("" ::: "memory");
#pragma unroll
            for (int m = 0; m < 4; ++m)
#pragma unroll
                for (int bj = 0; bj < 2; ++bj) {
                    const unsigned nw[4] = {nu[m][bj].x, nu[m][bj].y, nu[m][bj].z, nu[m][bj].w}, dw[4] = {de[m][bj].x, de[m][bj].y, de[m][bj].z, de[m][bj].w};
#pragma unroll
                    for (int q = 0; q < 4; ++q) {
                        const float r0 = bflo(dw[q]) * fast_rcp(bflo(nw[q])), r1 = bfhi(dw[q]) * fast_rcp(bfhi(nw[q]));
                        acc[ai][bj][m][q >> 1][(q & 1) * 2] *= r0; acc[ai][bj][m][q >> 1][(q & 1) * 2 + 1] *= r1;
                    }
                }
            asm volatile("" ::: "memory");
        }
    }
    __device__ __forceinline__ void operator()(const f32x4 (&acc)[2][2][4][2], const pg8::Unit& u, int wr, int wc, int fr, int fq) const {
        const int col0 = u.pn * 256 + wc * 32 + 8 * fq;
        const int row0 = u.pm * 256 + wr * 64 + fr;
        u32x4 sg[2][4][2];
#pragma unroll
        for (int ai = 0; ai < 2; ++ai)
#pragma unroll
            for (int m = 0; m < 4; ++m)
#pragma unroll
                for (int bj = 0; bj < 2; ++bj) sg[ai][m][bj] = *(const u32x4*)(G + (size_t)(row0 + ai * 128 + m * 16) * NPA + 2048 + col0 + bj * 128);
#pragma unroll
        for (int ai = 0; ai < 2; ++ai)
#pragma unroll
            for (int m = 0; m < 4; ++m) {
                const int r = row0 + ai * 128 + m * 16;
                bf16_t* op = out + (size_t)r * DM + col0;
#pragma unroll
                for (int bj = 0; bj < 2; ++bj) {
                    const u32x4 s = sg[ai][m][bj];
                    const f32x4 a0 = acc[ai][bj][m][0], a1 = acc[ai][bj][m][1];
                    u32x4 w;
                    w.x = pk(a0[0] * fast_rcp(bflo(s.x)), a0[1] * fast_rcp(bfhi(s.x))); w.y = pk(a0[2] * fast_rcp(bflo(s.y)), a0[3] * fast_rcp(bfhi(s.y)));
                    w.z = pk(a1[0] * fast_rcp(bflo(s.z)), a1[1] * fast_rcp(bfhi(s.z))); w.w = pk(a1[2] * fast_rcp(bflo(s.w)), a1[3] * fast_rcp(bfhi(s.w)));
                    *(u32x4*)(op + bj * 128) = w;
                }
            }
    }
};
struct EpiRes {
    static constexpr bool PERM = true, AFTER_DRAIN = false, MIDK = false;
    bf16_t* xb; float* ssq;
    __device__ __forceinline__ void operator()(const f32x4 (&acc)[2][2][4][2], const pg8::Unit& u, int wr, int wc, int fr, int fq) const {
        const int col0 = u.pn * 256 + wc * 32 + 8 * fq;
        const int row0 = u.pm * 256 + wr * 64 + fr;
        u32x4 bb[2][4][2];
#pragma unroll
        for (int ai = 0; ai < 2; ++ai)
#pragma unroll
            for (int m = 0; m < 4; ++m)
#pragma unroll
                for (int bj = 0; bj < 2; ++bj) bb[ai][m][bj] = *(const u32x4*)(xb + (size_t)(row0 + ai * 128 + m * 16) * DM + col0 + bj * 128);
        asm volatile("" ::: "memory");
#pragma unroll
        for (int ai = 0; ai < 2; ++ai) {
#pragma unroll
            for (int m = 0; m < 4; ++m) {
                const int r = row0 + ai * 128 + m * 16;
                float sq = 0.f;
#pragma unroll
                for (int bj = 0; bj < 2; ++bj) {
                    const u32x4 s = bb[ai][m][bj];
                    const f32x4 a0 = acc[ai][bj][m][0], a1 = acc[ai][bj][m][1];
                    const float o0 = bflo(s.x) + a0[0], o1 = bfhi(s.x) + a0[1], o2 = bflo(s.y) + a0[2], o3 = bfhi(s.y) + a0[3];
                    const float o4 = bflo(s.z) + a1[0], o5 = bfhi(s.z) + a1[1], o6 = bflo(s.w) + a1[2], o7 = bfhi(s.w) + a1[3];
                    u32x4 w; w.x = pk(o0, o1); w.y = pk(o2, o3); w.z = pk(o4, o5); w.w = pk(o6, o7);
                    *(u32x4*)(xb + (size_t)r * DM + col0 + bj * 128) = w;
                    sq += (o0 * o0 + o1 * o1) + (o2 * o2 + o3 * o3) + (o4 * o4 + o5 * o5) + (o6 * o6 + o7 * o7);
                }
                sq += __shfl_xor(sq, 16); sq += __shfl_xor(sq, 32);
                if (fq == 0) ssq[(size_t)r * 16 + u.pn * 4 + wc] = sq;
            }
            asm volatile("" ::: "memory");
        }
    }
};
__device__ __forceinline__ float dpp_ror1(float x) { return __int_as_float(__builtin_amdgcn_update_dpp(0, __float_as_int(x), 0x121, 0xf, 0xf, false)); }
__device__ __forceinline__ float dpp_ror2(float x) { return __int_as_float(__builtin_amdgcn_update_dpp(0, __float_as_int(x), 0x122, 0xf, 0xf, false)); }
__device__ __forceinline__ float dpp_shr1(float old, float x) { return __int_as_float(__builtin_amdgcn_update_dpp(__float_as_int(old), __float_as_int(x), 0x111, 0xf, 0xf, false)); }
__device__ __forceinline__ float dpp_shr2(float old, float x) { return __int_as_float(__builtin_amdgcn_update_dpp(__float_as_int(old), __float_as_int(x), 0x112, 0xf, 0xf, false)); }
struct EpiUp {
    static constexpr bool PERM = true, AFTER_DRAIN = false, MIDK = false;
    bf16_t* act; bf16_t* zs; const float* ssq; const float* cw; const float* cb;
    __device__ __forceinline__ void operator()(const f32x4 (&acc)[2][2][4][2], const pg8::Unit& u, int wr, int wc, int fr, int fq) const {
        const int c0 = u.pn * 128 + wc * 32 + 8 * fq;
        const int row0 = u.pm * 256 + wr * 64 + fr;
        float rs8[8]; rows_rstd8(ssq, row0, fq, rs8);
        u32x2 keep[2][4];
#pragma unroll
        for (int n = 0; n < 2; ++n) {
            const int c = c0 + 4 * n;
            const f32x4 gw0 = *(const f32x4*)(cw + c), gw1 = *(const f32x4*)(cw + NUP + c), gw2 = *(const f32x4*)(cw + 2 * NUP + c), gb = *(const f32x4*)(cb + c);
            const f32x4 vw0 = *(const f32x4*)(cw + DFF + c), vw1 = *(const f32x4*)(cw + NUP + DFF + c), vw2 = *(const f32x4*)(cw + 2 * NUP + DFF + c), vb = *(const f32x4*)(cb + DFF + c);
#pragma unroll
            for (int ai = 0; ai < 2; ++ai) {
                f32x4 pg = {0.f, 0.f, 0.f, 0.f}, pv = {0.f, 0.f, 0.f, 0.f};
                const int blk = u.pm * 4 + ai * 2 + wr;
#pragma unroll
                for (int m = 0; m < 4; ++m) {
                    const float rs = rs8[ai * 4 + m];
                    const f32x4 zg = acc[ai][0][m][n] * rs, zv = acc[ai][1][m][n] * rs;
                    float o[4];
#pragma unroll
                    for (int j = 0; j < 4; ++j) {
                        const float g1 = dpp_shr1(dpp_ror1(pg[j]), zg[j]), g2 = dpp_shr2(dpp_ror2(pg[j]), zg[j]);
                        const float v1 = dpp_shr1(dpp_ror1(pv[j]), zv[j]), v2 = dpp_shr2(dpp_ror2(pv[j]), zv[j]);
                        const float gg = gw2[j] * zg[j] + gw1[j] * g1 + gw0[j] * g2 + gb[j];
                        const float vv = vw2[j] * zv[j] + vw1[j] * v1 + vw0[j] * v2 + vb[j];
                        o[j] = silu_f(gg) * vv;
                    }
                    u32x2 w; w.x = pk(o[0], o[1]); w.y = pk(o[2], o[3]);
                    const int r = row0 + ai * 128 + m * 16;
                    if (n == 0) keep[ai][m] = w;
                    else if (!(m == 0 && fr < 2)) { u32x4 ww; ww.x = keep[ai][m].x; ww.y = keep[ai][m].y; ww.z = w.x; ww.w = w.y; st_nt16(act + (size_t)r * DFF + c0, ww); }
                    if (m == 0 && fr < 2) {
                        bf16_t* zp = zs + ((size_t)blk * 4 + 2 + fr) * NUP + c;
                        u32x2 a; a.x = pk(zg[0], zg[1]); a.y = pk(zg[2], zg[3]); *(u32x2*)zp = a;
                        u32x2 d; d.x = pk(zv[0], zv[1]); d.y = pk(zv[2], zv[3]); *(u32x2*)(zp + DFF) = d;
                    }
                    if (m == 3 && fr >= 14) {
                        bf16_t* zp = zs + ((size_t)blk * 4 + (fr - 14)) * NUP + c;
                        u32x2 a; a.x = pk(zg[0], zg[1]); a.y = pk(zg[2], zg[3]); *(u32x2*)zp = a;
                        u32x2 d; d.x = pk(zv[0], zv[1]); d.y = pk(zv[2], zv[3]); *(u32x2*)(zp + DFF) = d;
                    }
                    pg = zg; pv = zv;
                }
            }
        }
    }
};

__device__ __forceinline__ void transpose_tile(const float* __restrict__ W, int N, const float* __restrict__ g, bf16_t* __restrict__ Wt, int ldt, int koff, int k0, int n0, int nd0, float* tile, int tid) {
    {
        const int kk = tid >> 4, nn = (tid & 15) * 4;
#pragma unroll
        for (int h = 0; h < 2; ++h) {
            const int k = kk + h * 32;
            f32x4 v = *(const f32x4*)(W + (size_t)(k0 + k) * N + n0 + nn);
            const float s = g ? g[k0 + k] : 1.0f;
            tile[k * 65 + nn + 0] = v[0] * s; tile[k * 65 + nn + 1] = v[1] * s; tile[k * 65 + nn + 2] = v[2] * s; tile[k * 65 + nn + 3] = v[3] * s;
        }
    }
    __syncthreads();
    {
        const int n = tid >> 3, kq = (tid & 7) * 8;
        float v[8];
#pragma unroll
        for (int j = 0; j < 8; ++j) v[j] = tile[(kq + j) * 65 + n];
        u32x4 w; w.x = pk(v[0], v[1]); w.y = pk(v[2], v[3]); w.z = pk(v[4], v[5]); w.w = pk(v[6], v[7]);
        *(u32x4*)(Wt + (size_t)(nd0 + n) * ldt + koff + k0 + kq) = w;
    }
    __syncthreads();
}

__device__ __forceinline__ void prep_phase(const Params& p, int l, float* ldsf) {
    unsigned char* ws = p.ws;
    bf16_t* wt_in = (bf16_t*)(ws + WS_WIN); bf16_t* wt_br = (bf16_t*)(ws + WS_WBR); bf16_t* wt_o = (bf16_t*)(ws + WS_WO);
    bf16_t* wt_up = (bf16_t*)(ws + WS_WUP); bf16_t* wt_dn = (bf16_t*)(ws + WS_WDN);
    const float* g_mix = p.in[1] + (size_t)l * DM; const float* w_in = p.in[2] + (size_t)l * DM * NIN;
    const float* w_pool = p.in[3] + (size_t)l * 4 * 128 * 128; const float* pscale = p.in[4] + (size_t)l * 512;
    const float* w_ba = p.in[9] + (size_t)l * 512 * DM; const float* w_bb = p.in[10] + (size_t)l * 512 * DM; const float* w_bc = p.in[11] + (size_t)l * 512 * DM;
    const float* w_o = p.in[12] + (size_t)l * DM * DM; const float* g_ffn = p.in[13] + (size_t)l * DM;
    const float* w_up = p.in[14] + (size_t)l * DM * NUP; const float* w_dn = p.in[17] + (size_t)l * DFF * DM;
    const int tid = otid(), bid = obid();
    constexpr int T0 = 16 * 96, T1 = T0 + 128, T2 = T1 + 128, T3 = T2 + 256, T4 = T3 + 16 * 88, T5 = T4 + 44 * 16;
    for (int i = bid; i < T5; i += gridDim.x) {
        if (i < T0) { const int kt = i & 15, nt = i >> 4; transpose_tile(w_in, NIN, g_mix, wt_in, DM, 0, kt * 64, nt * 64, nt * 64, ldsf, tid); }
        else if (i < T1) { const int j = i - T0, kt = j & 7, nt = j >> 3; transpose_tile(w_bb, DM, nullptr, wt_br, NBR, 512, kt * 64, nt * 64, nt * 64, ldsf, tid); }
        else if (i < T2) { const int j = i - T1, kt = j & 7, nt = j >> 3; transpose_tile(w_bc, DM, nullptr, wt_br, NBR, 1024, kt * 64, nt * 64, nt * 64, ldsf, tid); }
        else if (i < T3) { const int j = i - T2, kt = j & 15, nt = j >> 4; transpose_tile(w_o, DM, nullptr, wt_o, DM, 0, kt * 64, nt * 64, nt * 64, ldsf, tid); }
        else if (i < T4) { const int j = i - T3, kt = j & 15, nt = j >> 4; const int n0 = nt * 64, bj = n0 / DFF, q0 = n0 - bj * DFF; transpose_tile(w_up, NUP, g_ffn, wt_up, DM, 0, kt * 64, n0, (q0 >> 7) * 256 + bj * 128 + (q0 & 127), ldsf, tid);   }
        else { const int j = i - T4, kt = j % 44, nt = j / 44; transpose_tile(w_dn, DM, nullptr, wt_dn, DFF, 0, kt * 64, nt * 64, nt * 64, ldsf, tid); }
    }
    {
        float* wpT = ldsf;
        float* wa = ldsf + 128 * 128;
        for (int it = (int)gridDim.x - 1 - bid; it < 64; it += gridDim.x) {
            const int g = it >> 4, n0 = (it & 15) * 64;
            for (int q = tid; q < 128 * 32; q += 512) {
                const int d = q >> 5, e4 = (q & 31) * 4;
                const f32x4 v = *(const f32x4*)(w_pool + ((size_t)g * 128 + d) * 128 + e4);
                const f32x4 s = *(const f32x4*)(pscale + g * 128 + e4);
                wpT[(e4 + 0) * 128 + d] = v[0] * s[0]; wpT[(e4 + 1) * 128 + d] = v[1] * s[1]; wpT[(e4 + 2) * 128 + d] = v[2] * s[2]; wpT[(e4 + 3) * 128 + d] = v[3] * s[3];
            }
            for (int q = tid; q < 128 * 16; q += 512) {
                const int e = q >> 4, c4 = (q & 15) * 4;
                *(f32x4*)(wa + e * 64 + c4) = *(const f32x4*)(w_ba + (size_t)(g * 128 + e) * DM + n0 + c4);
            }
            __syncthreads();
            const int d = tid & 127, ns = tid >> 7;
            float acc[16];
#pragma unroll
            for (int i = 0; i < 16; ++i) acc[i] = 0.f;
            for (int e = 0; e < 128; ++e) {
                const float w = wpT[e * 128 + d];
                const f32x4* wr4 = (const f32x4*)(wa + e * 64 + ns * 16);
#pragma unroll
                for (int c = 0; c < 4; ++c) { const f32x4 b = wr4[c]; acc[c * 4 + 0] += w * b[0]; acc[c * 4 + 1] += w * b[1]; acc[c * 4 + 2] += w * b[2]; acc[c * 4 + 3] += w * b[3]; }
            }
#pragma unroll
            for (int i = 0; i < 16; ++i) wt_br[(size_t)(n0 + ns * 16 + i) * NBR + g * 128 + d] = (bf16_t)(pk(acc[i], 0.f) & 0xffffu);
            __syncthreads();
        }
    }
    if (l == 0) {
        const float* x = p.in[0]; bf16_t* xb = (bf16_t*)(ws + WS_XB); float* ssq = (float*)(ws + WS_SSQ);
        const int lane = tid & 63, wave = tid >> 6;
        for (int r = bid * 8 + wave; r < MTOK; r += gridDim.x * 8) {
            float sq = 0.f;
#pragma unroll
            for (int i = 0; i < 4; ++i) {
                const f32x4 v = *(const f32x4*)(x + (size_t)r * DM + i * 256 + lane * 4);
                sq += (v[0] * v[0] + v[1] * v[1]) + (v[2] * v[2] + v[3] * v[3]);
                u32x2 w; w.x = pk(v[0], v[1]); w.y = pk(v[2], v[3]);
                *(u32x2*)(xb + (size_t)r * DM + i * 256 + lane * 4) = w;
            }
#pragma unroll
            for (int o = 32; o >= 1; o >>= 1) sq += __shfl_xor(sq, o);
            if (lane < 16) ssq[(size_t)r * 16 + lane] = (lane == 0) ? sq : 0.f;
        }
    }
}
__device__ __forceinline__ void ld8(const bf16_t* p, float (&v)[8]) {
    const u32x4 w = *(const u32x4*)p;
    v[0] = bflo(w.x); v[1] = bfhi(w.x); v[2] = bflo(w.y); v[3] = bfhi(w.y); v[4] = bflo(w.z); v[5] = bfhi(w.z); v[6] = bflo(w.w); v[7] = bfhi(w.w);
}
__device__ __forceinline__ void st8(bf16_t* p, const float (&v)[8]) {
    u32x4 w; w.x = pk(v[0], v[1]); w.y = pk(v[2], v[3]); w.z = pk(v[4], v[5]); w.w = pk(v[6], v[7]);
    *(u32x4*)p = w;
}
template <int W> __device__ __forceinline__ void pool_rows(const bf16_t* __restrict__ ap, bf16_t* __restrict__ yp, int r0, int pos0) {
#pragma unroll
    for (int b = 0; b < 4; ++b) {
        const int base = r0 + 4 * b;
        u32x4 h[W + 3];
#pragma unroll
        for (int i = 0; i < W + 3; ++i) { const int rr = base - (W - 1) + i; h[i] = (pos0 + rr >= 0) ? *(const u32x4*)(ap + (ptrdiff_t)rr * NPA) : (u32x4){0u, 0u, 0u, 0u}; }
        float s[8];
#pragma unroll
        for (int j = 0; j < 8; ++j) s[j] = 0.f;
#pragma unroll
        for (int i = 0; i < W - 1; ++i) { const u32x4 q = h[i];
            s[0] += bflo(q.x); s[1] += bfhi(q.x); s[2] += bflo(q.y); s[3] += bfhi(q.y); s[4] += bflo(q.z); s[5] += bfhi(q.z); s[6] += bflo(q.w); s[7] += bfhi(q.w); }
#pragma unroll
        for (int i = 0; i < 4; ++i) {
            const int rr = base + i, pos = pos0 + rr; const float inv = 1.0f / (float)(pos + 1 < W ? pos + 1 : W);
            const u32x4 q = h[W - 1 + i], od = h[i];
            const float v[8] = {bflo(q.x), bfhi(q.x), bflo(q.y), bfhi(q.y), bflo(q.z), bfhi(q.z), bflo(q.w), bfhi(q.w)};
            float o[8];
#pragma unroll
            for (int j = 0; j < 8; ++j) { s[j] += v[j]; o[j] = s[j] * inv - v[j]; }
            st8(yp + (size_t)rr * NBR, o);
            s[0] -= bflo(od.x); s[1] -= bfhi(od.x); s[2] -= bflo(od.y); s[3] -= bfhi(od.y); s[4] -= bflo(od.z); s[5] -= bfhi(od.z); s[6] -= bflo(od.w); s[7] -= bfhi(od.w);
        }
        asm volatile("" ::: "memory");
    }
}
constexpr int VT_PITCH = 136;
__device__ __forceinline__ void mixer_phase(const Params& p, int l, unsigned char* lds) {
    const bf16_t* PA = (const bf16_t*)(p.ws + WS_B1);
    bf16_t* Y = (bf16_t*)p.out;
    const float* g_sgu = p.in[5] + (size_t)l * 512;
    const float* w_sp = p.in[6] + (size_t)l * 4 * 128 * 128;
    const float* b_sp = p.in[7] + (size_t)l * 4 * 128;
    const float* conv_c = p.in[8] + (size_t)l * 3 * 512;
    float* rs = (float*)lds;
    bf16_t* vT = (bf16_t*)(lds + 1024);
    const int tid = otid(), lane = tid & 63, wave = __builtin_amdgcn_readfirstlane(tid >> 6), fr = lane & 15, fq = lane >> 4;
    for (int item = obid(); item < MTOK / 128; item += gridDim.x) {
        const int t0 = item * 128, pos0 = t0 & (SEQ - 1);
        {
            const int row = tid >> 2, q = tid & 3;
            const bf16_t* vp = PA + (size_t)(t0 + row) * NPA + 1024 + q * 128;
            float sq = 0.f;
#pragma unroll
            for (int i = 0; i < 16; ++i) { float v[8]; ld8(vp + i * 8, v);
#pragma unroll
                for (int j = 0; j < 8; ++j) sq += v[j] * v[j]; }
            sq += __shfl_xor(sq, 1); sq += __shfl_xor(sq, 2);
            if (q == 0) rs[row] = rsqrtf(sq * (1.0f / 512.0f) + EPS);
        }
        {
            const int grp = wave & 3;
            const int c8 = (grp * 16 + (lane & 15)) * 8; int r0 = ((wave >> 2) * 4 + (lane >> 4)) * 16;
            asm volatile("" : "+v"(r0));
            {
                const bf16_t* ap = PA + (size_t)t0 * NPA + c8;
                bf16_t* yp = Y + (size_t)t0 * NBR + c8;
                if (grp == 0) pool_rows<2>(ap, yp, r0, pos0); else if (grp == 1) pool_rows<4>(ap, yp, r0, pos0); else if (grp == 2) pool_rows<8>(ap, yp, r0, pos0); else pool_rows<16>(ap, yp, r0, pos0);
            }
            {
                const bf16_t* bp = PA + (size_t)t0 * NPA + 1536 + c8;
                bf16_t* yp = Y + (size_t)t0 * NBR + 1024 + c8;
                float w0[8], w1[8], w2[8], z1[8], z2[8];
#pragma unroll
                for (int j = 0; j < 8; ++j) { w0[j] = conv_c[c8 + j]; w1[j] = conv_c[512 + c8 + j]; w2[j] = conv_c[1024 + c8 + j]; z1[j] = 0.f; z2[j] = 0.f; }
                {
                    const bool h2 = pos0 + r0 - 2 >= 0, h1 = pos0 + r0 - 1 >= 0;
                    const u32x4 zz = {0u, 0u, 0u, 0u};
                    const u32x4 a2 = h2 ? *(const u32x4*)(bp + (ptrdiff_t)(r0 - 2) * NPA + 512) : zz, b2 = h2 ? *(const u32x4*)(bp + (ptrdiff_t)(r0 - 2) * NPA + 1024) : zz;
                    const u32x4 a1 = h1 ? *(const u32x4*)(bp + (ptrdiff_t)(r0 - 1) * NPA + 512) : zz, b1 = h1 ? *(const u32x4*)(bp + (ptrdiff_t)(r0 - 1) * NPA + 1024) : zz;
                    z2[0] = bflo(a2.x) * bflo(b2.x); z2[1] = bfhi(a2.x) * bfhi(b2.x); z2[2] = bflo(a2.y) * bflo(b2.y); z2[3] = bfhi(a2.y) * bfhi(b2.y);
                    z2[4] = bflo(a2.z) * bflo(b2.z); z2[5] = bfhi(a2.z) * bfhi(b2.z); z2[6] = bflo(a2.w) * bflo(b2.w); z2[7] = bfhi(a2.w) * bfhi(b2.w);
                    z1[0] = bflo(a1.x) * bflo(b1.x); z1[1] = bfhi(a1.x) * bfhi(b1.x); z1[2] = bflo(a1.y) * bflo(b1.y); z1[3] = bfhi(a1.y) * bfhi(b1.y);
                    z1[4] = bflo(a1.z) * bflo(b1.z); z1[5] = bfhi(a1.z) * bfhi(b1.z); z1[6] = bflo(a1.w) * bflo(b1.w); z1[7] = bfhi(a1.w) * bfhi(b1.w);
                }
#pragma unroll
                for (int hb = 0; hb < 4; ++hb) {
                    u32x4 qb[4], qc[4], qx[4];
#pragma unroll
                    for (int i = 0; i < 4; ++i) { const bf16_t* rp = bp + (size_t)(r0 + hb * 4 + i) * NPA; qb[i] = *(const u32x4*)rp; qc[i] = *(const u32x4*)(rp + 512); qx[i] = *(const u32x4*)(rp + 1024); }
#pragma unroll
                    for (int i = 0; i < 4; ++i) {
                        const float cb[8] = {bflo(qb[i].x), bfhi(qb[i].x), bflo(qb[i].y), bfhi(qb[i].y), bflo(qb[i].z), bfhi(qb[i].z), bflo(qb[i].w), bfhi(qb[i].w)};
                        const float a[8] = {bflo(qc[i].x), bfhi(qc[i].x), bflo(qc[i].y), bfhi(qc[i].y), bflo(qc[i].z), bfhi(qc[i].z), bflo(qc[i].w), bfhi(qc[i].w)};
                        const float b[8] = {bflo(qx[i].x), bfhi(qx[i].x), bflo(qx[i].y), bfhi(qx[i].y), bflo(qx[i].z), bfhi(qx[i].z), bflo(qx[i].w), bfhi(qx[i].w)};
                        float o[8];
#pragma unroll
                        for (int j = 0; j < 8; ++j) { const float z = a[j] * b[j]; o[j] = cb[j] * (w0[j] * z2[j] + w1[j] * z1[j] + w2[j] * z); z2[j] = z1[j]; z1[j] = z; }
                        st8(yp + (size_t)(r0 + hb * 4 + i) * NBR, o);
                    }
                    asm volatile("" ::: "memory");
                }
            }
        }
#pragma unroll 1
        for (int g = 0; g < 4; ++g) {
            const int t = wave * 16 + fr;
            const int nk = (wave >> 1) + 1;
            f32x4 wq[4][2];
#pragma unroll
            for (int k = 0; k < 4; ++k) { const float* wp = w_sp + ((size_t)g * 128 + t) * 128 + k * 32 + fq * 8; wq[k][0] = *(const f32x4*)wp; wq[k][1] = *(const f32x4*)(wp + 4); }
            const bf16_t* up = PA + (size_t)(t0 + t) * NPA + 512 + g * 128 + 4 * fq;
            u32x2 uu[8];
#pragma unroll
            for (int n = 0; n < 8; ++n) uu[n] = *(const u32x2*)(up + n * 16);
            const float bias = b_sp[g * 128 + t];
            u32x4 vq[4];
            const int s_ = tid >> 2, dq = (tid & 3) * 32;
            {
                const bf16_t* vp = PA + (size_t)(t0 + s_) * NPA + 1024 + g * 128 + dq;
#pragma unroll
                for (int i = 0; i < 4; ++i) vq[i] = *(const u32x4*)(vp + i * 8);
            }
            __syncthreads();
#pragma unroll
            for (int i = 0; i < 4; ++i) {
                const unsigned ww[4] = {vq[i].x, vq[i].y, vq[i].z, vq[i].w};
#pragma unroll
                for (int q = 0; q < 4; ++q) { vT[(dq + i * 8 + q * 2) * VT_PITCH + s_] = (bf16_t)(ww[q] & 0xffffu); vT[(dq + i * 8 + q * 2 + 1) * VT_PITCH + s_] = (bf16_t)(ww[q] >> 16); }
            }
            __syncthreads();
            f32x4 acc[8];
#pragma unroll
            for (int n = 0; n < 8; ++n) acc[n] = (f32x4){0.f, 0.f, 0.f, 0.f};
#pragma unroll
            for (int k = 0; k < 4; ++k) if (k < nk) {
                const int s0 = k * 32 + fq * 8;
                const f32x4 wa = wq[k][0], wb = wq[k][1];
                const f32x4 ra = *(const f32x4*)(rs + s0), rb = *(const f32x4*)(rs + s0 + 4);
                float a[8];
#pragma unroll
                for (int j = 0; j < 4; ++j) { a[j] = (s0 + j <= t) ? wa[j] * ra[j] : 0.f; a[4 + j] = (s0 + 4 + j <= t) ? wb[j] * rb[j] : 0.f; }
                union { u32x4 u; bf16x8 h; } af; af.u.x = pk(a[0], a[1]); af.u.y = pk(a[2], a[3]); af.u.z = pk(a[4], a[5]); af.u.w = pk(a[6], a[7]);
#pragma unroll
                for (int n = 0; n < 8; ++n) {
                    const bf16x8 bfrag = *(const bf16x8*)(vT + (n * 16 + fr) * VT_PITCH + s0);
                    acc[n] = __builtin_amdgcn_mfma_f32_16x16x32_bf16(bfrag, af.h, acc[n], 0, 0, 0);
                }
            }
            bf16_t* yp = Y + (size_t)(t0 + t) * NBR + 512 + g * 128 + 4 * fq;
#pragma unroll
            for (int n = 0; n < 8; ++n) {
                const f32x4 gs = *(const f32x4*)(g_sgu + g * 128 + n * 16 + 4 * fq);
                const float o0 = bflo(uu[n].x) * (acc[n][0] * gs[0] + bias), o1 = bfhi(uu[n].x) * (acc[n][1] * gs[1] + bias);
                const float o2 = bflo(uu[n].y) * (acc[n][2] * gs[2] + bias), o3 = bfhi(uu[n].y) * (acc[n][3] * gs[3] + bias);
                u32x2 w; w.x = pk(o0, o1); w.y = pk(o2, o3);
                *(u32x2*)(yp + n * 16) = w;
            }
        }
        __syncthreads();
    }
}

__device__ __forceinline__ void ffn_fixup_phase(const Params& p, int l) {
    const bf16_t* zs = (const bf16_t*)(p.ws + WS_B2);
    bf16_t* act = (bf16_t*)(p.ws + WS_B1);
    const float* cw = p.in[15] + (size_t)l * 3 * NUP; const float* cb = p.in[16] + (size_t)l * NUP;
    constexpr int NCG = DFF / 8, NU = (MTOK / 64) * NCG;
    for (int u = obid() * 512 + otid(); u < NU; u += gridDim.x * 512) {
        const int blk = u / NCG, c8 = (u - blk * NCG) * 8;
        const bool first = ((blk * 64) & (SEQ - 1)) == 0;
        float g2[8], g1[8], ga[8], gb2[8], v2[8], v1[8], va[8], vb2[8];
#pragma unroll
        for (int j = 0; j < 8; ++j) { g2[j] = g1[j] = v2[j] = v1[j] = 0.f; }
        const bf16_t* own = zs + (size_t)blk * 4 * NUP + c8;
        if (!first) { const bf16_t* prv = own - 4 * (ptrdiff_t)NUP; ld8(prv, g2); ld8(prv + NUP, g1); ld8(prv + DFF, v2); ld8(prv + NUP + DFF, v1); }
        ld8(own + 2 * NUP, ga); ld8(own + 3 * NUP, gb2); ld8(own + 2 * NUP + DFF, va); ld8(own + 3 * NUP + DFF, vb2);
        float o0[8], o1[8];
#pragma unroll
        for (int j = 0; j < 8; ++j) {
            const float w0 = cw[c8 + j], w1 = cw[NUP + c8 + j], w2 = cw[2 * NUP + c8 + j], bb = cb[c8 + j];
            const float x0 = cw[DFF + c8 + j], x1 = cw[NUP + DFF + c8 + j], x2 = cw[2 * NUP + DFF + c8 + j], xb_ = cb[DFF + c8 + j];
            const float gg0 = w0 * g2[j] + w1 * g1[j] + w2 * ga[j] + bb, vv0 = x0 * v2[j] + x1 * v1[j] + x2 * va[j] + xb_;
            const float gg1 = w0 * g1[j] + w1 * ga[j] + w2 * gb2[j] + bb, vv1 = x0 * v1[j] + x1 * va[j] + x2 * vb2[j] + xb_;
            o0[j] = silu_f(gg0) * vv0; o1[j] = silu_f(gg1) * vv1;
        }
        st8(act + (size_t)(blk * 64) * DFF + c8, o0); st8(act + (size_t)(blk * 64 + 1) * DFF + c8, o1);
    }
}

__device__ __forceinline__ void final_norm_phase(const Params& p) {
    const float* gf = p.in[18]; const float* ssq = (const float*)(p.ws + WS_SSQ); const bf16_t* xb = (const bf16_t*)(p.ws + WS_XB); float* out = p.out;
    const int tid = otid(), lane = tid & 63, wave = tid >> 6;
    for (int r = obid() * 8 + wave; r < MTOK; r += gridDim.x * 8) {
        const float rs = row_rstd(ssq, r);
#pragma unroll
        for (int i = 0; i < 2; ++i) {
            const int c = i * 512 + lane * 8;
            float v[8]; ld8(xb + (size_t)r * DM + c, v);
            const f32x4 g0 = *(const f32x4*)(gf + c), g1 = *(const f32x4*)(gf + c + 4);
            f32x4 o0, o1;
#pragma unroll
            for (int j = 0; j < 4; ++j) { o0[j] = v[j] * rs * g0[j]; o1[j] = v[4 + j] * rs * g1[j]; }
            float* q = out + (size_t)r * DM + c;
            __builtin_nontemporal_store(o0, (f32x4*)q); __builtin_nontemporal_store(o1, (f32x4*)(q + 4));
        }
    }
}

template <class Epi> __device__ __forceinline__ void run_gemm(unsigned char* lds, const bf16_t* A, const bf16_t* Bt, int M, int N, int K, const Epi& E, int stagger_step = 0) {
    pg8::Gemm g{A, Bt, M, N, K}; pg8::StaticOrder S; S.init(M, N, (int)gridDim.x, obid());
    if (stagger_step) {
        const unsigned long long t0 = wall_clock64(), d = (unsigned long long)(((obid() >> 3) & 7) * stagger_step);
        while (wall_clock64() - t0 < d) __builtin_amdgcn_s_sleep(16);
    }
    pg8::gemm_phase<Epi, pg8::StaticOrder, false>((PG8_LAS unsigned char*)lds, g, S, E, nullptr);
}

typedef const Params __attribute__((address_space(4)))* ParamsK;
__device__ __forceinline__ Params fresh_params() {
    ParamsK q = (ParamsK)__builtin_amdgcn_kernarg_segment_ptr();
    asm volatile("" : "+s"(q));
    Params r;
#pragma unroll
    for (int i = 0; i < 19; ++i) r.in[i] = q->in[i];
    r.out = q->out; r.ws = q->ws;
    return r;
}
__global__ void __launch_bounds__(512, 2) fwd_megakernel(Params p_unused) {
    extern __shared__ __attribute__((aligned(16))) unsigned char lds[];
    cg::grid_group grid = cg::this_grid();
#define WSP(off) ((bf16_t*)(p.ws + (off)))
    for (int l = 0; l < 2; ++l) {
        { const Params p = fresh_params(); prep_phase(p, l, (float*)lds); }
        grid.sync();
        { const Params p = fresh_params(); EpiIn E{WSP(WS_B1), WSP(WS_B2), (const float*)(p.ws + WS_SSQ)}; run_gemm(lds, WSP(WS_XB), WSP(WS_WIN), MTOK, NIN, DM, E); }
        grid.sync();
        { const Params p = fresh_params(); mixer_phase(p, l, lds); }
        grid.sync();
        { const Params p = fresh_params(); EpiBr E{WSP(WS_B2), WSP(WS_B1)}; run_gemm(lds, (const bf16_t*)p.out  , WSP(WS_WBR), MTOK, DM, NBR, E); }
        grid.sync();
        { const Params p = fresh_params(); EpiRes E{WSP(WS_XB), (float*)(p.ws + WS_SSQ)}; run_gemm(lds, WSP(WS_B1), WSP(WS_WO), MTOK, DM, DM, E); }
        grid.sync();
        { const Params p = fresh_params(); EpiUp E{WSP(WS_B1), WSP(WS_B2), (const float*)(p.ws + WS_SSQ), p.in[15] + (size_t)l * 3 * NUP, p.in[16] + (size_t)l * NUP}; run_gemm(lds, WSP(WS_XB), WSP(WS_WUP), MTOK, NUP, DM, E); }
        grid.sync();
        { const Params p = fresh_params(); ffn_fixup_phase(p, l); }
        grid.sync();
        { const Params p = fresh_params(); EpiRes E{WSP(WS_XB), (float*)(p.ws + WS_SSQ)}; run_gemm(lds, WSP(WS_B1), WSP(WS_WDN), MTOK, DM, DFF, E); }
        grid.sync();
    }
    { const Params p = fresh_params(); final_norm_phase(p); }
#undef WSP
}

extern "C" void kernel_launch(void* const* d_in, const int* in_sizes, int n_in, void* d_out, int out_size, void* d_ws, size_t ws_size, hipStream_t stream) {
    constexpr size_t kLds = pg8::STAGE_BYTES;
    static int grid_blocks = 0;
    if (!grid_blocks) {
        int dev = 0, cus = 0, per_cu = 0;
        (void)hipGetDevice(&dev);
        (void)hipDeviceGetAttribute(&cus, hipDeviceAttributeMultiprocessorCount, dev);
        (void)hipFuncSetAttribute((const void*)fwd_megakernel, hipFuncAttributeMaxDynamicSharedMemorySize, (int)kLds);
        (void)hipOccupancyMaxActiveBlocksPerMultiprocessor(&per_cu, (const void*)fwd_megakernel, 512, kLds);
        if (per_cu < 1) per_cu = 1;
        grid_blocks = cus;
        if (ws_size < WS_END || n_in != 19 || out_size != MTOK * DM) { fprintf(stderr, "kernel_launch: unexpected sizes: ws %zu (need %zu), n_in %d, out %d\n", ws_size, (size_t)WS_END, n_in, out_size); }
    }
    Params p{};
    for (int i = 0; i < 19; ++i) p.in[i] = (const float*)d_in[i];
    p.out = (float*)d_out; p.ws = (unsigned char*)d_ws;
    void* args[] = {&p};
    hipError_t e = hipLaunchCooperativeKernel((void*)fwd_megakernel, dim3(grid_blocks), dim3(512), args, kLds, stream);
    if (e != hipSuccess) fprintf(stderr, "cooperative launch failed: %s (grid %d)\n", hipGetErrorString(e), grid_blocks);
}
```

```cpp
#include <hip/hip_runtime.h>
#include <hip/hip_cooperative_groups.h>
#include <cstdio>
namespace cg = cooperative_groups;
namespace pg8 {
#define PG8_LAS __attribute__((address_space(3)))
typedef unsigned short bf16_t;
typedef short bf16x8 __attribute__((ext_vector_type(8)));
typedef float f32x4 __attribute__((ext_vector_type(4)));
typedef unsigned u32x4 __attribute__((ext_vector_type(4)));
constexpr int BM = 256, BK = 64, HALF = 128, HTB = HALF * BK * 2  , STAGE_BYTES = 8 * HTB, NXCD = 8, WGM = 8;

__host__ __device__ __forceinline__ int lds_byte(int r, int c) { const int st = (r >> 4) * 2 + (c >> 5), rr = r & 15, cc = c & 31, ob = rr * 64 + cc * 2; return st * 1024 + (ob ^ (((ob >> 9) & 1) << 5)); }
__host__ __device__ __forceinline__ void stage_rc(int b, int& R, int& C) { const int st = b / 1024, sb = b % 1024, swz = sb ^ (((sb >> 9) & 1) << 5); R = (st >> 1) * 16 + swz / 64; C = (st & 1) * 32 + (swz % 64) / 2; }
__host__ __device__ __forceinline__ int perm32(int rho) { const int n = rho >> 4, i = rho & 15; return 8 * (i >> 2) + 4 * n + (i & 3); }

struct Unit { int pm, pn; };
struct Gemm { const bf16_t* A; const bf16_t* Bt; int M, N, K; };

struct StaticOrder {
    int nM, nN, nwg, G, c;
    __host__ __device__ void init(int M, int N, int G_, int c_) { nM = M / BM; nN = N / BM; nwg = nM * nN; G = G_; c = c_; }
    __host__ __device__ bool next(int i, Unit& u) const {
        const long L = (long)i * G + c; if (L >= nwg) return false;
        int wgid = (int)L; { const int q = nwg / NXCD, r = nwg % NXCD, xcd = wgid % NXCD, off = wgid / NXCD; wgid = (xcd < r ? xcd * (q + 1) : r * (q + 1) + (xcd - r) * q) + off; }
        const int nig = WGM * nN, gid = wgid / nig, fm = gid * WGM, gsz = (nM - fm) < WGM ? (nM - fm) : WGM;
        u.pm = fm + ((wgid % nig) % gsz); u.pn = (wgid % nig) / gsz; return true;
    }
    __device__ __forceinline__ void a_ready(const Unit&) const {}
    __device__ __forceinline__ void done(const Unit&) const {}
};
__device__ __forceinline__ unsigned cvt_pk_bf16(float lo, float hi) { unsigned r; asm volatile("v_cvt_pk_bf16_f32 %0, %1, %2" : "=v"(r) : "v"(lo), "v"(hi)); return r; }

template <class Epi, class Sched, bool STAMP = false>
__device__ __forceinline__ void gemm_phase(PG8_LAS unsigned char* lds, const Gemm g, const Sched& S, const Epi& E, unsigned long long* stamps) {
    int tid_ = threadIdx.x; asm volatile("" : "+v"(tid_));
    const int tid = tid_, wid = __builtin_amdgcn_readfirstlane(tid >> 6), lane = tid & 63, wr = wid >> 2, wc = wid & 3, fr = lane & 15, fq = lane >> 4;
    const int K = g.K, nt = K / BK;
    int ts_lo = 0, ts_hi = 0, nts = 0; const unsigned long long rt_entry = STAMP ? (unsigned long long)wall_clock64() : 0ull;
#define PG8_STAMP() do { if (STAMP && wid == 0 && nts < 64) { const unsigned long long _c = (unsigned long long)clock64(); \
        ts_lo = (lane == nts) ? (int)(unsigned)_c : ts_lo; ts_hi = (lane == nts) ? (int)(unsigned)(_c >> 32) : ts_hi; ++nts; } } while (0)
    PG8_STAMP();
    unsigned voffA[2], voffB[2];
#pragma unroll
    for (int i = 0; i < 2; ++i) { int R, C; stage_rc(tid * 16 + i * 8192, R, C); const int Rb = Epi::PERM ? ((R & ~31) + perm32(R & 31)) : R;
        voffA[i] = (unsigned)(R * K + C) * 2u; voffB[i] = (unsigned)(Rb * K + C) * 2u; }
    const size_t kstep = (size_t)(BK * 2);
    const size_t hstep = (size_t)HALF * K * 2;
    const size_t tstep = 2 * hstep;
    const unsigned ldsw = (unsigned)wid * 1024u;
    const int aoff = lds_byte(wr * 64 + fr, fq * 8), boff = lds_byte(wc * 32 + fr, fq * 8);
#define PG8_SA(b, h) (((b) * 2 + (h)) * HTB)
#define PG8_SB(b, h) ((4 + (b) * 2 + (h)) * HTB)
#define PG8_STAGE(bufoff, gbase, voff) do { _Pragma("unroll") for (int _i = 0; _i < 2; ++_i) \
        __builtin_amdgcn_global_load_lds((const unsigned*)((const char*)(gbase) + (voff)[_i]), (PG8_LAS unsigned*)(lds + (bufoff) + ldsw + _i * 8192), 16, 0, 0); } while (0)
#define PG8_LDA(dst, b, h) do { _Pragma("unroll") for (int m = 0; m < 4; ++m) _Pragma("unroll") for (int k = 0; k < 2; ++k) dst[m][k] = *(const PG8_LAS bf16x8*)(lds + PG8_SA(b, h) + aoff + m * 2048 + k * 1024); } while (0)
#define PG8_LDB(dst, b, h) do { _Pragma("unroll") for (int n = 0; n < 2; ++n) _Pragma("unroll") for (int k = 0; k < 2; ++k) dst[n][k] = *(const PG8_LAS bf16x8*)(lds + PG8_SB(b, h) + boff + n * 2048 + k * 1024); } while (0)
#define PG8_MMA(ai, bj, At, Bt) do { __builtin_amdgcn_s_setprio(1); _Pragma("unroll") for (int m = 0; m < 4; ++m) _Pragma("unroll") for (int n = 0; n < 2; ++n) _Pragma("unroll") for (int k = 0; k < 2; ++k) \
        acc[ai][bj][m][n] = __builtin_amdgcn_mfma_f32_16x16x32_bf16(Bt[n][k], At[m][k], acc[ai][bj][m][n], 0, 0, 0); __builtin_amdgcn_s_setprio(0); } while (0)
#define PG8_WAIT_V(n) asm volatile("s_waitcnt vmcnt(" #n ")" ::: "memory")
#define PG8_WAIT_L(n) asm volatile("s_waitcnt lgkmcnt(" #n ")" ::: "memory")
#define PG8_BAR __builtin_amdgcn_s_barrier()
#define PG8_SCHED __builtin_amdgcn_sched_barrier(0)
    Unit cur, nxt; int ui = 0;
    if (!S.next(0, cur)) return;
    f32x4 acc[2][2][4][2];
#pragma unroll
    for (int a = 0; a < 2; ++a)
#pragma unroll
        for (int b = 0; b < 2; ++b)
#pragma unroll
            for (int m = 0; m < 4; ++m)
#pragma unroll
                for (int n = 0; n < 2; ++n) acc[a][b][m][n] = (f32x4){0.f, 0.f, 0.f, 0.f};
    bf16x8 At[4][2], B0[2][2], B1[2][2];
    const char* cA = (const char*)g.A + (size_t)cur.pm * tstep; const char* cB = (const char*)g.Bt + (size_t)cur.pn * tstep;
    S.a_ready(cur);
    PG8_STAGE(PG8_SB(0, 0), cB, voffB); PG8_STAGE(PG8_SA(0, 0), cA, voffA); PG8_STAGE(PG8_SB(0, 1), cB + hstep, voffB); PG8_STAGE(PG8_SA(0, 1), cA + hstep, voffA);
    if (wr == 1) PG8_BAR;
    PG8_WAIT_V(4); PG8_BAR;
    PG8_STAGE(PG8_SB(1, 0), cB + kstep, voffB); PG8_STAGE(PG8_SA(1, 0), cA + kstep, voffA); PG8_STAGE(PG8_SB(1, 1), cB + hstep + kstep, voffB);
    PG8_WAIT_V(6); PG8_BAR;
    PG8_STAMP();
    for (;;) {
        const bool has_next = S.next(ui + 1, nxt);
        const char* nA = has_next ? (const char*)g.A + (size_t)nxt.pm * tstep : cA; const char* nB = has_next ? (const char*)g.Bt + (size_t)nxt.pn * tstep : cB;
        for (int t = 0; t < nt; t += 2) {
            if constexpr (Epi::MIDK) { if (t == 8 || t == 16) E.mid(acc, cur, t, wr, wc, fr, fq); }
            const bool last = (t == nt - 2);
            const char* a1 = cA + (size_t)(t + 1) * kstep;
            const char* a2 = last ? nA : cA + (size_t)(t + 2) * kstep; const char* b2 = last ? nB : cB + (size_t)(t + 2) * kstep;
            const char* a3 = a2 + kstep; const char* b3 = b2 + kstep;
            if (last && has_next) S.a_ready(nxt);
            PG8_LDB(B0, 0, 0); PG8_SCHED; PG8_LDA(At, 0, 0); PG8_STAGE(PG8_SA(1, 1), a1 + hstep, voffA);
            PG8_WAIT_L(8); PG8_BAR; PG8_WAIT_L(0); PG8_MMA(0, 0, At, B0); PG8_BAR; PG8_SCHED;
            PG8_LDB(B1, 0, 1); PG8_STAGE(PG8_SB(0, 0), b2, voffB);
            PG8_BAR; PG8_WAIT_L(0); PG8_MMA(0, 1, At, B1); PG8_BAR;
            PG8_LDA(At, 0, 1); PG8_STAGE(PG8_SA(0, 0), a2, voffA);
            PG8_BAR; PG8_WAIT_L(0); PG8_MMA(1, 0, At, B0); PG8_BAR; PG8_SCHED;
            PG8_STAGE(PG8_SB(0, 1), b2 + hstep, voffB);
            PG8_WAIT_V(6); PG8_BAR; PG8_MMA(1, 1, At, B1); PG8_BAR;
            PG8_LDB(B0, 1, 0); PG8_SCHED; PG8_LDA(At, 1, 0); PG8_STAGE(PG8_SA(0, 1), a2 + hstep, voffA);
            PG8_WAIT_L(8); PG8_BAR; PG8_WAIT_L(0); PG8_MMA(0, 0, At, B0); PG8_BAR; PG8_SCHED;
            PG8_LDB(B1, 1, 1); PG8_STAGE(PG8_SB(1, 0), b3, voffB);
            PG8_BAR; PG8_WAIT_L(0); PG8_MMA(0, 1, At, B1); PG8_BAR;
            PG8_LDA(At, 1, 1); PG8_STAGE(PG8_SA(1, 0), a3, voffA);
            PG8_BAR; PG8_WAIT_L(0); PG8_MMA(1, 0, At, B0); PG8_BAR; PG8_SCHED;
            PG8_STAGE(PG8_SB(1, 1), b3 + hstep, voffB);
            PG8_WAIT_V(6); PG8_BAR; PG8_MMA(1, 1, At, B1); PG8_BAR;
        }
        PG8_STAMP();
        if constexpr (!Epi::AFTER_DRAIN) { E(acc, cur, wr, wc, fr, fq); S.done(cur); }
        PG8_STAMP();
        if (!has_next) break;
#pragma unroll
        for (int a = 0; a < 2; ++a)
#pragma unroll
            for (int b = 0; b < 2; ++b)
#pragma unroll
                for (int m = 0; m < 4; ++m)
#pragma unroll
                    for (int n = 0; n < 2; ++n) acc[a][b][m][n] = (f32x4){0.f, 0.f, 0.f, 0.f};
        cur = nxt; cA = nA; cB = nB; ++ui;
    }
    PG8_WAIT_V(0);
    if (wr == 0) PG8_BAR;
    PG8_BAR;
    if constexpr (Epi::AFTER_DRAIN) { E.fused(acc, cur, wr, wc, fr, fq, lds, wid, lane); S.done(cur); }
    PG8_STAMP();
    if (STAMP && wid == 0) { stamps[lane] = lane < nts ? (((unsigned long long)(unsigned)ts_hi << 32) | (unsigned)ts_lo) : 0ull;
        if (lane == 62) stamps[62] = rt_entry; if (lane == 63) stamps[63] = (unsigned long long)wall_clock64(); }
#undef PG8_STAMP
#undef PG8_SA
#undef PG8_SB
#undef PG8_STAGE
#undef PG8_LDA
#undef PG8_LDB
#undef PG8_MMA
#undef PG8_WAIT_V
#undef PG8_WAIT_L
#undef PG8_BAR
#undef PG8_SCHED
}
}
typedef pg8::bf16_t bf16_t;
typedef pg8::f32x4 f32x4;
typedef pg8::u32x4 u32x4;
typedef pg8::bf16x8 bf16x8;
typedef unsigned u32x2 __attribute__((ext_vector_type(2)));
#define LAS __attribute__((address_space(3)))
constexpr int MTOK = 65536, DM = 1024, NIN = 6144, DFF = 2816, NUP = 5632, SEQ = 8192, NBR = 1536, NPA = 3072;
constexpr int MH = MTOK / 2;
constexpr float EPS = 1e-6f;
constexpr size_t WS_WIN = 0;
constexpr size_t WS_WBR = WS_WIN + (size_t)NIN * DM * 2;
constexpr size_t WS_WO = WS_WBR + (size_t)DM * NBR * 2;
constexpr size_t WS_WUP = WS_WO + (size_t)DM * DM * 2;
constexpr size_t WS_WDN = WS_WUP + (size_t)NUP * DM * 2;
constexpr size_t WS_SSQ = WS_WDN + (size_t)DM * DFF * 2;
constexpr size_t WS_XB = WS_SSQ + (size_t)MTOK * 16 * 4;
constexpr size_t WS_B1 = WS_XB + (size_t)MTOK * NBR * 2;
constexpr size_t WS_B2 = WS_B1 + (size_t)MTOK * NPA * 2;
constexpr size_t WS_END = WS_B2 + (size_t)MTOK * NPA * 2;

__device__ __forceinline__ int otid() { int t = threadIdx.x; asm volatile("" : "+v"(t)); return t; }
__device__ __forceinline__ int obid() { int b = blockIdx.x; asm volatile("" : "+s"(b)); return b; }
struct Params {
    const float* in[19];
    float* out; unsigned char* ws;
};

__device__ __forceinline__ void st_nt16(void* p, u32x4 w) { __builtin_nontemporal_store(w, (u32x4*)p); }
__device__ __forceinline__ float bflo(unsigned w) { return __uint_as_float(w << 16); }
__device__ __forceinline__ float bfhi(unsigned w) { return __uint_as_float(w & 0xffff0000u); }
__device__ __forceinline__ unsigned pk(float a, float b) { return pg8::cvt_pk_bf16(a, b); }
__device__ __forceinline__ float fast_rcp(float x) { return __builtin_amdgcn_rcpf(x); }
__device__ __forceinline__ float gate_t(float x) { return 1.0f + __builtin_amdgcn_exp2f(fminf(x * -1.44269504f, 43.28f)); }
__device__ __forceinline__ float gelu_tanh_f(float x) {
    const float z2 = 1.5957691216f * (x + 0.044715f * x * x * x);
    return x * fast_rcp(1.0f + __expf(-z2));
}
__device__ __forceinline__ float silu_f(float x) { return x * fast_rcp(1.0f + __expf(-x)); }
__device__ __forceinline__ float row_rstd(const float* ssq, int r) {
    const f32x4* p = (const f32x4*)(ssq + (size_t)r * 16);
    const f32x4 a = p[0], b = p[1], c = p[2], d = p[3];
    const float s = ((a[0] + a[1]) + (a[2] + a[3])) + ((b[0] + b[1]) + (b[2] + b[3])) + ((c[0] + c[1]) + (c[2] + c[3])) + ((d[0] + d[1]) + (d[2] + d[3]));
    return rsqrtf(s * (1.0f / 1024.0f) + EPS);
}

__device__ __forceinline__ void rows_rstd8(const float* ssq, int row0, int fq, float (&rs)[8]) {
    f32x4 v[8];
#pragma unroll
    for (int i = 0; i < 8; ++i) v[i] = *(const f32x4*)(ssq + (size_t)(row0 + (i >> 2) * 128 + (i & 3) * 16) * 16 + fq * 4);
#pragma unroll
    for (int i = 0; i < 8; ++i) {
        float s = (v[i][0] + v[i][1]) + (v[i][2] + v[i][3]);
        s += __shfl_xor(s, 16); s += __shfl_xor(s, 32);
        rs[i] = rsqrtf(s * (1.0f / 1024.0f) + EPS);
    }
}
struct EpiIn {
    static constexpr bool PERM = true, AFTER_DRAIN = false, MIDK = false;
    bf16_t* PA; bf16_t* G; const float* ssq;
    __device__ __forceinline__ void operator()(const f32x4 (&acc)[2][2][4][2], const pg8::Unit& u, int wr, int wc, int fr, int fq) const {
        const int colt = u.pn * 256;
        const int act = (colt >= NPA) ? 2 : ((colt >= 512 && colt < 1536) ? 1 : 0);
        bf16_t* base = (colt >= NPA) ? G : PA;
        const int col0 = (colt >= NPA ? colt - NPA : colt) + wc * 32 + 8 * fq;
        const int row0 = u.pm * 256 + wr * 64 + fr;
        float rs8[8]; rows_rstd8(ssq, row0, fq, rs8);
#pragma unroll
        for (int ai = 0; ai < 2; ++ai)
#pragma unroll
            for (int m = 0; m < 4; ++m) {
                const int r = row0 + ai * 128 + m * 16;
                const float rs = rs8[ai * 4 + m];
                bf16_t* rowp = base + (size_t)r * NPA + col0;
#pragma unroll
                for (int bj = 0; bj < 2; ++bj) {
                    float v[8];
#pragma unroll
                    for (int j = 0; j < 4; ++j) { v[j] = acc[ai][bj][m][0][j] * rs; v[4 + j] = acc[ai][bj][m][1][j] * rs; }
                    if (act == 1) {
#pragma unroll
                        for (int j = 0; j < 8; ++j) v[j] = gelu_tanh_f(v[j]);
                    } else if (act == 2) {
#pragma unroll
                        for (int j = 0; j < 8; ++j) v[j] = gate_t(v[j]);
                    }
                    u32x4 w; w.x = pk(v[0], v[1]); w.y = pk(v[2], v[3]); w.z = pk(v[4], v[5]); w.w = pk(v[6], v[7]);
                    st_nt16(rowp + bj * 128, w);
                }
            }
    }
};
struct EpiBr {
    static constexpr bool PERM = true, AFTER_DRAIN = false, MIDK = true;
    const bf16_t* G; bf16_t* out;
    __device__ __forceinline__ void mid(f32x4 (&acc)[2][2][4][2], const pg8::Unit& u, int t, int wr, int wc, int fr, int fq) const {
        const int seg = (t == 8) ? 0 : 1024;
        int col0 = u.pn * 256 + wc * 32 + 8 * fq + seg;
        int row0 = u.pm * 256 + wr * 64 + fr;
        asm volatile("" : "+v"(col0), "+v"(row0));
#pragma unroll
        for (int ai = 0; ai < 2; ++ai) {
            u32x4 nu[4][2], de[4][2];
#pragma unroll
            for (int m = 0; m < 4; ++m)
#pragma unroll
                for (int bj = 0; bj < 2; ++bj) {
                    const bf16_t* gp = G + (size_t)(row0 + ai * 128 + m * 16) * NPA + col0 + bj * 128;
                    nu[m][bj] = *(const u32x4*)gp; de[m][bj] = *(const u32x4*)(gp + 1024);
                }
            asm volatile("" ::: "memory");
#pragma unroll
            for (int m = 0; m < 4; ++m)
#pragma unroll
                for (int bj = 0; bj < 2; ++bj) {
                    const unsigned nw[4] = {nu[m][bj].x, nu[m][bj].y, nu[m][bj].z, nu[m][bj].w}, dw[4] = {de[m][bj].x, de[m][bj].y, de[m][bj].z, de[m][bj].w};
#pragma unroll
                    for (int q = 0; q < 4; ++q) {
                        const float r0 = bflo(dw[q]) * fast_rcp(bflo(nw[q])), r1 = bfhi(dw[q]) * fast_rcp(bfhi(nw[q]));
                        acc[ai][bj][m][q >> 1][(q & 1) * 2] *= r0; acc[ai][bj][m][q >> 1][(q & 1) * 2 + 1] *= r1;
                    }
                }
            asm volatile("" ::: "memory");
        }
    }
    __device__ __forceinline__ void operator()(const f32x4 (&acc)[2][2][4][2], const pg8::Unit& u, int wr, int wc, int fr, int fq) const {
        const int col0 = u.pn * 256 + wc * 32 + 8 * fq;
        const int row0 = u.pm * 256 + wr * 64 + fr;
        u32x4 sg[2][4][2];
#pragma unroll
        for (int ai = 0; ai < 2; ++ai)
#pragma unroll
            for (int m = 0; m < 4; ++m)
#pragma unroll
                for (int bj = 0; bj < 2; ++bj) sg[ai][m][bj] = *(const u32x4*)(G + (size_t)(row0 + ai * 128 + m * 16) * NPA + 2048 + col0 + bj * 128);
#pragma unroll
        for (int ai = 0; ai < 2; ++ai)
#pragma unroll
            for (int m = 0; m < 4; ++m) {
                const int r = row0 + ai * 128 + m * 16;
                bf16_t* op = out + (size_t)r * DM + col0;
#pragma unroll
                for (int bj = 0; bj < 2; ++bj) {
                    const u32x4 s = sg[ai][m][bj];
                    const f32x4 a0 = acc[ai][bj][m][0], a1 = acc[ai][bj][m][1];
                    u32x4 w;
                    w.x = pk(a0[0] * fast_rcp(bflo(s.x)), a0[1] * fast_rcp(bfhi(s.x))); w.y = pk(a0[2] * fast_rcp(bflo(s.y)), a0[3] * fast_rcp(bfhi(s.y)));
                    w.z = pk(a1[0] * fast_rcp(bflo(s.z)), a1[1] * fast_rcp(bfhi(s.z))); w.w = pk(a1[2] * fast_rcp(bflo(s.w)), a1[3] * fast_rcp(bfhi(s.w)));
                    *(u32x4*)(op + bj * 128) = w;
                }
            }
    }
};
struct EpiRes {
    static constexpr bool PERM = true, AFTER_DRAIN = false, MIDK = false;
    bf16_t* xb; float* ssq;
    __device__ __forceinline__ void operator()(const f32x4 (&acc)[2][2][4][2], const pg8::Unit& u, int wr, int wc, int fr, int fq) const {
        const int col0 = u.pn * 256 + wc * 32 + 8 * fq;
        const int row0 = u.pm * 256 + wr * 64 + fr;
        u32x4 bb[2][4][2];
#pragma unroll
        for (int ai = 0; ai < 2; ++ai)
#pragma unroll
            for (int m = 0; m < 4; ++m)
#pragma unroll
                for (int bj = 0; bj < 2; ++bj) bb[ai][m][bj] = *(const u32x4*)(xb + (size_t)(row0 + ai * 128 + m * 16) * DM + col0 + bj * 128);
        asm volatile("" ::: "memory");
#pragma unroll
        for (int ai = 0; ai < 2; ++ai) {
#pragma unroll
            for (int m = 0; m < 4; ++m) {
                const int r = row0 + ai * 128 + m * 16;
                float sq = 0.f;
#pragma unroll
                for (int bj = 0; bj < 2; ++bj) {
                    const u32x4 s = bb[ai][m][bj];
                    const f32x4 a0 = acc[ai][bj][m][0], a1 = acc[ai][bj][m][1];
                    const float o0 = bflo(s.x) + a0[0], o1 = bfhi(s.x) + a0[1], o2 = bflo(s.y) + a0[2], o3 = bfhi(s.y) + a0[3];
                    const float o4 = bflo(s.z) + a1[0], o5 = bfhi(s.z) + a1[1], o6 = bflo(s.w) + a1[2], o7 = bfhi(s.w) + a1[3];
                    u32x4 w; w.x = pk(o0, o1); w.y = pk(o2, o3); w.z = pk(o4, o5); w.w = pk(o6, o7);
                    *(u32x4*)(xb + (size_t)r * DM + col0 + bj * 128) = w;
                    sq += (o0 * o0 + o1 * o1) + (o2 * o2 + o3 * o3) + (o4 * o4 + o5 * o5) + (o6 * o6 + o7 * o7);
                }
                sq += __shfl_xor(sq, 16); sq += __shfl_xor(sq, 32);
                if (fq == 0) ssq[(size_t)r * 16 + u.pn * 4 + wc] = sq;
            }
            asm volatile("" ::: "memory");
        }
    }
};
__device__ __forceinline__ float dpp_ror1(float x) { return __int_as_float(__builtin_amdgcn_update_dpp(0, __float_as_int(x), 0x121, 0xf, 0xf, false)); }
__device__ __forceinline__ float dpp_ror2(float x) { return __int_as_float(__builtin_amdgcn_update_dpp(0, __float_as_int(x), 0x122, 0xf, 0xf, false)); }
__device__ __forceinline__ float dpp_shr1(float old, float x) { return __int_as_float(__builtin_amdgcn_update_dpp(__float_as_int(old), __float_as_int(x), 0x111, 0xf, 0xf, false)); }
__device__ __forceinline__ float dpp_shr2(float old, float x) { return __int_as_float(__builtin_amdgcn_update_dpp(__float_as_int(old), __float_as_int(x), 0x112, 0xf, 0xf, false)); }
struct EpiUp {
    static constexpr bool PERM = true, AFTER_DRAIN = false, MIDK = false;
    bf16_t* act; bf16_t* zs; const float* ssq; const float* cw; const float* cb;
    __device__ __forceinline__ void operator()(const f32x4 (&acc)[2][2][4][2], const pg8::Unit& u, int wr, int wc, int fr, int fq) const {
        const int c0 = u.pn * 128 + wc * 32 + 8 * fq;
        const int row0 = u.pm * 256 + wr * 64 + fr;
        float rs8[8]; rows_rstd8(ssq, row0, fq, rs8);
        u32x2 keep[2][4];
#pragma unroll
        for (int n = 0; n < 2; ++n) {
            const int c = c0 + 4 * n;
            const f32x4 gw0 = *(const f32x4*)(cw + c), gw1 = *(const f32x4*)(cw + NUP + c), gw2 = *(const f32x4*)(cw + 2 * NUP + c), gb = *(const f32x4*)(cb + c);
            const f32x4 vw0 = *(const f32x4*)(cw + DFF + c), vw1 = *(const f32x4*)(cw + NUP + DFF + c), vw2 = *(const f32x4*)(cw + 2 * NUP + DFF + c), vb = *(const f32x4*)(cb + DFF + c);
#pragma unroll
            for (int ai = 0; ai < 2; ++ai) {
                f32x4 pg = {0.f, 0.f, 0.f, 0.f}, pv = {0.f, 0.f, 0.f, 0.f};
                const int blk = u.pm * 4 + ai * 2 + wr;
#pragma unroll
                for (int m = 0; m < 4; ++m) {
                    const float rs = rs8[ai * 4 + m];
                    const f32x4 zg = acc[ai][0][m][n] * rs, zv = acc[ai][1][m][n] * rs;
                    float o[4];
#pragma unroll
                    for (int j = 0; j < 4; ++j) {
                        const float g1 = dpp_shr1(dpp_ror1(pg[j]), zg[j]), g2 = dpp_shr2(dpp_ror2(pg[j]), zg[j]);
                        const float v1 = dpp_shr1(dpp_ror1(pv[j]), zv[j]), v2 = dpp_shr2(dpp_ror2(pv[j]), zv[j]);
                        const float gg = gw2[j] * zg[j] + gw1[j] * g1 + gw0[j] * g2 + gb[j];
                        const float vv = vw2[j] * zv[j] + vw1[j] * v1 + vw0[j] * v2 + vb[j];
                        o[j] = silu_f(gg) * vv;
                    }
                    u32x2 w; w.x = pk(o[0], o[1]); w.y = pk(o[2], o[3]);
                    const int r = row0 + ai * 128 + m * 16;
                    if (n == 0) keep[ai][m] = w;
                    else if (!(m == 0 && fr < 2)) { u32x4 ww; ww.x = keep[ai][m].x; ww.y = keep[ai][m].y; ww.z = w.x; ww.w = w.y; st_nt16(act + (size_t)r * DFF + c0, ww); }
                    if (m == 0 && fr < 2) {
                        bf16_t* zp = zs + ((size_t)blk * 4 + 2 + fr) * NUP + c;
                        u32x2 a; a.x = pk(zg[0], zg[1]); a.y = pk(zg[2], zg[3]); *(u32x2*)zp = a;
                        u32x2 d; d.x = pk(zv[0], zv[1]); d.y = pk(zv[2], zv[3]); *(u32x2*)(zp + DFF) = d;
                    }
                    if (m == 3 && fr >= 14) {
                        bf16_t* zp = zs + ((size_t)blk * 4 + (fr - 14)) * NUP + c;
                        u32x2 a; a.x = pk(zg[0], zg[1]); a.y = pk(zg[2], zg[3]); *(u32x2*)zp = a;
                        u32x2 d; d.x = pk(zv[0], zv[1]); d.y = pk(zv[2], zv[3]); *(u32x2*)(zp + DFF) = d;
                    }
                    pg = zg; pv = zv;
                }
            }
        }
    }
};

__device__ __forceinline__ void transpose_tile(const float* __restrict__ W, int N, const float* __restrict__ g, bf16_t* __restrict__ Wt, int ldt, int koff, int k0, int n0, int nd0, float* tile, int tid) {
    {
        const int kk = tid >> 4, nn = (tid & 15) * 4;
#pragma unroll
        for (int h = 0; h < 2; ++h) {
            const int k = kk + h * 32;
            f32x4 v = *(const f32x4*)(W + (size_t)(k0 + k) * N + n0 + nn);
            const float s = g ? g[k0 + k] : 1.0f;
            tile[k * 65 + nn + 0] = v[0] * s; tile[k * 65 + nn + 1] = v[1] * s; tile[k * 65 + nn + 2] = v[2] * s; tile[k * 65 + nn + 3] = v[3] * s;
        }
    }
    __syncthreads();
    {
        const int n = tid >> 3, kq = (tid & 7) * 8;
        float v[8];
#pragma unroll
        for (int j = 0; j < 8; ++j) v[j] = tile[(kq + j) * 65 + n];
        u32x4 w; w.x = pk(v[0], v[1]); w.y = pk(v[2], v[3]); w.z = pk(v[4], v[5]); w.w = pk(v[6], v[7]);
        *(u32x4*)(Wt + (size_t)(nd0 + n) * ldt + koff + k0 + kq) = w;
    }
    __syncthreads();
}

__device__ __forceinline__ void prep_phase(const Params& p, int l, float* ldsf) {
    unsigned char* ws = p.ws;
    bf16_t* wt_in = (bf16_t*)(ws + WS_WIN); bf16_t* wt_br = (bf16_t*)(ws + WS_WBR); bf16_t* wt_o = (bf16_t*)(ws + WS_WO);
    bf16_t* wt_up = (bf16_t*)(ws + WS_WUP); bf16_t* wt_dn = (bf16_t*)(ws + WS_WDN);
    const float* g_mix = p.in[1] + (size_t)l * DM; const float* w_in = p.in[2] + (size_t)l * DM * NIN;
    const float* w_pool = p.in[3] + (size_t)l * 4 * 128 * 128; const float* pscale = p.in[4] + (size_t)l * 512;
    const float* w_ba = p.in[9] + (size_t)l * 512 * DM; const float* w_bb = p.in[10] + (size_t)l * 512 * DM; const float* w_bc = p.in[11] + (size_t)l * 512 * DM;
    const float* w_o = p.in[12] + (size_t)l * DM * DM; const float* g_ffn = p.in[13] + (size_t)l * DM;
    const float* w_up = p.in[14] + (size_t)l * DM * NUP; const float* w_dn = p.in[17] + (size_t)l * DFF * DM;
    const int tid = otid(), bid = obid();
    constexpr int T0 = 16 * 96, T1 = T0 + 128, T2 = T1 + 128, T3 = T2 + 256, T4 = T3 + 16 * 88, T5 = T4 + 44 * 16;
    for (int i = bid; i < T5; i += gridDim.x) {
        if (i < T0) { const int kt = i & 15, nt = i >> 4; transpose_tile(w_in, NIN, g_mix, wt_in, DM, 0, kt * 64, nt * 64, nt * 64, ldsf, tid); }
        else if (i < T1) { const int j = i - T0, kt = j & 7, nt = j >> 3; transpose_tile(w_bb, DM, nullptr, wt_br, NBR, 512, kt * 64, nt * 64, nt * 64, ldsf, tid); }
        else if (i < T2) { const int j = i - T1, kt = j & 7, nt = j >> 3; transpose_tile(w_bc, DM, nullptr, wt_br, NBR, 1024, kt * 64, nt * 64, nt * 64, ldsf, tid); }
        else if (i < T3) { const int j = i - T2, kt = j & 15, nt = j >> 4; transpose_tile(w_o, DM, nullptr, wt_o, DM, 0, kt * 64, nt * 64, nt * 64, ldsf, tid); }
        else if (i < T4) { const int j = i - T3, kt = j & 15, nt = j >> 4; const int n0 = nt * 64, bj = n0 / DFF, q0 = n0 - bj * DFF; transpose_tile(w_up, NUP, g_ffn, wt_up, DM, 0, kt * 64, n0, (q0 >> 7) * 256 + bj * 128 + (q0 & 127), ldsf, tid);   }
        else { const int j = i - T4, kt = j % 44, nt = j / 44; transpose_tile(w_dn, DM, nullptr, wt_dn, DFF, 0, kt * 64, nt * 64, nt * 64, ldsf, tid); }
    }
    {
        float* wpT = ldsf;
        float* wa = ldsf + 128 * 128;
        for (int it = (int)gridDim.x - 1 - bid; it < 64; it += gridDim.x) {
            const int g = it >> 4, n0 = (it & 15) * 64;
            for (int q = tid; q < 128 * 32; q += 512) {
                const int d = q >> 5, e4 = (q & 31) * 4;
                const f32x4 v = *(const f32x4*)(w_pool + ((size_t)g * 128 + d) * 128 + e4);
                const f32x4 s = *(const f32x4*)(pscale + g * 128 + e4);
                wpT[(e4 + 0) * 128 + d] = v[0] * s[0]; wpT[(e4 + 1) * 128 + d] = v[1] * s[1]; wpT[(e4 + 2) * 128 + d] = v[2] * s[2]; wpT[(e4 + 3) * 128 + d] = v[3] * s[3];
            }
            for (int q = tid; q < 128 * 16; q += 512) {
                const int e = q >> 4, c4 = (q & 15) * 4;
                *(f32x4*)(wa + e * 64 + c4) = *(const f32x4*)(w_ba + (size_t)(g * 128 + e) * DM + n0 + c4);
            }
            __syncthreads();
            const int d = tid & 127, ns = tid >> 7;
            float acc[16];
#pragma unroll
            for (int i = 0; i < 16; ++i) acc[i] = 0.f;
            for (int e = 0; e < 128; ++e) {
                const float w = wpT[e * 128 + d];
                const f32x4* wr4 = (const f32x4*)(wa + e * 64 + ns * 16);
#pragma unroll
                for (int c = 0; c < 4; ++c) { const f32x4 b = wr4[c]; acc[c * 4 + 0] += w * b[0]; acc[c * 4 + 1] += w * b[1]; acc[c * 4 + 2] += w * b[2]; acc[c * 4 + 3] += w * b[3]; }
            }
#pragma unroll
            for (int i = 0; i < 16; ++i) wt_br[(size_t)(n0 + ns * 16 + i) * NBR + g * 128 + d] = (bf16_t)(pk(acc[i], 0.f) & 0xffffu);
            __syncthreads();
        }
    }
    if (l == 0) {
        const float* x = p.in[0]; bf16_t* xb = (bf16_t*)(ws + WS_XB); float* ssq = (float*)(ws + WS_SSQ);
        const int lane = tid & 63, wave = tid >> 6;
        for (int r = bid * 8 + wave; r < MTOK; r += gridDim.x * 8) {
            float sq = 0.f;
#pragma unroll
            for (int i = 0; i < 4; ++i) {
                const f32x4 v = *(const f32x4*)(x + (size_t)r * DM + i * 256 + lane * 4);
                sq += (v[0] * v[0] + v[1] * v[1]) + (v[2] * v[2] + v[3] * v[3]);
                u32x2 w; w.x = pk(v[0], v[1]); w.y = pk(v[2], v[3]);
                *(u32x2*)(xb + (size_t)r * DM + i * 256 + lane * 4) = w;
            }
#pragma unroll
            for (int o = 32; o >= 1; o >>= 1) sq += __shfl_xor(sq, o);
            if (lane < 16) ssq[(size_t)r * 16 + lane] = (lane == 0) ? sq : 0.f;
        }
    }
}
__device__ __forceinline__ void ld8(const bf16_t* p, float (&v)[8]) {
    const u32x4 w = *(const u32x4*)p;
    v[0] = bflo(w.x); v[1] = bfhi(w.x); v[2] = bflo(w.y); v[3] = bfhi(w.y); v[4] = bflo(w.z); v[5] = bfhi(w.z); v[6] = bflo(w.w); v[7] = bfhi(w.w);
}
__device__ __forceinline__ void st8(bf16_t* p, const float (&v)[8]) {
    u32x4 w; w.x = pk(v[0], v[1]); w.y = pk(v[2], v[3]); w.z = pk(v[4], v[5]); w.w = pk(v[6], v[7]);
    *(u32x4*)p = w;
}
template <int W> __device__ __forceinline__ void pool_rows(const bf16_t* __restrict__ ap, bf16_t* __restrict__ yp, int r0, int pos0) {
#pragma unroll
    for (int b = 0; b < 4; ++b) {
        const int base = r0 + 4 * b;
        u32x4 h[W + 3];
#pragma unroll
        for (int i = 0; i < W + 3; ++i) { const int rr = base - (W - 1) + i; h[i] = (pos0 + rr >= 0) ? *(const u32x4*)(ap + (ptrdiff_t)rr * NPA) : (u32x4){0u, 0u, 0u, 0u}; }
        float s[8];
#pragma unroll
        for (int j = 0; j < 8; ++j) s[j] = 0.f;
#pragma unroll
        for (int i = 0; i < W - 1; ++i) { const u32x4 q = h[i];
            s[0] += bflo(q.x); s[1] += bfhi(q.x); s[2] += bflo(q.y); s[3] += bfhi(q.y); s[4] += bflo(q.z); s[5] += bfhi(q.z); s[6] += bflo(q.w); s[7] += bfhi(q.w); }
#pragma unroll
        for (int i = 0; i < 4; ++i) {
            const int rr = base + i, pos = pos0 + rr; const float inv = 1.0f / (float)(pos + 1 < W ? pos + 1 : W);
            const u32x4 q = h[W - 1 + i], od = h[i];
            const float v[8] = {bflo(q.x), bfhi(q.x), bflo(q.y), bfhi(q.y), bflo(q.z), bfhi(q.z), bflo(q.w), bfhi(q.w)};
            float o[8];
#pragma unroll
            for (int j = 0; j < 8; ++j) { s[j] += v[j]; o[j] = s[j] * inv - v[j]; }
            st8(yp + (size_t)rr * NBR, o);
            s[0] -= bflo(od.x); s[1] -= bfhi(od.x); s[2] -= bflo(od.y); s[3] -= bfhi(od.y); s[4] -= bflo(od.z); s[5] -= bfhi(od.z); s[6] -= bflo(od.w); s[7] -= bfhi(od.w);
        }
        asm volatile("" ::: "memory");
    }
}
constexpr int VT_PITCH = 136;
__device__ __forceinline__ void mixer_phase(const Params& p, int l, unsigned char* lds) {
    const bf16_t* PA = (const bf16_t*)(p.ws + WS_B1);
    bf16_t* Y = (bf16_t*)p.out;
    const float* g_sgu = p.in[5] + (size_t)l * 512;
    const float* w_sp = p.in[6] + (size_t)l * 4 * 128 * 128;
    const float* b_sp = p.in[7] + (size_t)l * 4 * 128;
    const float* conv_c = p.in[8] + (size_t)l * 3 * 512;
    float* rs = (float*)lds;
    bf16_t* vT = (bf16_t*)(lds + 1024);
    const int tid = otid(), lane = tid & 63, wave = __builtin_amdgcn_readfirstlane(tid >> 6), fr = lane & 15, fq = lane >> 4;
    for (int item = obid(); item < MTOK / 128; item += gridDim.x) {
        const int t0 = item * 128, pos0 = t0 & (SEQ - 1);
        {
            const int row = tid >> 2, q = tid & 3;
            const bf16_t* vp = PA + (size_t)(t0 + row) * NPA + 1024 + q * 128;
            float sq = 0.f;
#pragma unroll
            for (int i = 0; i < 16; ++i) { float v[8]; ld8(vp + i * 8, v);
#pragma unroll
                for (int j = 0; j < 8; ++j) sq += v[j] * v[j]; }
            sq += __shfl_xor(sq, 1); sq += __shfl_xor(sq, 2);
            if (q == 0) rs[row] = rsqrtf(sq * (1.0f / 512.0f) + EPS);
        }
        {
            const int grp = wave & 3;
            const int c8 = (grp * 16 + (lane & 15)) * 8; int r0 = ((wave >> 2) * 4 + (lane >> 4)) * 16;
            asm volatile("" : "+v"(r0));
            {
                const bf16_t* ap = PA + (size_t)t0 * NPA + c8;
                bf16_t* yp = Y + (size_t)t0 * NBR + c8;
                if (grp == 0) pool_rows<2>(ap, yp, r0, pos0); else if (grp == 1) pool_rows<4>(ap, yp, r0, pos0); else if (grp == 2) pool_rows<8>(ap, yp, r0, pos0); else pool_rows<16>(ap, yp, r0, pos0);
            }
            {
                const bf16_t* bp = PA + (size_t)t0 * NPA + 1536 + c8;
                bf16_t* yp = Y + (size_t)t0 * NBR + 1024 + c8;
                float w0[8], w1[8], w2[8], z1[8], z2[8];
#pragma unroll
                for (int j = 0; j < 8; ++j) { w0[j] = conv_c[c8 + j]; w1[j] = conv_c[512 + c8 + j]; w2[j] = conv_c[1024 + c8 + j]; z1[j] = 0.f; z2[j] = 0.f; }
                {
                    const bool h2 = pos0 + r0 - 2 >= 0, h1 = pos0 + r0 - 1 >= 0;
                    const u32x4 zz = {0u, 0u, 0u, 0u};
                    const u32x4 a2 = h2 ? *(const u32x4*)(bp + (ptrdiff_t)(r0 - 2) * NPA + 512) : zz, b2 = h2 ? *(const u32x4*)(bp + (ptrdiff_t)(r0 - 2) * NPA + 1024) : zz;
                    const u32x4 a1 = h1 ? *(const u32x4*)(bp + (ptrdiff_t)(r0 - 1) * NPA + 512) : zz, b1 = h1 ? *(const u32x4*)(bp + (ptrdiff_t)(r0 - 1) * NPA + 1024) : zz;
                    z2[0] = bflo(a2.x) * bflo(b2.x); z2[1] = bfhi(a2.x) * bfhi(b2.x); z2[2] = bflo(a2.y) * bflo(b2.y); z2[3] = bfhi(a2.y) * bfhi(b2.y);
                    z2[4] = bflo(a2.z) * bflo(b2.z); z2[5] = bfhi(a2.z) * bfhi(b2.z); z2[6] = bflo(a2.w) * bflo(b2.w); z2[7] = bfhi(a2.w) * bfhi(b2.w);
                    z1[0] = bflo(a1.x) * bflo(b1.x); z1[1] = bfhi(a1.x) * bfhi(b1.x); z1[2] = bflo(a1.y) * bflo(b1.y); z1[3] = bfhi(a1.y) * bfhi(b1.y);
                    z1[4] = bflo(a1.z) * bflo(b1.z); z1[5] = bfhi(a1.z) * bfhi(b1.z); z1[6] = bflo(a1.w) * bflo(b1.w); z1[7] = bfhi(a1.w) * bfhi(b1.w);
                }
#pragma unroll
                for (int hb = 0; hb < 4; ++hb) {
                    u32x4 qb[4], qc[4], qx[4];
#pragma unroll
                    for (int i = 0; i < 4; ++i) { const bf16_t* rp = bp + (size_t)(r0 + hb * 4 + i) * NPA; qb[i] = *(const u32x4*)rp; qc[i] = *(const u32x4*)(rp + 512); qx[i] = *(const u32x4*)(rp + 1024); }
#pragma unroll
                    for (int i = 0; i < 4; ++i) {
                        const float cb[8] = {bflo(qb[i].x), bfhi(qb[i].x), bflo(qb[i].y), bfhi(qb[i].y), bflo(qb[i].z), bfhi(qb[i].z), bflo(qb[i].w), bfhi(qb[i].w)};
                        const float a[8] = {bflo(qc[i].x), bfhi(qc[i].x), bflo(qc[i].y), bfhi(qc[i].y), bflo(qc[i].z), bfhi(qc[i].z), bflo(qc[i].w), bfhi(qc[i].w)};
                        const float b[8] = {bflo(qx[i].x), bfhi(qx[i].x), bflo(qx[i].y), bfhi(qx[i].y), bflo(qx[i].z), bfhi(qx[i].z), bflo(qx[i].w), bfhi(qx[i].w)};
                        float o[8];
#pragma unroll
                        for (int j = 0; j < 8; ++j) { const float z = a[j] * b[j]; o[j] = cb[j] * (w0[j] * z2[j] + w1[j] * z1[j] + w2[j] * z); z2[j] = z1[j]; z1[j] = z; }
                        st8(yp + (size_t)(r0 + hb * 4 + i) * NBR, o);
                    }
                    asm volatile("" ::: "memory");
                }
            }
        }
#pragma unroll 1
        for (int g = 0; g < 4; ++g) {
            const int t = wave * 16 + fr;
            const int nk = (wave >> 1) + 1;
            f32x4 wq[4][2];
#pragma unroll
            for (int k = 0; k < 4; ++k) { const float* wp = w_sp + ((size_t)g * 128 + t) * 128 + k * 32 + fq * 8; wq[k][0] = *(const f32x4*)wp; wq[k][1] = *(const f32x4*)(wp + 4); }
            const bf16_t* up = PA + (size_t)(t0 + t) * NPA + 512 + g * 128 + 4 * fq;
            u32x2 uu[8];
#pragma unroll
            for (int n = 0; n < 8; ++n) uu[n] = *(const u32x2*)(up + n * 16);
            const float bias = b_sp[g * 128 + t];
            u32x4 vq[4];
            const int s_ = tid >> 2, dq = (tid & 3) * 32;
            {
                const bf16_t* vp = PA + (size_t)(t0 + s_) * NPA + 1024 + g * 128 + dq;
#pragma unroll
                for (int i = 0; i < 4; ++i) vq[i] = *(const u32x4*)(vp + i * 8);
            }
            __syncthreads();
#pragma unroll
            for (int i = 0; i < 4; ++i) {
                const unsigned ww[4] = {vq[i].x, vq[i].y, vq[i].z, vq[i].w};
#pragma unroll
                for (int q = 0; q < 4; ++q) { vT[(dq + i * 8 + q * 2) * VT_PITCH + s_] = (bf16_t)(ww[q] & 0xffffu); vT[(dq + i * 8 + q * 2 + 1) * VT_PITCH + s_] = (bf16_t)(ww[q] >> 16); }
            }
            __syncthreads();
            f32x4 acc[8];
#pragma unroll
            for (int n = 0; n < 8; ++n) acc[n] = (f32x4){0.f, 0.f, 0.f, 0.f};
#pragma unroll
            for (int k = 0; k < 4; ++k) if (k < nk) {
                const int s0 = k * 32 + fq * 8;
                const f32x4 wa = wq[k][0], wb = wq[k][1];
                const f32x4 ra = *(const f32x4*)(rs + s0), rb = *(const f32x4*)(rs + s0 + 4);
                float a[8];
#pragma unroll
                for (int j = 0; j < 4; ++j) { a[j] = (s0 + j <= t) ? wa[j] * ra[j] : 0.f; a[4 + j] = (s0 + 4 + j <= t) ? wb[j] * rb[j] : 0.f; }
                union { u32x4 u; bf16x8 h; } af; af.u.x = pk(a[0], a[1]); af.u.y = pk(a[2], a[3]); af.u.z = pk(a[4], a[5]); af.u.w = pk(a[6], a[7]);
#pragma unroll
                for (int n = 0; n < 8; ++n) {
                    const bf16x8 bfrag = *(const bf16x8*)(vT + (n * 16 + fr) * VT_PITCH + s0);
                    acc[n] = __builtin_amdgcn_mfma_f32_16x16x32_bf16(bfrag, af.h, acc[n], 0, 0, 0);
                }
            }
            bf16_t* yp = Y + (size_t)(t0 + t) * NBR + 512 + g * 128 + 4 * fq;
#pragma unroll
            for (int n = 0; n < 8; ++n) {
                const f32x4 gs = *(const f32x4*)(g_sgu + g * 128 + n * 16 + 4 * fq);
                const float o0 = bflo(uu[n].x) * (acc[n][0] * gs[0] + bias), o1 = bfhi(uu[n].x) * (acc[n][1] * gs[1] + bias);
                const float o2 = bflo(uu[n].y) * (acc[n][2] * gs[2] + bias), o3 = bfhi(uu[n].y) * (acc[n][3] * gs[3] + bias);
                u32x2 w; w.x = pk(o0, o1); w.y = pk(o2, o3);
                *(u32x2*)(yp + n * 16) = w;
            }
        }
        __syncthreads();
    }
}

__device__ __forceinline__ void ffn_fixup_phase(const Params& p, int l) {
    const bf16_t* zs = (const bf16_t*)(p.ws + WS_B2);
    bf16_t* act = (bf16_t*)(p.ws + WS_B1);
    const float* cw = p.in[15] + (size_t)l * 3 * NUP; const float* cb = p.in[16] + (size_t)l * NUP;
    constexpr int NCG = DFF / 8, NU = (MTOK / 64) * NCG;
    for (int u = obid() * 512 + otid(); u < NU; u += gridDim.x * 512) {
        const int blk = u / NCG, c8 = (u - blk * NCG) * 8;
        const bool first = ((blk * 64) & (SEQ - 1)) == 0;
        float g2[8], g1[8], ga[8], gb2[8], v2[8], v1[8], va[8], vb2[8];
#pragma unroll
        for (int j = 0; j < 8; ++j) { g2[j] = g1[j] = v2[j] = v1[j] = 0.f; }
        const bf16_t* own = zs + (size_t)blk * 4 * NUP + c8;
        if (!first) { const bf16_t* prv = own - 4 * (ptrdiff_t)NUP; ld8(prv, g2); ld8(prv + NUP, g1); ld8(prv + DFF, v2); ld8(prv + NUP + DFF, v1); }
        ld8(own + 2 * NUP, ga); ld8(own + 3 * NUP, gb2); ld8(own + 2 * NUP + DFF, va); ld8(own + 3 * NUP + DFF, vb2);
        float o0[8], o1[8];
#pragma unroll
        for (int j = 0; j < 8; ++j) {
            const float w0 = cw[c8 + j], w1 = cw[NUP + c8 + j], w2 = cw[2 * NUP + c8 + j], bb = cb[c8 + j];
            const float x0 = cw[DFF + c8 + j], x1 = cw[NUP + DFF + c8 + j], x2 = cw[2 * NUP + DFF + c8 + j], xb_ = cb[DFF + c8 + j];
            const float gg0 = w0 * g2[j] + w1 * g1[j] + w2 * ga[j] + bb, vv0 = x0 * v2[j] + x1 * v1[j] + x2 * va[j] + xb_;
            const float gg1 = w0 * g1[j] + w1 * ga[j] + w2 * gb2[j] + bb, vv1 = x0 * v1[j] + x1 * va[j] + x2 * vb2[j] + xb_;
            o0[j] = silu_f(gg0) * vv0; o1[j] = silu_f(gg1) * vv1;
        }
        st8(act + (size_t)(blk * 64) * DFF + c8, o0); st8(act + (size_t)(blk * 64 + 1) * DFF + c8, o1);
    }
}

__device__ __forceinline__ void final_norm_phase(const Params& p) {
    const float* gf = p.in[18]; const float* ssq = (const float*)(p.ws + WS_SSQ); const bf16_t* xb = (const bf16_t*)(p.ws + WS_XB); float* out = p.out;
    const int tid = otid(), lane = tid & 63, wave = tid >> 6;
    for (int r = obid() * 8 + wave; r < MTOK; r += gridDim.x * 8) {
        const float rs = row_rstd(ssq, r);
#pragma unroll
        for (int i = 0; i < 2; ++i) {
            const int c = i * 512 + lane * 8;
            float v[8]; ld8(xb + (size_t)r * DM + c, v);
            const f32x4 g0 = *(const f32x4*)(gf + c), g1 = *(const f32x4*)(gf + c + 4);
            f32x4 o0, o1;
#pragma unroll
            for (int j = 0; j < 4; ++j) { o0[j] = v[j] * rs * g0[j]; o1[j] = v[4 + j] * rs * g1[j]; }
            float* q = out + (size_t)r * DM + c;
            __builtin_nontemporal_store(o0, (f32x4*)q); __builtin_nontemporal_store(o1, (f32x4*)(q + 4));
        }
    }
}

template <class Epi> __device__ __forceinline__ void run_gemm(unsigned char* lds, const bf16_t* A, const bf16_t* Bt, int M, int N, int K, const Epi& E, int stagger_step = 0) {
    pg8::Gemm g{A, Bt, M, N, K}; pg8::StaticOrder S; S.init(M, N, (int)gridDim.x, obid());
    if (stagger_step) {
        const unsigned long long t0 = wall_clock64(), d = (unsigned long long)(((obid() >> 3) & 7) * stagger_step);
        while (wall_clock64() - t0 < d) __builtin_amdgcn_s_sleep(16);
    }
    pg8::gemm_phase<Epi, pg8::StaticOrder, false>((PG8_LAS unsigned char*)lds, g, S, E, nullptr);
}

#define XB_TMO      128
#define XB_XCNT(j)  (256  + 64 * (j))
#define XB_XSUB(j)  (1280 + 64 * (j))
#define XB_XGEN(j)  (2304 + 64 * (j))
#define XB_TOP      3328
#define XB_TOPGEN   3392
#define XCD_BAR_WORDS 3456
#define XB_SPIN_CAP (1u << 18)

__device__ __forceinline__ unsigned xb_ld(unsigned* p)              { return __hip_atomic_load(p, __ATOMIC_RELAXED, __HIP_MEMORY_SCOPE_AGENT); }
__device__ __forceinline__ unsigned xb_add(unsigned* p, unsigned v) { return __hip_atomic_fetch_add(p, v, __ATOMIC_RELAXED, __HIP_MEMORY_SCOPE_AGENT); }
__device__ __forceinline__ unsigned xb_xcc_id() { return (unsigned)__builtin_amdgcn_s_getreg((3 << 11) | 20) & 0xFu; }
#define XB_SPIN(cond, bar) do { unsigned _sp = 0; while (cond) { __builtin_amdgcn_s_sleep(1); \
    if ((++_sp & 255u) == 0u) { if (xb_ld(&(bar)[XB_TMO])) break; if (_sp > XB_SPIN_CAP) { atomicAdd(&(bar)[XB_TMO], 1u); break; } } } } while (0)

struct XcdBarrier {
    unsigned* bar; unsigned x;
    volatile LAS unsigned* st;
};

__device__ __forceinline__ XcdBarrier xcd_barrier_post(unsigned* bar, volatile LAS unsigned* st) {
    XcdBarrier b; b.bar = bar; b.x = xb_xcc_id(); b.st = st;
    if (threadIdx.x == 0) (void)xb_add(&bar[XB_XCNT(b.x)], 1u);
    return b;
}
__device__ __forceinline__ void xcd_barrier_complete(unsigned* bar, unsigned x, unsigned& nloc, unsigned& nx) {
    const unsigned G = gridDim.x * gridDim.y * gridDim.z;
    unsigned sum, cnt, mine, sp = 0u;
    for (;;) {
        sum = 0u; cnt = 0u; mine = 0u;
#pragma unroll
        for (unsigned j = 0; j < 16; ++j) { const unsigned c = xb_ld(&bar[XB_XCNT(j)]); sum += c; cnt += (c > 0u) ? 1u : 0u; mine = (j == x) ? c : mine; }
        if (sum == G) break;
        __builtin_amdgcn_s_sleep(1);
        if ((++sp & 255u) == 0u) { if (xb_ld(&bar[XB_TMO])) break; if (sp > XB_SPIN_CAP) { atomicAdd(&bar[XB_TMO], 1u); break; } }
    }
    nloc = mine > 0u ? mine : 1u; nx = cnt > 0u ? cnt : 1u;
}

__device__ __forceinline__ void xcd_barrier(const XcdBarrier& b) {
    asm volatile("s_waitcnt vmcnt(0)" ::: "memory");
    __syncthreads();
    if (threadIdx.x == 0) {
        unsigned* bar = b.bar;
        __builtin_amdgcn_s_waitcnt(0);
        unsigned nloc = b.st[0], nx = b.st[1];
        if (nloc == 0u) { xcd_barrier_complete(bar, b.x, nloc, nx); b.st[0] = nloc; b.st[1] = nx; }
        const unsigned old = xb_add(&bar[XB_XSUB(b.x)], 1u);
        const unsigned gen = old / nloc;
        if (old + 1u == (gen + 1u) * nloc) {
            __builtin_amdgcn_fence(__ATOMIC_RELEASE, "agent");
            asm volatile("s_waitcnt vmcnt(0)" ::: "memory");
            const unsigned og = xb_add(&bar[XB_TOP], 1u);
            const unsigned tg = og / nx;
            if (og + 1u == (tg + 1u) * nx) xb_add(&bar[XB_TOPGEN], 1u);
            else XB_SPIN(xb_ld(&bar[XB_TOPGEN]) == tg, bar);
            __builtin_amdgcn_fence(__ATOMIC_ACQUIRE, "agent");
            xb_add(&bar[XB_XGEN(b.x)], 1u);
            asm volatile("s_waitcnt vmcnt(0)" ::: "memory");
        } else {
            XB_SPIN(xb_ld(&bar[XB_XGEN(b.x)]) == gen, bar);
            __builtin_amdgcn_fence(__ATOMIC_ACQUIRE, "agent");
            asm volatile("s_waitcnt vmcnt(0)" ::: "memory");
        }
    }
    __syncthreads();
}

typedef const Params __attribute__((address_space(4)))* ParamsK;
__device__ __forceinline__ Params fresh_params() {
    ParamsK q = (ParamsK)__builtin_amdgcn_kernarg_segment_ptr();
    asm volatile("" : "+s"(q));
    Params r;
#pragma unroll
    for (int i = 0; i < 19; ++i) r.in[i] = q->in[i];
    r.out = q->out; r.ws = q->ws;
    return r;
}
constexpr size_t WS_BAR = WS_END;
constexpr int LDS_TOTAL = pg8::STAGE_BYTES + 256;
__global__ void __launch_bounds__(512, 2) fwd_megakernel(Params p_unused) {
    extern __shared__ __attribute__((aligned(16))) unsigned char lds[];
    cg::grid_group grid = cg::this_grid();
    volatile LAS unsigned* st = (volatile LAS unsigned*)((LAS unsigned char*)lds + pg8::STAGE_BYTES);
    unsigned* bar;
    {
        const Params p = fresh_params(); bar = (unsigned*)(p.ws + WS_BAR);
        if (threadIdx.x < 4) st[threadIdx.x] = 0u;
        if (blockIdx.x == 0) for (int i = threadIdx.x; i < XCD_BAR_WORDS; i += 512) bar[i] = 0u;
        __syncthreads();
    }
#define WSP(off) ((bf16_t*)(p.ws + (off)))
#define GRID_BAR() do { XcdBarrier b_; b_.bar = (unsigned*)(fresh_params().ws + WS_BAR); b_.x = xb_xcc_id(); b_.st = (volatile LAS unsigned*)((LAS unsigned char*)lds + pg8::STAGE_BYTES); xcd_barrier(b_); } while (0)
    for (int l = 0; l < 2; ++l) {
        { const Params p = fresh_params(); prep_phase(p, l, (float*)lds); }
        if (l == 0) { grid.sync(); (void)xcd_barrier_post((unsigned*)(fresh_params().ws + WS_BAR), (volatile LAS unsigned*)((LAS unsigned char*)lds + pg8::STAGE_BYTES)); }
        else GRID_BAR();
        { const Params p = fresh_params(); EpiIn E{WSP(WS_B1), WSP(WS_B2), (const float*)(p.ws + WS_SSQ)}; run_gemm(lds, WSP(WS_XB), WSP(WS_WIN), MTOK, NIN, DM, E); }
        GRID_BAR();
        { const Params p = fresh_params(); mixer_phase(p, l, lds); }
        GRID_BAR();
        { const Params p = fresh_params(); EpiBr E{WSP(WS_B2), WSP(WS_B1)}; run_gemm(lds, (const bf16_t*)p.out  , WSP(WS_WBR), MTOK, DM, NBR, E); }
        GRID_BAR();
        { const Params p = fresh_params(); EpiRes E{WSP(WS_XB), (float*)(p.ws + WS_SSQ)}; run_gemm(lds, WSP(WS_B1), WSP(WS_WO), MTOK, DM, DM, E); }
        GRID_BAR();
        { const Params p = fresh_params(); EpiUp E{WSP(WS_B1), WSP(WS_B2), (const float*)(p.ws + WS_SSQ), p.in[15] + (size_t)l * 3 * NUP, p.in[16] + (size_t)l * NUP}; run_gemm(lds, WSP(WS_XB), WSP(WS_WUP), MTOK, NUP, DM, E); }
        GRID_BAR();
        { const Params p = fresh_params(); ffn_fixup_phase(p, l); }
        GRID_BAR();
        { const Params p = fresh_params(); EpiRes E{WSP(WS_XB), (float*)(p.ws + WS_SSQ)}; run_gemm(lds, WSP(WS_B1), WSP(WS_WDN), MTOK, DM, DFF, E); }
        GRID_BAR();
    }
    { const Params p = fresh_params(); final_norm_phase(p); }
#undef WSP
#undef GRID_BAR
}

extern "C" void kernel_launch(void* const* d_in, const int* in_sizes, int n_in, void* d_out, int out_size, void* d_ws, size_t ws_size, hipStream_t stream) {
    constexpr size_t kLds = LDS_TOTAL;
    static int grid_blocks = 0;
    if (!grid_blocks) {
        int dev = 0, cus = 0, per_cu = 0;
        (void)hipGetDevice(&dev);
        (void)hipDeviceGetAttribute(&cus, hipDeviceAttributeMultiprocessorCount, dev);
        (void)hipFuncSetAttribute((const void*)fwd_megakernel, hipFuncAttributeMaxDynamicSharedMemorySize, (int)kLds);
        (void)hipOccupancyMaxActiveBlocksPerMultiprocessor(&per_cu, (const void*)fwd_megakernel, 512, kLds);
        if (per_cu < 1) per_cu = 1;
        grid_blocks = cus;
        if (ws_size < WS_END + 16384 || n_in != 19 || out_size != MTOK * DM) { fprintf(stderr, "kernel_launch: unexpected sizes: ws %zu (need %zu), n_in %d, out %d\n", ws_size, (size_t)WS_END, n_in, out_size); }
    }
    Params p{};
    for (int i = 0; i < 19; ++i) p.in[i] = (const float*)d_in[i];
    p.out = (float*)d_out; p.ws = (unsigned char*)d_ws;
    void* args[] = {&p};
    hipError_t e = hipLaunchCooperativeKernel((void*)fwd_megakernel, dim3(grid_blocks), dim3(512), args, kLds, stream);
    if (e != hipSuccess) fprintf(stderr, "cooperative launch failed: %s (grid %d)\n", hipGetErrorString(e), grid_blocks);
}
```

```cpp
#include <hip/hip_runtime.h>
#include <hip/hip_cooperative_groups.h>
#include <cstdio>
namespace cg = cooperative_groups;
namespace pg8 {
#define PG8_LAS __attribute__((address_space(3)))
typedef unsigned short bf16_t;
typedef short bf16x8 __attribute__((ext_vector_type(8)));
typedef float f32x4 __attribute__((ext_vector_type(4)));
typedef unsigned u32x4 __attribute__((ext_vector_type(4)));
constexpr int BM = 256, BK = 64, HALF = 128, HTB = HALF * BK * 2  , STAGE_BYTES = 8 * HTB, NXCD = 8, WGM = 8;

__host__ __device__ __forceinline__ int lds_byte(int r, int c) { const int st = (r >> 4) * 2 + (c >> 5), rr = r & 15, cc = c & 31, ob = rr * 64 + cc * 2; return st * 1024 + (ob ^ (((ob >> 9) & 1) << 5)); }
__host__ __device__ __forceinline__ void stage_rc(int b, int& R, int& C) { const int st = b / 1024, sb = b % 1024, swz = sb ^ (((sb >> 9) & 1) << 5); R = (st >> 1) * 16 + swz / 64; C = (st & 1) * 32 + (swz % 64) / 2; }
__host__ __device__ __forceinline__ int perm32(int rho) { const int n = rho >> 4, i = rho & 15; return 8 * (i >> 2) + 4 * n + (i & 3); }

struct Unit { int pm, pn; };
struct Gemm { const bf16_t* A; const bf16_t* Bt; int M, N, K; };

struct StaticOrder {
    int nM, nN, nwg, G, c;
    __host__ __device__ void init(int M, int N, int G_, int c_) { nM = M / BM; nN = N / BM; nwg = nM * nN; G = G_; c = c_; }
    __host__ __device__ bool next(int i, Unit& u) const {
        const long L = (long)i * G + c; if (L >= nwg) return false;
        int wgid = (int)L; { const int q = nwg / NXCD, r = nwg % NXCD, xcd = wgid % NXCD, off = wgid / NXCD; wgid = (xcd < r ? xcd * (q + 1) : r * (q + 1) + (xcd - r) * q) + off; }
        const int nig = WGM * nN, gid = wgid / nig, fm = gid * WGM, gsz = (nM - fm) < WGM ? (nM - fm) : WGM;
        u.pm = fm + ((wgid % nig) % gsz); u.pn = (wgid % nig) / gsz; return true;
    }
    __device__ __forceinline__ void a_ready(const Unit&) const {}
    __device__ __forceinline__ void done(const Unit&) const {}
};
__device__ __forceinline__ unsigned cvt_pk_bf16(float lo, float hi) { unsigned r; asm volatile("v_cvt_pk_bf16_f32 %0, %1, %2" : "=v"(r) : "v"(lo), "v"(hi)); return r; }

template <class Epi, class Sched, bool STAMP = false>
__device__ __forceinline__ void gemm_phase(PG8_LAS unsigned char* lds, const Gemm g, const Sched& S, const Epi& E, unsigned long long* stamps) {
    int tid_ = threadIdx.x; asm volatile("" : "+v"(tid_));
    const int tid = tid_, wid = __builtin_amdgcn_readfirstlane(tid >> 6), lane = tid & 63, wr = wid >> 2, wc = wid & 3, fr = lane & 15, fq = lane >> 4;
    const int K = g.K, nt = K / BK;
    int ts_lo = 0, ts_hi = 0, nts = 0; const unsigned long long rt_entry = STAMP ? (unsigned long long)wall_clock64() : 0ull;
#define PG8_STAMP() do { if (STAMP && wid == 0 && nts < 64) { const unsigned long long _c = (unsigned long long)clock64(); \
        ts_lo = (lane == nts) ? (int)(unsigned)_c : ts_lo; ts_hi = (lane == nts) ? (int)(unsigned)(_c >> 32) : ts_hi; ++nts; } } while (0)
    PG8_STAMP();
    unsigned voffA[2], voffB[2];
#pragma unroll
    for (int i = 0; i < 2; ++i) { int R, C; stage_rc(tid * 16 + i * 8192, R, C); const int Rb = Epi::PERM ? ((R & ~31) + perm32(R & 31)) : R;
        voffA[i] = (unsigned)(R * K + C) * 2u; voffB[i] = (unsigned)(Rb * K + C) * 2u; }
    const size_t kstep = (size_t)(BK * 2);
    const size_t hstep = (size_t)HALF * K * 2;
    const size_t tstep = 2 * hstep;
    const unsigned ldsw = (unsigned)wid * 1024u;
    const int aoff = lds_byte(wr * 64 + fr, fq * 8), boff = lds_byte(wc * 32 + fr, fq * 8);
#define PG8_SA(b, h) (((b) * 2 + (h)) * HTB)
#define PG8_SB(b, h) ((4 + (b) * 2 + (h)) * HTB)
#define PG8_STAGE(bufoff, gbase, voff) do { _Pragma("unroll") for (int _i = 0; _i < 2; ++_i) \
        __builtin_amdgcn_global_load_lds((const unsigned*)((const char*)(gbase) + (voff)[_i]), (PG8_LAS unsigned*)(lds + (bufoff) + ldsw + _i * 8192), 16, 0, 0); } while (0)
#define PG8_LDA(dst, b, h) do { _Pragma("unroll") for (int m = 0; m < 4; ++m) _Pragma("unroll") for (int k = 0; k < 2; ++k) dst[m][k] = *(const PG8_LAS bf16x8*)(lds + PG8_SA(b, h) + aoff + m * 2048 + k * 1024); } while (0)
#define PG8_LDB(dst, b, h) do { _Pragma("unroll") for (int n = 0; n < 2; ++n) _Pragma("unroll") for (int k = 0; k < 2; ++k) dst[n][k] = *(const PG8_LAS bf16x8*)(lds + PG8_SB(b, h) + boff + n * 2048 + k * 1024); } while (0)
#define PG8_MMA(ai, bj, At, Bt) do { __builtin_amdgcn_s_setprio(1); _Pragma("unroll") for (int m = 0; m < 4; ++m) _Pragma("unroll") for (int n = 0; n < 2; ++n) _Pragma("unroll") for (int k = 0; k < 2; ++k) \
        acc[ai][bj][m][n] = __builtin_amdgcn_mfma_f32_16x16x32_bf16(Bt[n][k], At[m][k], acc[ai][bj][m][n], 0, 0, 0); __builtin_amdgcn_s_setprio(0); } while (0)
#define PG8_WAIT_V(n) asm volatile("s_waitcnt vmcnt(" #n ")" ::: "memory")
#define PG8_WAIT_L(n) asm volatile("s_waitcnt lgkmcnt(" #n ")" ::: "memory")
#define PG8_BAR __builtin_amdgcn_s_barrier()
#define PG8_SCHED __builtin_amdgcn_sched_barrier(0)
    Unit cur, nxt; int ui = 0;
    if (!S.next(0, cur)) return;
    f32x4 acc[2][2][4][2];
#pragma unroll
    for (int a = 0; a < 2; ++a)
#pragma unroll
        for (int b = 0; b < 2; ++b)
#pragma unroll
            for (int m = 0; m < 4; ++m)
#pragma unroll
                for (int n = 0; n < 2; ++n) acc[a][b][m][n] = (f32x4){0.f, 0.f, 0.f, 0.f};
    bf16x8 At[4][2], B0[2][2], B1[2][2];
    const char* cA = (const char*)g.A + (size_t)cur.pm * tstep; const char* cB = (const char*)g.Bt + (size_t)cur.pn * tstep;
    S.a_ready(cur);
    PG8_STAGE(PG8_SB(0, 0), cB, voffB); PG8_STAGE(PG8_SA(0, 0), cA, voffA); PG8_STAGE(PG8_SB(0, 1), cB + hstep, voffB); PG8_STAGE(PG8_SA(0, 1), cA + hstep, voffA);
    if (wr == 1) PG8_BAR;
    PG8_WAIT_V(4); PG8_BAR;
    PG8_STAGE(PG8_SB(1, 0), cB + kstep, voffB); PG8_STAGE(PG8_SA(1, 0), cA + kstep, voffA); PG8_STAGE(PG8_SB(1, 1), cB + hstep + kstep, voffB);
    PG8_WAIT_V(6); PG8_BAR;
    PG8_STAMP();
    for (;;) {
        const bool has_next = S.next(ui + 1, nxt);
        const char* nA = has_next ? (const char*)g.A + (size_t)nxt.pm * tstep : cA; const char* nB = has_next ? (const char*)g.Bt + (size_t)nxt.pn * tstep : cB;
        for (int t = 0; t < nt; t += 2) {
            if constexpr (Epi::MIDK) { if (t == 8 || t == 16) E.mid(acc, cur, t, wr, wc, fr, fq); }
            const bool last = (t == nt - 2);
            const char* a1 = cA + (size_t)(t + 1) * kstep;
            const char* a2 = last ? nA : cA + (size_t)(t + 2) * kstep; const char* b2 = last ? nB : cB + (size_t)(t + 2) * kstep;
            const char* a3 = a2 + kstep; const char* b3 = b2 + kstep;
            if (last && has_next) S.a_ready(nxt);
            PG8_LDB(B0, 0, 0); PG8_SCHED; PG8_LDA(At, 0, 0); PG8_STAGE(PG8_SA(1, 1), a1 + hstep, voffA);
            PG8_WAIT_L(8); PG8_BAR; PG8_WAIT_L(0); PG8_MMA(0, 0, At, B0); PG8_BAR; PG8_SCHED;
            PG8_LDB(B1, 0, 1); PG8_STAGE(PG8_SB(0, 0), b2, voffB);
            PG8_BAR; PG8_WAIT_L(0); PG8_MMA(0, 1, At, B1); PG8_BAR;
            PG8_LDA(At, 0, 1); PG8_STAGE(PG8_SA(0, 0), a2, voffA);
            PG8_BAR; PG8_WAIT_L(0); PG8_MMA(1, 0, At, B0); PG8_BAR; PG8_SCHED;
            PG8_STAGE(PG8_SB(0, 1), b2 + hstep, voffB);
            PG8_WAIT_V(6); PG8_BAR; PG8_MMA(1, 1, At, B1); PG8_BAR;
            PG8_LDB(B0, 1, 0); PG8_SCHED; PG8_LDA(At, 1, 0); PG8_STAGE(PG8_SA(0, 1), a2 + hstep, voffA);
            PG8_WAIT_L(8); PG8_BAR; PG8_WAIT_L(0); PG8_MMA(0, 0, At, B0); PG8_BAR; PG8_SCHED;
            PG8_LDB(B1, 1, 1); PG8_STAGE(PG8_SB(1, 0), b3, voffB);
            PG8_BAR; PG8_WAIT_L(0); PG8_MMA(0, 1, At, B1); PG8_BAR;
            PG8_LDA(At, 1, 1); PG8_STAGE(PG8_SA(1, 0), a3, voffA);
            PG8_BAR; PG8_WAIT_L(0); PG8_MMA(1, 0, At, B0); PG8_BAR; PG8_SCHED;
            PG8_STAGE(PG8_SB(1, 1), b3 + hstep, voffB);
            PG8_WAIT_V(6); PG8_BAR; PG8_MMA(1, 1, At, B1); PG8_BAR;
        }
        PG8_STAMP();
        if constexpr (!Epi::AFTER_DRAIN) { E(acc, cur, wr, wc, fr, fq); S.done(cur); }
        PG8_STAMP();
        if (!has_next) break;
#pragma unroll
        for (int a = 0; a < 2; ++a)
#pragma unroll
            for (int b = 0; b < 2; ++b)
#pragma unroll
                for (int m = 0; m < 4; ++m)
#pragma unroll
                    for (int n = 0; n < 2; ++n) acc[a][b][m][n] = (f32x4){0.f, 0.f, 0.f, 0.f};
        cur = nxt; cA = nA; cB = nB; ++ui;
    }
    PG8_WAIT_V(0);
    if (wr == 0) PG8_BAR;
    PG8_BAR;
    if constexpr (Epi::AFTER_DRAIN) { E.fused(acc, cur, wr, wc, fr, fq, lds, wid, lane); S.done(cur); }
    PG8_STAMP();
    if (STAMP && wid == 0) { stamps[lane] = lane < nts ? (((unsigned long long)(unsigned)ts_hi << 32) | (unsigned)ts_lo) : 0ull;
        if (lane == 62) stamps[62] = rt_entry; if (lane == 63) stamps[63] = (unsigned long long)wall_clock64(); }
#undef PG8_STAMP
#undef PG8_SA
#undef PG8_SB
#undef PG8_STAGE
#undef PG8_LDA
#undef PG8_LDB
#undef PG8_MMA
#undef PG8_WAIT_V
#undef PG8_WAIT_L
#undef PG8_BAR
#undef PG8_SCHED
}
}
typedef pg8::bf16_t bf16_t;
typedef pg8::f32x4 f32x4;
typedef pg8::u32x4 u32x4;
typedef pg8::bf16x8 bf16x8;
typedef unsigned u32x2 __attribute__((ext_vector_type(2)));
#define LAS __attribute__((address_space(3)))
constexpr int MTOK = 65536, DM = 1024, NIN = 6144, DFF = 2816, NUP = 5632, SEQ = 8192, NBR = 1536, NPA = 3072;
constexpr int MH = MTOK / 2;
constexpr float EPS = 1e-6f;
constexpr size_t WS_WIN = 0;
constexpr size_t WS_WBR = WS_WIN + (size_t)NIN * DM * 2;
constexpr size_t WS_WO = WS_WBR + (size_t)DM * NBR * 2;
constexpr size_t WS_WUP = WS_WO + (size_t)DM * DM * 2;
constexpr size_t WS_WDN = WS_WUP + (size_t)NUP * DM * 2;
constexpr size_t WS_SSQ = WS_WDN + (size_t)DM * DFF * 2;
constexpr size_t WS_XB = WS_SSQ + (size_t)MTOK * 16 * 4;
constexpr size_t WS_B1 = WS_XB + (size_t)MTOK * NBR * 2;
constexpr size_t WS_B2 = WS_B1 + (size_t)MTOK * NPA * 2;
constexpr size_t WS_END = WS_B2 + (size_t)MTOK * NPA * 2;

__device__ __forceinline__ int otid() { int t = threadIdx.x; asm volatile("" : "+v"(t)); return t; }
__device__ __forceinline__ int obid() { int b = blockIdx.x; asm volatile("" : "+s"(b)); return b; }
struct Params {
    const float* in[19];
    float* out; unsigned char* ws;
};

__device__ __forceinline__ void st_nt16(void* p, u32x4 w) { __builtin_nontemporal_store(w, (u32x4*)p); }
__device__ __forceinline__ float bflo(unsigned w) { return __uint_as_float(w << 16); }
__device__ __forceinline__ float bfhi(unsigned w) { return __uint_as_float(w & 0xffff0000u); }
__device__ __forceinline__ unsigned pk(float a, float b) { return pg8::cvt_pk_bf16(a, b); }
__device__ __forceinline__ float fast_rcp(float x) { return __builtin_amdgcn_rcpf(x); }
__device__ __forceinline__ float gate_t2(float y) { return 1.0f + __builtin_amdgcn_exp2f(fminf(y, 43.28f)); }
__device__ __forceinline__ float gelu_tanh_f(float x) {
    const float z2 = 1.5957691216f * (x + 0.044715f * x * x * x);
    return x * fast_rcp(1.0f + __expf(-z2));
}
__device__ __forceinline__ float silu_f(float x) { return x * fast_rcp(1.0f + __expf(-x)); }
__device__ __forceinline__ float row_rstd(const float* ssq, int r) {
    const f32x4* p = (const f32x4*)(ssq + (size_t)r * 16);
    const f32x4 a = p[0], b = p[1], c = p[2], d = p[3];
    const float s = ((a[0] + a[1]) + (a[2] + a[3])) + ((b[0] + b[1]) + (b[2] + b[3])) + ((c[0] + c[1]) + (c[2] + c[3])) + ((d[0] + d[1]) + (d[2] + d[3]));
    return rsqrtf(s * (1.0f / 1024.0f) + EPS);
}

__device__ __forceinline__ void rows_rstd8(const float* ssq, int row0, int fq, float (&rs)[8]) {
    f32x4 v[8];
#pragma unroll
    for (int i = 0; i < 8; ++i) v[i] = *(const f32x4*)(ssq + (size_t)(row0 + (i >> 2) * 128 + (i & 3) * 16) * 16 + fq * 4);
#pragma unroll
    for (int i = 0; i < 8; ++i) {
        float s = (v[i][0] + v[i][1]) + (v[i][2] + v[i][3]);
        s += __shfl_xor(s, 16); s += __shfl_xor(s, 32);
        rs[i] = rsqrtf(s * (1.0f / 1024.0f) + EPS);
    }
}
struct EpiIn {
    static constexpr bool PERM = true, AFTER_DRAIN = false, MIDK = false;
    bf16_t* PA; bf16_t* G; const float* ssq;
    __device__ __forceinline__ void operator()(const f32x4 (&acc)[2][2][4][2], const pg8::Unit& u, int wr, int wc, int fr, int fq) const {
        const int colt = u.pn * 256;
        const int act = (colt >= NPA) ? 2 : ((colt >= 512 && colt < 1536) ? 1 : 0);
        bf16_t* base = (colt >= NPA) ? G : PA;
        const int col0 = (colt >= NPA ? colt - NPA : colt) + wc * 32 + 8 * fq;
        const int row0 = u.pm * 256 + wr * 64 + fr;
        float rs8[8]; rows_rstd8(ssq, row0, fq, rs8);
#pragma unroll
        for (int ai = 0; ai < 2; ++ai)
#pragma unroll
            for (int m = 0; m < 4; ++m) {
                const int r = row0 + ai * 128 + m * 16;
                const float rs = (act == 2) ? rs8[ai * 4 + m] * -1.44269504f : rs8[ai * 4 + m];
                bf16_t* rowp = base + (size_t)r * NPA + col0;
#pragma unroll
                for (int bj = 0; bj < 2; ++bj) {
                    float v[8];
#pragma unroll
                    for (int j = 0; j < 4; ++j) { v[j] = acc[ai][bj][m][0][j] * rs; v[4 + j] = acc[ai][bj][m][1][j] * rs; }
                    if (act == 1) {
#pragma unroll
                        for (int j = 0; j < 8; ++j) v[j] = gelu_tanh_f(v[j]);
                    } else if (act == 2) {
#pragma unroll
                        for (int j = 0; j < 8; ++j) v[j] = gate_t2(v[j]);
                    }
                    u32x4 w; w.x = pk(v[0], v[1]); w.y = pk(v[2], v[3]); w.z = pk(v[4], v[5]); w.w = pk(v[6], v[7]);
                    st_nt16(rowp + bj * 128, w);
                }
            }
    }
};
struct EpiBr {
    static constexpr bool PERM = true, AFTER_DRAIN = false, MIDK = true;
    const bf16_t* G; bf16_t* out;
    __device__ __forceinline__ void mid(f32x4 (&acc)[2][2][4][2], const pg8::Unit& u, int t, int wr, int wc, int fr, int fq) const {
        const int seg = (t == 8) ? 0 : 1024;
        int col0 = u.pn * 256 + wc * 32 + 8 * fq + seg;
        int row0 = u.pm * 256 + wr * 64 + fr;
        asm volatile("" : "+v"(col0), "+v"(row0));
#pragma unroll
        for (int ai = 0; ai < 2; ++ai) {
            u32x4 nu[4][2], de[4][2];
#pragma unroll
            for (int m = 0; m < 4; ++m)
#pragma unroll
                for (int bj = 0; bj < 2; ++bj) {
                    const bf16_t* gp = G + (size_t)(row0 + ai * 128 + m * 16) * NPA + col0 + bj * 128;
                    nu[m][bj] = *(const u32x4*)gp; de[m][bj] = *(const u32x4*)(gp + 1024);
                }
            asm volatile("" ::: "memory");
#pragma unroll
            for (int m = 0; m < 4; ++m)
#pragma unroll
                for (int bj = 0; bj < 2; ++bj) {
                    const unsigned nw[4] = {nu[m][bj].x, nu[m][bj].y, nu[m][bj].z, nu[m][bj].w}, dw[4] = {de[m][bj].x, de[m][bj].y, de[m][bj].z, de[m][bj].w};
#pragma unroll
                    for (int q = 0; q < 4; ++q) {
                        const float r0 = bflo(dw[q]) * fast_rcp(bflo(nw[q])), r1 = bfhi(dw[q]) * fast_rcp(bfhi(nw[q]));
                        acc[ai][bj][m][q >> 1][(q & 1) * 2] *= r0; acc[ai][bj][m][q >> 1][(q & 1) * 2 + 1] *= r1;
                    }
                }
            asm volatile("" ::: "memory");
        }
    }
    __device__ __forceinline__ void operator()(const f32x4 (&acc)[2][2][4][2], const pg8::Unit& u, int wr, int wc, int fr, int fq) const {
        const int col0 = u.pn * 256 + wc * 32 + 8 * fq;
        const int row0 = u.pm * 256 + wr * 64 + fr;
        u32x4 sg[2][4][2];
#pragma unroll
        for (int ai = 0; ai < 2; ++ai)
#pragma unroll
            for (int m = 0; m < 4; ++m)
#pragma unroll
                for (int bj = 0; bj < 2; ++bj) sg[ai][m][bj] = *(const u32x4*)(G + (size_t)(row0 + ai * 128 + m * 16) * NPA + 2048 + col0 + bj * 128);
#pragma unroll
        for (int ai = 0; ai < 2; ++ai)
#pragma unroll
            for (int m = 0; m < 4; ++m) {
                const int r = row0 + ai * 128 + m * 16;
                bf16_t* op = out + (size_t)r * DM + col0;
#pragma unroll
                for (int bj = 0; bj < 2; ++bj) {
                    const u32x4 s = sg[ai][m][bj];
                    const f32x4 a0 = acc[ai][bj][m][0], a1 = acc[ai][bj][m][1];
                    u32x4 w;
                    w.x = pk(a0[0] * fast_rcp(bflo(s.x)), a0[1] * fast_rcp(bfhi(s.x))); w.y = pk(a0[2] * fast_rcp(bflo(s.y)), a0[3] * fast_rcp(bfhi(s.y)));
                    w.z = pk(a1[0] * fast_rcp(bflo(s.z)), a1[1] * fast_rcp(bfhi(s.z))); w.w = pk(a1[2] * fast_rcp(bflo(s.w)), a1[3] * fast_rcp(bfhi(s.w)));
                    *(u32x4*)(op + bj * 128) = w;
                }
            }
    }
};
struct EpiRes {
    static constexpr bool PERM = true, AFTER_DRAIN = false, MIDK = false;
    bf16_t* xb; float* ssq;
    __device__ __forceinline__ void operator()(const f32x4 (&acc)[2][2][4][2], const pg8::Unit& u, int wr, int wc, int fr, int fq) const {
        const int col0 = u.pn * 256 + wc * 32 + 8 * fq;
        const int row0 = u.pm * 256 + wr * 64 + fr;
        u32x4 bb[2][4][2];
#pragma unroll
        for (int ai = 0; ai < 2; ++ai)
#pragma unroll
            for (int m = 0; m < 4; ++m)
#pragma unroll
                for (int bj = 0; bj < 2; ++bj) bb[ai][m][bj] = *(const u32x4*)(xb + (size_t)(row0 + ai * 128 + m * 16) * DM + col0 + bj * 128);
        asm volatile("" ::: "memory");
#pragma unroll
        for (int ai = 0; ai < 2; ++ai) {
#pragma unroll
            for (int m = 0; m < 4; ++m) {
                const int r = row0 + ai * 128 + m * 16;
                float sq = 0.f;
#pragma unroll
                for (int bj = 0; bj < 2; ++bj) {
                    const u32x4 s = bb[ai][m][bj];
                    const f32x4 a0 = acc[ai][bj][m][0], a1 = acc[ai][bj][m][1];
                    const float o0 = bflo(s.x) + a0[0], o1 = bfhi(s.x) + a0[1], o2 = bflo(s.y) + a0[2], o3 = bfhi(s.y) + a0[3];
                    const float o4 = bflo(s.z) + a1[0], o5 = bfhi(s.z) + a1[1], o6 = bflo(s.w) + a1[2], o7 = bfhi(s.w) + a1[3];
                    u32x4 w; w.x = pk(o0, o1); w.y = pk(o2, o3); w.z = pk(o4, o5); w.w = pk(o6, o7);
                    *(u32x4*)(xb + (size_t)r * DM + col0 + bj * 128) = w;
                    sq += (o0 * o0 + o1 * o1) + (o2 * o2 + o3 * o3) + (o4 * o4 + o5 * o5) + (o6 * o6 + o7 * o7);
                }
                sq += __shfl_xor(sq, 16); sq += __shfl_xor(sq, 32);
                if (fq == 0) ssq[(size_t)r * 16 + u.pn * 4 + wc] = sq;
            }
            asm volatile("" ::: "memory");
        }
    }
};
__device__ __forceinline__ float dpp_ror1(float x) { return __int_as_float(__builtin_amdgcn_mov_dpp(__float_as_int(x), 0x121, 0xf, 0xf, true)); }
__device__ __forceinline__ float dpp_ror2(float x) { return __int_as_float(__builtin_amdgcn_mov_dpp(__float_as_int(x), 0x122, 0xf, 0xf, true)); }
__device__ __forceinline__ float dpp_shr1(float old, float x) { return __int_as_float(__builtin_amdgcn_update_dpp(__float_as_int(old), __float_as_int(x), 0x111, 0xf, 0xf, false)); }
__device__ __forceinline__ float dpp_shr2(float old, float x) { return __int_as_float(__builtin_amdgcn_update_dpp(__float_as_int(old), __float_as_int(x), 0x112, 0xf, 0xf, false)); }
struct EpiUp {
    static constexpr bool PERM = true, AFTER_DRAIN = false, MIDK = false;
    bf16_t* act; bf16_t* zs; const float* ssq; const float* cw; const float* cb;
    __device__ __forceinline__ void operator()(const f32x4 (&acc)[2][2][4][2], const pg8::Unit& u, int wr, int wc, int fr, int fq) const {
        const int c0 = u.pn * 128 + wc * 32 + 8 * fq;
        const int row0 = u.pm * 256 + wr * 64 + fr;
        float rs8[8]; rows_rstd8(ssq, row0, fq, rs8);
        u32x2 keep[2][4];
#pragma unroll
        for (int n = 0; n < 2; ++n) {
            const int c = c0 + 4 * n;
            const f32x4 gw0 = *(const f32x4*)(cw + c), gw1 = *(const f32x4*)(cw + NUP + c), gw2 = *(const f32x4*)(cw + 2 * NUP + c), gb = *(const f32x4*)(cb + c);
            const f32x4 vw0 = *(const f32x4*)(cw + DFF + c), vw1 = *(const f32x4*)(cw + NUP + DFF + c), vw2 = *(const f32x4*)(cw + 2 * NUP + DFF + c), vb = *(const f32x4*)(cb + DFF + c);
#pragma unroll
            for (int ai = 0; ai < 2; ++ai) {
                f32x4 pg = {0.f, 0.f, 0.f, 0.f}, pv = {0.f, 0.f, 0.f, 0.f};
                const int blk = u.pm * 4 + ai * 2 + wr;
#pragma unroll
                for (int m = 0; m < 4; ++m) {
                    const float rs = rs8[ai * 4 + m];
                    const f32x4 zg = acc[ai][0][m][n] * rs, zv = acc[ai][1][m][n] * rs;
                    float o[4];
#pragma unroll
                    for (int j = 0; j < 4; ++j) {
                        const float g1 = dpp_shr1(dpp_ror1(pg[j]), zg[j]), g2 = dpp_shr2(dpp_ror2(pg[j]), zg[j]);
                        const float v1 = dpp_shr1(dpp_ror1(pv[j]), zv[j]), v2 = dpp_shr2(dpp_ror2(pv[j]), zv[j]);
                        const float gg = gw2[j] * zg[j] + gw1[j] * g1 + gw0[j] * g2 + gb[j];
                        const float vv = vw2[j] * zv[j] + vw1[j] * v1 + vw0[j] * v2 + vb[j];
                        o[j] = silu_f(gg) * vv;
                    }
                    u32x2 w; w.x = pk(o[0], o[1]); w.y = pk(o[2], o[3]);
                    const int r = row0 + ai * 128 + m * 16;
                    if (n == 0) keep[ai][m] = w;
                    else if (!(m == 0 && fr < 2)) { u32x4 ww; ww.x = keep[ai][m].x; ww.y = keep[ai][m].y; ww.z = w.x; ww.w = w.y; st_nt16(act + (size_t)r * DFF + c0, ww); }
                    if (m == 0 && fr < 2) {
                        bf16_t* zp = zs + ((size_t)blk * 4 + 2 + fr) * NUP + c;
                        u32x2 a; a.x = pk(zg[0], zg[1]); a.y = pk(zg[2], zg[3]); *(u32x2*)zp = a;
                        u32x2 d; d.x = pk(zv[0], zv[1]); d.y = pk(zv[2], zv[3]); *(u32x2*)(zp + DFF) = d;
                    }
                    if (m == 3 && fr >= 14) {
                        bf16_t* zp = zs + ((size_t)blk * 4 + (fr - 14)) * NUP + c;
                        u32x2 a; a.x = pk(zg[0], zg[1]); a.y = pk(zg[2], zg[3]); *(u32x2*)zp = a;
                        u32x2 d; d.x = pk(zv[0], zv[1]); d.y = pk(zv[2], zv[3]); *(u32x2*)(zp + DFF) = d;
                    }
                    pg = zg; pv = zv;
                }
            }
        }
    }
};

__device__ __forceinline__ void transpose_tile(const float* __restrict__ W, int N, const float* __restrict__ g, bf16_t* __restrict__ Wt, int ldt, int koff, int k0, int n0, int nd0, float* tile, int tid) {
    {
        const int kk = tid >> 4, nn = (tid & 15) * 4;
#pragma unroll
        for (int h = 0; h < 2; ++h) {
            const int k = kk + h * 32;
            f32x4 v = *(const f32x4*)(W + (size_t)(k0 + k) * N + n0 + nn);
            const float s = g ? g[k0 + k] : 1.0f;
            tile[k * 65 + nn + 0] = v[0] * s; tile[k * 65 + nn + 1] = v[1] * s; tile[k * 65 + nn + 2] = v[2] * s; tile[k * 65 + nn + 3] = v[3] * s;
        }
    }
    __syncthreads();
    {
        const int n = tid >> 3, kq = (tid & 7) * 8;
        float v[8];
#pragma unroll
        for (int j = 0; j < 8; ++j) v[j] = tile[(kq + j) * 65 + n];
        u32x4 w; w.x = pk(v[0], v[1]); w.y = pk(v[2], v[3]); w.z = pk(v[4], v[5]); w.w = pk(v[6], v[7]);
        *(u32x4*)(Wt + (size_t)(nd0 + n) * ldt + koff + k0 + kq) = w;
    }
    __syncthreads();
}

__device__ __forceinline__ void prep_phase(const Params& p, int l, float* ldsf) {
    unsigned char* ws = p.ws;
    bf16_t* wt_in = (bf16_t*)(ws + WS_WIN); bf16_t* wt_br = (bf16_t*)(ws + WS_WBR); bf16_t* wt_o = (bf16_t*)(ws + WS_WO);
    bf16_t* wt_up = (bf16_t*)(ws + WS_WUP); bf16_t* wt_dn = (bf16_t*)(ws + WS_WDN);
    const float* g_mix = p.in[1] + (size_t)l * DM; const float* w_in = p.in[2] + (size_t)l * DM * NIN;
    const float* w_pool = p.in[3] + (size_t)l * 4 * 128 * 128; const float* pscale = p.in[4] + (size_t)l * 512;
    const float* w_ba = p.in[9] + (size_t)l * 512 * DM; const float* w_bb = p.in[10] + (size_t)l * 512 * DM; const float* w_bc = p.in[11] + (size_t)l * 512 * DM;
    const float* w_o = p.in[12] + (size_t)l * DM * DM; const float* g_ffn = p.in[13] + (size_t)l * DM;
    const float* w_up = p.in[14] + (size_t)l * DM * NUP; const float* w_dn = p.in[17] + (size_t)l * DFF * DM;
    const int tid = otid(), bid = obid();
    constexpr int T0 = 16 * 96, T1 = T0 + 128, T2 = T1 + 128, T3 = T2 + 256, T4 = T3 + 16 * 88, T5 = T4 + 44 * 16;
    for (int i = bid; i < T5; i += gridDim.x) {
        if (i < T0) { const int kt = i & 15, nt = i >> 4; transpose_tile(w_in, NIN, g_mix, wt_in, DM, 0, kt * 64, nt * 64, nt * 64, ldsf, tid); }
        else if (i < T1) { const int j = i - T0, kt = j & 7, nt = j >> 3; transpose_tile(w_bb, DM, nullptr, wt_br, NBR, 512, kt * 64, nt * 64, nt * 64, ldsf, tid); }
        else if (i < T2) { const int j = i - T1, kt = j & 7, nt = j >> 3; transpose_tile(w_bc, DM, nullptr, wt_br, NBR, 1024, kt * 64, nt * 64, nt * 64, ldsf, tid); }
        else if (i < T3) { const int j = i - T2, kt = j & 15, nt = j >> 4; transpose_tile(w_o, DM, nullptr, wt_o, DM, 0, kt * 64, nt * 64, nt * 64, ldsf, tid); }
        else if (i < T4) { const int j = i - T3, kt = j & 15, nt = j >> 4; const int n0 = nt * 64, bj = n0 / DFF, q0 = n0 - bj * DFF; transpose_tile(w_up, NUP, g_ffn, wt_up, DM, 0, kt * 64, n0, (q0 >> 7) * 256 + bj * 128 + (q0 & 127), ldsf, tid);   }
        else { const int j = i - T4, kt = j % 44, nt = j / 44; transpose_tile(w_dn, DM, nullptr, wt_dn, DFF, 0, kt * 64, nt * 64, nt * 64, ldsf, tid); }
    }
    {
        float* wpT = ldsf;
        float* wa = ldsf + 128 * 128;
        for (int it = (int)gridDim.x - 1 - bid; it < 64; it += gridDim.x) {
            const int g = it >> 4, n0 = (it & 15) * 64;
            for (int q = tid; q < 128 * 32; q += 512) {
                const int d = q >> 5, e4 = (q & 31) * 4;
                const f32x4 v = *(const f32x4*)(w_pool + ((size_t)g * 128 + d) * 128 + e4);
                const f32x4 s = *(const f32x4*)(pscale + g * 128 + e4);
                wpT[(e4 + 0) * 128 + d] = v[0] * s[0]; wpT[(e4 + 1) * 128 + d] = v[1] * s[1]; wpT[(e4 + 2) * 128 + d] = v[2] * s[2]; wpT[(e4 + 3) * 128 + d] = v[3] * s[3];
            }
            for (int q = tid; q < 128 * 16; q += 512) {
                const int e = q >> 4, c4 = (q & 15) * 4;
                *(f32x4*)(wa + e * 64 + c4) = *(const f32x4*)(w_ba + (size_t)(g * 128 + e) * DM + n0 + c4);
            }
            __syncthreads();
            const int d = tid & 127, ns = tid >> 7;
            float acc[16];
#pragma unroll
            for (int i = 0; i < 16; ++i) acc[i] = 0.f;
            for (int e = 0; e < 128; ++e) {
                const float w = wpT[e * 128 + d];
                const f32x4* wr4 = (const f32x4*)(wa + e * 64 + ns * 16);
#pragma unroll
                for (int c = 0; c < 4; ++c) { const f32x4 b = wr4[c]; acc[c * 4 + 0] += w * b[0]; acc[c * 4 + 1] += w * b[1]; acc[c * 4 + 2] += w * b[2]; acc[c * 4 + 3] += w * b[3]; }
            }
#pragma unroll
            for (int i = 0; i < 16; ++i) wt_br[(size_t)(n0 + ns * 16 + i) * NBR + g * 128 + d] = (bf16_t)(pk(acc[i], 0.f) & 0xffffu);
            __syncthreads();
        }
    }
    if (l == 0) {
        const float* x = p.in[0]; bf16_t* xb = (bf16_t*)(ws + WS_XB); float* ssq = (float*)(ws + WS_SSQ);
        const int lane = tid & 63, wave = tid >> 6;
        for (int r = bid * 8 + wave; r < MTOK; r += gridDim.x * 8) {
            float sq = 0.f;
#pragma unroll
            for (int i = 0; i < 4; ++i) {
                const f32x4 v = *(const f32x4*)(x + (size_t)r * DM + i * 256 + lane * 4);
                sq += (v[0] * v[0] + v[1] * v[1]) + (v[2] * v[2] + v[3] * v[3]);
                u32x2 w; w.x = pk(v[0], v[1]); w.y = pk(v[2], v[3]);
                *(u32x2*)(xb + (size_t)r * DM + i * 256 + lane * 4) = w;
            }
#pragma unroll
            for (int o = 32; o >= 1; o >>= 1) sq += __shfl_xor(sq, o);
            if (lane < 16) ssq[(size_t)r * 16 + lane] = (lane == 0) ? sq : 0.f;
        }
    }
}
__device__ __forceinline__ void ld8(const bf16_t* p, float (&v)[8]) {
    const u32x4 w = *(const u32x4*)p;
    v[0] = bflo(w.x); v[1] = bfhi(w.x); v[2] = bflo(w.y); v[3] = bfhi(w.y); v[4] = bflo(w.z); v[5] = bfhi(w.z); v[6] = bflo(w.w); v[7] = bfhi(w.w);
}
__device__ __forceinline__ void st8(bf16_t* p, const float (&v)[8]) {
    u32x4 w; w.x = pk(v[0], v[1]); w.y = pk(v[2], v[3]); w.z = pk(v[4], v[5]); w.w = pk(v[6], v[7]);
    *(u32x4*)p = w;
}
template <int W> __device__ __forceinline__ void pool_rows(const bf16_t* __restrict__ ap, bf16_t* __restrict__ yp, int r0, int pos0) {
#pragma unroll
    for (int b = 0; b < 4; ++b) {
        const int base = r0 + 4 * b;
        u32x4 h[W + 3];
#pragma unroll
        for (int i = 0; i < W + 3; ++i) { const int rr = base - (W - 1) + i; h[i] = (pos0 + rr >= 0) ? *(const u32x4*)(ap + (ptrdiff_t)rr * NPA) : (u32x4){0u, 0u, 0u, 0u}; }
        float s[8];
#pragma unroll
        for (int j = 0; j < 8; ++j) s[j] = 0.f;
#pragma unroll
        for (int i = 0; i < W - 1; ++i) { const u32x4 q = h[i];
            s[0] += bflo(q.x); s[1] += bfhi(q.x); s[2] += bflo(q.y); s[3] += bfhi(q.y); s[4] += bflo(q.z); s[5] += bfhi(q.z); s[6] += bflo(q.w); s[7] += bfhi(q.w); }
#pragma unroll
        for (int i = 0; i < 4; ++i) {
            const int rr = base + i, pos = pos0 + rr; const float inv = 1.0f / (float)(pos + 1 < W ? pos + 1 : W);
            const u32x4 q = h[W - 1 + i], od = h[i];
            const float v[8] = {bflo(q.x), bfhi(q.x), bflo(q.y), bfhi(q.y), bflo(q.z), bfhi(q.z), bflo(q.w), bfhi(q.w)};
            float o[8];
#pragma unroll
            for (int j = 0; j < 8; ++j) { s[j] += v[j]; o[j] = s[j] * inv - v[j]; }
            st8(yp + (size_t)rr * NBR, o);
            s[0] -= bflo(od.x); s[1] -= bfhi(od.x); s[2] -= bflo(od.y); s[3] -= bfhi(od.y); s[4] -= bflo(od.z); s[5] -= bfhi(od.z); s[6] -= bflo(od.w); s[7] -= bfhi(od.w);
        }
        asm volatile("" ::: "memory");
    }
}
constexpr int VT_PITCH = 136;
__device__ __forceinline__ void mixer_phase(const Params& p, int l, unsigned char* lds) {
    const bf16_t* PA = (const bf16_t*)(p.ws + WS_B1);
    bf16_t* Y = (bf16_t*)p.out;
    const float* g_sgu = p.in[5] + (size_t)l * 512;
    const float* w_sp = p.in[6] + (size_t)l * 4 * 128 * 128;
    const float* b_sp = p.in[7] + (size_t)l * 4 * 128;
    const float* conv_c = p.in[8] + (size_t)l * 3 * 512;
    float* rs = (float*)lds;
    bf16_t* vT = (bf16_t*)(lds + 1024);
    const int tid = otid(), lane = tid & 63, wave = __builtin_amdgcn_readfirstlane(tid >> 6), fr = lane & 15, fq = lane >> 4;
    for (int item = obid(); item < MTOK / 128; item += gridDim.x) {
        const int t0 = item * 128, pos0 = t0 & (SEQ - 1);
        {
            const int row = tid >> 2, q = tid & 3;
            const bf16_t* vp = PA + (size_t)(t0 + row) * NPA + 1024 + q * 128;
            float sq = 0.f;
#pragma unroll
            for (int i = 0; i < 16; ++i) { float v[8]; ld8(vp + i * 8, v);
#pragma unroll
                for (int j = 0; j < 8; ++j) sq += v[j] * v[j]; }
            sq += __shfl_xor(sq, 1); sq += __shfl_xor(sq, 2);
            if (q == 0) rs[row] = rsqrtf(sq * (1.0f / 512.0f) + EPS);
        }
        {
            const int grp = wave & 3;
            const int c8 = (grp * 16 + (lane & 15)) * 8; int r0 = ((wave >> 2) * 4 + (lane >> 4)) * 16;
            asm volatile("" : "+v"(r0));
            {
                const bf16_t* ap = PA + (size_t)t0 * NPA + c8;
                bf16_t* yp = Y + (size_t)t0 * NBR + c8;
                if (grp == 0) pool_rows<2>(ap, yp, r0, pos0); else if (grp == 1) pool_rows<4>(ap, yp, r0, pos0); else if (grp == 2) pool_rows<8>(ap, yp, r0, pos0); else pool_rows<16>(ap, yp, r0, pos0);
            }
            {
                const bf16_t* bp = PA + (size_t)t0 * NPA + 1536 + c8;
                bf16_t* yp = Y + (size_t)t0 * NBR + 1024 + c8;
                float w0[8], w1[8], w2[8], z1[8], z2[8];
#pragma unroll
                for (int j = 0; j < 8; ++j) { w0[j] = conv_c[c8 + j]; w1[j] = conv_c[512 + c8 + j]; w2[j] = conv_c[1024 + c8 + j]; z1[j] = 0.f; z2[j] = 0.f; }
                {
                    const bool h2 = pos0 + r0 - 2 >= 0, h1 = pos0 + r0 - 1 >= 0;
                    const u32x4 zz = {0u, 0u, 0u, 0u};
                    const u32x4 a2 = h2 ? *(const u32x4*)(bp + (ptrdiff_t)(r0 - 2) * NPA + 512) : zz, b2 = h2 ? *(const u32x4*)(bp + (ptrdiff_t)(r0 - 2) * NPA + 1024) : zz;
                    const u32x4 a1 = h1 ? *(const u32x4*)(bp + (ptrdiff_t)(r0 - 1) * NPA + 512) : zz, b1 = h1 ? *(const u32x4*)(bp + (ptrdiff_t)(r0 - 1) * NPA + 1024) : zz;
                    z2[0] = bflo(a2.x) * bflo(b2.x); z2[1] = bfhi(a2.x) * bfhi(b2.x); z2[2] = bflo(a2.y) * bflo(b2.y); z2[3] = bfhi(a2.y) * bfhi(b2.y);
                    z2[4] = bflo(a2.z) * bflo(b2.z); z2[5] = bfhi(a2.z) * bfhi(b2.z); z2[6] = bflo(a2.w) * bflo(b2.w); z2[7] = bfhi(a2.w) * bfhi(b2.w);
                    z1[0] = bflo(a1.x) * bflo(b1.x); z1[1] = bfhi(a1.x) * bfhi(b1.x); z1[2] = bflo(a1.y) * bflo(b1.y); z1[3] = bfhi(a1.y) * bfhi(b1.y);
                    z1[4] = bflo(a1.z) * bflo(b1.z); z1[5] = bfhi(a1.z) * bfhi(b1.z); z1[6] = bflo(a1.w) * bflo(b1.w); z1[7] = bfhi(a1.w) * bfhi(b1.w);
                }
#pragma unroll
                for (int hb = 0; hb < 4; ++hb) {
                    u32x4 qb[4], qc[4], qx[4];
#pragma unroll
                    for (int i = 0; i < 4; ++i) { const bf16_t* rp = bp + (size_t)(r0 + hb * 4 + i) * NPA; qb[i] = *(const u32x4*)rp; qc[i] = *(const u32x4*)(rp + 512); qx[i] = *(const u32x4*)(rp + 1024); }
#pragma unroll
                    for (int i = 0; i < 4; ++i) {
                        const float cb[8] = {bflo(qb[i].x), bfhi(qb[i].x), bflo(qb[i].y), bfhi(qb[i].y), bflo(qb[i].z), bfhi(qb[i].z), bflo(qb[i].w), bfhi(qb[i].w)};
                        const float a[8] = {bflo(qc[i].x), bfhi(qc[i].x), bflo(qc[i].y), bfhi(qc[i].y), bflo(qc[i].z), bfhi(qc[i].z), bflo(qc[i].w), bfhi(qc[i].w)};
                        const float b[8] = {bflo(qx[i].x), bfhi(qx[i].x), bflo(qx[i].y), bfhi(qx[i].y), bflo(qx[i].z), bfhi(qx[i].z), bflo(qx[i].w), bfhi(qx[i].w)};
                        float o[8];
#pragma unroll
                        for (int j = 0; j < 8; ++j) { const float z = a[j] * b[j]; o[j] = cb[j] * (w0[j] * z2[j] + w1[j] * z1[j] + w2[j] * z); z2[j] = z1[j]; z1[j] = z; }
                        st8(yp + (size_t)(r0 + hb * 4 + i) * NBR, o);
                    }
                    asm volatile("" ::: "memory");
                }
            }
        }
#pragma unroll 1
        for (int g = 0; g < 4; ++g) {
            const int t = wave * 16 + fr;
            const int nk = (wave >> 1) + 1;
            f32x4 wq[4][2];
#pragma unroll
            for (int k = 0; k < 4; ++k) { const float* wp = w_sp + ((size_t)g * 128 + t) * 128 + k * 32 + fq * 8; wq[k][0] = *(const f32x4*)wp; wq[k][1] = *(const f32x4*)(wp + 4); }
            const bf16_t* up = PA + (size_t)(t0 + t) * NPA + 512 + g * 128 + 4 * fq;
            u32x2 uu[8];
#pragma unroll
            for (int n = 0; n < 8; ++n) uu[n] = *(const u32x2*)(up + n * 16);
            const float bias = b_sp[g * 128 + t];
            u32x4 vq[4];
            const int s_ = tid >> 2, dq = (tid & 3) * 32;
            {
                const bf16_t* vp = PA + (size_t)(t0 + s_) * NPA + 1024 + g * 128 + dq;
#pragma unroll
                for (int i = 0; i < 4; ++i) vq[i] = *(const u32x4*)(vp + i * 8);
            }
            __syncthreads();
#pragma unroll
            for (int i = 0; i < 4; ++i) {
                const unsigned ww[4] = {vq[i].x, vq[i].y, vq[i].z, vq[i].w};
#pragma unroll
                for (int q = 0; q < 4; ++q) { vT[(dq + i * 8 + q * 2) * VT_PITCH + s_] = (bf16_t)(ww[q] & 0xffffu); vT[(dq + i * 8 + q * 2 + 1) * VT_PITCH + s_] = (bf16_t)(ww[q] >> 16); }
            }
            __syncthreads();
            f32x4 acc[8];
#pragma unroll
            for (int n = 0; n < 8; ++n) acc[n] = (f32x4){0.f, 0.f, 0.f, 0.f};
#pragma unroll
            for (int k = 0; k < 4; ++k) if (k < nk) {
                const int s0 = k * 32 + fq * 8;
                const f32x4 wa = wq[k][0], wb = wq[k][1];
                const f32x4 ra = *(const f32x4*)(rs + s0), rb = *(const f32x4*)(rs + s0 + 4);
                float a[8];
#pragma unroll
                for (int j = 0; j < 4; ++j) { a[j] = (s0 + j <= t) ? wa[j] * ra[j] : 0.f; a[4 + j] = (s0 + 4 + j <= t) ? wb[j] * rb[j] : 0.f; }
                union { u32x4 u; bf16x8 h; } af; af.u.x = pk(a[0], a[1]); af.u.y = pk(a[2], a[3]); af.u.z = pk(a[4], a[5]); af.u.w = pk(a[6], a[7]);
#pragma unroll
                for (int n = 0; n < 8; ++n) {
                    const bf16x8 bfrag = *(const bf16x8*)(vT + (n * 16 + fr) * VT_PITCH + s0);
                    acc[n] = __builtin_amdgcn_mfma_f32_16x16x32_bf16(bfrag, af.h, acc[n], 0, 0, 0);
                }
            }
            bf16_t* yp = Y + (size_t)(t0 + t) * NBR + 512 + g * 128 + 4 * fq;
#pragma unroll
            for (int n = 0; n < 8; ++n) {
                const f32x4 gs = *(const f32x4*)(g_sgu + g * 128 + n * 16 + 4 * fq);
                const float o0 = bflo(uu[n].x) * (acc[n][0] * gs[0] + bias), o1 = bfhi(uu[n].x) * (acc[n][1] * gs[1] + bias);
                const float o2 = bflo(uu[n].y) * (acc[n][2] * gs[2] + bias), o3 = bfhi(uu[n].y) * (acc[n][3] * gs[3] + bias);
                u32x2 w; w.x = pk(o0, o1); w.y = pk(o2, o3);
                *(u32x2*)(yp + n * 16) = w;
            }
        }
        __syncthreads();
    }
}

__device__ __forceinline__ void ffn_fixup_phase(const Params& p, int l) {
    const bf16_t* zs = (const bf16_t*)(p.ws + WS_B2);
    bf16_t* act = (bf16_t*)(p.ws + WS_B1);
    const float* cw = p.in[15] + (size_t)l * 3 * NUP; const float* cb = p.in[16] + (size_t)l * NUP;
    constexpr int NCG = DFF / 8, NU = (MTOK / 64) * NCG;
    for (int u = obid() * 512 + otid(); u < NU; u += gridDim.x * 512) {
        const int blk = u / NCG, c8 = (u - blk * NCG) * 8;
        const bool first = ((blk * 64) & (SEQ - 1)) == 0;
        float g2[8], g1[8], ga[8], gb2[8], v2[8], v1[8], va[8], vb2[8];
#pragma unroll
        for (int j = 0; j < 8; ++j) { g2[j] = g1[j] = v2[j] = v1[j] = 0.f; }
        const bf16_t* own = zs + (size_t)blk * 4 * NUP + c8;
        if (!first) { const bf16_t* prv = own - 4 * (ptrdiff_t)NUP; ld8(prv, g2); ld8(prv + NUP, g1); ld8(prv + DFF, v2); ld8(prv + NUP + DFF, v1); }
        ld8(own + 2 * NUP, ga); ld8(own + 3 * NUP, gb2); ld8(own + 2 * NUP + DFF, va); ld8(own + 3 * NUP + DFF, vb2);
        float o0[8], o1[8];
#pragma unroll
        for (int j = 0; j < 8; ++j) {
            const float w0 = cw[c8 + j], w1 = cw[NUP + c8 + j], w2 = cw[2 * NUP + c8 + j], bb = cb[c8 + j];
            const float x0 = cw[DFF + c8 + j], x1 = cw[NUP + DFF + c8 + j], x2 = cw[2 * NUP + DFF + c8 + j], xb_ = cb[DFF + c8 + j];
            const float gg0 = w0 * g2[j] + w1 * g1[j] + w2 * ga[j] + bb, vv0 = x0 * v2[j] + x1 * v1[j] + x2 * va[j] + xb_;
            const float gg1 = w0 * g1[j] + w1 * ga[j] + w2 * gb2[j] + bb, vv1 = x0 * v1[j] + x1 * va[j] + x2 * vb2[j] + xb_;
            o0[j] = silu_f(gg0) * vv0; o1[j] = silu_f(gg1) * vv1;
        }
        st8(act + (size_t)(blk * 64) * DFF + c8, o0); st8(act + (size_t)(blk * 64 + 1) * DFF + c8, o1);
    }
}

__device__ __forceinline__ void final_norm_phase(const Params& p) {
    const float* gf = p.in[18]; const float* ssq = (const float*)(p.ws + WS_SSQ); const bf16_t* xb = (const bf16_t*)(p.ws + WS_XB); float* out = p.out;
    const int tid = otid(), lane = tid & 63, wave = tid >> 6;
    for (int r = obid() * 8 + wave; r < MTOK; r += gridDim.x * 8) {
        const float rs = row_rstd(ssq, r);
#pragma unroll
        for (int i = 0; i < 2; ++i) {
            const int c = i * 512 + lane * 8;
            float v[8]; ld8(xb + (size_t)r * DM + c, v);
            const f32x4 g0 = *(const f32x4*)(gf + c), g1 = *(const f32x4*)(gf + c + 4);
            f32x4 o0, o1;
#pragma unroll
            for (int j = 0; j < 4; ++j) { o0[j] = v[j] * rs * g0[j]; o1[j] = v[4 + j] * rs * g1[j]; }
            float* q = out + (size_t)r * DM + c;
            __builtin_nontemporal_store(o0, (f32x4*)q); __builtin_nontemporal_store(o1, (f32x4*)(q + 4));
        }
    }
}

template <class Epi> __device__ __forceinline__ void run_gemm(unsigned char* lds, const bf16_t* A, const bf16_t* Bt, int M, int N, int K, const Epi& E, int stagger_step = 0) {
    pg8::Gemm g{A, Bt, M, N, K}; pg8::StaticOrder S; S.init(M, N, (int)gridDim.x, obid());
    if (stagger_step) {
        const unsigned long long t0 = wall_clock64(), d = (unsigned long long)(((obid() >> 3) & 7) * stagger_step);
        while (wall_clock64() - t0 < d) __builtin_amdgcn_s_sleep(16);
    }
    pg8::gemm_phase<Epi, pg8::StaticOrder, false>((PG8_LAS unsigned char*)lds, g, S, E, nullptr);
}

#define XB_TMO      128
#define XB_XCNT(j)  (256  + 64 * (j))
#define XB_XSUB(j)  (1280 + 64 * (j))
#define XB_XGEN(j)  (2304 + 64 * (j))
#define XB_TOP      3328
#define XB_TOPGEN   3392
#define XCD_BAR_WORDS 3456
#define XB_SPIN_CAP (1u << 18)

__device__ __forceinline__ unsigned xb_ld(unsigned* p)              { return __hip_atomic_load(p, __ATOMIC_RELAXED, __HIP_MEMORY_SCOPE_AGENT); }
__device__ __forceinline__ unsigned xb_add(unsigned* p, unsigned v) { return __hip_atomic_fetch_add(p, v, __ATOMIC_RELAXED, __HIP_MEMORY_SCOPE_AGENT); }
__device__ __forceinline__ unsigned xb_xcc_id() { return (unsigned)__builtin_amdgcn_s_getreg((3 << 11) | 20) & 0xFu; }
#define XB_SPIN(cond, bar) do { unsigned _sp = 0; while (cond) { __builtin_amdgcn_s_sleep(1); \
    if ((++_sp & 255u) == 0u) { if (xb_ld(&(bar)[XB_TMO])) break; if (_sp > XB_SPIN_CAP) { atomicAdd(&(bar)[XB_TMO], 1u); break; } } } } while (0)

struct XcdBarrier {
    unsigned* bar; unsigned x;
    volatile LAS unsigned* st;
};

__device__ __forceinline__ XcdBarrier xcd_barrier_post(unsigned* bar, volatile LAS unsigned* st) {
    XcdBarrier b; b.bar = bar; b.x = xb_xcc_id(); b.st = st;
    if (threadIdx.x == 0) (void)xb_add(&bar[XB_XCNT(b.x)], 1u);
    return b;
}
__device__ __forceinline__ void xcd_barrier_complete(unsigned* bar, unsigned x, unsigned& nloc, unsigned& nx) {
    const unsigned G = gridDim.x * gridDim.y * gridDim.z;
    unsigned sum, cnt, mine, sp = 0u;
    for (;;) {
        sum = 0u; cnt = 0u; mine = 0u;
#pragma unroll
        for (unsigned j = 0; j < 16; ++j) { const unsigned c = xb_ld(&bar[XB_XCNT(j)]); sum += c; cnt += (c > 0u) ? 1u : 0u; mine = (j == x) ? c : mine; }
        if (sum == G) break;
        __builtin_amdgcn_s_sleep(1);
        if ((++sp & 255u) == 0u) { if (xb_ld(&bar[XB_TMO])) break; if (sp > XB_SPIN_CAP) { atomicAdd(&bar[XB_TMO], 1u); break; } }
    }
    nloc = mine > 0u ? mine : 1u; nx = cnt > 0u ? cnt : 1u;
}

__device__ __forceinline__ void xcd_barrier(const XcdBarrier& b) {
    asm volatile("s_waitcnt vmcnt(0)" ::: "memory");
    __syncthreads();
    if (threadIdx.x == 0) {
        unsigned* bar = b.bar;
        __builtin_amdgcn_s_waitcnt(0);
        unsigned nloc = b.st[0], nx = b.st[1];
        if (nloc == 0u) { xcd_barrier_complete(bar, b.x, nloc, nx); b.st[0] = nloc; b.st[1] = nx; }
        const unsigned old = xb_add(&bar[XB_XSUB(b.x)], 1u);
        const unsigned gen = old / nloc;
        if (old + 1u == (gen + 1u) * nloc) {
            __builtin_amdgcn_fence(__ATOMIC_RELEASE, "agent");
            asm volatile("s_waitcnt vmcnt(0)" ::: "memory");
            const unsigned og = xb_add(&bar[XB_TOP], 1u);
            const unsigned tg = og / nx;
            if (og + 1u == (tg + 1u) * nx) xb_add(&bar[XB_TOPGEN], 1u);
            else XB_SPIN(xb_ld(&bar[XB_TOPGEN]) == tg, bar);
            __builtin_amdgcn_fence(__ATOMIC_ACQUIRE, "agent");
            xb_add(&bar[XB_XGEN(b.x)], 1u);
            asm volatile("s_waitcnt vmcnt(0)" ::: "memory");
        } else {
            XB_SPIN(xb_ld(&bar[XB_XGEN(b.x)]) == gen, bar);
            __builtin_amdgcn_fence(__ATOMIC_ACQUIRE, "agent");
            asm volatile("s_waitcnt vmcnt(0)" ::: "memory");
        }
    }
    __syncthreads();
}

typedef const Params __attribute__((address_space(4)))* ParamsK;
__device__ __forceinline__ Params fresh_params() {
    ParamsK q = (ParamsK)__builtin_amdgcn_kernarg_segment_ptr();
    asm volatile("" : "+s"(q));
    Params r;
#pragma unroll
    for (int i = 0; i < 19; ++i) r.in[i] = q->in[i];
    r.out = q->out; r.ws = q->ws;
    return r;
}
constexpr size_t WS_BAR = WS_END;
constexpr int LDS_TOTAL = pg8::STAGE_BYTES + 256;
__global__ void __launch_bounds__(512, 2) fwd_megakernel(Params p_unused) {
    extern __shared__ __attribute__((aligned(16))) unsigned char lds[];
    cg::grid_group grid = cg::this_grid();
    volatile LAS unsigned* st = (volatile LAS unsigned*)((LAS unsigned char*)lds + pg8::STAGE_BYTES);
    unsigned* bar;
    {
        const Params p = fresh_params(); bar = (unsigned*)(p.ws + WS_BAR);
        if (threadIdx.x < 4) st[threadIdx.x] = 0u;
        if (blockIdx.x == 0) for (int i = threadIdx.x; i < XCD_BAR_WORDS; i += 512) bar[i] = 0u;
        __syncthreads();
    }
#define WSP(off) ((bf16_t*)(p.ws + (off)))
#define GRID_BAR() do { XcdBarrier b_; b_.bar = (unsigned*)(fresh_params().ws + WS_BAR); b_.x = xb_xcc_id(); b_.st = (volatile LAS unsigned*)((LAS unsigned char*)lds + pg8::STAGE_BYTES); xcd_barrier(b_); } while (0)
    for (int l = 0; l < 2; ++l) {
        { const Params p = fresh_params(); prep_phase(p, l, (float*)lds); }
        if (l == 0) { grid.sync(); (void)xcd_barrier_post((unsigned*)(fresh_params().ws + WS_BAR), (volatile LAS unsigned*)((LAS unsigned char*)lds + pg8::STAGE_BYTES)); }
        else GRID_BAR();
        { const Params p = fresh_params(); EpiIn E{WSP(WS_B1), WSP(WS_B2), (const float*)(p.ws + WS_SSQ)}; run_gemm(lds, WSP(WS_XB), WSP(WS_WIN), MTOK, NIN, DM, E); }
        GRID_BAR();
        { const Params p = fresh_params(); mixer_phase(p, l, lds); }
        GRID_BAR();
        { const Params p = fresh_params(); EpiBr E{WSP(WS_B2), WSP(WS_B1)}; run_gemm(lds, (const bf16_t*)p.out  , WSP(WS_WBR), MTOK, DM, NBR, E); }
        GRID_BAR();
        { const Params p = fresh_params(); EpiRes E{WSP(WS_XB), (float*)(p.ws + WS_SSQ)}; run_gemm(lds, WSP(WS_B1), WSP(WS_WO), MTOK, DM, DM, E); }
        GRID_BAR();
        { const Params p = fresh_params(); EpiUp E{WSP(WS_B1), WSP(WS_B2), (const float*)(p.ws + WS_SSQ), p.in[15] + (size_t)l * 3 * NUP, p.in[16] + (size_t)l * NUP}; run_gemm(lds, WSP(WS_XB), WSP(WS_WUP), MTOK, NUP, DM, E); }
        GRID_BAR();
        { const Params p = fresh_params(); ffn_fixup_phase(p, l); }
        GRID_BAR();
        { const Params p = fresh_params(); EpiRes E{WSP(WS_XB), (float*)(p.ws + WS_SSQ)}; run_gemm(lds, WSP(WS_B1), WSP(WS_WDN), MTOK, DM, DFF, E); }
        GRID_BAR();
    }
    { const Params p = fresh_params(); final_norm_phase(p); }
#undef WSP
#undef GRID_BAR
}

extern "C" void kernel_launch(void* const* d_in, const int* in_sizes, int n_in, void* d_out, int out_size, void* d_ws, size_t ws_size, hipStream_t stream) {
    constexpr size_t kLds = LDS_TOTAL;
    static int grid_blocks = 0;
    if (!grid_blocks) {
        int dev = 0, cus = 0, per_cu = 0;
        (void)hipGetDevice(&dev);
        (void)hipDeviceGetAttribute(&cus, hipDeviceAttributeMultiprocessorCount, dev);
        (void)hipFuncSetAttribute((const void*)fwd_megakernel, hipFuncAttributeMaxDynamicSharedMemorySize, (int)kLds);
        (void)hipOccupancyMaxActiveBlocksPerMultiprocessor(&per_cu, (const void*)fwd_megakernel, 512, kLds);
        if (per_cu < 1) per_cu = 1;
        grid_blocks = cus;
        if (ws_size < WS_END + 16384 || n_in != 19 || out_size != MTOK * DM) { fprintf(stderr, "kernel_launch: unexpected sizes: ws %zu (need %zu), n_in %d, out %d\n", ws_size, (size_t)WS_END, n_in, out_size); }
    }
    Params p{};
    for (int i = 0; i < 19; ++i) p.in[i] = (const float*)d_in[i];
    p.out = (float*)d_out; p.ws = (unsigned char*)d_ws;
    void* args[] = {&p};
    hipError_t e = hipLaunchCooperativeKernel((void*)fwd_megakernel, dim3(grid_blocks), dim3(512), args, kLds, stream);
    if (e != hipSuccess) fprintf(stderr, "cooperative launch failed: %s (grid %d)\n", hipGetErrorString(e), grid_blocks);
}
```

```cpp
#include <hip/hip_runtime.h>
#include <hip/hip_cooperative_groups.h>
#include <cstdio>
namespace cg = cooperative_groups;
namespace pg8 {
#define PG8_LAS __attribute__((address_space(3)))
typedef unsigned short bf16_t;
typedef short bf16x8 __attribute__((ext_vector_type(8)));
typedef float f32x4 __attribute__((ext_vector_type(4)));
typedef unsigned u32x4 __attribute__((ext_vector_type(4)));
constexpr int BM = 256, BK = 64, HALF = 128, HTB = HALF * BK * 2  , STAGE_BYTES = 8 * HTB, NXCD = 8, WGM = 8;

__host__ __device__ __forceinline__ int lds_byte(int r, int c) { const int st = (r >> 4) * 2 + (c >> 5), rr = r & 15, cc = c & 31, ob = rr * 64 + cc * 2; return st * 1024 + (ob ^ (((ob >> 9) & 1) << 5)); }
__host__ __device__ __forceinline__ void stage_rc(int b, int& R, int& C) { const int st = b / 1024, sb = b % 1024, swz = sb ^ (((sb >> 9) & 1) << 5); R = (st >> 1) * 16 + swz / 64; C = (st & 1) * 32 + (swz % 64) / 2; }
__host__ __device__ __forceinline__ int perm32(int rho) { const int n = rho >> 4, i = rho & 15; return 8 * (i >> 2) + 4 * n + (i & 3); }

struct Unit { int pm, pn; };
struct Gemm { const bf16_t* A; const bf16_t* Bt; int M, N, K; };

struct StaticOrder {
    int nM, nN, nwg, G, c;
    __host__ __device__ void init(int M, int N, int G_, int c_) { nM = M / BM; nN = N / BM; nwg = nM * nN; G = G_; c = c_; }
    __host__ __device__ bool next(int i, Unit& u) const {
        const long L = (long)i * G + c; if (L >= nwg) return false;
        int wgid = (int)L; { const int q = nwg / NXCD, r = nwg % NXCD, xcd = wgid % NXCD, off = wgid / NXCD; wgid = (xcd < r ? xcd * (q + 1) : r * (q + 1) + (xcd - r) * q) + off; }
        const int nig = WGM * nN, gid = wgid / nig, fm = gid * WGM, gsz = (nM - fm) < WGM ? (nM - fm) : WGM;
        u.pm = fm + ((wgid % nig) % gsz); u.pn = (wgid % nig) / gsz; return true;
    }
    __device__ __forceinline__ void a_ready(const Unit&) const {}
    __device__ __forceinline__ void done(const Unit&) const {}
};
__device__ __forceinline__ unsigned cvt_pk_bf16(float lo, float hi) { unsigned r; asm volatile("v_cvt_pk_bf16_f32 %0, %1, %2" : "=v"(r) : "v"(lo), "v"(hi)); return r; }

template <class Epi, class Sched, bool STAMP = false>
__device__ __forceinline__ void gemm_phase(PG8_LAS unsigned char* lds, const Gemm g, const Sched& S, const Epi& E, unsigned long long* stamps) {
    int tid_ = threadIdx.x; asm volatile("" : "+v"(tid_));
    const int tid = tid_, wid = __builtin_amdgcn_readfirstlane(tid >> 6), lane = tid & 63, wr = wid >> 2, wc = wid & 3, fr = lane & 15, fq = lane >> 4;
    const int K = g.K, nt = K / BK;
    int ts_lo = 0, ts_hi = 0, nts = 0; const unsigned long long rt_entry = STAMP ? (unsigned long long)wall_clock64() : 0ull;
#define PG8_STAMP() do { if (STAMP && wid == 0 && nts < 64) { const unsigned long long _c = (unsigned long long)clock64(); \
        ts_lo = (lane == nts) ? (int)(unsigned)_c : ts_lo; ts_hi = (lane == nts) ? (int)(unsigned)(_c >> 32) : ts_hi; ++nts; } } while (0)
    PG8_STAMP();
    unsigned voffA[2], voffB[2];
#pragma unroll
    for (int i = 0; i < 2; ++i) { int R, C; stage_rc(tid * 16 + i * 8192, R, C); const int Rb = Epi::PERM ? ((R & ~31) + perm32(R & 31)) : R;
        voffA[i] = (unsigned)(R * K + C) * 2u; voffB[i] = (unsigned)(Rb * K + C) * 2u; }
    const size_t kstep = (size_t)(BK * 2);
    const size_t hstep = (size_t)HALF * K * 2;
    const size_t tstep = 2 * hstep;
    const unsigned ldsw = (unsigned)wid * 1024u;
    const int aoff = lds_byte(wr * 64 + fr, fq * 8), boff = lds_byte(wc * 32 + fr, fq * 8);
#define PG8_SA(b, h) (((b) * 2 + (h)) * HTB)
#define PG8_SB(b, h) ((4 + (b) * 2 + (h)) * HTB)
#define PG8_STAGE(bufoff, gbase, voff) do { _Pragma("unroll") for (int _i = 0; _i < 2; ++_i) \
        __builtin_amdgcn_global_load_lds((const unsigned*)((const char*)(gbase) + (voff)[_i]), (PG8_LAS unsigned*)(lds + (bufoff) + ldsw + _i * 8192), 16, 0, 0); } while (0)
#define PG8_LDA(dst, b, h) do { _Pragma("unroll") for (int m = 0; m < 4; ++m) _Pragma("unroll") for (int k = 0; k < 2; ++k) dst[m][k] = *(const PG8_LAS bf16x8*)(lds + PG8_SA(b, h) + aoff + m * 2048 + k * 1024); } while (0)
#define PG8_LDB(dst, b, h) do { _Pragma("unroll") for (int n = 0; n < 2; ++n) _Pragma("unroll") for (int k = 0; k < 2; ++k) dst[n][k] = *(const PG8_LAS bf16x8*)(lds + PG8_SB(b, h) + boff + n * 2048 + k * 1024); } while (0)
#define PG8_MMA(ai, bj, At, Bt) do { __builtin_amdgcn_s_setprio(1); _Pragma("unroll") for (int m = 0; m < 4; ++m) _Pragma("unroll") for (int n = 0; n < 2; ++n) _Pragma("unroll") for (int k = 0; k < 2; ++k) \
        acc[ai][bj][m][n] = __builtin_amdgcn_mfma_f32_16x16x32_bf16(Bt[n][k], At[m][k], acc[ai][bj][m][n], 0, 0, 0); __builtin_amdgcn_s_setprio(0); } while (0)
#define PG8_WAIT_V(n) asm volatile("s_waitcnt vmcnt(" #n ")" ::: "memory")
#define PG8_WAIT_L(n) asm volatile("s_waitcnt lgkmcnt(" #n ")" ::: "memory")
#define PG8_BAR __builtin_amdgcn_s_barrier()
#define PG8_SCHED __builtin_amdgcn_sched_barrier(0)
    Unit cur, nxt; int ui = 0;
    if (!S.next(0, cur)) return;
    f32x4 acc[2][2][4][2];
#pragma unroll
    for (int a = 0; a < 2; ++a)
#pragma unroll
        for (int b = 0; b < 2; ++b)
#pragma unroll
            for (int m = 0; m < 4; ++m)
#pragma unroll
                for (int n = 0; n < 2; ++n) acc[a][b][m][n] = (f32x4){0.f, 0.f, 0.f, 0.f};
    bf16x8 At[4][2], B0[2][2], B1[2][2];
    const char* cA = (const char*)g.A + (size_t)cur.pm * tstep; const char* cB = (const char*)g.Bt + (size_t)cur.pn * tstep;
    S.a_ready(cur);
    PG8_STAGE(PG8_SB(0, 0), cB, voffB); PG8_STAGE(PG8_SA(0, 0), cA, voffA); PG8_STAGE(PG8_SB(0, 1), cB + hstep, voffB); PG8_STAGE(PG8_SA(0, 1), cA + hstep, voffA);
    if (wr == 1) PG8_BAR;
    PG8_WAIT_V(4); PG8_BAR;
    PG8_STAGE(PG8_SB(1, 0), cB + kstep, voffB); PG8_STAGE(PG8_SA(1, 0), cA + kstep, voffA); PG8_STAGE(PG8_SB(1, 1), cB + hstep + kstep, voffB);
    PG8_WAIT_V(6); PG8_BAR;
    PG8_STAMP();
    for (;;) {
        const bool has_next = S.next(ui + 1, nxt);
        const char* nA = has_next ? (const char*)g.A + (size_t)nxt.pm * tstep : cA; const char* nB = has_next ? (const char*)g.Bt + (size_t)nxt.pn * tstep : cB;
        for (int t = 0; t < nt; t += 2) {
            if constexpr (Epi::MIDK) { if (t == 8 || t == 16) E.mid(acc, cur, t, wr, wc, fr, fq); }
            const bool last = (t == nt - 2);
            const char* a1 = cA + (size_t)(t + 1) * kstep;
            const char* a2 = last ? nA : cA + (size_t)(t + 2) * kstep; const char* b2 = last ? nB : cB + (size_t)(t + 2) * kstep;
            const char* a3 = a2 + kstep; const char* b3 = b2 + kstep;
            if (last && has_next) S.a_ready(nxt);
            PG8_LDB(B0, 0, 0); PG8_SCHED; PG8_LDA(At, 0, 0); PG8_STAGE(PG8_SA(1, 1), a1 + hstep, voffA);
            PG8_WAIT_L(8); PG8_BAR; PG8_WAIT_L(0); PG8_MMA(0, 0, At, B0); PG8_BAR; PG8_SCHED;
            PG8_LDB(B1, 0, 1); PG8_STAGE(PG8_SB(0, 0), b2, voffB);
            PG8_BAR; PG8_WAIT_L(0); PG8_MMA(0, 1, At, B1); PG8_BAR;
            PG8_LDA(At, 0, 1); PG8_STAGE(PG8_SA(0, 0), a2, voffA);
            PG8_BAR; PG8_WAIT_L(0); PG8_MMA(1, 0, At, B0); PG8_BAR; PG8_SCHED;
            PG8_STAGE(PG8_SB(0, 1), b2 + hstep, voffB);
            PG8_WAIT_V(6); PG8_BAR; PG8_MMA(1, 1, At, B1); PG8_BAR;
            PG8_LDB(B0, 1, 0); PG8_SCHED; PG8_LDA(At, 1, 0); PG8_STAGE(PG8_SA(0, 1), a2 + hstep, voffA);
            PG8_WAIT_L(8); PG8_BAR; PG8_WAIT_L(0); PG8_MMA(0, 0, At, B0); PG8_BAR; PG8_SCHED;
            PG8_LDB(B1, 1, 1); PG8_STAGE(PG8_SB(1, 0), b3, voffB);
            PG8_BAR; PG8_WAIT_L(0); PG8_MMA(0, 1, At, B1); PG8_BAR;
            PG8_LDA(At, 1, 1); PG8_STAGE(PG8_SA(1, 0), a3, voffA);
            PG8_BAR; PG8_WAIT_L(0); PG8_MMA(1, 0, At, B0); PG8_BAR; PG8_SCHED;
            PG8_STAGE(PG8_SB(1, 1), b3 + hstep, voffB);
            PG8_WAIT_V(6); PG8_BAR; PG8_MMA(1, 1, At, B1); PG8_BAR;
        }
        PG8_STAMP();
        if constexpr (!Epi::AFTER_DRAIN) { E(acc, cur, wr, wc, fr, fq); S.done(cur); }
        PG8_STAMP();
        if (!has_next) break;
#pragma unroll
        for (int a = 0; a < 2; ++a)
#pragma unroll
            for (int b = 0; b < 2; ++b)
#pragma unroll
                for (int m = 0; m < 4; ++m)
#pragma unroll
                    for (int n = 0; n < 2; ++n) acc[a][b][m][n] = (f32x4){0.f, 0.f, 0.f, 0.f};
        cur = nxt; cA = nA; cB = nB; ++ui;
    }
    PG8_WAIT_V(0);
    if (wr == 0) PG8_BAR;
    PG8_BAR;
    if constexpr (Epi::AFTER_DRAIN) { E.fused(acc, cur, wr, wc, fr, fq, lds, wid, lane); S.done(cur); }
    PG8_STAMP();
    if (STAMP && wid == 0) { stamps[lane] = lane < nts ? (((unsigned long long)(unsigned)ts_hi << 32) | (unsigned)ts_lo) : 0ull;
        if (lane == 62) stamps[62] = rt_entry; if (lane == 63) stamps[63] = (unsigned long long)wall_clock64(); }
#undef PG8_STAMP
#undef PG8_SA
#undef PG8_SB
#undef PG8_STAGE
#undef PG8_LDA
#undef PG8_LDB
#undef PG8_MMA
#undef PG8_WAIT_V
#undef PG8_WAIT_L
#undef PG8_BAR
#undef PG8_SCHED
}
}
typedef pg8::bf16_t bf16_t;
typedef pg8::f32x4 f32x4;
typedef pg8::u32x4 u32x4;
typedef pg8::bf16x8 bf16x8;
typedef unsigned u32x2 __attribute__((ext_vector_type(2)));
#define LAS __attribute__((address_space(3)))
constexpr int MTOK = 65536, DM = 1024, NIN = 6144, DFF = 2816, NUP = 5632, SEQ = 8192, NBR = 1536, NPA = 3072;
constexpr int NPA2 = 1536;
constexpr int MH = MTOK / 2;
constexpr float EPS = 1e-6f;
constexpr size_t WS_WIN = 0;
constexpr size_t WS_WBR = WS_WIN + (size_t)NIN * DM * 2;
constexpr size_t WS_WO = WS_WBR + (size_t)DM * NBR * 2;
constexpr size_t WS_WUP = WS_WO + (size_t)DM * DM * 2;
constexpr size_t WS_WDN = WS_WUP + (size_t)NUP * DM * 2;
constexpr size_t WS_SSQ = WS_WDN + (size_t)DM * DFF * 2;
constexpr size_t WS_XB = WS_SSQ + (size_t)MTOK * 16 * 4;
constexpr size_t WS_B1 = WS_XB + (size_t)MTOK * NBR * 2;
constexpr size_t WS_B2 = WS_B1 + (size_t)MTOK * NPA * 2;
constexpr size_t WS_END = WS_B2 + (size_t)MTOK * NPA * 2;
constexpr size_t WS_BAR = WS_END;
constexpr size_t WS_SC = WS_BAR + 16384;
constexpr size_t WS_SCB = WS_SC + (size_t)(MTOK / 64) * 4 * 512 * 2;
constexpr size_t WS_TOTAL = WS_SCB + (size_t)(MTOK / 64) * 2 * 512 * 2;

__device__ __forceinline__ int otid() { int t = threadIdx.x; asm volatile("" : "+v"(t)); return t; }
__device__ __forceinline__ int obid() { int b = blockIdx.x; asm volatile("" : "+s"(b)); return b; }
struct Params {
    const float* in[19];
    float* out; unsigned char* ws;
};

__device__ __forceinline__ void st_nt16(void* p, u32x4 w) { __builtin_nontemporal_store(w, (u32x4*)p); }
__device__ __forceinline__ float bflo(unsigned w) { return __uint_as_float(w << 16); }
__device__ __forceinline__ float bfhi(unsigned w) { return __uint_as_float(w & 0xffff0000u); }
__device__ __forceinline__ unsigned pk(float a, float b) { return pg8::cvt_pk_bf16(a, b); }
__device__ __forceinline__ float fast_rcp(float x) { return __builtin_amdgcn_rcpf(x); }
__device__ __forceinline__ float gate_t2(float y) { return 1.0f + __builtin_amdgcn_exp2f(fminf(y, 43.28f)); }
__device__ __forceinline__ float gelu_tanh_f(float x) {
    const float z2 = 1.5957691216f * (x + 0.044715f * x * x * x);
    return x * fast_rcp(1.0f + __expf(-z2));
}
__device__ __forceinline__ float silu_f(float x) { return x * fast_rcp(1.0f + __expf(-x)); }
__device__ __forceinline__ float row_rstd(const float* ssq, int r) {
    const f32x4* p = (const f32x4*)(ssq + (size_t)r * 16);
    const f32x4 a = p[0], b = p[1], c = p[2], d = p[3];
    const float s = ((a[0] + a[1]) + (a[2] + a[3])) + ((b[0] + b[1]) + (b[2] + b[3])) + ((c[0] + c[1]) + (c[2] + c[3])) + ((d[0] + d[1]) + (d[2] + d[3]));
    return rsqrtf(s * (1.0f / 1024.0f) + EPS);
}

__device__ __forceinline__ void rows_rstd8(const float* ssq, int row0, int fq, float (&rs)[8]) {
    f32x4 v[8];
#pragma unroll
    for (int i = 0; i < 8; ++i) v[i] = *(const f32x4*)(ssq + (size_t)(row0 + (i >> 2) * 128 + (i & 3) * 16) * 16 + fq * 4);
#pragma unroll
    for (int i = 0; i < 8; ++i) {
        float s = (v[i][0] + v[i][1]) + (v[i][2] + v[i][3]);
        s += __shfl_xor(s, 16); s += __shfl_xor(s, 32);
        rs[i] = rsqrtf(s * (1.0f / 1024.0f) + EPS);
    }
}
__device__ __forceinline__ float dpp_ror1(float x) { return __int_as_float(__builtin_amdgcn_mov_dpp(__float_as_int(x), 0x121, 0xf, 0xf, true)); }
__device__ __forceinline__ float dpp_ror2(float x) { return __int_as_float(__builtin_amdgcn_mov_dpp(__float_as_int(x), 0x122, 0xf, 0xf, true)); }
__device__ __forceinline__ float dpp_shr1(float old, float x) { return __int_as_float(__builtin_amdgcn_update_dpp(__float_as_int(old), __float_as_int(x), 0x111, 0xf, 0xf, false)); }
__device__ __forceinline__ float dpp_shr2(float old, float x) { return __int_as_float(__builtin_amdgcn_update_dpp(__float_as_int(old), __float_as_int(x), 0x112, 0xf, 0xf, false)); }
struct EpiIn {
    static constexpr bool PERM = true, AFTER_DRAIN = false, MIDK = false;
    bf16_t* PA; bf16_t* G; const float* ssq; bf16_t* Y; bf16_t* sc; bf16_t* scb; const float* cw;
    __device__ __forceinline__ void operator()(const f32x4 (&acc)[2][2][4][2], const pg8::Unit& u, int wr, int wc, int fr, int fq) const {
        const int row0 = u.pm * 256 + wr * 64 + fr;
        float rs8[8]; rows_rstd8(ssq, row0, fq, rs8);
        if (u.pn >= 16) {
            const int q0 = (u.pn - 16) * 64 + wc * 16 + fq * 4;
            const f32x4 w0 = *(const f32x4*)(cw + q0), w1 = *(const f32x4*)(cw + 512 + q0), w2 = *(const f32x4*)(cw + 1024 + q0);
#pragma unroll
            for (int ai = 0; ai < 2; ++ai) {
                f32x4 pz = {0.f, 0.f, 0.f, 0.f};
                const int blk = u.pm * 4 + ai * 2 + wr;
#pragma unroll
                for (int m = 0; m < 4; ++m) {
                    const float rs = rs8[ai * 4 + m];
                    const f32x4 cb = acc[ai][0][m][0] * rs, cc = acc[ai][0][m][1] * rs, cx = acc[ai][1][m][0] * rs, av = acc[ai][1][m][1] * rs;
                    const f32x4 z = cc * cx;
                    float y[4];
#pragma unroll
                    for (int j = 0; j < 4; ++j) {
                        const float z1 = dpp_shr1(dpp_ror1(pz[j]), z[j]), z2 = dpp_shr2(dpp_ror2(pz[j]), z[j]);
                        y[j] = cb[j] * (w0[j] * z2 + w1[j] * z1 + w2[j] * z[j]);
                        asm volatile("" : "+v"(y[j]));
                    }
                    const int r = row0 + ai * 128 + m * 16;
                    u32x2 w;
                    w.x = pk(av[0], av[1]); w.y = pk(av[2], av[3]); *(u32x2*)(PA + (size_t)r * NPA2 + q0) = w;
                    if (!(m == 0 && fr < 2)) { w.x = pk(y[0], y[1]); w.y = pk(y[2], y[3]); *(u32x2*)(Y + (size_t)r * NBR + 1024 + q0) = w; }
                    if (m == 0 && fr < 2) {
                        w.x = pk(z[0], z[1]); w.y = pk(z[2], z[3]); *(u32x2*)(sc + ((size_t)blk * 4 + 2 + fr) * 512 + q0) = w;
                        w.x = pk(cb[0], cb[1]); w.y = pk(cb[2], cb[3]); *(u32x2*)(scb + ((size_t)blk * 2 + fr) * 512 + q0) = w;
                    }
                    if (m == 3 && fr >= 14) { w.x = pk(z[0], z[1]); w.y = pk(z[2], z[3]); *(u32x2*)(sc + ((size_t)blk * 4 + (fr - 14)) * 512 + q0) = w; }
                    pz = z;
                }
            }
        } else {
            const int q0 = u.pn * 64 + wc * 16 + fq * 4;
#pragma unroll
            for (int ai = 0; ai < 2; ++ai)
#pragma unroll
                for (int m = 0; m < 4; ++m) {
                    const float rs = rs8[ai * 4 + m], rsn = rs * -1.44269504f;
                    const f32x4 ga = acc[ai][0][m][0] * rsn, gb = acc[ai][0][m][1] * rsn, gc = acc[ai][1][m][0] * rsn, uv = acc[ai][1][m][1] * rs;
                    float r1[4], r2[4], s3[4], ug[4];
#pragma unroll
                    for (int j = 0; j < 4; ++j) {
                        const float ta = gate_t2(ga[j]), tb = gate_t2(gb[j]), tc = gate_t2(gc[j]);
                        r1[j] = ta; r2[j] = tb; s3[j] = tc;
                        ug[j] = gelu_tanh_f(uv[j]);
                    }
                    const size_t ro = (size_t)(row0 + ai * 128 + m * 16) * NPA, rp = (size_t)(row0 + ai * 128 + m * 16) * NPA2;
                    u32x2 w;
                    w.x = pk(r1[0], r1[1]); w.y = pk(r1[2], r1[3]); *(u32x2*)(G + ro + q0) = w;
                    w.x = pk(r2[0], r2[1]); w.y = pk(r2[2], r2[3]); *(u32x2*)(G + ro + 1024 + q0) = w;
                    w.x = pk(s3[0], s3[1]); w.y = pk(s3[2], s3[3]); *(u32x2*)(G + ro + 2048 + q0) = w;
                    w.x = pk(ug[0], ug[1]); w.y = pk(ug[2], ug[3]); *(u32x2*)(PA + rp + 512 + q0) = w;
                }
        }
    }
};
struct EpiBr {
    static constexpr bool PERM = true, AFTER_DRAIN = false, MIDK = true;
    const bf16_t* G; bf16_t* out;
    __device__ __forceinline__ void mid(f32x4 (&acc)[2][2][4][2], const pg8::Unit& u, int t, int wr, int wc, int fr, int fq) const {
        const int seg = (t == 8) ? 0 : 1024;
        int col0 = u.pn * 256 + wc * 32 + 8 * fq + seg;
        int row0 = u.pm * 256 + wr * 64 + fr;
        asm volatile("" : "+v"(col0), "+v"(row0));
#pragma unroll
        for (int ai = 0; ai < 2; ++ai) {
            u32x4 nu[4][2], de[4][2];
#pragma unroll
            for (int m = 0; m < 4; ++m)
#pragma unroll
                for (int bj = 0; bj < 2; ++bj) {
                    const bf16_t* gp = G + (size_t)(row0 + ai * 128 + m * 16) * NPA + col0 + bj * 128;
                    nu[m][bj] = *(const u32x4*)gp; de[m][bj] = *(const u32x4*)(gp + 1024);
                }
            asm volatile("" ::: "memory");
#pragma unroll
            for (int m = 0; m < 4; ++m)
#pragma unroll
                for (int bj = 0; bj < 2; ++bj) {
                    const unsigned nw[4] = {nu[m][bj].x, nu[m][bj].y, nu[m][bj].z, nu[m][bj].w}, dw[4] = {de[m][bj].x, de[m][bj].y, de[m][bj].z, de[m][bj].w};
#pragma unroll
                    for (int q = 0; q < 4; ++q) {
                        const float r0 = bflo(dw[q]) * fast_rcp(bflo(nw[q])), r1 = bfhi(dw[q]) * fast_rcp(bfhi(nw[q]));
                        acc[ai][bj][m][q >> 1][(q & 1) * 2] *= r0; acc[ai][bj][m][q >> 1][(q & 1) * 2 + 1] *= r1;
                    }
                }
            asm volatile("" ::: "memory");
        }
    }
    __device__ __forceinline__ void operator()(const f32x4 (&acc)[2][2][4][2], const pg8::Unit& u, int wr, int wc, int fr, int fq) const {
        const int col0 = u.pn * 256 + wc * 32 + 8 * fq;
        const int row0 = u.pm * 256 + wr * 64 + fr;
        u32x4 sg[2][4][2];
#pragma unroll
        for (int ai = 0; ai < 2; ++ai)
#pragma unroll
            for (int m = 0; m < 4; ++m)
#pragma unroll
                for (int bj = 0; bj < 2; ++bj) sg[ai][m][bj] = *(const u32x4*)(G + (size_t)(row0 + ai * 128 + m * 16) * NPA + 2048 + col0 + bj * 128);
#pragma unroll
        for (int ai = 0; ai < 2; ++ai)
#pragma unroll
            for (int m = 0; m < 4; ++m) {
                const int r = row0 + ai * 128 + m * 16;
                bf16_t* op = out + (size_t)r * DM + col0;
#pragma unroll
                for (int bj = 0; bj < 2; ++bj) {
                    const u32x4 s = sg[ai][m][bj];
                    const f32x4 a0 = acc[ai][bj][m][0], a1 = acc[ai][bj][m][1];
                    u32x4 w;
                    w.x = pk(a0[0] * fast_rcp(bflo(s.x)), a0[1] * fast_rcp(bfhi(s.x))); w.y = pk(a0[2] * fast_rcp(bflo(s.y)), a0[3] * fast_rcp(bfhi(s.y)));
                    w.z = pk(a1[0] * fast_rcp(bflo(s.z)), a1[1] * fast_rcp(bfhi(s.z))); w.w = pk(a1[2] * fast_rcp(bflo(s.w)), a1[3] * fast_rcp(bfhi(s.w)));
                    *(u32x4*)(op + bj * 128) = w;
                }
            }
    }
};
struct EpiRes {
    static constexpr bool PERM = true, AFTER_DRAIN = false, MIDK = false;
    bf16_t* xb; float* ssq;
    __device__ __forceinline__ void operator()(const f32x4 (&acc)[2][2][4][2], const pg8::Unit& u, int wr, int wc, int fr, int fq) const {
        const int col0 = u.pn * 256 + wc * 32 + 8 * fq;
        const int row0 = u.pm * 256 + wr * 64 + fr;
        u32x4 bb[2][4][2];
#pragma unroll
        for (int ai = 0; ai < 2; ++ai)
#pragma unroll
            for (int m = 0; m < 4; ++m)
#pragma unroll
                for (int bj = 0; bj < 2; ++bj) bb[ai][m][bj] = *(const u32x4*)(xb + (size_t)(row0 + ai * 128 + m * 16) * DM + col0 + bj * 128);
        asm volatile("" ::: "memory");
#pragma unroll
        for (int ai = 0; ai < 2; ++ai) {
#pragma unroll
            for (int m = 0; m < 4; ++m) {
                const int r = row0 + ai * 128 + m * 16;
                float sq = 0.f;
#pragma unroll
                for (int bj = 0; bj < 2; ++bj) {
                    const u32x4 s = bb[ai][m][bj];
                    const f32x4 a0 = acc[ai][bj][m][0], a1 = acc[ai][bj][m][1];
                    const float o0 = bflo(s.x) + a0[0], o1 = bfhi(s.x) + a0[1], o2 = bflo(s.y) + a0[2], o3 = bfhi(s.y) + a0[3];
                    const float o4 = bflo(s.z) + a1[0], o5 = bfhi(s.z) + a1[1], o6 = bflo(s.w) + a1[2], o7 = bfhi(s.w) + a1[3];
                    u32x4 w; w.x = pk(o0, o1); w.y = pk(o2, o3); w.z = pk(o4, o5); w.w = pk(o6, o7);
                    *(u32x4*)(xb + (size_t)r * DM + col0 + bj * 128) = w;
                    sq += (o0 * o0 + o1 * o1) + (o2 * o2 + o3 * o3) + (o4 * o4 + o5 * o5) + (o6 * o6 + o7 * o7);
                }
                sq += __shfl_xor(sq, 16); sq += __shfl_xor(sq, 32);
                if (fq == 0) ssq[(size_t)r * 16 + u.pn * 4 + wc] = sq;
            }
            asm volatile("" ::: "memory");
        }
    }
};
struct EpiUp {
    static constexpr bool PERM = true, AFTER_DRAIN = false, MIDK = false;
    bf16_t* act; bf16_t* zs; const float* ssq; const float* cw; const float* cb;
    __device__ __forceinline__ void operator()(const f32x4 (&acc)[2][2][4][2], const pg8::Unit& u, int wr, int wc, int fr, int fq) const {
        const int c0 = u.pn * 128 + wc * 32 + 8 * fq;
        const int row0 = u.pm * 256 + wr * 64 + fr;
        float rs8[8]; rows_rstd8(ssq, row0, fq, rs8);
        u32x2 keep[2][4];
#pragma unroll
        for (int n = 0; n < 2; ++n) {
            const int c = c0 + 4 * n;
            const f32x4 gw0 = *(const f32x4*)(cw + c), gw1 = *(const f32x4*)(cw + NUP + c), gw2 = *(const f32x4*)(cw + 2 * NUP + c), gb = *(const f32x4*)(cb + c);
            const f32x4 vw0 = *(const f32x4*)(cw + DFF + c), vw1 = *(const f32x4*)(cw + NUP + DFF + c), vw2 = *(const f32x4*)(cw + 2 * NUP + DFF + c), vb = *(const f32x4*)(cb + DFF + c);
#pragma unroll
            for (int ai = 0; ai < 2; ++ai) {
                f32x4 pg = {0.f, 0.f, 0.f, 0.f}, pv = {0.f, 0.f, 0.f, 0.f};
                const int blk = u.pm * 4 + ai * 2 + wr;
#pragma unroll
                for (int m = 0; m < 4; ++m) {
                    const float rs = rs8[ai * 4 + m];
                    const f32x4 zg = acc[ai][0][m][n] * rs, zv = acc[ai][1][m][n] * rs;
                    float o[4];
#pragma unroll
                    for (int j = 0; j < 4; ++j) {
                        const float g1 = dpp_shr1(dpp_ror1(pg[j]), zg[j]), g2 = dpp_shr2(dpp_ror2(pg[j]), zg[j]);
                        const float v1 = dpp_shr1(dpp_ror1(pv[j]), zv[j]), v2 = dpp_shr2(dpp_ror2(pv[j]), zv[j]);
                        const float gg = gw2[j] * zg[j] + gw1[j] * g1 + gw0[j] * g2 + gb[j];
                        const float vv = vw2[j] * zv[j] + vw1[j] * v1 + vw0[j] * v2 + vb[j];
                        o[j] = silu_f(gg) * vv;
                    }
                    u32x2 w; w.x = pk(o[0], o[1]); w.y = pk(o[2], o[3]);
                    const int r = row0 + ai * 128 + m * 16;
                    if (n == 0) keep[ai][m] = w;
                    else if (!(m == 0 && fr < 2)) { u32x4 ww; ww.x = keep[ai][m].x; ww.y = keep[ai][m].y; ww.z = w.x; ww.w = w.y; st_nt16(act + (size_t)r * DFF + c0, ww); }
                    if (m == 0 && fr < 2) {
                        bf16_t* zp = zs + ((size_t)blk * 4 + 2 + fr) * NUP + c;
                        u32x2 a; a.x = pk(zg[0], zg[1]); a.y = pk(zg[2], zg[3]); *(u32x2*)zp = a;
                        u32x2 d; d.x = pk(zv[0], zv[1]); d.y = pk(zv[2], zv[3]); *(u32x2*)(zp + DFF) = d;
                    }
                    if (m == 3 && fr >= 14) {
                        bf16_t* zp = zs + ((size_t)blk * 4 + (fr - 14)) * NUP + c;
                        u32x2 a; a.x = pk(zg[0], zg[1]); a.y = pk(zg[2], zg[3]); *(u32x2*)zp = a;
                        u32x2 d; d.x = pk(zv[0], zv[1]); d.y = pk(zv[2], zv[3]); *(u32x2*)(zp + DFF) = d;
                    }
                    pg = zg; pv = zv;
                }
            }
        }
    }
};

__device__ __forceinline__ int win_dest_row(int col) {
    int ch, bj, n, t0;
    if (col < 512) { ch = col; bj = 1; n = 1; t0 = 16; }
    else if (col < 1536) { ch = col - 512; bj = 1; n = 1; t0 = 0; }
    else if (col < 3072) { const int s = (col - 1536) >> 9; ch = (col - 1536) & 511; bj = s >> 1; n = s & 1; t0 = 16; }
    else { const int gi = (col - 3072) >> 10; ch = (col - 3072) & 1023; bj = gi >> 1; n = gi & 1; t0 = 0; }
    const int k = t0 + (ch >> 6), r = ch & 63;
    return 256 * k + 128 * bj + 32 * (r >> 4) + 8 * ((r >> 2) & 3) + 4 * n + (r & 3);
}
__device__ __forceinline__ void transpose_tile(const float* __restrict__ W, int N, const float* __restrict__ g, bf16_t* __restrict__ Wt, int ldt, int koff, int k0, int n0, int nd0, float* tile, int tid, bool winmap = false) {
    {
        const int kk = tid >> 4, nn = (tid & 15) * 4;
#pragma unroll
        for (int h = 0; h < 2; ++h) {
            const int k = kk + h * 32;
            f32x4 v = *(const f32x4*)(W + (size_t)(k0 + k) * N + n0 + nn);
            const float s = g ? g[k0 + k] : 1.0f;
            tile[k * 65 + nn + 0] = v[0] * s; tile[k * 65 + nn + 1] = v[1] * s; tile[k * 65 + nn + 2] = v[2] * s; tile[k * 65 + nn + 3] = v[3] * s;
        }
    }
    __syncthreads();
    {
        const int n = tid >> 3, kq = (tid & 7) * 8;
        float v[8];
#pragma unroll
        for (int j = 0; j < 8; ++j) v[j] = tile[(kq + j) * 65 + n];
        u32x4 w; w.x = pk(v[0], v[1]); w.y = pk(v[2], v[3]); w.z = pk(v[4], v[5]); w.w = pk(v[6], v[7]);
        *(u32x4*)(Wt + (size_t)(winmap ? win_dest_row(n0 + n) : nd0 + n) * ldt + koff + k0 + kq) = w;
    }
    __syncthreads();
}

__device__ __forceinline__ void prep_phase(const Params& p, int l, float* ldsf) {
    unsigned char* ws = p.ws;
    bf16_t* wt_in = (bf16_t*)(ws + WS_WIN); bf16_t* wt_br = (bf16_t*)(ws + WS_WBR); bf16_t* wt_o = (bf16_t*)(ws + WS_WO);
    bf16_t* wt_up = (bf16_t*)(ws + WS_WUP); bf16_t* wt_dn = (bf16_t*)(ws + WS_WDN);
    const float* g_mix = p.in[1] + (size_t)l * DM; const float* w_in = p.in[2] + (size_t)l * DM * NIN;
    const float* w_pool = p.in[3] + (size_t)l * 4 * 128 * 128; const float* pscale = p.in[4] + (size_t)l * 512;
    const float* w_ba = p.in[9] + (size_t)l * 512 * DM; const float* w_bb = p.in[10] + (size_t)l * 512 * DM; const float* w_bc = p.in[11] + (size_t)l * 512 * DM;
    const float* w_o = p.in[12] + (size_t)l * DM * DM; const float* g_ffn = p.in[13] + (size_t)l * DM;
    const float* w_up = p.in[14] + (size_t)l * DM * NUP; const float* w_dn = p.in[17] + (size_t)l * DFF * DM;
    const int tid = otid(), bid = obid();
    constexpr int T0 = 16 * 96, T1 = T0 + 128, T2 = T1 + 128, T3 = T2 + 256, T4 = T3 + 16 * 88, T5 = T4 + 44 * 16;
    for (int i = bid; i < T5; i += gridDim.x) {
        if (i < T0) { const int kt = i & 15, nt = i >> 4; transpose_tile(w_in, NIN, g_mix, wt_in, DM, 0, kt * 64, nt * 64, nt * 64, ldsf, tid, true); }
        else if (i < T1) { const int j = i - T0, kt = j & 7, nt = j >> 3; transpose_tile(w_bb, DM, nullptr, wt_br, NBR, 512, kt * 64, nt * 64, nt * 64, ldsf, tid); }
        else if (i < T2) { const int j = i - T1, kt = j & 7, nt = j >> 3; transpose_tile(w_bc, DM, nullptr, wt_br, NBR, 1024, kt * 64, nt * 64, nt * 64, ldsf, tid); }
        else if (i < T3) { const int j = i - T2, kt = j & 15, nt = j >> 4; transpose_tile(w_o, DM, nullptr, wt_o, DM, 0, kt * 64, nt * 64, nt * 64, ldsf, tid); }
        else if (i < T4) { const int j = i - T3, kt = j & 15, nt = j >> 4; const int n0 = nt * 64, bj = n0 / DFF, q0 = n0 - bj * DFF; transpose_tile(w_up, NUP, g_ffn, wt_up, DM, 0, kt * 64, n0, (q0 >> 7) * 256 + bj * 128 + (q0 & 127), ldsf, tid);   }
        else { const int j = i - T4, kt = j % 44, nt = j / 44; transpose_tile(w_dn, DM, nullptr, wt_dn, DFF, 0, kt * 64, nt * 64, nt * 64, ldsf, tid); }
    }
    {
        float* wpT = ldsf;
        float* wa = ldsf + 128 * 128;
        for (int it = (int)gridDim.x - 1 - bid; it < 64; it += gridDim.x) {
            const int g = it >> 4, n0 = (it & 15) * 64;
            for (int q = tid; q < 128 * 32; q += 512) {
                const int d = q >> 5, e4 = (q & 31) * 4;
                const f32x4 v = *(const f32x4*)(w_pool + ((size_t)g * 128 + d) * 128 + e4);
                const f32x4 s = *(const f32x4*)(pscale + g * 128 + e4);
                wpT[(e4 + 0) * 128 + d] = v[0] * s[0]; wpT[(e4 + 1) * 128 + d] = v[1] * s[1]; wpT[(e4 + 2) * 128 + d] = v[2] * s[2]; wpT[(e4 + 3) * 128 + d] = v[3] * s[3];
            }
            for (int q = tid; q < 128 * 16; q += 512) {
                const int e = q >> 4, c4 = (q & 15) * 4;
                *(f32x4*)(wa + e * 64 + c4) = *(const f32x4*)(w_ba + (size_t)(g * 128 + e) * DM + n0 + c4);
            }
            __syncthreads();
            const int d = tid & 127, ns = tid >> 7;
            float acc[16];
#pragma unroll
            for (int i = 0; i < 16; ++i) acc[i] = 0.f;
            for (int e = 0; e < 128; ++e) {
                const float w = wpT[e * 128 + d];
                const f32x4* wr4 = (const f32x4*)(wa + e * 64 + ns * 16);
#pragma unroll
                for (int c = 0; c < 4; ++c) { const f32x4 b = wr4[c]; acc[c * 4 + 0] += w * b[0]; acc[c * 4 + 1] += w * b[1]; acc[c * 4 + 2] += w * b[2]; acc[c * 4 + 3] += w * b[3]; }
            }
#pragma unroll
            for (int i = 0; i < 16; ++i) wt_br[(size_t)(n0 + ns * 16 + i) * NBR + g * 128 + d] = (bf16_t)(pk(acc[i], 0.f) & 0xffffu);
            __syncthreads();
        }
    }
    if (l == 0) {
        const float* x = p.in[0]; bf16_t* xb = (bf16_t*)(ws + WS_XB); float* ssq = (float*)(ws + WS_SSQ);
        const int lane = tid & 63, wave = tid >> 6;
        for (int r = bid * 8 + wave; r < MTOK; r += gridDim.x * 8) {
            float sq = 0.f;
#pragma unroll
            for (int i = 0; i < 4; ++i) {
                const f32x4 v = *(const f32x4*)(x + (size_t)r * DM + i * 256 + lane * 4);
                sq += (v[0] * v[0] + v[1] * v[1]) + (v[2] * v[2] + v[3] * v[3]);
                u32x2 w; w.x = pk(v[0], v[1]); w.y = pk(v[2], v[3]);
                *(u32x2*)(xb + (size_t)r * DM + i * 256 + lane * 4) = w;
            }
#pragma unroll
            for (int o = 32; o >= 1; o >>= 1) sq += __shfl_xor(sq, o);
            if (lane < 16) ssq[(size_t)r * 16 + lane] = (lane == 0) ? sq : 0.f;
        }
    }
}
__device__ __forceinline__ void ld8(const bf16_t* p, float (&v)[8]) {
    const u32x4 w = *(const u32x4*)p;
    v[0] = bflo(w.x); v[1] = bfhi(w.x); v[2] = bflo(w.y); v[3] = bfhi(w.y); v[4] = bflo(w.z); v[5] = bfhi(w.z); v[6] = bflo(w.w); v[7] = bfhi(w.w);
}
__device__ __forceinline__ void st8(bf16_t* p, const float (&v)[8]) {
    u32x4 w; w.x = pk(v[0], v[1]); w.y = pk(v[2], v[3]); w.z = pk(v[4], v[5]); w.w = pk(v[6], v[7]);
    *(u32x4*)p = w;
}
template <int W> __device__ __forceinline__ void pool_rows(const bf16_t* __restrict__ ap, bf16_t* __restrict__ yp, int r0, int pos0) {
#pragma unroll
    for (int b = 0; b < 4; ++b) {
        const int base = r0 + 4 * b;
        u32x4 h[W + 3];
#pragma unroll
        for (int i = 0; i < W + 3; ++i) { const int rr = base - (W - 1) + i; h[i] = (pos0 + rr >= 0) ? *(const u32x4*)(ap + (ptrdiff_t)rr * NPA2) : (u32x4){0u, 0u, 0u, 0u}; }
        float s[8];
#pragma unroll
        for (int j = 0; j < 8; ++j) s[j] = 0.f;
#pragma unroll
        for (int i = 0; i < W - 1; ++i) { const u32x4 q = h[i];
            s[0] += bflo(q.x); s[1] += bfhi(q.x); s[2] += bflo(q.y); s[3] += bfhi(q.y); s[4] += bflo(q.z); s[5] += bfhi(q.z); s[6] += bflo(q.w); s[7] += bfhi(q.w); }
#pragma unroll
        for (int i = 0; i < 4; ++i) {
            const int rr = base + i, pos = pos0 + rr; const float inv = 1.0f / (float)(pos + 1 < W ? pos + 1 : W);
            const u32x4 q = h[W - 1 + i], od = h[i];
            const float v[8] = {bflo(q.x), bfhi(q.x), bflo(q.y), bfhi(q.y), bflo(q.z), bfhi(q.z), bflo(q.w), bfhi(q.w)};
            float o[8];
#pragma unroll
            for (int j = 0; j < 8; ++j) { s[j] += v[j]; o[j] = s[j] * inv - v[j]; }
            st8(yp + (size_t)rr * NBR, o);
            s[0] -= bflo(od.x); s[1] -= bfhi(od.x); s[2] -= bflo(od.y); s[3] -= bfhi(od.y); s[4] -= bflo(od.z); s[5] -= bfhi(od.z); s[6] -= bflo(od.w); s[7] -= bfhi(od.w);
        }
        asm volatile("" ::: "memory");
    }
}
constexpr int VT_PITCH = 136;
__device__ __forceinline__ void mixer_phase(const Params& p, int l, unsigned char* lds) {
    const bf16_t* PA = (const bf16_t*)(p.ws + WS_B1);
    bf16_t* Y = (bf16_t*)p.out;
    const float* g_sgu = p.in[5] + (size_t)l * 512;
    const float* w_sp = p.in[6] + (size_t)l * 4 * 128 * 128;
    const float* b_sp = p.in[7] + (size_t)l * 4 * 128;
    const float* conv_c = p.in[8] + (size_t)l * 3 * 512;
    float* rs = (float*)lds;
    bf16_t* vT = (bf16_t*)(lds + 1024);
    const int tid = otid(), lane = tid & 63, wave = __builtin_amdgcn_readfirstlane(tid >> 6), fr = lane & 15, fq = lane >> 4;
    for (int item = obid(); item < MTOK / 128; item += gridDim.x) {
        const int t0 = item * 128, pos0 = t0 & (SEQ - 1);
        {
            const int row = tid >> 2, q = tid & 3;
            const bf16_t* vp = PA + (size_t)(t0 + row) * NPA2 + 1024 + q * 128;
            float sq = 0.f;
#pragma unroll
            for (int i = 0; i < 16; ++i) { float v[8]; ld8(vp + i * 8, v);
#pragma unroll
                for (int j = 0; j < 8; ++j) sq += v[j] * v[j]; }
            sq += __shfl_xor(sq, 1); sq += __shfl_xor(sq, 2);
            if (q == 0) rs[row] = rsqrtf(sq * (1.0f / 512.0f) + EPS);
        }
        {
            const int grp = wave & 3;
            const int c8 = (grp * 16 + (lane & 15)) * 8; int r0 = ((wave >> 2) * 4 + (lane >> 4)) * 16;
            asm volatile("" : "+v"(r0));
            {
                const bf16_t* ap = PA + (size_t)t0 * NPA2 + c8;
                bf16_t* yp = Y + (size_t)t0 * NBR + c8;
                if (grp == 0) pool_rows<2>(ap, yp, r0, pos0); else if (grp == 1) pool_rows<4>(ap, yp, r0, pos0); else if (grp == 2) pool_rows<8>(ap, yp, r0, pos0); else pool_rows<16>(ap, yp, r0, pos0);
            }
        }
        if (tid < 256) {
            const bf16_t* sc = (const bf16_t*)(p.ws + WS_SC); const bf16_t* scb = (const bf16_t*)(p.ws + WS_SCB);
            const int b_ = tid >> 7, ri = (tid >> 6) & 1, c8 = (tid & 63) * 8;
            const int blk = (t0 >> 6) + b_;
            const bool first = ((blk * 64) & (SEQ - 1)) == 0;
            float z2[8], z1[8], z0[8], cbv[8], o[8];
#pragma unroll
            for (int j = 0; j < 8; ++j) { z2[j] = 0.f; z1[j] = 0.f; }
            const bf16_t* own = sc + (size_t)blk * 4 * 512 + c8;
            if (ri == 0) { if (!first) { ld8(own - 4 * 512, z2); ld8(own - 3 * 512, z1); } ld8(own + 2 * 512, z0); }
            else { if (!first) ld8(own - 3 * 512, z2); ld8(own + 2 * 512, z1); ld8(own + 3 * 512, z0); }
            ld8(scb + ((size_t)blk * 2 + ri) * 512 + c8, cbv);
#pragma unroll
            for (int j = 0; j < 8; ++j) o[j] = cbv[j] * (conv_c[c8 + j] * z2[j] + conv_c[512 + c8 + j] * z1[j] + conv_c[1024 + c8 + j] * z0[j]);
            st8(Y + (size_t)(blk * 64 + ri) * NBR + 1024 + c8, o);
        }
#pragma unroll 1
        for (int g = 0; g < 4; ++g) {
            const int t = wave * 16 + fr;
            const int nk = (wave >> 1) + 1;
            f32x4 wq[4][2];
#pragma unroll
            for (int k = 0; k < 4; ++k) { const float* wp = w_sp + ((size_t)g * 128 + t) * 128 + k * 32 + fq * 8; wq[k][0] = *(const f32x4*)wp; wq[k][1] = *(const f32x4*)(wp + 4); }
            const bf16_t* up = PA + (size_t)(t0 + t) * NPA2 + 512 + g * 128 + 4 * fq;
            u32x2 uu[8];
#pragma unroll
            for (int n = 0; n < 8; ++n) uu[n] = *(const u32x2*)(up + n * 16);
            const float bias = b_sp[g * 128 + t];
            u32x4 vq[4];
            const int s_ = tid >> 2, dq = (tid & 3) * 32;
            {
                const bf16_t* vp = PA + (size_t)(t0 + s_) * NPA2 + 1024 + g * 128 + dq;
#pragma unroll
                for (int i = 0; i < 4; ++i) vq[i] = *(const u32x4*)(vp + i * 8);
            }
            __syncthreads();
#pragma unroll
            for (int i = 0; i < 4; ++i) {
                const unsigned ww[4] = {vq[i].x, vq[i].y, vq[i].z, vq[i].w};
#pragma unroll
                for (int q = 0; q < 4; ++q) { vT[(dq + i * 8 + q * 2) * VT_PITCH + s_] = (bf16_t)(ww[q] & 0xffffu); vT[(dq + i * 8 + q * 2 + 1) * VT_PITCH + s_] = (bf16_t)(ww[q] >> 16); }
            }
            __syncthreads();
            f32x4 acc[8];
#pragma unroll
            for (int n = 0; n < 8; ++n) acc[n] = (f32x4){0.f, 0.f, 0.f, 0.f};
#pragma unroll
            for (int k = 0; k < 4; ++k) if (k < nk) {
                const int s0 = k * 32 + fq * 8;
                const f32x4 wa = wq[k][0], wb = wq[k][1];
                const f32x4 ra = *(const f32x4*)(rs + s0), rb = *(const f32x4*)(rs + s0 + 4);
                float a[8];
#pragma unroll
                for (int j = 0; j < 4; ++j) { a[j] = (s0 + j <= t) ? wa[j] * ra[j] : 0.f; a[4 + j] = (s0 + 4 + j <= t) ? wb[j] * rb[j] : 0.f; }
                union { u32x4 u; bf16x8 h; } af; af.u.x = pk(a[0], a[1]); af.u.y = pk(a[2], a[3]); af.u.z = pk(a[4], a[5]); af.u.w = pk(a[6], a[7]);
#pragma unroll
                for (int n = 0; n < 8; ++n) {
                    const bf16x8 bfrag = *(const bf16x8*)(vT + (n * 16 + fr) * VT_PITCH + s0);
                    acc[n] = __builtin_amdgcn_mfma_f32_16x16x32_bf16(bfrag, af.h, acc[n], 0, 0, 0);
                }
            }
            bf16_t* yp = Y + (size_t)(t0 + t) * NBR + 512 + g * 128 + 4 * fq;
#pragma unroll
            for (int n = 0; n < 8; ++n) {
                const f32x4 gs = *(const f32x4*)(g_sgu + g * 128 + n * 16 + 4 * fq);
                const float o0 = bflo(uu[n].x) * (acc[n][0] * gs[0] + bias), o1 = bfhi(uu[n].x) * (acc[n][1] * gs[1] + bias);
                const float o2 = bflo(uu[n].y) * (acc[n][2] * gs[2] + bias), o3 = bfhi(uu[n].y) * (acc[n][3] * gs[3] + bias);
                u32x2 w; w.x = pk(o0, o1); w.y = pk(o2, o3);
                *(u32x2*)(yp + n * 16) = w;
            }
        }
        __syncthreads();
    }
}

__device__ __forceinline__ void ffn_fixup_phase(const Params& p, int l) {
    const bf16_t* zs = (const bf16_t*)(p.ws + WS_B2);
    bf16_t* act = (bf16_t*)(p.ws + WS_B1);
    const float* cw = p.in[15] + (size_t)l * 3 * NUP; const float* cb = p.in[16] + (size_t)l * NUP;
    constexpr int NCG = DFF / 8, NU = (MTOK / 64) * NCG;
    for (int u = obid() * 512 + otid(); u < NU; u += gridDim.x * 512) {
        const int blk = u / NCG, c8 = (u - blk * NCG) * 8;
        const bool first = ((blk * 64) & (SEQ - 1)) == 0;
        float g2[8], g1[8], ga[8], gb2[8], v2[8], v1[8], va[8], vb2[8];
#pragma unroll
        for (int j = 0; j < 8; ++j) { g2[j] = g1[j] = v2[j] = v1[j] = 0.f; }
        const bf16_t* own = zs + (size_t)blk * 4 * NUP + c8;
        if (!first) { const bf16_t* prv = own - 4 * (ptrdiff_t)NUP; ld8(prv, g2); ld8(prv + NUP, g1); ld8(prv + DFF, v2); ld8(prv + NUP + DFF, v1); }
        ld8(own + 2 * NUP, ga); ld8(own + 3 * NUP, gb2); ld8(own + 2 * NUP + DFF, va); ld8(own + 3 * NUP + DFF, vb2);
        float o0[8], o1[8];
#pragma unroll
        for (int j = 0; j < 8; ++j) {
            const float w0 = cw[c8 + j], w1 = cw[NUP + c8 + j], w2 = cw[2 * NUP + c8 + j], bb = cb[c8 + j];
            const float x0 = cw[DFF + c8 + j], x1 = cw[NUP + DFF + c8 + j], x2 = cw[2 * NUP + DFF + c8 + j], xb_ = cb[DFF + c8 + j];
            const float gg0 = w0 * g2[j] + w1 * g1[j] + w2 * ga[j] + bb, vv0 = x0 * v2[j] + x1 * v1[j] + x2 * va[j] + xb_;
            const float gg1 = w0 * g1[j] + w1 * ga[j] + w2 * gb2[j] + bb, vv1 = x0 * v1[j] + x1 * va[j] + x2 * vb2[j] + xb_;
            o0[j] = silu_f(gg0) * vv0; o1[j] = silu_f(gg1) * vv1;
        }
        st8(act + (size_t)(blk * 64) * DFF + c8, o0); st8(act + (size_t)(blk * 64 + 1) * DFF + c8, o1);
    }
}

__device__ __forceinline__ void final_norm_phase(const Params& p) {
    const float* gf = p.in[18]; const float* ssq = (const float*)(p.ws + WS_SSQ); const bf16_t* xb = (const bf16_t*)(p.ws + WS_XB); float* out = p.out;
    const int tid = otid(), lane = tid & 63, wave = tid >> 6;
    for (int r = obid() * 8 + wave; r < MTOK; r += gridDim.x * 8) {
        const float rs = row_rstd(ssq, r);
#pragma unroll
        for (int i = 0; i < 2; ++i) {
            const int c = i * 512 + lane * 8;
            float v[8]; ld8(xb + (size_t)r * DM + c, v);
            const f32x4 g0 = *(const f32x4*)(gf + c), g1 = *(const f32x4*)(gf + c + 4);
            f32x4 o0, o1;
#pragma unroll
            for (int j = 0; j < 4; ++j) { o0[j] = v[j] * rs * g0[j]; o1[j] = v[4 + j] * rs * g1[j]; }
            float* q = out + (size_t)r * DM + c;
            __builtin_nontemporal_store(o0, (f32x4*)q); __builtin_nontemporal_store(o1, (f32x4*)(q + 4));
        }
    }
}

template <class Epi> __device__ __forceinline__ void run_gemm(unsigned char* lds, const bf16_t* A, const bf16_t* Bt, int M, int N, int K, const Epi& E, int stagger_step = 0) {
    pg8::Gemm g{A, Bt, M, N, K}; pg8::StaticOrder S; S.init(M, N, (int)gridDim.x, obid());
    if (stagger_step) {
        const unsigned long long t0 = wall_clock64(), d = (unsigned long long)(((obid() >> 3) & 7) * stagger_step);
        while (wall_clock64() - t0 < d) __builtin_amdgcn_s_sleep(16);
    }
    pg8::gemm_phase<Epi, pg8::StaticOrder, false>((PG8_LAS unsigned char*)lds, g, S, E, nullptr);
}

#define XB_TMO      128
#define XB_XCNT(j)  (256  + 64 * (j))
#define XB_XSUB(j)  (1280 + 64 * (j))
#define XB_XGEN(j)  (2304 + 64 * (j))
#define XB_TOP      3328
#define XB_TOPGEN   3392
#define XCD_BAR_WORDS 3456
#define XB_SPIN_CAP (1u << 18)

__device__ __forceinline__ unsigned xb_ld(unsigned* p)              { return __hip_atomic_load(p, __ATOMIC_RELAXED, __HIP_MEMORY_SCOPE_AGENT); }
__device__ __forceinline__ unsigned xb_add(unsigned* p, unsigned v) { return __hip_atomic_fetch_add(p, v, __ATOMIC_RELAXED, __HIP_MEMORY_SCOPE_AGENT); }
__device__ __forceinline__ unsigned xb_xcc_id() { return (unsigned)__builtin_amdgcn_s_getreg((3 << 11) | 20) & 0xFu; }
#define XB_SPIN(cond, bar) do { unsigned _sp = 0; while (cond) { __builtin_amdgcn_s_sleep(1); \
    if ((++_sp & 255u) == 0u) { if (xb_ld(&(bar)[XB_TMO])) break; if (_sp > XB_SPIN_CAP) { atomicAdd(&(bar)[XB_TMO], 1u); break; } } } } while (0)

struct XcdBarrier {
    unsigned* bar; unsigned x;
    volatile LAS unsigned* st;
};

__device__ __forceinline__ XcdBarrier xcd_barrier_post(unsigned* bar, volatile LAS unsigned* st) {
    XcdBarrier b; b.bar = bar; b.x = xb_xcc_id(); b.st = st;
    if (threadIdx.x == 0) (void)xb_add(&bar[XB_XCNT(b.x)], 1u);
    return b;
}
__device__ __forceinline__ void xcd_barrier_complete(unsigned* bar, unsigned x, unsigned& nloc, unsigned& nx) {
    const unsigned G = gridDim.x * gridDim.y * gridDim.z;
    unsigned sum, cnt, mine, sp = 0u;
    for (;;) {
        sum = 0u; cnt = 0u; mine = 0u;
#pragma unroll
        for (unsigned j = 0; j < 16; ++j) { const unsigned c = xb_ld(&bar[XB_XCNT(j)]); sum += c; cnt += (c > 0u) ? 1u : 0u; mine = (j == x) ? c : mine; }
        if (sum == G) break;
        __builtin_amdgcn_s_sleep(1);
        if ((++sp & 255u) == 0u) { if (xb_ld(&bar[XB_TMO])) break; if (sp > XB_SPIN_CAP) { atomicAdd(&bar[XB_TMO], 1u); break; } }
    }
    nloc = mine > 0u ? mine : 1u; nx = cnt > 0u ? cnt : 1u;
}

__device__ __forceinline__ void xcd_barrier(const XcdBarrier& b) {
    asm volatile("s_waitcnt vmcnt(0)" ::: "memory");
    __syncthreads();
    if (threadIdx.x == 0) {
        unsigned* bar = b.bar;
        __builtin_amdgcn_s_waitcnt(0);
        unsigned nloc = b.st[0], nx = b.st[1];
        if (nloc == 0u) { xcd_barrier_complete(bar, b.x, nloc, nx); b.st[0] = nloc; b.st[1] = nx; }
        const unsigned old = xb_add(&bar[XB_XSUB(b.x)], 1u);
        const unsigned gen = old / nloc;
        if (old + 1u == (gen + 1u) * nloc) {
            __builtin_amdgcn_fence(__ATOMIC_RELEASE, "agent");
            asm volatile("s_waitcnt vmcnt(0)" ::: "memory");
            const unsigned og = xb_add(&bar[XB_TOP], 1u);
            const unsigned tg = og / nx;
            if (og + 1u == (tg + 1u) * nx) xb_add(&bar[XB_TOPGEN], 1u);
            else XB_SPIN(xb_ld(&bar[XB_TOPGEN]) == tg, bar);
            __builtin_amdgcn_fence(__ATOMIC_ACQUIRE, "agent");
            xb_add(&bar[XB_XGEN(b.x)], 1u);
            asm volatile("s_waitcnt vmcnt(0)" ::: "memory");
        } else {
            XB_SPIN(xb_ld(&bar[XB_XGEN(b.x)]) == gen, bar);
            __builtin_amdgcn_fence(__ATOMIC_ACQUIRE, "agent");
            asm volatile("s_waitcnt vmcnt(0)" ::: "memory");
        }
    }
    __syncthreads();
}

typedef const Params __attribute__((address_space(4)))* ParamsK;
__device__ __forceinline__ Params fresh_params() {
    ParamsK q = (ParamsK)__builtin_amdgcn_kernarg_segment_ptr();
    asm volatile("" : "+s"(q));
    Params r;
#pragma unroll
    for (int i = 0; i < 19; ++i) r.in[i] = q->in[i];
    r.out = q->out; r.ws = q->ws;
    return r;
}
constexpr int LDS_TOTAL = pg8::STAGE_BYTES + 256;
__global__ void __launch_bounds__(512, 2) fwd_megakernel(Params p_unused) {
    extern __shared__ __attribute__((aligned(16))) unsigned char lds[];
    cg::grid_group grid = cg::this_grid();
    volatile LAS unsigned* st = (volatile LAS unsigned*)((LAS unsigned char*)lds + pg8::STAGE_BYTES);
    unsigned* bar;
    {
        const Params p = fresh_params(); bar = (unsigned*)(p.ws + WS_BAR);
        if (threadIdx.x < 4) st[threadIdx.x] = 0u;
        if (blockIdx.x == 0) for (int i = threadIdx.x; i < XCD_BAR_WORDS; i += 512) bar[i] = 0u;
        __syncthreads();
    }
#define WSP(off) ((bf16_t*)(p.ws + (off)))
#define GRID_BAR() do { XcdBarrier b_; b_.bar = (unsigned*)(fresh_params().ws + WS_BAR); b_.x = xb_xcc_id(); b_.st = (volatile LAS unsigned*)((LAS unsigned char*)lds + pg8::STAGE_BYTES); xcd_barrier(b_); } while (0)
    for (int l = 0; l < 2; ++l) {
        { const Params p = fresh_params(); prep_phase(p, l, (float*)lds); }
        if (l == 0) { grid.sync(); (void)xcd_barrier_post((unsigned*)(fresh_params().ws + WS_BAR), (volatile LAS unsigned*)((LAS unsigned char*)lds + pg8::STAGE_BYTES)); }
        else GRID_BAR();
        { const Params p = fresh_params(); EpiIn E{WSP(WS_B1), WSP(WS_B2), (const float*)(p.ws + WS_SSQ), (bf16_t*)p.out, WSP(WS_SC), WSP(WS_SCB), p.in[8] + (size_t)l * 3 * 512}; run_gemm(lds, WSP(WS_XB), WSP(WS_WIN), MTOK, NIN, DM, E); }
        GRID_BAR();
        { const Params p = fresh_params(); mixer_phase(p, l, lds); }
        GRID_BAR();
        { const Params p = fresh_params(); EpiBr E{WSP(WS_B2), WSP(WS_B1)}; run_gemm(lds, (const bf16_t*)p.out  , WSP(WS_WBR), MTOK, DM, NBR, E); }
        GRID_BAR();
        { const Params p = fresh_params(); EpiRes E{WSP(WS_XB), (float*)(p.ws + WS_SSQ)}; run_gemm(lds, WSP(WS_B1), WSP(WS_WO), MTOK, DM, DM, E); }
        GRID_BAR();
        { const Params p = fresh_params(); EpiUp E{WSP(WS_B1), WSP(WS_B2), (const float*)(p.ws + WS_SSQ), p.in[15] + (size_t)l * 3 * NUP, p.in[16] + (size_t)l * NUP}; run_gemm(lds, WSP(WS_XB), WSP(WS_WUP), MTOK, NUP, DM, E); }
        GRID_BAR();
        { const Params p = fresh_params(); ffn_fixup_phase(p, l); }
        GRID_BAR();
        { const Params p = fresh_params(); EpiRes E{WSP(WS_XB), (float*)(p.ws + WS_SSQ)}; run_gemm(lds, WSP(WS_B1), WSP(WS_WDN), MTOK, DM, DFF, E); }
        GRID_BAR();
    }
    { const Params p = fresh_params(); final_norm_phase(p); }
#undef WSP
#undef GRID_BAR
}

extern "C" void kernel_launch(void* const* d_in, const int* in_sizes, int n_in, void* d_out, int out_size, void* d_ws, size_t ws_size, hipStream_t stream) {
    constexpr size_t kLds = LDS_TOTAL;
    static int grid_blocks = 0;
    if (!grid_blocks) {
        int dev = 0, cus = 0, per_cu = 0;
        (void)hipGetDevice(&dev);
        (void)hipDeviceGetAttribute(&cus, hipDeviceAttributeMultiprocessorCount, dev);
        (void)hipFuncSetAttribute((const void*)fwd_megakernel, hipFuncAttributeMaxDynamicSharedMemorySize, (int)kLds);
        (void)hipOccupancyMaxActiveBlocksPerMultiprocessor(&per_cu, (const void*)fwd_megakernel, 512, kLds);
        if (per_cu < 1) per_cu = 1;
        grid_blocks = cus;
        if (ws_size < WS_TOTAL || n_in != 19 || out_size != MTOK * DM) { fprintf(stderr, "kernel_launch: unexpected sizes: ws %zu (need %zu), n_in %d, out %d\n", ws_size, (size_t)WS_END, n_in, out_size); }
    }
    Params p{};
    for (int i = 0; i < 19; ++i) p.in[i] = (const float*)d_in[i];
    p.out = (float*)d_out; p.ws = (unsigned char*)d_ws;
    void* args[] = {&p};
    hipError_t e = hipLaunchCooperativeKernel((void*)fwd_megakernel, dim3(grid_blocks), dim3(512), args, kLds, stream);
    if (e != hipSuccess) fprintf(stderr, "cooperative launch failed: %s (grid %d)\n", hipGetErrorString(e), grid_blocks);
}
```

```cpp
#include <hip/hip_runtime.h>
#include <hip/hip_cooperative_groups.h>
#include <cstdio>
namespace cg = cooperative_groups;
namespace pg8 {
#define PG8_LAS __attribute__((address_space(3)))
typedef unsigned short bf16_t;
typedef short bf16x8 __attribute__((ext_vector_type(8)));
typedef float f32x4 __attribute__((ext_vector_type(4)));
typedef unsigned u32x4 __attribute__((ext_vector_type(4)));
constexpr int BM = 256, BK = 64, HALF = 128, HTB = HALF * BK * 2  , STAGE_BYTES = 8 * HTB, NXCD = 8, WGM = 8;

__host__ __device__ __forceinline__ int lds_byte(int r, int c) { const int st = (r >> 4) * 2 + (c >> 5), rr = r & 15, cc = c & 31, ob = rr * 64 + cc * 2; return st * 1024 + (ob ^ (((ob >> 9) & 1) << 5)); }
__host__ __device__ __forceinline__ void stage_rc(int b, int& R, int& C) { const int st = b / 1024, sb = b % 1024, swz = sb ^ (((sb >> 9) & 1) << 5); R = (st >> 1) * 16 + swz / 64; C = (st & 1) * 32 + (swz % 64) / 2; }
__host__ __device__ __forceinline__ int perm32(int rho) { const int n = rho >> 4, i = rho & 15; return 8 * (i >> 2) + 4 * n + (i & 3); }

struct Unit { int pm, pn; };
struct Gemm { const bf16_t* A; const bf16_t* Bt; int M, N, K; };

struct StaticOrder {
    int nM, nN, nwg, G, c;
    __host__ __device__ void init(int M, int N, int G_, int c_) { nM = M / BM; nN = N / BM; nwg = nM * nN; G = G_; c = c_; }
    __host__ __device__ bool next(int i, Unit& u) const {
        const long L = (long)i * G + c; if (L >= nwg) return false;
        int wgid = (int)L; { const int q = nwg / NXCD, r = nwg % NXCD, xcd = wgid % NXCD, off = wgid / NXCD; wgid = (xcd < r ? xcd * (q + 1) : r * (q + 1) + (xcd - r) * q) + off; }
        const int nig = WGM * nN, gid = wgid / nig, fm = gid * WGM, gsz = (nM - fm) < WGM ? (nM - fm) : WGM;
        u.pm = fm + ((wgid % nig) % gsz); u.pn = (wgid % nig) / gsz; return true;
    }
    __device__ __forceinline__ void a_ready(const Unit&) const {}
    __device__ __forceinline__ void done(const Unit&) const {}
};
__device__ __forceinline__ unsigned cvt_pk_bf16(float lo, float hi) { unsigned r; asm volatile("v_cvt_pk_bf16_f32 %0, %1, %2" : "=v"(r) : "v"(lo), "v"(hi)); return r; }

template <class Epi, class Sched, bool STAMP = false>
__device__ __forceinline__ void gemm_phase(PG8_LAS unsigned char* lds, const Gemm g, const Sched& S, const Epi& E, unsigned long long* stamps) {
    int tid_ = threadIdx.x; asm volatile("" : "+v"(tid_));
    const int tid = tid_, wid = __builtin_amdgcn_readfirstlane(tid >> 6), lane = tid & 63, wr = wid >> 2, wc = wid & 3, fr = lane & 15, fq = lane >> 4;
    const int K = g.K, nt = K / BK;
    int ts_lo = 0, ts_hi = 0, nts = 0; const unsigned long long rt_entry = STAMP ? (unsigned long long)wall_clock64() : 0ull;
#define PG8_STAMP() do { if (STAMP && wid == 0 && nts < 64) { const unsigned long long _c = (unsigned long long)clock64(); \
        ts_lo = (lane == nts) ? (int)(unsigned)_c : ts_lo; ts_hi = (lane == nts) ? (int)(unsigned)(_c >> 32) : ts_hi; ++nts; } } while (0)
    PG8_STAMP();
    unsigned voffA[2], voffB[2];
#pragma unroll
    for (int i = 0; i < 2; ++i) { int R, C; stage_rc(tid * 16 + i * 8192, R, C); const int Rb = Epi::PERM ? ((R & ~31) + perm32(R & 31)) : R;
        voffA[i] = (unsigned)(R * K + C) * 2u; voffB[i] = (unsigned)(Rb * K + C) * 2u; }
    const size_t kstep = (size_t)(BK * 2);
    const size_t hstep = (size_t)HALF * K * 2;
    const size_t tstep = 2 * hstep;
    const unsigned ldsw = (unsigned)wid * 1024u;
    const int aoff = lds_byte(wr * 64 + fr, fq * 8), boff = lds_byte(wc * 32 + fr, fq * 8);
#define PG8_SA(b, h) (((b) * 2 + (h)) * HTB)
#define PG8_SB(b, h) ((4 + (b) * 2 + (h)) * HTB)
#define PG8_STAGE(bufoff, gbase, voff) do { _Pragma("unroll") for (int _i = 0; _i < 2; ++_i) \
        __builtin_amdgcn_global_load_lds((const unsigned*)((const char*)(gbase) + (voff)[_i]), (PG8_LAS unsigned*)(lds + (bufoff) + ldsw + _i * 8192), 16, 0, 0); } while (0)
#define PG8_LDA(dst, b, h) do { _Pragma("unroll") for (int m = 0; m < 4; ++m) _Pragma("unroll") for (int k = 0; k < 2; ++k) dst[m][k] = *(const PG8_LAS bf16x8*)(lds + PG8_SA(b, h) + aoff + m * 2048 + k * 1024); } while (0)
#define PG8_LDB(dst, b, h) do { _Pragma("unroll") for (int n = 0; n < 2; ++n) _Pragma("unroll") for (int k = 0; k < 2; ++k) dst[n][k] = *(const PG8_LAS bf16x8*)(lds + PG8_SB(b, h) + boff + n * 2048 + k * 1024); } while (0)
#define PG8_MMA(ai, bj, At, Bt) do { __builtin_amdgcn_s_setprio(1); _Pragma("unroll") for (int m = 0; m < 4; ++m) _Pragma("unroll") for (int n = 0; n < 2; ++n) _Pragma("unroll") for (int k = 0; k < 2; ++k) \
        acc[ai][bj][m][n] = __builtin_amdgcn_mfma_f32_16x16x32_bf16(Bt[n][k], At[m][k], acc[ai][bj][m][n], 0, 0, 0); __builtin_amdgcn_s_setprio(0); } while (0)
#define PG8_WAIT_V(n) asm volatile("s_waitcnt vmcnt(" #n ")" ::: "memory")
#define PG8_WAIT_L(n) asm volatile("s_waitcnt lgkmcnt(" #n ")" ::: "memory")
#define PG8_BAR __builtin_amdgcn_s_barrier()
#define PG8_SCHED __builtin_amdgcn_sched_barrier(0)
    Unit cur, nxt; int ui = 0;
    if (!S.next(0, cur)) return;
    f32x4 acc[2][2][4][2];
#pragma unroll
    for (int a = 0; a < 2; ++a)
#pragma unroll
        for (int b = 0; b < 2; ++b)
#pragma unroll
            for (int m = 0; m < 4; ++m)
#pragma unroll
                for (int n = 0; n < 2; ++n) acc[a][b][m][n] = (f32x4){0.f, 0.f, 0.f, 0.f};
    bf16x8 At[4][2], B0[2][2], B1[2][2];
    const char* cA = (const char*)g.A + (size_t)cur.pm * tstep; const char* cB = (const char*)g.Bt + (size_t)cur.pn * tstep;
    S.a_ready(cur);
    PG8_STAGE(PG8_SB(0, 0), cB, voffB); PG8_STAGE(PG8_SA(0, 0), cA, voffA); PG8_STAGE(PG8_SB(0, 1), cB + hstep, voffB); PG8_STAGE(PG8_SA(0, 1), cA + hstep, voffA);
    if (wr == 1) PG8_BAR;
    PG8_WAIT_V(4); PG8_BAR;
    PG8_STAGE(PG8_SB(1, 0), cB + kstep, voffB); PG8_STAGE(PG8_SA(1, 0), cA + kstep, voffA); PG8_STAGE(PG8_SB(1, 1), cB + hstep + kstep, voffB);
    PG8_WAIT_V(6); PG8_BAR;
    PG8_STAMP();
    for (;;) {
        const bool has_next = S.next(ui + 1, nxt);
        const char* nA = has_next ? (const char*)g.A + (size_t)nxt.pm * tstep : cA; const char* nB = has_next ? (const char*)g.Bt + (size_t)nxt.pn * tstep : cB;
        for (int t = 0; t < nt; t += 2) {
            if constexpr (Epi::MIDK) { if (t == 8 || t == 16) E.mid(acc, cur, t, wr, wc, fr, fq); }
            const bool last = (t == nt - 2);
            const char* a1 = cA + (size_t)(t + 1) * kstep;
            const char* a2 = last ? nA : cA + (size_t)(t + 2) * kstep; const char* b2 = last ? nB : cB + (size_t)(t + 2) * kstep;
            const char* a3 = a2 + kstep; const char* b3 = b2 + kstep;
            if (last && has_next) S.a_ready(nxt);
            PG8_LDB(B0, 0, 0); PG8_SCHED; PG8_LDA(At, 0, 0); PG8_STAGE(PG8_SA(1, 1), a1 + hstep, voffA);
            PG8_WAIT_L(8); PG8_BAR; PG8_WAIT_L(0); PG8_MMA(0, 0, At, B0); PG8_BAR; PG8_SCHED;
            PG8_LDB(B1, 0, 1); PG8_STAGE(PG8_SB(0, 0), b2, voffB);
            PG8_BAR; PG8_WAIT_L(0); PG8_MMA(0, 1, At, B1); PG8_BAR;
            PG8_LDA(At, 0, 1); PG8_STAGE(PG8_SA(0, 0), a2, voffA);
            PG8_BAR; PG8_WAIT_L(0); PG8_MMA(1, 0, At, B0); PG8_BAR; PG8_SCHED;
            PG8_STAGE(PG8_SB(0, 1), b2 + hstep, voffB);
            PG8_WAIT_V(6); PG8_BAR; PG8_MMA(1, 1, At, B1); PG8_BAR;
            PG8_LDB(B0, 1, 0); PG8_SCHED; PG8_LDA(At, 1, 0); PG8_STAGE(PG8_SA(0, 1), a2 + hstep, voffA);
            PG8_WAIT_L(8); PG8_BAR; PG8_WAIT_L(0); PG8_MMA(0, 0, At, B0); PG8_BAR; PG8_SCHED;
            PG8_LDB(B1, 1, 1); PG8_STAGE(PG8_SB(1, 0), b3, voffB);
            PG8_BAR; PG8_WAIT_L(0); PG8_MMA(0, 1, At, B1); PG8_BAR;
            PG8_LDA(At, 1, 1); PG8_STAGE(PG8_SA(1, 0), a3, voffA);
            PG8_BAR; PG8_WAIT_L(0); PG8_MMA(1, 0, At, B0); PG8_BAR; PG8_SCHED;
            PG8_STAGE(PG8_SB(1, 1), b3 + hstep, voffB);
            PG8_WAIT_V(6); PG8_BAR; PG8_MMA(1, 1, At, B1); PG8_BAR;
        }
        PG8_STAMP();
        if constexpr (!Epi::AFTER_DRAIN) { E(acc, cur, wr, wc, fr, fq); S.done(cur); }
        PG8_STAMP();
        if (!has_next) break;
#pragma unroll
        for (int a = 0; a < 2; ++a)
#pragma unroll
            for (int b = 0; b < 2; ++b)
#pragma unroll
                for (int m = 0; m < 4; ++m)
#pragma unroll
                    for (int n = 0; n < 2; ++n) acc[a][b][m][n] = (f32x4){0.f, 0.f, 0.f, 0.f};
        cur = nxt; cA = nA; cB = nB; ++ui;
    }
    PG8_WAIT_V(0);
    if (wr == 0) PG8_BAR;
    PG8_BAR;
    if constexpr (Epi::AFTER_DRAIN) { E.fused(acc, cur, wr, wc, fr, fq, lds, wid, lane); S.done(cur); }
    PG8_STAMP();
    if (STAMP && wid == 0) { stamps[lane] = lane < nts ? (((unsigned long long)(unsigned)ts_hi << 32) | (unsigned)ts_lo) : 0ull;
        if (lane == 62) stamps[62] = rt_entry; if (lane == 63) stamps[63] = (unsigned long long)wall_clock64(); }
#undef PG8_STAMP
#undef PG8_SA
#undef PG8_SB
#undef PG8_STAGE
#undef PG8_LDA
#undef PG8_LDB
#undef PG8_MMA
#undef PG8_WAIT_V
#undef PG8_WAIT_L
#undef PG8_BAR
#undef PG8_SCHED
}
}
typedef pg8::bf16_t bf16_t;
typedef pg8::f32x4 f32x4;
typedef pg8::u32x4 u32x4;
typedef pg8::bf16x8 bf16x8;
typedef unsigned u32x2 __attribute__((ext_vector_type(2)));
#define LAS __attribute__((address_space(3)))
constexpr int MTOK = 65536, DM = 1024, NIN = 6144, DFF = 2816, NUP = 5632, SEQ = 8192, NBR = 1536, NPA = 3072;
constexpr int NPA2 = 1536;
constexpr int MH = MTOK / 2;
constexpr float EPS = 1e-6f;
constexpr size_t WS_WIN = 0;
constexpr size_t WS_WBR = WS_WIN + (size_t)NIN * DM * 2;
constexpr size_t WS_WO = WS_WBR + (size_t)DM * NBR * 2;
constexpr size_t WS_WUP = WS_WO + (size_t)DM * DM * 2;
constexpr size_t WS_WDN = WS_WUP + (size_t)NUP * DM * 2;
constexpr size_t WS_SSQ = WS_WDN + (size_t)DM * DFF * 2;
constexpr size_t WS_XB = WS_SSQ + (size_t)MTOK * 16 * 4;
constexpr size_t WS_B1 = WS_XB + (size_t)MTOK * NBR * 2;
constexpr size_t WS_B2 = WS_B1 + (size_t)MTOK * NPA * 2;
constexpr size_t WS_END = WS_B2 + (size_t)MTOK * NPA * 2;
constexpr size_t WS_BAR = WS_END;
constexpr size_t WS_SC = WS_BAR + 16384;
constexpr size_t WS_SCB = WS_SC + (size_t)(MTOK / 64) * 4 * 512 * 2;
constexpr size_t WS_TOTAL = WS_SCB + (size_t)(MTOK / 64) * 2 * 512 * 2;

__device__ __forceinline__ int otid() { int t = threadIdx.x; asm volatile("" : "+v"(t)); return t; }
__device__ __forceinline__ int obid() { int b = blockIdx.x; asm volatile("" : "+s"(b)); return b; }
struct Params {
    const float* in[19];
    float* out; unsigned char* ws;
};

__device__ __forceinline__ void st_nt16(void* p, u32x4 w) { __builtin_nontemporal_store(w, (u32x4*)p); }
__device__ __forceinline__ float bflo(unsigned w) { return __uint_as_float(w << 16); }
__device__ __forceinline__ float bfhi(unsigned w) { return __uint_as_float(w & 0xffff0000u); }
__device__ __forceinline__ unsigned pk(float a, float b) { return pg8::cvt_pk_bf16(a, b); }
__device__ __forceinline__ float fast_rcp(float x) { return __builtin_amdgcn_rcpf(x); }
__device__ __forceinline__ float gate_t2(float y) { return 1.0f + __builtin_amdgcn_exp2f(fminf(y, 43.28f)); }
__device__ __forceinline__ float gelu_tanh_f(float x) {
    const float z2 = 1.5957691216f * (x + 0.044715f * x * x * x);
    return x * fast_rcp(1.0f + __expf(-z2));
}
__device__ __forceinline__ float silu_f(float x) { return x * fast_rcp(1.0f + __expf(-x)); }
__device__ __forceinline__ float row_rstd(const float* ssq, int r) {
    const f32x4* p = (const f32x4*)(ssq + (size_t)r * 16);
    const f32x4 a = p[0], b = p[1], c = p[2], d = p[3];
    const float s = ((a[0] + a[1]) + (a[2] + a[3])) + ((b[0] + b[1]) + (b[2] + b[3])) + ((c[0] + c[1]) + (c[2] + c[3])) + ((d[0] + d[1]) + (d[2] + d[3]));
    return rsqrtf(s * (1.0f / 1024.0f) + EPS);
}

__device__ __forceinline__ void rows_rstd8(const float* ssq, int row0, int fq, float (&rs)[8]) {
    f32x4 v[8];
#pragma unroll
    for (int i = 0; i < 8; ++i) v[i] = *(const f32x4*)(ssq + (size_t)(row0 + (i >> 2) * 128 + (i & 3) * 16) * 16 + fq * 4);
#pragma unroll
    for (int i = 0; i < 8; ++i) {
        float s = (v[i][0] + v[i][1]) + (v[i][2] + v[i][3]);
        s += __shfl_xor(s, 16); s += __shfl_xor(s, 32);
        rs[i] = rsqrtf(s * (1.0f / 1024.0f) + EPS);
    }
}
__device__ __forceinline__ float dpp_ror1(float x) { return __int_as_float(__builtin_amdgcn_mov_dpp(__float_as_int(x), 0x121, 0xf, 0xf, true)); }
__device__ __forceinline__ float dpp_ror2(float x) { return __int_as_float(__builtin_amdgcn_mov_dpp(__float_as_int(x), 0x122, 0xf, 0xf, true)); }
__device__ __forceinline__ float dpp_shr1(float old, float x) { return __int_as_float(__builtin_amdgcn_update_dpp(__float_as_int(old), __float_as_int(x), 0x111, 0xf, 0xf, false)); }
__device__ __forceinline__ float dpp_shr2(float old, float x) { return __int_as_float(__builtin_amdgcn_update_dpp(__float_as_int(old), __float_as_int(x), 0x112, 0xf, 0xf, false)); }
struct EpiIn {
    static constexpr bool PERM = true, AFTER_DRAIN = false, MIDK = false;
    bf16_t* PA; bf16_t* G; const float* ssq; bf16_t* Y; bf16_t* sc; bf16_t* scb; const float* cw;
    __device__ __forceinline__ void operator()(const f32x4 (&acc)[2][2][4][2], const pg8::Unit& u, int wr, int wc, int fr, int fq) const {
        const int row0 = u.pm * 256 + wr * 64 + fr;
        float rs8[8]; rows_rstd8(ssq, row0, fq, rs8);
        if (u.pn >= 16) {
            const int q0 = (u.pn - 16) * 64 + wc * 16 + fq * 4;
            const f32x4 w0 = *(const f32x4*)(cw + q0), w1 = *(const f32x4*)(cw + 512 + q0), w2 = *(const f32x4*)(cw + 1024 + q0);
#pragma unroll
            for (int ai = 0; ai < 2; ++ai) {
                f32x4 pz = {0.f, 0.f, 0.f, 0.f};
                const int blk = u.pm * 4 + ai * 2 + wr;
#pragma unroll
                for (int m = 0; m < 4; ++m) {
                    const float rs = rs8[ai * 4 + m];
                    const f32x4 cb = acc[ai][0][m][0] * rs, cc = acc[ai][0][m][1] * rs, cx = acc[ai][1][m][0] * rs, av = acc[ai][1][m][1] * rs;
                    const f32x4 z = cc * cx;
                    float y[4];
#pragma unroll
                    for (int j = 0; j < 4; ++j) {
                        const float z1 = dpp_shr1(dpp_ror1(pz[j]), z[j]), z2 = dpp_shr2(dpp_ror2(pz[j]), z[j]);
                        y[j] = cb[j] * (w0[j] * z2 + w1[j] * z1 + w2[j] * z[j]);
                        asm volatile("" : "+v"(y[j]));
                    }
                    const int r = row0 + ai * 128 + m * 16;
                    u32x2 w;
                    w.x = pk(av[0], av[1]); w.y = pk(av[2], av[3]); *(u32x2*)(PA + (size_t)r * NPA2 + q0) = w;
                    if (!(m == 0 && fr < 2)) { w.x = pk(y[0], y[1]); w.y = pk(y[2], y[3]); *(u32x2*)(Y + (size_t)r * NBR + 1024 + q0) = w; }
                    if (m == 0 && fr < 2) {
                        w.x = pk(z[0], z[1]); w.y = pk(z[2], z[3]); *(u32x2*)(sc + ((size_t)blk * 4 + 2 + fr) * 512 + q0) = w;
                        w.x = pk(cb[0], cb[1]); w.y = pk(cb[2], cb[3]); *(u32x2*)(scb + ((size_t)blk * 2 + fr) * 512 + q0) = w;
                    }
                    if (m == 3 && fr >= 14) { w.x = pk(z[0], z[1]); w.y = pk(z[2], z[3]); *(u32x2*)(sc + ((size_t)blk * 4 + (fr - 14)) * 512 + q0) = w; }
                    pz = z;
                }
            }
        } else {
            const int q0 = u.pn * 64 + wc * 16 + fq * 4;
#pragma unroll
            for (int ai = 0; ai < 2; ++ai)
#pragma unroll
                for (int m = 0; m < 4; ++m) {
                    const float rs = rs8[ai * 4 + m], rsn = rs * -1.44269504f;
                    const f32x4 ga = acc[ai][0][m][0] * rsn, gb = acc[ai][0][m][1] * rsn, gc = acc[ai][1][m][0] * rsn, uv = acc[ai][1][m][1] * rs;
                    float r1[4], r2[4], s3[4], ug[4];
#pragma unroll
                    for (int j = 0; j < 4; ++j) {
                        const float ta = gate_t2(ga[j]), tb = gate_t2(gb[j]), tc = gate_t2(gc[j]);
                        r1[j] = tb * fast_rcp(ta); r2[j] = tc * fast_rcp(tb); s3[j] = fast_rcp(tc);
                        ug[j] = gelu_tanh_f(uv[j]);
                    }
                    const size_t ro = (size_t)(row0 + ai * 128 + m * 16) * NPA, rp = (size_t)(row0 + ai * 128 + m * 16) * NPA2;
                    u32x2 w;
                    w.x = pk(r1[0], r1[1]); w.y = pk(r1[2], r1[3]); *(u32x2*)(G + ro + q0) = w;
                    w.x = pk(r2[0], r2[1]); w.y = pk(r2[2], r2[3]); *(u32x2*)(G + ro + 1024 + q0) = w;
                    w.x = pk(s3[0], s3[1]); w.y = pk(s3[2], s3[3]); *(u32x2*)(G + ro + 2048 + q0) = w;
                    w.x = pk(ug[0], ug[1]); w.y = pk(ug[2], ug[3]); *(u32x2*)(PA + rp + 512 + q0) = w;
                }
        }
    }
};
struct EpiBr {
    static constexpr bool PERM = true, AFTER_DRAIN = false, MIDK = true;
    const bf16_t* G; bf16_t* out;
    __device__ __forceinline__ void mid(f32x4 (&acc)[2][2][4][2], const pg8::Unit& u, int t, int wr, int wc, int fr, int fq) const {
        const int seg = (t == 8) ? 0 : 1024;
        int col0 = u.pn * 256 + wc * 32 + 8 * fq + seg;
        int row0 = u.pm * 256 + wr * 64 + fr;
        asm volatile("" : "+v"(col0), "+v"(row0));
#pragma unroll
        for (int ai = 0; ai < 2; ++ai) {
            u32x4 nu[4][2];
#pragma unroll
            for (int m = 0; m < 4; ++m)
#pragma unroll
                for (int bj = 0; bj < 2; ++bj) nu[m][bj] = *(const u32x4*)(G + (size_t)(row0 + ai * 128 + m * 16) * NPA + col0 + bj * 128);
            asm volatile("" ::: "memory");
#pragma unroll
            for (int m = 0; m < 4; ++m)
#pragma unroll
                for (int bj = 0; bj < 2; ++bj) {
                    const unsigned nw[4] = {nu[m][bj].x, nu[m][bj].y, nu[m][bj].z, nu[m][bj].w};
#pragma unroll
                    for (int q = 0; q < 4; ++q) { acc[ai][bj][m][q >> 1][(q & 1) * 2] *= bflo(nw[q]); acc[ai][bj][m][q >> 1][(q & 1) * 2 + 1] *= bfhi(nw[q]); }
                }
            asm volatile("" ::: "memory");
        }
    }
    __device__ __forceinline__ void operator()(const f32x4 (&acc)[2][2][4][2], const pg8::Unit& u, int wr, int wc, int fr, int fq) const {
        const int col0 = u.pn * 256 + wc * 32 + 8 * fq;
        const int row0 = u.pm * 256 + wr * 64 + fr;
        u32x4 sg[2][4][2];
#pragma unroll
        for (int ai = 0; ai < 2; ++ai)
#pragma unroll
            for (int m = 0; m < 4; ++m)
#pragma unroll
                for (int bj = 0; bj < 2; ++bj) sg[ai][m][bj] = *(const u32x4*)(G + (size_t)(row0 + ai * 128 + m * 16) * NPA + 2048 + col0 + bj * 128);
#pragma unroll
        for (int ai = 0; ai < 2; ++ai)
#pragma unroll
            for (int m = 0; m < 4; ++m) {
                const int r = row0 + ai * 128 + m * 16;
                bf16_t* op = out + (size_t)r * DM + col0;
#pragma unroll
                for (int bj = 0; bj < 2; ++bj) {
                    const u32x4 s = sg[ai][m][bj];
                    const f32x4 a0 = acc[ai][bj][m][0], a1 = acc[ai][bj][m][1];
                    u32x4 w;
                    w.x = pk(a0[0] * bflo(s.x), a0[1] * bfhi(s.x)); w.y = pk(a0[2] * bflo(s.y), a0[3] * bfhi(s.y));
                    w.z = pk(a1[0] * bflo(s.z), a1[1] * bfhi(s.z)); w.w = pk(a1[2] * bflo(s.w), a1[3] * bfhi(s.w));
                    *(u32x4*)(op + bj * 128) = w;
                }
            }
    }
};
struct EpiRes {
    static constexpr bool PERM = true, AFTER_DRAIN = false, MIDK = false;
    bf16_t* xb; float* ssq;
    __device__ __forceinline__ void operator()(const f32x4 (&acc)[2][2][4][2], const pg8::Unit& u, int wr, int wc, int fr, int fq) const {
        const int col0 = u.pn * 256 + wc * 32 + 8 * fq;
        const int row0 = u.pm * 256 + wr * 64 + fr;
        u32x4 bb[2][4][2];
#pragma unroll
        for (int ai = 0; ai < 2; ++ai)
#pragma unroll
            for (int m = 0; m < 4; ++m)
#pragma unroll
                for (int bj = 0; bj < 2; ++bj) bb[ai][m][bj] = *(const u32x4*)(xb + (size_t)(row0 + ai * 128 + m * 16) * DM + col0 + bj * 128);
        asm volatile("" ::: "memory");
#pragma unroll
        for (int ai = 0; ai < 2; ++ai) {
#pragma unroll
            for (int m = 0; m < 4; ++m) {
                const int r = row0 + ai * 128 + m * 16;
                float sq = 0.f;
#pragma unroll
                for (int bj = 0; bj < 2; ++bj) {
                    const u32x4 s = bb[ai][m][bj];
                    const f32x4 a0 = acc[ai][bj][m][0], a1 = acc[ai][bj][m][1];
                    const float o0 = bflo(s.x) + a0[0], o1 = bfhi(s.x) + a0[1], o2 = bflo(s.y) + a0[2], o3 = bfhi(s.y) + a0[3];
                    const float o4 = bflo(s.z) + a1[0], o5 = bfhi(s.z) + a1[1], o6 = bflo(s.w) + a1[2], o7 = bfhi(s.w) + a1[3];
                    u32x4 w; w.x = pk(o0, o1); w.y = pk(o2, o3); w.z = pk(o4, o5); w.w = pk(o6, o7);
                    *(u32x4*)(xb + (size_t)r * DM + col0 + bj * 128) = w;
                    sq += (o0 * o0 + o1 * o1) + (o2 * o2 + o3 * o3) + (o4 * o4 + o5 * o5) + (o6 * o6 + o7 * o7);
                }
                sq += __shfl_xor(sq, 16); sq += __shfl_xor(sq, 32);
                if (fq == 0) ssq[(size_t)r * 16 + u.pn * 4 + wc] = sq;
            }
            asm volatile("" ::: "memory");
        }
    }
};
struct EpiUp {
    static constexpr bool PERM = true, AFTER_DRAIN = false, MIDK = false;
    bf16_t* act; bf16_t* zs; const float* ssq; const float* cw; const float* cb;
    __device__ __forceinline__ void operator()(const f32x4 (&acc)[2][2][4][2], const pg8::Unit& u, int wr, int wc, int fr, int fq) const {
        const int c0 = u.pn * 128 + wc * 32 + 8 * fq;
        const int row0 = u.pm * 256 + wr * 64 + fr;
        float rs8[8]; rows_rstd8(ssq, row0, fq, rs8);
        u32x2 keep[2][4];
#pragma unroll
        for (int n = 0; n < 2; ++n) {
            const int c = c0 + 4 * n;
            const f32x4 gw0 = *(const f32x4*)(cw + c), gw1 = *(const f32x4*)(cw + NUP + c), gw2 = *(const f32x4*)(cw + 2 * NUP + c), gb = *(const f32x4*)(cb + c);
            const f32x4 vw0 = *(const f32x4*)(cw + DFF + c), vw1 = *(const f32x4*)(cw + NUP + DFF + c), vw2 = *(const f32x4*)(cw + 2 * NUP + DFF + c), vb = *(const f32x4*)(cb + DFF + c);
#pragma unroll
            for (int ai = 0; ai < 2; ++ai) {
                f32x4 pg = {0.f, 0.f, 0.f, 0.f}, pv = {0.f, 0.f, 0.f, 0.f};
                const int blk = u.pm * 4 + ai * 2 + wr;
#pragma unroll
                for (int m = 0; m < 4; ++m) {
                    const float rs = rs8[ai * 4 + m];
                    const f32x4 zg = acc[ai][0][m][n] * rs, zv = acc[ai][1][m][n] * rs;
                    float o[4];
#pragma unroll
                    for (int j = 0; j < 4; ++j) {
                        const float g1 = dpp_shr1(dpp_ror1(pg[j]), zg[j]), g2 = dpp_shr2(dpp_ror2(pg[j]), zg[j]);
                        const float v1 = dpp_shr1(dpp_ror1(pv[j]), zv[j]), v2 = dpp_shr2(dpp_ror2(pv[j]), zv[j]);
                        const float gg = gw2[j] * zg[j] + gw1[j] * g1 + gw0[j] * g2 + gb[j];
                        const float vv = vw2[j] * zv[j] + vw1[j] * v1 + vw0[j] * v2 + vb[j];
                        o[j] = silu_f(gg) * vv;
                    }
                    u32x2 w; w.x = pk(o[0], o[1]); w.y = pk(o[2], o[3]);
                    const int r = row0 + ai * 128 + m * 16;
                    if (n == 0) keep[ai][m] = w;
                    else if (!(m == 0 && fr < 2)) { u32x4 ww; ww.x = keep[ai][m].x; ww.y = keep[ai][m].y; ww.z = w.x; ww.w = w.y; st_nt16(act + (size_t)r * DFF + c0, ww); }
                    if (m == 0 && fr < 2) {
                        bf16_t* zp = zs + ((size_t)blk * 4 + 2 + fr) * NUP + c;
                        u32x2 a; a.x = pk(zg[0], zg[1]); a.y = pk(zg[2], zg[3]); *(u32x2*)zp = a;
                        u32x2 d; d.x = pk(zv[0], zv[1]); d.y = pk(zv[2], zv[3]); *(u32x2*)(zp + DFF) = d;
                    }
                    if (m == 3 && fr >= 14) {
                        bf16_t* zp = zs + ((size_t)blk * 4 + (fr - 14)) * NUP + c;
                        u32x2 a; a.x = pk(zg[0], zg[1]); a.y = pk(zg[2], zg[3]); *(u32x2*)zp = a;
                        u32x2 d; d.x = pk(zv[0], zv[1]); d.y = pk(zv[2], zv[3]); *(u32x2*)(zp + DFF) = d;
                    }
                    pg = zg; pv = zv;
                }
            }
        }
    }
};

__device__ __forceinline__ int win_dest_row(int col) {
    int ch, bj, n, t0;
    if (col < 512) { ch = col; bj = 1; n = 1; t0 = 16; }
    else if (col < 1536) { ch = col - 512; bj = 1; n = 1; t0 = 0; }
    else if (col < 3072) { const int s = (col - 1536) >> 9; ch = (col - 1536) & 511; bj = s >> 1; n = s & 1; t0 = 16; }
    else { const int gi = (col - 3072) >> 10; ch = (col - 3072) & 1023; bj = gi >> 1; n = gi & 1; t0 = 0; }
    const int k = t0 + (ch >> 6), r = ch & 63;
    return 256 * k + 128 * bj + 32 * (r >> 4) + 8 * ((r >> 2) & 3) + 4 * n + (r & 3);
}
__device__ __forceinline__ void transpose_tile(const float* __restrict__ W, int N, const float* __restrict__ g, bf16_t* __restrict__ Wt, int ldt, int koff, int k0, int n0, int nd0, float* tile, int tid, bool winmap = false) {
    {
        const int kk = tid >> 4, nn = (tid & 15) * 4;
#pragma unroll
        for (int h = 0; h < 2; ++h) {
            const int k = kk + h * 32;
            f32x4 v = *(const f32x4*)(W + (size_t)(k0 + k) * N + n0 + nn);
            const float s = g ? g[k0 + k] : 1.0f;
            tile[k * 65 + nn + 0] = v[0] * s; tile[k * 65 + nn + 1] = v[1] * s; tile[k * 65 + nn + 2] = v[2] * s; tile[k * 65 + nn + 3] = v[3] * s;
        }
    }
    __syncthreads();
    {
        const int n = tid >> 3, kq = (tid & 7) * 8;
        float v[8];
#pragma unroll
        for (int j = 0; j < 8; ++j) v[j] = tile[(kq + j) * 65 + n];
        u32x4 w; w.x = pk(v[0], v[1]); w.y = pk(v[2], v[3]); w.z = pk(v[4], v[5]); w.w = pk(v[6], v[7]);
        *(u32x4*)(Wt + (size_t)(winmap ? win_dest_row(n0 + n) : nd0 + n) * ldt + koff + k0 + kq) = w;
    }
    __syncthreads();
}

__device__ __forceinline__ void prep_phase(const Params& p, int l, float* ldsf) {
    unsigned char* ws = p.ws;
    bf16_t* wt_in = (bf16_t*)(ws + WS_WIN); bf16_t* wt_br = (bf16_t*)(ws + WS_WBR); bf16_t* wt_o = (bf16_t*)(ws + WS_WO);
    bf16_t* wt_up = (bf16_t*)(ws + WS_WUP); bf16_t* wt_dn = (bf16_t*)(ws + WS_WDN);
    const float* g_mix = p.in[1] + (size_t)l * DM; const float* w_in = p.in[2] + (size_t)l * DM * NIN;
    const float* w_pool = p.in[3] + (size_t)l * 4 * 128 * 128; const float* pscale = p.in[4] + (size_t)l * 512;
    const float* w_ba = p.in[9] + (size_t)l * 512 * DM; const float* w_bb = p.in[10] + (size_t)l * 512 * DM; const float* w_bc = p.in[11] + (size_t)l * 512 * DM;
    const float* w_o = p.in[12] + (size_t)l * DM * DM; const float* g_ffn = p.in[13] + (size_t)l * DM;
    const float* w_up = p.in[14] + (size_t)l * DM * NUP; const float* w_dn = p.in[17] + (size_t)l * DFF * DM;
    const int tid = otid(), bid = obid();
    constexpr int T0 = 16 * 96, T1 = T0 + 128, T2 = T1 + 128, T3 = T2 + 256, T4 = T3 + 16 * 88, T5 = T4 + 44 * 16;
    for (int i = bid; i < T5; i += gridDim.x) {
        if (i < T0) { const int kt = i & 15, nt = i >> 4; transpose_tile(w_in, NIN, g_mix, wt_in, DM, 0, kt * 64, nt * 64, nt * 64, ldsf, tid, true); }
        else if (i < T1) { const int j = i - T0, kt = j & 7, nt = j >> 3; transpose_tile(w_bb, DM, nullptr, wt_br, NBR, 512, kt * 64, nt * 64, nt * 64, ldsf, tid); }
        else if (i < T2) { const int j = i - T1, kt = j & 7, nt = j >> 3; transpose_tile(w_bc, DM, nullptr, wt_br, NBR, 1024, kt * 64, nt * 64, nt * 64, ldsf, tid); }
        else if (i < T3) { const int j = i - T2, kt = j & 15, nt = j >> 4; transpose_tile(w_o, DM, nullptr, wt_o, DM, 0, kt * 64, nt * 64, nt * 64, ldsf, tid); }
        else if (i < T4) { const int j = i - T3, kt = j & 15, nt = j >> 4; const int n0 = nt * 64, bj = n0 / DFF, q0 = n0 - bj * DFF; transpose_tile(w_up, NUP, g_ffn, wt_up, DM, 0, kt * 64, n0, (q0 >> 7) * 256 + bj * 128 + (q0 & 127), ldsf, tid);   }
        else { const int j = i - T4, kt = j % 44, nt = j / 44; transpose_tile(w_dn, DM, nullptr, wt_dn, DFF, 0, kt * 64, nt * 64, nt * 64, ldsf, tid); }
    }
    {
        float* wpT = ldsf;
        float* wa = ldsf + 128 * 128;
        for (int it = (int)gridDim.x - 1 - bid; it < 64; it += gridDim.x) {
            const int g = it >> 4, n0 = (it & 15) * 64;
            for (int q = tid; q < 128 * 32; q += 512) {
                const int d = q >> 5, e4 = (q & 31) * 4;
                const f32x4 v = *(const f32x4*)(w_pool + ((size_t)g * 128 + d) * 128 + e4);
                const f32x4 s = *(const f32x4*)(pscale + g * 128 + e4);
                wpT[(e4 + 0) * 128 + d] = v[0] * s[0]; wpT[(e4 + 1) * 128 + d] = v[1] * s[1]; wpT[(e4 + 2) * 128 + d] = v[2] * s[2]; wpT[(e4 + 3) * 128 + d] = v[3] * s[3];
            }
            for (int q = tid; q < 128 * 16; q += 512) {
                const int e = q >> 4, c4 = (q & 15) * 4;
                *(f32x4*)(wa + e * 64 + c4) = *(const f32x4*)(w_ba + (size_t)(g * 128 + e) * DM + n0 + c4);
            }
            __syncthreads();
            const int d = tid & 127, ns = tid >> 7;
            float acc[16];
#pragma unroll
            for (int i = 0; i < 16; ++i) acc[i] = 0.f;
            for (int e = 0; e < 128; ++e) {
                const float w = wpT[e * 128 + d];
                const f32x4* wr4 = (const f32x4*)(wa + e * 64 + ns * 16);
#pragma unroll
                for (int c = 0; c < 4; ++c) { const f32x4 b = wr4[c]; acc[c * 4 + 0] += w * b[0]; acc[c * 4 + 1] += w * b[1]; acc[c * 4 + 2] += w * b[2]; acc[c * 4 + 3] += w * b[3]; }
            }
#pragma unroll
            for (int i = 0; i < 16; ++i) wt_br[(size_t)(n0 + ns * 16 + i) * NBR + g * 128 + d] = (bf16_t)(pk(acc[i], 0.f) & 0xffffu);
            __syncthreads();
        }
    }
    if (l == 0) {
        const float* x = p.in[0]; bf16_t* xb = (bf16_t*)(ws + WS_XB); float* ssq = (float*)(ws + WS_SSQ);
        const int lane = tid & 63, wave = tid >> 6;
        for (int r = bid * 8 + wave; r < MTOK; r += gridDim.x * 8) {
            float sq = 0.f;
#pragma unroll
            for (int i = 0; i < 4; ++i) {
                const f32x4 v = *(const f32x4*)(x + (size_t)r * DM + i * 256 + lane * 4);
                sq += (v[0] * v[0] + v[1] * v[1]) + (v[2] * v[2] + v[3] * v[3]);
                u32x2 w; w.x = pk(v[0], v[1]); w.y = pk(v[2], v[3]);
                *(u32x2*)(xb + (size_t)r * DM + i * 256 + lane * 4) = w;
            }
#pragma unroll
            for (int o = 32; o >= 1; o >>= 1) sq += __shfl_xor(sq, o);
            if (lane < 16) ssq[(size_t)r * 16 + lane] = (lane == 0) ? sq : 0.f;
        }
    }
}
__device__ __forceinline__ void ld8(const bf16_t* p, float (&v)[8]) {
    const u32x4 w = *(const u32x4*)p;
    v[0] = bflo(w.x); v[1] = bfhi(w.x); v[2] = bflo(w.y); v[3] = bfhi(w.y); v[4] = bflo(w.z); v[5] = bfhi(w.z); v[6] = bflo(w.w); v[7] = bfhi(w.w);
}
__device__ __forceinline__ void st8(bf16_t* p, const float (&v)[8]) {
    u32x4 w; w.x = pk(v[0], v[1]); w.y = pk(v[2], v[3]); w.z = pk(v[4], v[5]); w.w = pk(v[6], v[7]);
    *(u32x4*)p = w;
}
template <int W> __device__ __forceinline__ void pool_rows(const bf16_t* __restrict__ ap, bf16_t* __restrict__ yp, int r0, int pos0) {
#pragma unroll
    for (int b = 0; b < 4; ++b) {
        const int base = r0 + 4 * b;
        u32x4 h[W + 3];
#pragma unroll
        for (int i = 0; i < W + 3; ++i) { const int rr = base - (W - 1) + i; h[i] = (pos0 + rr >= 0) ? *(const u32x4*)(ap + (ptrdiff_t)rr * NPA2) : (u32x4){0u, 0u, 0u, 0u}; }
        float s[8];
#pragma unroll
        for (int j = 0; j < 8; ++j) s[j] = 0.f;
#pragma unroll
        for (int i = 0; i < W - 1; ++i) { const u32x4 q = h[i];
            s[0] += bflo(q.x); s[1] += bfhi(q.x); s[2] += bflo(q.y); s[3] += bfhi(q.y); s[4] += bflo(q.z); s[5] += bfhi(q.z); s[6] += bflo(q.w); s[7] += bfhi(q.w); }
#pragma unroll
        for (int i = 0; i < 4; ++i) {
            const int rr = base + i, pos = pos0 + rr; const float inv = 1.0f / (float)(pos + 1 < W ? pos + 1 : W);
            const u32x4 q = h[W - 1 + i], od = h[i];
            const float v[8] = {bflo(q.x), bfhi(q.x), bflo(q.y), bfhi(q.y), bflo(q.z), bfhi(q.z), bflo(q.w), bfhi(q.w)};
            float o[8];
#pragma unroll
            for (int j = 0; j < 8; ++j) { s[j] += v[j]; o[j] = s[j] * inv - v[j]; }
            st8(yp + (size_t)rr * NBR, o);
            s[0] -= bflo(od.x); s[1] -= bfhi(od.x); s[2] -= bflo(od.y); s[3] -= bfhi(od.y); s[4] -= bflo(od.z); s[5] -= bfhi(od.z); s[6] -= bflo(od.w); s[7] -= bfhi(od.w);
        }
        asm volatile("" ::: "memory");
    }
}
constexpr int VT_PITCH = 136;
__device__ __forceinline__ void mixer_phase(const Params& p, int l, unsigned char* lds) {
    const bf16_t* PA = (const bf16_t*)(p.ws + WS_B1);
    bf16_t* Y = (bf16_t*)p.out;
    const float* g_sgu = p.in[5] + (size_t)l * 512;
    const float* w_sp = p.in[6] + (size_t)l * 4 * 128 * 128;
    const float* b_sp = p.in[7] + (size_t)l * 4 * 128;
    const float* conv_c = p.in[8] + (size_t)l * 3 * 512;
    float* rs = (float*)lds;
    bf16_t* vT = (bf16_t*)(lds + 1024);
    const int tid = otid(), lane = tid & 63, wave = __builtin_amdgcn_readfirstlane(tid >> 6), fr = lane & 15, fq = lane >> 4;
    for (int item = obid(); item < MTOK / 128; item += gridDim.x) {
        const int t0 = item * 128, pos0 = t0 & (SEQ - 1);
        {
            const int row = tid >> 2, q = tid & 3;
            const bf16_t* vp = PA + (size_t)(t0 + row) * NPA2 + 1024 + q * 128;
            float sq = 0.f;
#pragma unroll
            for (int i = 0; i < 16; ++i) { float v[8]; ld8(vp + i * 8, v);
#pragma unroll
                for (int j = 0; j < 8; ++j) sq += v[j] * v[j]; }
            sq += __shfl_xor(sq, 1); sq += __shfl_xor(sq, 2);
            if (q == 0) rs[row] = rsqrtf(sq * (1.0f / 512.0f) + EPS);
        }
        {
            const int grp = wave & 3;
            const int c8 = (grp * 16 + (lane & 15)) * 8; int r0 = ((wave >> 2) * 4 + (lane >> 4)) * 16;
            asm volatile("" : "+v"(r0));
            {
                const bf16_t* ap = PA + (size_t)t0 * NPA2 + c8;
                bf16_t* yp = Y + (size_t)t0 * NBR + c8;
                if (grp == 0) pool_rows<2>(ap, yp, r0, pos0); else if (grp == 1) pool_rows<4>(ap, yp, r0, pos0); else if (grp == 2) pool_rows<8>(ap, yp, r0, pos0); else pool_rows<16>(ap, yp, r0, pos0);
            }
        }
        if (tid < 256) {
            const bf16_t* sc = (const bf16_t*)(p.ws + WS_SC); const bf16_t* scb = (const bf16_t*)(p.ws + WS_SCB);
            const int b_ = tid >> 7, ri = (tid >> 6) & 1, c8 = (tid & 63) * 8;
            const int blk = (t0 >> 6) + b_;
            const bool first = ((blk * 64) & (SEQ - 1)) == 0;
            float z2[8], z1[8], z0[8], cbv[8], o[8];
#pragma unroll
            for (int j = 0; j < 8; ++j) { z2[j] = 0.f; z1[j] = 0.f; }
            const bf16_t* own = sc + (size_t)blk * 4 * 512 + c8;
            if (ri == 0) { if (!first) { ld8(own - 4 * 512, z2); ld8(own - 3 * 512, z1); } ld8(own + 2 * 512, z0); }
            else { if (!first) ld8(own - 3 * 512, z2); ld8(own + 2 * 512, z1); ld8(own + 3 * 512, z0); }
            ld8(scb + ((size_t)blk * 2 + ri) * 512 + c8, cbv);
#pragma unroll
            for (int j = 0; j < 8; ++j) o[j] = cbv[j] * (conv_c[c8 + j] * z2[j] + conv_c[512 + c8 + j] * z1[j] + conv_c[1024 + c8 + j] * z0[j]);
            st8(Y + (size_t)(blk * 64 + ri) * NBR + 1024 + c8, o);
        }
#pragma unroll 1
        for (int g = 0; g < 4; ++g) {
            const int t = wave * 16 + fr;
            const int nk = (wave >> 1) + 1;
            f32x4 wq[4][2];
#pragma unroll
            for (int k = 0; k < 4; ++k) { const float* wp = w_sp + ((size_t)g * 128 + t) * 128 + k * 32 + fq * 8; wq[k][0] = *(const f32x4*)wp; wq[k][1] = *(const f32x4*)(wp + 4); }
            const bf16_t* up = PA + (size_t)(t0 + t) * NPA2 + 512 + g * 128 + 4 * fq;
            u32x2 uu[8];
#pragma unroll
            for (int n = 0; n < 8; ++n) uu[n] = *(const u32x2*)(up + n * 16);
            const float bias = b_sp[g * 128 + t];
            u32x4 vq[4];
            const int s_ = tid >> 2, dq = (tid & 3) * 32;
            {
                const bf16_t* vp = PA + (size_t)(t0 + s_) * NPA2 + 1024 + g * 128 + dq;
#pragma unroll
                for (int i = 0; i < 4; ++i) vq[i] = *(const u32x4*)(vp + i * 8);
            }
            __syncthreads();
#pragma unroll
            for (int i = 0; i < 4; ++i) {
                const unsigned ww[4] = {vq[i].x, vq[i].y, vq[i].z, vq[i].w};
#pragma unroll
                for (int q = 0; q < 4; ++q) { vT[(dq + i * 8 + q * 2) * VT_PITCH + s_] = (bf16_t)(ww[q] & 0xffffu); vT[(dq + i * 8 + q * 2 + 1) * VT_PITCH + s_] = (bf16_t)(ww[q] >> 16); }
            }
            __syncthreads();
            f32x4 acc[8];
#pragma unroll
            for (int n = 0; n < 8; ++n) acc[n] = (f32x4){0.f, 0.f, 0.f, 0.f};
#pragma unroll
            for (int k = 0; k < 4; ++k) if (k < nk) {
                const int s0 = k * 32 + fq * 8;
                const f32x4 wa = wq[k][0], wb = wq[k][1];
                const f32x4 ra = *(const f32x4*)(rs + s0), rb = *(const f32x4*)(rs + s0 + 4);
                float a[8];
#pragma unroll
                for (int j = 0; j < 4; ++j) { a[j] = (s0 + j <= t) ? wa[j] * ra[j] : 0.f; a[4 + j] = (s0 + 4 + j <= t) ? wb[j] * rb[j] : 0.f; }
                union { u32x4 u; bf16x8 h; } af; af.u.x = pk(a[0], a[1]); af.u.y = pk(a[2], a[3]); af.u.z = pk(a[4], a[5]); af.u.w = pk(a[6], a[7]);
#pragma unroll
                for (int n = 0; n < 8; ++n) {
                    const bf16x8 bfrag = *(const bf16x8*)(vT + (n * 16 + fr) * VT_PITCH + s0);
                    acc[n] = __builtin_amdgcn_mfma_f32_16x16x32_bf16(bfrag, af.h, acc[n], 0, 0, 0);
                }
            }
            bf16_t* yp = Y + (size_t)(t0 + t) * NBR + 512 + g * 128 + 4 * fq;
#pragma unroll
            for (int n = 0; n < 8; ++n) {
                const f32x4 gs = *(const f32x4*)(g_sgu + g * 128 + n * 16 + 4 * fq);
                const float o0 = bflo(uu[n].x) * (acc[n][0] * gs[0] + bias), o1 = bfhi(uu[n].x) * (acc[n][1] * gs[1] + bias);
                const float o2 = bflo(uu[n].y) * (acc[n][2] * gs[2] + bias), o3 = bfhi(uu[n].y) * (acc[n][3] * gs[3] + bias);
                u32x2 w; w.x = pk(o0, o1); w.y = pk(o2, o3);
                *(u32x2*)(yp + n * 16) = w;
            }
        }
        __syncthreads();
    }
}

__device__ __forceinline__ void ffn_fixup_phase(const Params& p, int l) {
    const bf16_t* zs = (const bf16_t*)(p.ws + WS_B2);
    bf16_t* act = (bf16_t*)(p.ws + WS_B1);
    const float* cw = p.in[15] + (size_t)l * 3 * NUP; const float* cb = p.in[16] + (size_t)l * NUP;
    constexpr int NCG = DFF / 8, NU = (MTOK / 64) * NCG;
    for (int u = obid() * 512 + otid(); u < NU; u += gridDim.x * 512) {
        const int blk = u / NCG, c8 = (u - blk * NCG) * 8;
        const bool first = ((blk * 64) & (SEQ - 1)) == 0;
        float g2[8], g1[8], ga[8], gb2[8], v2[8], v1[8], va[8], vb2[8];
#pragma unroll
        for (int j = 0; j < 8; ++j) { g2[j] = g1[j] = v2[j] = v1[j] = 0.f; }
        const bf16_t* own = zs + (size_t)blk * 4 * NUP + c8;
        if (!first) { const bf16_t* prv = own - 4 * (ptrdiff_t)NUP; ld8(prv, g2); ld8(prv + NUP, g1); ld8(prv + DFF, v2); ld8(prv + NUP + DFF, v1); }
        ld8(own + 2 * NUP, ga); ld8(own + 3 * NUP, gb2); ld8(own + 2 * NUP + DFF, va); ld8(own + 3 * NUP + DFF, vb2);
        float o0[8], o1[8];
#pragma unroll
        for (int j = 0; j < 8; ++j) {
            const float w0 = cw[c8 + j], w1 = cw[NUP + c8 + j], w2 = cw[2 * NUP + c8 + j], bb = cb[c8 + j];
            const float x0 = cw[DFF + c8 + j], x1 = cw[NUP + DFF + c8 + j], x2 = cw[2 * NUP + DFF + c8 + j], xb_ = cb[DFF + c8 + j];
            const float gg0 = w0 * g2[j] + w1 * g1[j] + w2 * ga[j] + bb, vv0 = x0 * v2[j] + x1 * v1[j] + x2 * va[j] + xb_;
            const float gg1 = w0 * g1[j] + w1 * ga[j] + w2 * gb2[j] + bb, vv1 = x0 * v1[j] + x1 * va[j] + x2 * vb2[j] + xb_;
            o0[j] = silu_f(gg0) * vv0; o1[j] = silu_f(gg1) * vv1;
        }
        st8(act + (size_t)(blk * 64) * DFF + c8, o0); st8(act + (size_t)(blk * 64 + 1) * DFF + c8, o1);
    }
}

__device__ __forceinline__ void final_norm_phase(const Params& p) {
    const float* gf = p.in[18]; const float* ssq = (const float*)(p.ws + WS_SSQ); const bf16_t* xb = (const bf16_t*)(p.ws + WS_XB); float* out = p.out;
    const int tid = otid(), lane = tid & 63, wave = tid >> 6;
    for (int r = obid() * 8 + wave; r < MTOK; r += gridDim.x * 8) {
        const float rs = row_rstd(ssq, r);
#pragma unroll
        for (int i = 0; i < 2; ++i) {
            const int c = i * 512 + lane * 8;
            float v[8]; ld8(xb + (size_t)r * DM + c, v);
            const f32x4 g0 = *(const f32x4*)(gf + c), g1 = *(const f32x4*)(gf + c + 4);
            f32x4 o0, o1;
#pragma unroll
            for (int j = 0; j < 4; ++j) { o0[j] = v[j] * rs * g0[j]; o1[j] = v[4 + j] * rs * g1[j]; }
            float* q = out + (size_t)r * DM + c;
            __builtin_nontemporal_store(o0, (f32x4*)q); __builtin_nontemporal_store(o1, (f32x4*)(q + 4));
        }
    }
}

template <class Epi> __device__ __forceinline__ void run_gemm(unsigned char* lds, const bf16_t* A, const bf16_t* Bt, int M, int N, int K, const Epi& E, int stagger_step = 0) {
    pg8::Gemm g{A, Bt, M, N, K}; pg8::StaticOrder S; S.init(M, N, (int)gridDim.x, obid());
    if (stagger_step) {
        const unsigned long long t0 = wall_clock64(), d = (unsigned long long)(((obid() >> 3) & 7) * stagger_step);
        while (wall_clock64() - t0 < d) __builtin_amdgcn_s_sleep(16);
    }
    pg8::gemm_phase<Epi, pg8::StaticOrder, false>((PG8_LAS unsigned char*)lds, g, S, E, nullptr);
}

#define XB_TMO      128
#define XB_XCNT(j)  (256  + 64 * (j))
#define XB_XSUB(j)  (1280 + 64 * (j))
#define XB_XGEN(j)  (2304 + 64 * (j))
#define XB_TOP      3328
#define XB_TOPGEN   3392
#define XCD_BAR_WORDS 3456
#define XB_SPIN_CAP (1u << 18)

__device__ __forceinline__ unsigned xb_ld(unsigned* p)              { return __hip_atomic_load(p, __ATOMIC_RELAXED, __HIP_MEMORY_SCOPE_AGENT); }
__device__ __forceinline__ unsigned xb_add(unsigned* p, unsigned v) { return __hip_atomic_fetch_add(p, v, __ATOMIC_RELAXED, __HIP_MEMORY_SCOPE_AGENT); }
__device__ __forceinline__ unsigned xb_xcc_id() { return (unsigned)__builtin_amdgcn_s_getreg((3 << 11) | 20) & 0xFu; }
#define XB_SPIN(cond, bar) do { unsigned _sp = 0; while (cond) { __builtin_amdgcn_s_sleep(1); \
    if ((++_sp & 255u) == 0u) { if (xb_ld(&(bar)[XB_TMO])) break; if (_sp > XB_SPIN_CAP) { atomicAdd(&(bar)[XB_TMO], 1u); break; } } } } while (0)

struct XcdBarrier {
    unsigned* bar; unsigned x;
    volatile LAS unsigned* st;
};

__device__ __forceinline__ XcdBarrier xcd_barrier_post(unsigned* bar, volatile LAS unsigned* st) {
    XcdBarrier b; b.bar = bar; b.x = xb_xcc_id(); b.st = st;
    if (threadIdx.x == 0) (void)xb_add(&bar[XB_XCNT(b.x)], 1u);
    return b;
}
__device__ __forceinline__ void xcd_barrier_complete(unsigned* bar, unsigned x, unsigned& nloc, unsigned& nx) {
    const unsigned G = gridDim.x * gridDim.y * gridDim.z;
    unsigned sum, cnt, mine, sp = 0u;
    for (;;) {
        sum = 0u; cnt = 0u; mine = 0u;
#pragma unroll
        for (unsigned j = 0; j < 16; ++j) { const unsigned c = xb_ld(&bar[XB_XCNT(j)]); sum += c; cnt += (c > 0u) ? 1u : 0u; mine = (j == x) ? c : mine; }
        if (sum == G) break;
        __builtin_amdgcn_s_sleep(1);
        if ((++sp & 255u) == 0u) { if (xb_ld(&bar[XB_TMO])) break; if (sp > XB_SPIN_CAP) { atomicAdd(&bar[XB_TMO], 1u); break; } }
    }
    nloc = mine > 0u ? mine : 1u; nx = cnt > 0u ? cnt : 1u;
}

__device__ __forceinline__ void xcd_barrier(const XcdBarrier& b) {
    asm volatile("s_waitcnt vmcnt(0)" ::: "memory");
    __syncthreads();
    if (threadIdx.x == 0) {
        unsigned* bar = b.bar;
        __builtin_amdgcn_s_waitcnt(0);
        unsigned nloc = b.st[0], nx = b.st[1];
        if (nloc == 0u) { xcd_barrier_complete(bar, b.x, nloc, nx); b.st[0] = nloc; b.st[1] = nx; }
        const unsigned old = xb_add(&bar[XB_XSUB(b.x)], 1u);
        const unsigned gen = old / nloc;
        if (old + 1u == (gen + 1u) * nloc) {
            __builtin_amdgcn_fence(__ATOMIC_RELEASE, "agent");
            asm volatile("s_waitcnt vmcnt(0)" ::: "memory");
            const unsigned og = xb_add(&bar[XB_TOP], 1u);
            const unsigned tg = og / nx;
            if (og + 1u == (tg + 1u) * nx) xb_add(&bar[XB_TOPGEN], 1u);
            else XB_SPIN(xb_ld(&bar[XB_TOPGEN]) == tg, bar);
            __builtin_amdgcn_fence(__ATOMIC_ACQUIRE, "agent");
            xb_add(&bar[XB_XGEN(b.x)], 1u);
            asm volatile("s_waitcnt vmcnt(0)" ::: "memory");
        } else {
            XB_SPIN(xb_ld(&bar[XB_XGEN(b.x)]) == gen, bar);
            __builtin_amdgcn_fence(__ATOMIC_ACQUIRE, "agent");
            asm volatile("s_waitcnt vmcnt(0)" ::: "memory");
        }
    }
    __syncthreads();
}

typedef const Params __attribute__((address_space(4)))* ParamsK;
__device__ __forceinline__ Params fresh_params() {
    ParamsK q = (ParamsK)__builtin_amdgcn_kernarg_segment_ptr();
    asm volatile("" : "+s"(q));
    Params r;
#pragma unroll
    for (int i = 0; i < 19; ++i) r.in[i] = q->in[i];
    r.out = q->out; r.ws = q->ws;
    return r;
}
constexpr int LDS_TOTAL = pg8::STAGE_BYTES + 256;
__global__ void __launch_bounds__(512, 2) fwd_megakernel(Params p_unused) {
    extern __shared__ __attribute__((aligned(16))) unsigned char lds[];
    cg::grid_group grid = cg::this_grid();
    volatile LAS unsigned* st = (volatile LAS unsigned*)((LAS unsigned char*)lds + pg8::STAGE_BYTES);
    unsigned* bar;
    {
        const Params p = fresh_params(); bar = (unsigned*)(p.ws + WS_BAR);
        if (threadIdx.x < 4) st[threadIdx.x] = 0u;
        if (blockIdx.x == 0) for (int i = threadIdx.x; i < XCD_BAR_WORDS; i += 512) bar[i] = 0u;
        __syncthreads();
    }
#define WSP(off) ((bf16_t*)(p.ws + (off)))
#define GRID_BAR() do { XcdBarrier b_; b_.bar = (unsigned*)(fresh_params().ws + WS_BAR); b_.x = xb_xcc_id(); b_.st = (volatile LAS unsigned*)((LAS unsigned char*)lds + pg8::STAGE_BYTES); xcd_barrier(b_); } while (0)
    for (int l = 0; l < 2; ++l) {
        { const Params p = fresh_params(); prep_phase(p, l, (float*)lds); }
        if (l == 0) { grid.sync(); (void)xcd_barrier_post((unsigned*)(fresh_params().ws + WS_BAR), (volatile LAS unsigned*)((LAS unsigned char*)lds + pg8::STAGE_BYTES)); }
        else GRID_BAR();
        { const Params p = fresh_params(); EpiIn E{WSP(WS_B1), WSP(WS_B2), (const float*)(p.ws + WS_SSQ), (bf16_t*)p.out, WSP(WS_SC), WSP(WS_SCB), p.in[8] + (size_t)l * 3 * 512}; run_gemm(lds, WSP(WS_XB), WSP(WS_WIN), MTOK, NIN, DM, E); }
        GRID_BAR();
        { const Params p = fresh_params(); mixer_phase(p, l, lds); }
        GRID_BAR();
        { const Params p = fresh_params(); EpiBr E{WSP(WS_B2), WSP(WS_B1)}; run_gemm(lds, (const bf16_t*)p.out  , WSP(WS_WBR), MTOK, DM, NBR, E); }
        GRID_BAR();
        { const Params p = fresh_params(); EpiRes E{WSP(WS_XB), (float*)(p.ws + WS_SSQ)}; run_gemm(lds, WSP(WS_B1), WSP(WS_WO), MTOK, DM, DM, E); }
        GRID_BAR();
        { const Params p = fresh_params(); EpiUp E{WSP(WS_B1), WSP(WS_B2), (const float*)(p.ws + WS_SSQ), p.in[15] + (size_t)l * 3 * NUP, p.in[16] + (size_t)l * NUP}; run_gemm(lds, WSP(WS_XB), WSP(WS_WUP), MTOK, NUP, DM, E); }
        GRID_BAR();
        { const Params p = fresh_params(); ffn_fixup_phase(p, l); }
        GRID_BAR();
        { const Params p = fresh_params(); EpiRes E{WSP(WS_XB), (float*)(p.ws + WS_SSQ)}; run_gemm(lds, WSP(WS_B1), WSP(WS_WDN), MTOK, DM, DFF, E); }
        GRID_BAR();
    }
    { const Params p = fresh_params(); final_norm_phase(p); }
#undef WSP
#undef GRID_BAR
}

extern "C" void kernel_launch(void* const* d_in, const int* in_sizes, int n_in, void* d_out, int out_size, void* d_ws, size_t ws_size, hipStream_t stream) {
    constexpr size_t kLds = LDS_TOTAL;
    static int grid_blocks = 0;
    if (!grid_blocks) {
        int dev = 0, cus = 0, per_cu = 0;
        (void)hipGetDevice(&dev);
        (void)hipDeviceGetAttribute(&cus, hipDeviceAttributeMultiprocessorCount, dev);
        (void)hipFuncSetAttribute((const void*)fwd_megakernel, hipFuncAttributeMaxDynamicSharedMemorySize, (int)kLds);
        (void)hipOccupancyMaxActiveBlocksPerMultiprocessor(&per_cu, (const void*)fwd_megakernel, 512, kLds);
        if (per_cu < 1) per_cu = 1;
        grid_blocks = cus;
        if (ws_size < WS_TOTAL || n_in != 19 || out_size != MTOK * DM) { fprintf(stderr, "kernel_launch: unexpected sizes: ws %zu (need %zu), n_in %d, out %d\n", ws_size, (size_t)WS_END, n_in, out_size); }
    }
    Params p{};
    for (int i = 0; i < 19; ++i) p.in[i] = (const float*)d_in[i];
    p.out = (float*)d_out; p.ws = (unsigned char*)d_ws;
    void* args[] = {&p};
    hipError_t e = hipLaunchCooperativeKernel((void*)fwd_megakernel, dim3(grid_blocks), dim3(512), args, kLds, stream);
    if (e != hipSuccess) fprintf(stderr, "cooperative launch failed: %s (grid %d)\n", hipGetErrorString(e), grid_blocks);
}
```

```cpp
#include <hip/hip_runtime.h>
#include <hip/hip_cooperative_groups.h>
#include <cstdio>
namespace cg = cooperative_groups;
namespace pg8 {
#define PG8_LAS __attribute__((address_space(3)))
typedef unsigned short bf16_t;
typedef short bf16x8 __attribute__((ext_vector_type(8)));
typedef float f32x4 __attribute__((ext_vector_type(4)));
typedef unsigned u32x4 __attribute__((ext_vector_type(4)));
constexpr int BM = 256, BK = 64, HALF = 128, HTB = HALF * BK * 2  , STAGE_BYTES = 8 * HTB, NXCD = 8, WGM = 8;

__host__ __device__ __forceinline__ int lds_byte(int r, int c) { const int st = (r >> 4) * 2 + (c >> 5), rr = r & 15, cc = c & 31, ob = rr * 64 + cc * 2; return st * 1024 + (ob ^ (((ob >> 9) & 1) << 5)); }
__host__ __device__ __forceinline__ void stage_rc(int b, int& R, int& C) { const int st = b / 1024, sb = b % 1024, swz = sb ^ (((sb >> 9) & 1) << 5); R = (st >> 1) * 16 + swz / 64; C = (st & 1) * 32 + (swz % 64) / 2; }
__host__ __device__ __forceinline__ int perm32(int rho) { const int n = rho >> 4, i = rho & 15; return 8 * (i >> 2) + 4 * n + (i & 3); }

struct Unit { int pm, pn; };
struct Gemm { const bf16_t* A; const bf16_t* Bt; int M, N, K; };

struct StaticOrder {
    int nM, nN, nwg, G, c;
    __host__ __device__ void init(int M, int N, int G_, int c_) { nM = M / BM; nN = N / BM; nwg = nM * nN; G = G_; c = c_; }
    __host__ __device__ bool next(int i, Unit& u) const {
        const long L = (long)i * G + c; if (L >= nwg) return false;
        int wgid = (int)L; { const int q = nwg / NXCD, r = nwg % NXCD, xcd = wgid % NXCD, off = wgid / NXCD; wgid = (xcd < r ? xcd * (q + 1) : r * (q + 1) + (xcd - r) * q) + off; }
        const int nig = WGM * nN, gid = wgid / nig, fm = gid * WGM, gsz = (nM - fm) < WGM ? (nM - fm) : WGM;
        u.pm = fm + ((wgid % nig) % gsz); u.pn = (wgid % nig) / gsz; return true;
    }
    __device__ __forceinline__ void a_ready(const Unit&) const {}
    __device__ __forceinline__ void done(const Unit&) const {}
};
__device__ __forceinline__ unsigned cvt_pk_bf16(float lo, float hi) { unsigned r; asm volatile("v_cvt_pk_bf16_f32 %0, %1, %2" : "=v"(r) : "v"(lo), "v"(hi)); return r; }

template <class Epi, class Sched, bool STAMP = false>
__device__ __forceinline__ void gemm_phase(PG8_LAS unsigned char* lds, const Gemm g, const Sched& S, const Epi& E, unsigned long long* stamps) {
    int tid_ = threadIdx.x; asm volatile("" : "+v"(tid_));
    const int tid = tid_, wid = __builtin_amdgcn_readfirstlane(tid >> 6), lane = tid & 63, wr = wid >> 2, wc = wid & 3, fr = lane & 15, fq = lane >> 4;
    const int K = g.K, nt = K / BK;
    int ts_lo = 0, ts_hi = 0, nts = 0; const unsigned long long rt_entry = STAMP ? (unsigned long long)wall_clock64() : 0ull;
#define PG8_STAMP() do { if (STAMP && wid == 0 && nts < 64) { const unsigned long long _c = (unsigned long long)clock64(); \
        ts_lo = (lane == nts) ? (int)(unsigned)_c : ts_lo; ts_hi = (lane == nts) ? (int)(unsigned)(_c >> 32) : ts_hi; ++nts; } } while (0)
    PG8_STAMP();
    unsigned voffA[2], voffB[2];
#pragma unroll
    for (int i = 0; i < 2; ++i) { int R, C; stage_rc(tid * 16 + i * 8192, R, C); const int Rb = Epi::PERM ? ((R & ~31) + perm32(R & 31)) : R;
        voffA[i] = (unsigned)(R * K + C) * 2u; voffB[i] = (unsigned)(Rb * K + C) * 2u; }
    const size_t kstep = (size_t)(BK * 2);
    const size_t hstep = (size_t)HALF * K * 2;
    const size_t tstep = 2 * hstep;
    const unsigned ldsw = (unsigned)wid * 1024u;
    const int aoff = lds_byte(wr * 64 + fr, fq * 8), boff = lds_byte(wc * 32 + fr, fq * 8);
#define PG8_SA(b, h) (((b) * 2 + (h)) * HTB)
#define PG8_SB(b, h) ((4 + (b) * 2 + (h)) * HTB)
#define PG8_STAGE(bufoff, gbase, voff) do { _Pragma("unroll") for (int _i = 0; _i < 2; ++_i) \
        __builtin_amdgcn_global_load_lds((const unsigned*)((const char*)(gbase) + (voff)[_i]), (PG8_LAS unsigned*)(lds + (bufoff) + ldsw + _i * 8192), 16, 0, 0); } while (0)
#define PG8_LDA(dst, b, h) do { _Pragma("unroll") for (int m = 0; m < 4; ++m) _Pragma("unroll") for (int k = 0; k < 2; ++k) dst[m][k] = *(const PG8_LAS bf16x8*)(lds + PG8_SA(b, h) + aoff + m * 2048 + k * 1024); } while (0)
#define PG8_LDB(dst, b, h) do { _Pragma("unroll") for (int n = 0; n < 2; ++n) _Pragma("unroll") for (int k = 0; k < 2; ++k) dst[n][k] = *(const PG8_LAS bf16x8*)(lds + PG8_SB(b, h) + boff + n * 2048 + k * 1024); } while (0)
#define PG8_MMA(ai, bj, At, Bt) do { __builtin_amdgcn_s_setprio(1); _Pragma("unroll") for (int m = 0; m < 4; ++m) _Pragma("unroll") for (int n = 0; n < 2; ++n) _Pragma("unroll") for (int k = 0; k < 2; ++k) \
        acc[ai][bj][m][n] = __builtin_amdgcn_mfma_f32_16x16x32_bf16(Bt[n][k], At[m][k], acc[ai][bj][m][n], 0, 0, 0); __builtin_amdgcn_s_setprio(0); } while (0)
#define PG8_WAIT_V(n) asm volatile("s_waitcnt vmcnt(" #n ")" ::: "memory")
#define PG8_WAIT_L(n) asm volatile("s_waitcnt lgkmcnt(" #n ")" ::: "memory")
#define PG8_BAR __builtin_amdgcn_s_barrier()
#define PG8_SCHED __builtin_amdgcn_sched_barrier(0)
    Unit cur, nxt; int ui = 0;
    if (!S.next(0, cur)) return;
    f32x4 acc[2][2][4][2];
#pragma unroll
    for (int a = 0; a < 2; ++a)
#pragma unroll
        for (int b = 0; b < 2; ++b)
#pragma unroll
            for (int m = 0; m < 4; ++m)
#pragma unroll
                for (int n = 0; n < 2; ++n) acc[a][b][m][n] = (f32x4){0.f, 0.f, 0.f, 0.f};
    bf16x8 At[4][2], B0[2][2], B1[2][2];
    const char* cA = (const char*)g.A + (size_t)cur.pm * tstep; const char* cB = (const char*)g.Bt + (size_t)cur.pn * tstep;
    S.a_ready(cur);
    PG8_STAGE(PG8_SB(0, 0), cB, voffB); PG8_STAGE(PG8_SA(0, 0), cA, voffA); PG8_STAGE(PG8_SB(0, 1), cB + hstep, voffB); PG8_STAGE(PG8_SA(0, 1), cA + hstep, voffA);
    if (wr == 1) PG8_BAR;
    PG8_WAIT_V(4); PG8_BAR;
    PG8_STAGE(PG8_SB(1, 0), cB + kstep, voffB); PG8_STAGE(PG8_SA(1, 0), cA + kstep, voffA); PG8_STAGE(PG8_SB(1, 1), cB + hstep + kstep, voffB);
    PG8_WAIT_V(6); PG8_BAR;
    PG8_STAMP();
    for (;;) {
        const bool has_next = S.next(ui + 1, nxt);
        const char* nA = has_next ? (const char*)g.A + (size_t)nxt.pm * tstep : cA; const char* nB = has_next ? (const char*)g.Bt + (size_t)nxt.pn * tstep : cB;
        for (int t = 0; t < nt; t += 2) {
            if constexpr (Epi::MIDK) { if (t == 8 || t == 16) E.mid(acc, cur, t, wr, wc, fr, fq); }
            const bool last = (t == nt - 2);
            const char* a1 = cA + (size_t)(t + 1) * kstep;
            const char* a2 = last ? nA : cA + (size_t)(t + 2) * kstep; const char* b2 = last ? nB : cB + (size_t)(t + 2) * kstep;
            const char* a3 = a2 + kstep; const char* b3 = b2 + kstep;
            if (last && has_next) S.a_ready(nxt);
            PG8_LDB(B0, 0, 0); PG8_SCHED; PG8_LDA(At, 0, 0); PG8_STAGE(PG8_SA(1, 1), a1 + hstep, voffA);
            PG8_WAIT_L(8); PG8_BAR; PG8_WAIT_L(0); PG8_MMA(0, 0, At, B0); PG8_BAR; PG8_SCHED;
            PG8_LDB(B1, 0, 1); PG8_STAGE(PG8_SB(0, 0), b2, voffB);
            PG8_BAR; PG8_WAIT_L(0); PG8_MMA(0, 1, At, B1); PG8_BAR;
            PG8_LDA(At, 0, 1); PG8_STAGE(PG8_SA(0, 0), a2, voffA);
            PG8_BAR; PG8_WAIT_L(0); PG8_MMA(1, 0, At, B0); PG8_BAR; PG8_SCHED;
            PG8_STAGE(PG8_SB(0, 1), b2 + hstep, voffB);
            PG8_WAIT_V(6); PG8_BAR; PG8_MMA(1, 1, At, B1); PG8_BAR;
            PG8_LDB(B0, 1, 0); PG8_SCHED; PG8_LDA(At, 1, 0); PG8_STAGE(PG8_SA(0, 1), a2 + hstep, voffA);
            PG8_WAIT_L(8); PG8_BAR; PG8_WAIT_L(0); PG8_MMA(0, 0, At, B0); PG8_BAR; PG8_SCHED;
            PG8_LDB(B1, 1, 1); PG8_STAGE(PG8_SB(1, 0), b3, voffB);
            PG8_BAR; PG8_WAIT_L(0); PG8_MMA(0, 1, At, B1); PG8_BAR;
            PG8_LDA(At, 1, 1); PG8_STAGE(PG8_SA(1, 0), a3, voffA);
            PG8_BAR; PG8_WAIT_L(0); PG8_MMA(1, 0, At, B0); PG8_BAR; PG8_SCHED;
            PG8_STAGE(PG8_SB(1, 1), b3 + hstep, voffB);
            PG8_WAIT_V(6); PG8_BAR; PG8_MMA(1, 1, At, B1); PG8_BAR;
        }
        PG8_STAMP();
        if constexpr (!Epi::AFTER_DRAIN) { E(acc, cur, wr, wc, fr, fq); S.done(cur); }
        PG8_STAMP();
        if (!has_next) break;
#pragma unroll
        for (int a = 0; a < 2; ++a)
#pragma unroll
            for (int b = 0; b < 2; ++b)
#pragma unroll
                for (int m = 0; m < 4; ++m)
#pragma unroll
                    for (int n = 0; n < 2; ++n) acc[a][b][m][n] = (f32x4){0.f, 0.f, 0.f, 0.f};
        cur = nxt; cA = nA; cB = nB; ++ui;
    }
    PG8_WAIT_V(0);
    if (wr == 0) PG8_BAR;
    PG8_BAR;
    if constexpr (Epi::AFTER_DRAIN) { E.fused(acc, cur, wr, wc, fr, fq, lds, wid, lane); S.done(cur); }
    PG8_STAMP();
    if (STAMP && wid == 0) { stamps[lane] = lane < nts ? (((unsigned long long)(unsigned)ts_hi << 32) | (unsigned)ts_lo) : 0ull;
        if (lane == 62) stamps[62] = rt_entry; if (lane == 63) stamps[63] = (unsigned long long)wall_clock64(); }
#undef PG8_STAMP
#undef PG8_SA
#undef PG8_SB
#undef PG8_STAGE
#undef PG8_LDA
#undef PG8_LDB
#undef PG8_MMA
#undef PG8_WAIT_V
#undef PG8_WAIT_L
#undef PG8_BAR
#undef PG8_SCHED
}
}
typedef pg8::bf16_t bf16_t;
typedef pg8::f32x4 f32x4;
typedef pg8::u32x4 u32x4;
typedef pg8::bf16x8 bf16x8;
typedef unsigned u32x2 __attribute__((ext_vector_type(2)));
#define LAS __attribute__((address_space(3)))
constexpr int MTOK = 65536, DM = 1024, NIN = 6144, DFF = 2816, NUP = 5632, SEQ = 8192, NBR = 1536, NPA = 3072;
constexpr int NPA2 = 1536;
constexpr int MH = MTOK / 2;
constexpr float EPS = 1e-6f;
constexpr size_t WS_WIN = 0;
constexpr size_t WS_WBR = WS_WIN + (size_t)NIN * DM * 2;
constexpr size_t WS_WO = WS_WBR + (size_t)DM * NBR * 2;
constexpr size_t WS_WUP = WS_WO + (size_t)DM * DM * 2;
constexpr size_t WS_WDN = WS_WUP + (size_t)NUP * DM * 2;
constexpr size_t WS_SSQ = WS_WDN + (size_t)DM * DFF * 2;
constexpr size_t WS_XB = WS_SSQ + (size_t)MTOK * 16 * 4;
constexpr size_t WS_B1 = WS_XB + (size_t)MTOK * NBR * 2;
constexpr size_t WS_B2 = WS_B1 + (size_t)MTOK * NPA * 2;
constexpr size_t WS_END = WS_B2 + (size_t)MTOK * NPA * 2;
constexpr size_t WS_BAR = WS_END;
constexpr size_t WS_SC = WS_BAR + 16384;
constexpr size_t WS_SCB = WS_SC + (size_t)(MTOK / 64) * 4 * 512 * 2;
constexpr size_t WS_TOTAL = WS_SCB + (size_t)(MTOK / 64) * 2 * 512 * 2;

__device__ __forceinline__ int otid() { int t = threadIdx.x; asm volatile("" : "+v"(t)); return t; }
__device__ __forceinline__ int obid() { int b = blockIdx.x; asm volatile("" : "+s"(b)); return b; }
struct Params {
    const float* in[19];
    float* out; unsigned char* ws;
};

__device__ __forceinline__ void st_nt16(void* p, u32x4 w) { __builtin_nontemporal_store(w, (u32x4*)p); }
__device__ __forceinline__ float bflo(unsigned w) { return __uint_as_float(w << 16); }
__device__ __forceinline__ float bfhi(unsigned w) { return __uint_as_float(w & 0xffff0000u); }
__device__ __forceinline__ unsigned pk(float a, float b) { return pg8::cvt_pk_bf16(a, b); }
__device__ __forceinline__ float fast_rcp(float x) { return __builtin_amdgcn_rcpf(x); }
__device__ __forceinline__ float gate_t2(float y) { return 1.0f + __builtin_amdgcn_exp2f(fminf(y, 43.28f)); }
__device__ __forceinline__ float gelu_tanh_f(float x) {
    const float z2 = 1.5957691216f * (x + 0.044715f * x * x * x);
    return x * fast_rcp(1.0f + __expf(-z2));
}
__device__ __forceinline__ float silu_f(float x) { return x * fast_rcp(1.0f + __expf(-x)); }
__device__ __forceinline__ float row_rstd(const float* ssq, int r) {
    const f32x4* p = (const f32x4*)(ssq + (size_t)r * 16);
    const f32x4 a = p[0], b = p[1], c = p[2], d = p[3];
    const float s = ((a[0] + a[1]) + (a[2] + a[3])) + ((b[0] + b[1]) + (b[2] + b[3])) + ((c[0] + c[1]) + (c[2] + c[3])) + ((d[0] + d[1]) + (d[2] + d[3]));
    return rsqrtf(s * (1.0f / 1024.0f) + EPS);
}

__device__ __forceinline__ void rows_rstd8(const float* ssq, int row0, int fq, float (&rs)[8]) {
    f32x4 v[8];
#pragma unroll
    for (int i = 0; i < 8; ++i) v[i] = *(const f32x4*)(ssq + (size_t)(row0 + (i >> 2) * 128 + (i & 3) * 16) * 16 + fq * 4);
#pragma unroll
    for (int i = 0; i < 8; ++i) {
        float s = (v[i][0] + v[i][1]) + (v[i][2] + v[i][3]);
        s += __shfl_xor(s, 16); s += __shfl_xor(s, 32);
        rs[i] = rsqrtf(s * (1.0f / 1024.0f) + EPS);
    }
}
__device__ __forceinline__ float dpp_ror1(float x) { return __int_as_float(__builtin_amdgcn_mov_dpp(__float_as_int(x), 0x121, 0xf, 0xf, true)); }
__device__ __forceinline__ float dpp_ror2(float x) { return __int_as_float(__builtin_amdgcn_mov_dpp(__float_as_int(x), 0x122, 0xf, 0xf, true)); }
__device__ __forceinline__ float dpp_shr1(float old, float x) { return __int_as_float(__builtin_amdgcn_update_dpp(__float_as_int(old), __float_as_int(x), 0x111, 0xf, 0xf, false)); }
__device__ __forceinline__ float dpp_shr2(float old, float x) { return __int_as_float(__builtin_amdgcn_update_dpp(__float_as_int(old), __float_as_int(x), 0x112, 0xf, 0xf, false)); }
struct EpiIn {
    static constexpr bool PERM = true, AFTER_DRAIN = false, MIDK = false;
    bf16_t* PA; bf16_t* G; const float* ssq; bf16_t* Y; bf16_t* sc; bf16_t* scb; const float* cw;
    __device__ __forceinline__ void operator()(const f32x4 (&acc)[2][2][4][2], const pg8::Unit& u, int wr, int wc, int fr, int fq) const {
        const int row0 = u.pm * 256 + wr * 64 + fr;
        float rs8[8]; rows_rstd8(ssq, row0, fq, rs8);
        if (u.pn >= 16) {
            const int q0 = (u.pn - 16) * 64 + wc * 16 + fq * 4;
            const f32x4 w0 = *(const f32x4*)(cw + q0), w1 = *(const f32x4*)(cw + 512 + q0), w2 = *(const f32x4*)(cw + 1024 + q0);
#pragma unroll
            for (int ai = 0; ai < 2; ++ai) {
                f32x4 pz = {0.f, 0.f, 0.f, 0.f};
                const int blk = u.pm * 4 + ai * 2 + wr;
#pragma unroll
                for (int m = 0; m < 4; ++m) {
                    const float rs = rs8[ai * 4 + m];
                    const f32x4 cb = acc[ai][0][m][0] * rs, cc = acc[ai][0][m][1] * rs, cx = acc[ai][1][m][0] * rs, av = acc[ai][1][m][1] * rs;
                    const f32x4 z = cc * cx;
                    float y[4];
#pragma unroll
                    for (int j = 0; j < 4; ++j) {
                        const float z1 = dpp_shr1(dpp_ror1(pz[j]), z[j]), z2 = dpp_shr2(dpp_ror2(pz[j]), z[j]);
                        y[j] = cb[j] * (w0[j] * z2 + w1[j] * z1 + w2[j] * z[j]);
                        asm volatile("" : "+v"(y[j]));
                    }
                    const int r = row0 + ai * 128 + m * 16;
                    u32x2 w;
                    w.x = pk(av[0], av[1]); w.y = pk(av[2], av[3]); *(u32x2*)(PA + (size_t)r * NPA2 + q0) = w;
                    if (!(m == 0 && fr < 2)) { w.x = pk(y[0], y[1]); w.y = pk(y[2], y[3]); *(u32x2*)(Y + (size_t)r * NBR + 1024 + q0) = w; }
                    if (m == 0 && fr < 2) {
                        w.x = pk(z[0], z[1]); w.y = pk(z[2], z[3]); *(u32x2*)(sc + ((size_t)blk * 4 + 2 + fr) * 512 + q0) = w;
                        w.x = pk(cb[0], cb[1]); w.y = pk(cb[2], cb[3]); *(u32x2*)(scb + ((size_t)blk * 2 + fr) * 512 + q0) = w;
                    }
                    if (m == 3 && fr >= 14) { w.x = pk(z[0], z[1]); w.y = pk(z[2], z[3]); *(u32x2*)(sc + ((size_t)blk * 4 + (fr - 14)) * 512 + q0) = w; }
                    pz = z;
                }
            }
        } else {
            const int q0 = u.pn * 64 + wc * 16 + fq * 4;
#pragma unroll
            for (int ai = 0; ai < 2; ++ai)
#pragma unroll
                for (int m = 0; m < 4; ++m) {
                    const float rs = rs8[ai * 4 + m], rsn = rs * -1.44269504f;
                    const f32x4 ga = acc[ai][0][m][0] * rsn, gb = acc[ai][0][m][1] * rsn, gc = acc[ai][1][m][0] * rsn, uv = acc[ai][1][m][1] * rs;
                    float r1[4], r2[4], s3[4], ug[4];
#pragma unroll
                    for (int j = 0; j < 4; ++j) {
                        const float ta = gate_t2(ga[j]), tb = gate_t2(gb[j]), tc = gate_t2(gc[j]);
                        r1[j] = tb * fast_rcp(ta); r2[j] = tc * fast_rcp(tb); s3[j] = fast_rcp(tc);
                        ug[j] = gelu_tanh_f(uv[j]);
                    }
                    const size_t ro = (size_t)(row0 + ai * 128 + m * 16) * NPA, rp = (size_t)(row0 + ai * 128 + m * 16) * NPA2;
                    u32x2 w;
                    w.x = pk(r1[0], r1[1]); w.y = pk(r1[2], r1[3]); *(u32x2*)(G + ro + q0) = w;
                    w.x = pk(r2[0], r2[1]); w.y = pk(r2[2], r2[3]); *(u32x2*)(G + ro + 1024 + q0) = w;
                    w.x = pk(s3[0], s3[1]); w.y = pk(s3[2], s3[3]); *(u32x2*)(G + ro + 2048 + q0) = w;
                    w.x = pk(ug[0], ug[1]); w.y = pk(ug[2], ug[3]); *(u32x2*)(PA + rp + 512 + q0) = w;
                }
        }
    }
};
struct EpiBr {
    static constexpr bool PERM = true, AFTER_DRAIN = false, MIDK = true;
    const bf16_t* G; bf16_t* out;
    __device__ __forceinline__ void mid(f32x4 (&acc)[2][2][4][2], const pg8::Unit& u, int t, int wr, int wc, int fr, int fq) const {
        const int seg = (t == 8) ? 0 : 1024;
        int col0 = u.pn * 256 + wc * 32 + 8 * fq + seg;
        int row0 = u.pm * 256 + wr * 64 + fr;
        asm volatile("" : "+v"(col0), "+v"(row0));
#pragma unroll
        for (int ai = 0; ai < 2; ++ai) {
            u32x4 nu[4][2];
#pragma unroll
            for (int m = 0; m < 4; ++m)
#pragma unroll
                for (int bj = 0; bj < 2; ++bj) nu[m][bj] = *(const u32x4*)(G + (size_t)(row0 + ai * 128 + m * 16) * NPA + col0 + bj * 128);
            asm volatile("" ::: "memory");
#pragma unroll
            for (int m = 0; m < 4; ++m)
#pragma unroll
                for (int bj = 0; bj < 2; ++bj) {
                    const unsigned nw[4] = {nu[m][bj].x, nu[m][bj].y, nu[m][bj].z, nu[m][bj].w};
#pragma unroll
                    for (int q = 0; q < 4; ++q) { acc[ai][bj][m][q >> 1][(q & 1) * 2] *= bflo(nw[q]); acc[ai][bj][m][q >> 1][(q & 1) * 2 + 1] *= bfhi(nw[q]); }
                }
            asm volatile("" ::: "memory");
        }
    }
    __device__ __forceinline__ void operator()(const f32x4 (&acc)[2][2][4][2], const pg8::Unit& u, int wr, int wc, int fr, int fq) const {
        const int col0 = u.pn * 256 + wc * 32 + 8 * fq;
        const int row0 = u.pm * 256 + wr * 64 + fr;
        u32x4 sg[2][4][2];
#pragma unroll
        for (int ai = 0; ai < 2; ++ai)
#pragma unroll
            for (int m = 0; m < 4; ++m)
#pragma unroll
                for (int bj = 0; bj < 2; ++bj) sg[ai][m][bj] = *(const u32x4*)(G + (size_t)(row0 + ai * 128 + m * 16) * NPA + 2048 + col0 + bj * 128);
#pragma unroll
        for (int ai = 0; ai < 2; ++ai)
#pragma unroll
            for (int m = 0; m < 4; ++m) {
                const int r = row0 + ai * 128 + m * 16;
                bf16_t* op = out + (size_t)r * DM + col0;
#pragma unroll
                for (int bj = 0; bj < 2; ++bj) {
                    const u32x4 s = sg[ai][m][bj];
                    const f32x4 a0 = acc[ai][bj][m][0], a1 = acc[ai][bj][m][1];
                    u32x4 w;
                    w.x = pk(a0[0] * bflo(s.x), a0[1] * bfhi(s.x)); w.y = pk(a0[2] * bflo(s.y), a0[3] * bfhi(s.y));
                    w.z = pk(a1[0] * bflo(s.z), a1[1] * bfhi(s.z)); w.w = pk(a1[2] * bflo(s.w), a1[3] * bfhi(s.w));
                    *(u32x4*)(op + bj * 128) = w;
                }
            }
    }
};
struct EpiRes {
    static constexpr bool PERM = true, AFTER_DRAIN = false, MIDK = false;
    bf16_t* xb; float* ssq;
    __device__ __forceinline__ void operator()(const f32x4 (&acc)[2][2][4][2], const pg8::Unit& u, int wr, int wc, int fr, int fq) const {
        const int col0 = u.pn * 256 + wc * 32 + 8 * fq;
        const int row0 = u.pm * 256 + wr * 64 + fr;
        u32x4 bb[2][4][2];
#pragma unroll
        for (int ai = 0; ai < 2; ++ai)
#pragma unroll
            for (int m = 0; m < 4; ++m)
#pragma unroll
                for (int bj = 0; bj < 2; ++bj) bb[ai][m][bj] = *(const u32x4*)(xb + (size_t)(row0 + ai * 128 + m * 16) * DM + col0 + bj * 128);
        asm volatile("" ::: "memory");
#pragma unroll
        for (int ai = 0; ai < 2; ++ai) {
#pragma unroll
            for (int m = 0; m < 4; ++m) {
                const int r = row0 + ai * 128 + m * 16;
                float sq = 0.f;
#pragma unroll
                for (int bj = 0; bj < 2; ++bj) {
                    const u32x4 s = bb[ai][m][bj];
                    const f32x4 a0 = acc[ai][bj][m][0], a1 = acc[ai][bj][m][1];
                    const float o0 = bflo(s.x) + a0[0], o1 = bfhi(s.x) + a0[1], o2 = bflo(s.y) + a0[2], o3 = bfhi(s.y) + a0[3];
                    const float o4 = bflo(s.z) + a1[0], o5 = bfhi(s.z) + a1[1], o6 = bflo(s.w) + a1[2], o7 = bfhi(s.w) + a1[3];
                    u32x4 w; w.x = pk(o0, o1); w.y = pk(o2, o3); w.z = pk(o4, o5); w.w = pk(o6, o7);
                    *(u32x4*)(xb + (size_t)r * DM + col0 + bj * 128) = w;
                    sq += (o0 * o0 + o1 * o1) + (o2 * o2 + o3 * o3) + (o4 * o4 + o5 * o5) + (o6 * o6 + o7 * o7);
                }
                sq += __shfl_xor(sq, 16); sq += __shfl_xor(sq, 32);
                if (fq == 0) ssq[(size_t)r * 16 + u.pn * 4 + wc] = sq;
            }
            asm volatile("" ::: "memory");
        }
    }
};
struct EpiUp {
    static constexpr bool PERM = true, AFTER_DRAIN = false, MIDK = false;
    bf16_t* act; bf16_t* zs; const float* ssq; const float* cw; const float* cb;
    __device__ __forceinline__ void operator()(const f32x4 (&acc)[2][2][4][2], const pg8::Unit& u, int wr, int wc, int fr, int fq) const {
        const int c0 = u.pn * 128 + wc * 32 + 8 * fq;
        const int row0 = u.pm * 256 + wr * 64 + fr;
        float rs8[8]; rows_rstd8(ssq, row0, fq, rs8);
        u32x2 keep[2][4];
#pragma unroll
        for (int n = 0; n < 2; ++n) {
            const int c = c0 + 4 * n;
            const f32x4 gw0 = *(const f32x4*)(cw + c), gw1 = *(const f32x4*)(cw + NUP + c), gw2 = *(const f32x4*)(cw + 2 * NUP + c), gb = *(const f32x4*)(cb + c);
            const f32x4 vw0 = *(const f32x4*)(cw + DFF + c), vw1 = *(const f32x4*)(cw + NUP + DFF + c), vw2 = *(const f32x4*)(cw + 2 * NUP + DFF + c), vb = *(const f32x4*)(cb + DFF + c);
#pragma unroll
            for (int ai = 0; ai < 2; ++ai) {
                f32x4 pg = {0.f, 0.f, 0.f, 0.f}, pv = {0.f, 0.f, 0.f, 0.f};
                const int blk = u.pm * 4 + ai * 2 + wr;
#pragma unroll
                for (int m = 0; m < 4; ++m) {
                    const float rs = rs8[ai * 4 + m];
                    const f32x4 zg = acc[ai][0][m][n] * rs, zv = acc[ai][1][m][n] * rs;
                    float o[4];
#pragma unroll
                    for (int j = 0; j < 4; ++j) {
                        const float g1 = dpp_shr1(dpp_ror1(pg[j]), zg[j]), g2 = dpp_shr2(dpp_ror2(pg[j]), zg[j]);
                        const float v1 = dpp_shr1(dpp_ror1(pv[j]), zv[j]), v2 = dpp_shr2(dpp_ror2(pv[j]), zv[j]);
                        const float gg = gw2[j] * zg[j] + gw1[j] * g1 + gw0[j] * g2 + gb[j];
                        const float vv = vw2[j] * zv[j] + vw1[j] * v1 + vw0[j] * v2 + vb[j];
                        o[j] = silu_f(gg) * vv;
                    }
                    u32x2 w; w.x = pk(o[0], o[1]); w.y = pk(o[2], o[3]);
                    const int r = row0 + ai * 128 + m * 16;
                    if (n == 0) keep[ai][m] = w;
                    else if (!(m == 0 && fr < 2)) { u32x4 ww; ww.x = keep[ai][m].x; ww.y = keep[ai][m].y; ww.z = w.x; ww.w = w.y; st_nt16(act + (size_t)r * DFF + c0, ww); }
                    if (m == 0 && fr < 2) {
                        bf16_t* zp = zs + ((size_t)blk * 4 + 2 + fr) * NUP + c;
                        u32x2 a; a.x = pk(zg[0], zg[1]); a.y = pk(zg[2], zg[3]); *(u32x2*)zp = a;
                        u32x2 d; d.x = pk(zv[0], zv[1]); d.y = pk(zv[2], zv[3]); *(u32x2*)(zp + DFF) = d;
                    }
                    if (m == 3 && fr >= 14) {
                        bf16_t* zp = zs + ((size_t)blk * 4 + (fr - 14)) * NUP + c;
                        u32x2 a; a.x = pk(zg[0], zg[1]); a.y = pk(zg[2], zg[3]); *(u32x2*)zp = a;
                        u32x2 d; d.x = pk(zv[0], zv[1]); d.y = pk(zv[2], zv[3]); *(u32x2*)(zp + DFF) = d;
                    }
                    pg = zg; pv = zv;
                }
            }
        }
    }
};

__device__ __forceinline__ int win_dest_row(int col) {
    int ch, bj, n, t0;
    if (col < 512) { ch = col; bj = 1; n = 1; t0 = 16; }
    else if (col < 1536) { ch = col - 512; bj = 1; n = 1; t0 = 0; }
    else if (col < 3072) { const int s = (col - 1536) >> 9; ch = (col - 1536) & 511; bj = s >> 1; n = s & 1; t0 = 16; }
    else { const int gi = (col - 3072) >> 10; ch = (col - 3072) & 1023; bj = gi >> 1; n = gi & 1; t0 = 0; }
    const int k = t0 + (ch >> 6), r = ch & 63;
    return 256 * k + 128 * bj + 32 * (r >> 4) + 8 * ((r >> 2) & 3) + 4 * n + (r & 3);
}
__device__ __forceinline__ void transpose_tile(const float* __restrict__ W, int N, const float* __restrict__ g, bf16_t* __restrict__ Wt, int ldt, int koff, int k0, int n0, int nd0, float* tile, int tid, bool winmap = false) {
    {
        const int kk = tid >> 4, nn = (tid & 15) * 4;
#pragma unroll
        for (int h = 0; h < 2; ++h) {
            const int k = kk + h * 32;
            f32x4 v = *(const f32x4*)(W + (size_t)(k0 + k) * N + n0 + nn);
            const float s = g ? g[k0 + k] : 1.0f;
            tile[k * 65 + nn + 0] = v[0] * s; tile[k * 65 + nn + 1] = v[1] * s; tile[k * 65 + nn + 2] = v[2] * s; tile[k * 65 + nn + 3] = v[3] * s;
        }
    }
    __syncthreads();
    {
        const int n = tid >> 3, kq = (tid & 7) * 8;
        float v[8];
#pragma unroll
        for (int j = 0; j < 8; ++j) v[j] = tile[(kq + j) * 65 + n];
        u32x4 w; w.x = pk(v[0], v[1]); w.y = pk(v[2], v[3]); w.z = pk(v[4], v[5]); w.w = pk(v[6], v[7]);
        *(u32x4*)(Wt + (size_t)(winmap ? win_dest_row(n0 + n) : nd0 + n) * ldt + koff + k0 + kq) = w;
    }
    __syncthreads();
}

__device__ __forceinline__ void prep_phase(const Params& p, int l, float* ldsf) {
    unsigned char* ws = p.ws;
    bf16_t* wt_in = (bf16_t*)(ws + WS_WIN); bf16_t* wt_br = (bf16_t*)(ws + WS_WBR); bf16_t* wt_o = (bf16_t*)(ws + WS_WO);
    bf16_t* wt_up = (bf16_t*)(ws + WS_WUP); bf16_t* wt_dn = (bf16_t*)(ws + WS_WDN);
    const float* g_mix = p.in[1] + (size_t)l * DM; const float* w_in = p.in[2] + (size_t)l * DM * NIN;
    const float* w_pool = p.in[3] + (size_t)l * 4 * 128 * 128; const float* pscale = p.in[4] + (size_t)l * 512;
    const float* w_ba = p.in[9] + (size_t)l * 512 * DM; const float* w_bb = p.in[10] + (size_t)l * 512 * DM; const float* w_bc = p.in[11] + (size_t)l * 512 * DM;
    const float* w_o = p.in[12] + (size_t)l * DM * DM; const float* g_ffn = p.in[13] + (size_t)l * DM;
    const float* w_up = p.in[14] + (size_t)l * DM * NUP; const float* w_dn = p.in[17] + (size_t)l * DFF * DM;
    const int tid = otid(), bid = obid();
    constexpr int T0 = 16 * 96, T1 = T0 + 128, T2 = T1 + 128, T3 = T2 + 256, T4 = T3 + 16 * 88, T5 = T4 + 44 * 16;
    for (int i = bid; i < T5; i += gridDim.x) {
        if (i < T0) { const int kt = i & 15, nt = i >> 4; transpose_tile(w_in, NIN, g_mix, wt_in, DM, 0, kt * 64, nt * 64, nt * 64, ldsf, tid, true); }
        else if (i < T1) { const int j = i - T0, kt = j & 7, nt = j >> 3; transpose_tile(w_bb, DM, nullptr, wt_br, NBR, 512, kt * 64, nt * 64, nt * 64, ldsf, tid); }
        else if (i < T2) { const int j = i - T1, kt = j & 7, nt = j >> 3; transpose_tile(w_bc, DM, nullptr, wt_br, NBR, 1024, kt * 64, nt * 64, nt * 64, ldsf, tid); }
        else if (i < T3) { const int j = i - T2, kt = j & 15, nt = j >> 4; transpose_tile(w_o, DM, nullptr, wt_o, DM, 0, kt * 64, nt * 64, nt * 64, ldsf, tid); }
        else if (i < T4) { const int j = i - T3, kt = j & 15, nt = j >> 4; const int n0 = nt * 64, bj = n0 / DFF, q0 = n0 - bj * DFF; transpose_tile(w_up, NUP, g_ffn, wt_up, DM, 0, kt * 64, n0, (q0 >> 7) * 256 + bj * 128 + (q0 & 127), ldsf, tid);   }
        else { const int j = i - T4, kt = j % 44, nt = j / 44; transpose_tile(w_dn, DM, nullptr, wt_dn, DFF, 0, kt * 64, nt * 64, nt * 64, ldsf, tid); }
    }
    {
        float* wpT = ldsf;
        float* wa = ldsf + 128 * 128;
        for (int it = (int)gridDim.x - 1 - bid; it < 64; it += gridDim.x) {
            const int g = it >> 4, n0 = (it & 15) * 64;
            for (int q = tid; q < 128 * 32; q += 512) {
                const int d = q >> 5, e4 = (q & 31) * 4;
                const f32x4 v = *(const f32x4*)(w_pool + ((size_t)g * 128 + d) * 128 + e4);
                const f32x4 s = *(const f32x4*)(pscale + g * 128 + e4);
                wpT[(e4 + 0) * 128 + d] = v[0] * s[0]; wpT[(e4 + 1) * 128 + d] = v[1] * s[1]; wpT[(e4 + 2) * 128 + d] = v[2] * s[2]; wpT[(e4 + 3) * 128 + d] = v[3] * s[3];
            }
            for (int q = tid; q < 128 * 16; q += 512) {
                const int e = q >> 4, c4 = (q & 15) * 4;
                *(f32x4*)(wa + e * 64 + c4) = *(const f32x4*)(w_ba + (size_t)(g * 128 + e) * DM + n0 + c4);
            }
            __syncthreads();
            const int d = tid & 127, ns = tid >> 7;
            float acc[16];
#pragma unroll
            for (int i = 0; i < 16; ++i) acc[i] = 0.f;
            for (int e = 0; e < 128; ++e) {
                const float w = wpT[e * 128 + d];
                const f32x4* wr4 = (const f32x4*)(wa + e * 64 + ns * 16);
#pragma unroll
                for (int c = 0; c < 4; ++c) { const f32x4 b = wr4[c]; acc[c * 4 + 0] += w * b[0]; acc[c * 4 + 1] += w * b[1]; acc[c * 4 + 2] += w * b[2]; acc[c * 4 + 3] += w * b[3]; }
            }
#pragma unroll
            for (int i = 0; i < 16; ++i) wt_br[(size_t)(n0 + ns * 16 + i) * NBR + g * 128 + d] = (bf16_t)(pk(acc[i], 0.f) & 0xffffu);
            __syncthreads();
        }
    }
    if (l == 0) {
        const float* x = p.in[0]; bf16_t* xb = (bf16_t*)(ws + WS_XB); float* ssq = (float*)(ws + WS_SSQ);
        const int lane = tid & 63, wave = tid >> 6;
        for (int r0 = (bid * 8 + wave) * 2; r0 < MTOK; r0 += gridDim.x * 16) {
            f32x4 v[2][4];
#pragma unroll
            for (int rr = 0; rr < 2; ++rr)
#pragma unroll
                for (int i = 0; i < 4; ++i) v[rr][i] = *(const f32x4*)(x + (size_t)(r0 + rr) * DM + i * 256 + lane * 4);
#pragma unroll
            for (int rr = 0; rr < 2; ++rr) {
                const int r = r0 + rr;
                float sq = 0.f;
#pragma unroll
                for (int i = 0; i < 4; ++i) {
                    const f32x4 t = v[rr][i];
                    sq += (t[0] * t[0] + t[1] * t[1]) + (t[2] * t[2] + t[3] * t[3]);
                    u32x2 w; w.x = pk(t[0], t[1]); w.y = pk(t[2], t[3]);
                    *(u32x2*)(xb + (size_t)r * DM + i * 256 + lane * 4) = w;
                }
#pragma unroll
                for (int o = 32; o >= 1; o >>= 1) sq += __shfl_xor(sq, o);
                if (lane < 16) ssq[(size_t)r * 16 + lane] = (lane == 0) ? sq : 0.f;
            }
        }
    }
}
__device__ __forceinline__ void ld8(const bf16_t* p, float (&v)[8]) {
    const u32x4 w = *(const u32x4*)p;
    v[0] = bflo(w.x); v[1] = bfhi(w.x); v[2] = bflo(w.y); v[3] = bfhi(w.y); v[4] = bflo(w.z); v[5] = bfhi(w.z); v[6] = bflo(w.w); v[7] = bfhi(w.w);
}
__device__ __forceinline__ void st8(bf16_t* p, const float (&v)[8]) {
    u32x4 w; w.x = pk(v[0], v[1]); w.y = pk(v[2], v[3]); w.z = pk(v[4], v[5]); w.w = pk(v[6], v[7]);
    *(u32x4*)p = w;
}
template <int W> __device__ __forceinline__ void pool_rows(const bf16_t* __restrict__ ap, bf16_t* __restrict__ yp, int r0, int pos0) {
#pragma unroll
    for (int b = 0; b < 4; ++b) {
        const int base = r0 + 4 * b;
        u32x4 h[W + 3];
#pragma unroll
        for (int i = 0; i < W + 3; ++i) { const int rr = base - (W - 1) + i; h[i] = (pos0 + rr >= 0) ? *(const u32x4*)(ap + (ptrdiff_t)rr * NPA2) : (u32x4){0u, 0u, 0u, 0u}; }
        float s[8];
#pragma unroll
        for (int j = 0; j < 8; ++j) s[j] = 0.f;
#pragma unroll
        for (int i = 0; i < W - 1; ++i) { const u32x4 q = h[i];
            s[0] += bflo(q.x); s[1] += bfhi(q.x); s[2] += bflo(q.y); s[3] += bfhi(q.y); s[4] += bflo(q.z); s[5] += bfhi(q.z); s[6] += bflo(q.w); s[7] += bfhi(q.w); }
#pragma unroll
        for (int i = 0; i < 4; ++i) {
            const int rr = base + i, pos = pos0 + rr; const float inv = 1.0f / (float)(pos + 1 < W ? pos + 1 : W);
            const u32x4 q = h[W - 1 + i], od = h[i];
            const float v[8] = {bflo(q.x), bfhi(q.x), bflo(q.y), bfhi(q.y), bflo(q.z), bfhi(q.z), bflo(q.w), bfhi(q.w)};
            float o[8];
#pragma unroll
            for (int j = 0; j < 8; ++j) { s[j] += v[j]; o[j] = s[j] * inv - v[j]; }
            st8(yp + (size_t)rr * NBR, o);
            s[0] -= bflo(od.x); s[1] -= bfhi(od.x); s[2] -= bflo(od.y); s[3] -= bfhi(od.y); s[4] -= bflo(od.z); s[5] -= bfhi(od.z); s[6] -= bflo(od.w); s[7] -= bfhi(od.w);
        }
        asm volatile("" ::: "memory");
    }
}
constexpr int VT_PITCH = 136;
__device__ __forceinline__ void mixer_phase(const Params& p, int l, unsigned char* lds) {
    const bf16_t* PA = (const bf16_t*)(p.ws + WS_B1);
    bf16_t* Y = (bf16_t*)p.out;
    const float* g_sgu = p.in[5] + (size_t)l * 512;
    const float* w_sp = p.in[6] + (size_t)l * 4 * 128 * 128;
    const float* b_sp = p.in[7] + (size_t)l * 4 * 128;
    const float* conv_c = p.in[8] + (size_t)l * 3 * 512;
    float* rs = (float*)lds;
    bf16_t* vT = (bf16_t*)(lds + 1024);
    const int tid = otid(), lane = tid & 63, wave = __builtin_amdgcn_readfirstlane(tid >> 6), fr = lane & 15, fq = lane >> 4;
    for (int item = obid(); item < MTOK / 128; item += gridDim.x) {
        const int t0 = item * 128, pos0 = t0 & (SEQ - 1);
        {
            const int row = tid >> 2, q = tid & 3;
            const bf16_t* vp = PA + (size_t)(t0 + row) * NPA2 + 1024 + q * 128;
            float sq = 0.f;
#pragma unroll
            for (int i = 0; i < 16; ++i) { float v[8]; ld8(vp + i * 8, v);
#pragma unroll
                for (int j = 0; j < 8; ++j) sq += v[j] * v[j]; }
            sq += __shfl_xor(sq, 1); sq += __shfl_xor(sq, 2);
            if (q == 0) rs[row] = rsqrtf(sq * (1.0f / 512.0f) + EPS);
        }
        {
            const int grp = wave & 3;
            const int c8 = (grp * 16 + (lane & 15)) * 8; int r0 = ((wave >> 2) * 4 + (lane >> 4)) * 16;
            asm volatile("" : "+v"(r0));
            {
                const bf16_t* ap = PA + (size_t)t0 * NPA2 + c8;
                bf16_t* yp = Y + (size_t)t0 * NBR + c8;
                if (grp == 0) pool_rows<2>(ap, yp, r0, pos0); else if (grp == 1) pool_rows<4>(ap, yp, r0, pos0); else if (grp == 2) pool_rows<8>(ap, yp, r0, pos0); else pool_rows<16>(ap, yp, r0, pos0);
            }
        }
        if (tid < 256) {
            const bf16_t* sc = (const bf16_t*)(p.ws + WS_SC); const bf16_t* scb = (const bf16_t*)(p.ws + WS_SCB);
            const int b_ = tid >> 7, ri = (tid >> 6) & 1, c8 = (tid & 63) * 8;
            const int blk = (t0 >> 6) + b_;
            const bool first = ((blk * 64) & (SEQ - 1)) == 0;
            float z2[8], z1[8], z0[8], cbv[8], o[8];
#pragma unroll
            for (int j = 0; j < 8; ++j) { z2[j] = 0.f; z1[j] = 0.f; }
            const bf16_t* own = sc + (size_t)blk * 4 * 512 + c8;
            if (ri == 0) { if (!first) { ld8(own - 4 * 512, z2); ld8(own - 3 * 512, z1); } ld8(own + 2 * 512, z0); }
            else { if (!first) ld8(own - 3 * 512, z2); ld8(own + 2 * 512, z1); ld8(own + 3 * 512, z0); }
            ld8(scb + ((size_t)blk * 2 + ri) * 512 + c8, cbv);
#pragma unroll
            for (int j = 0; j < 8; ++j) o[j] = cbv[j] * (conv_c[c8 + j] * z2[j] + conv_c[512 + c8 + j] * z1[j] + conv_c[1024 + c8 + j] * z0[j]);
            st8(Y + (size_t)(blk * 64 + ri) * NBR + 1024 + c8, o);
        }
#pragma unroll 1
        for (int g = 0; g < 4; ++g) {
            const int t = wave * 16 + fr;
            const int nk = (wave >> 1) + 1;
            f32x4 wq[4][2];
#pragma unroll
            for (int k = 0; k < 4; ++k) { const float* wp = w_sp + ((size_t)g * 128 + t) * 128 + k * 32 + fq * 8; wq[k][0] = *(const f32x4*)wp; wq[k][1] = *(const f32x4*)(wp + 4); }
            const bf16_t* up = PA + (size_t)(t0 + t) * NPA2 + 512 + g * 128 + 4 * fq;
            u32x2 uu[8];
#pragma unroll
            for (int n = 0; n < 8; ++n) uu[n] = *(const u32x2*)(up + n * 16);
            const float bias = b_sp[g * 128 + t];
            u32x4 vq[4];
            const int s_ = tid >> 2, dq = (tid & 3) * 32;
            {
                const bf16_t* vp = PA + (size_t)(t0 + s_) * NPA2 + 1024 + g * 128 + dq;
#pragma unroll
                for (int i = 0; i < 4; ++i) vq[i] = *(const u32x4*)(vp + i * 8);
            }
            __syncthreads();
#pragma unroll
            for (int i = 0; i < 4; ++i) {
                const unsigned ww[4] = {vq[i].x, vq[i].y, vq[i].z, vq[i].w};
#pragma unroll
                for (int q = 0; q < 4; ++q) { vT[(dq + i * 8 + q * 2) * VT_PITCH + s_] = (bf16_t)(ww[q] & 0xffffu); vT[(dq + i * 8 + q * 2 + 1) * VT_PITCH + s_] = (bf16_t)(ww[q] >> 16); }
            }
            __syncthreads();
            f32x4 acc[8];
#pragma unroll
            for (int n = 0; n < 8; ++n) acc[n] = (f32x4){0.f, 0.f, 0.f, 0.f};
#pragma unroll
            for (int k = 0; k < 4; ++k) if (k < nk) {
                const int s0 = k * 32 + fq * 8;
                const f32x4 wa = wq[k][0], wb = wq[k][1];
                const f32x4 ra = *(const f32x4*)(rs + s0), rb = *(const f32x4*)(rs + s0 + 4);
                float a[8];
#pragma unroll
                for (int j = 0; j < 4; ++j) { a[j] = (s0 + j <= t) ? wa[j] * ra[j] : 0.f; a[4 + j] = (s0 + 4 + j <= t) ? wb[j] * rb[j] : 0.f; }
                union { u32x4 u; bf16x8 h; } af; af.u.x = pk(a[0], a[1]); af.u.y = pk(a[2], a[3]); af.u.z = pk(a[4], a[5]); af.u.w = pk(a[6], a[7]);
#pragma unroll
                for (int n = 0; n < 8; ++n) {
                    const bf16x8 bfrag = *(const bf16x8*)(vT + (n * 16 + fr) * VT_PITCH + s0);
                    acc[n] = __builtin_amdgcn_mfma_f32_16x16x32_bf16(bfrag, af.h, acc[n], 0, 0, 0);
                }
            }
            bf16_t* yp = Y + (size_t)(t0 + t) * NBR + 512 + g * 128 + 4 * fq;
#pragma unroll
            for (int n = 0; n < 8; ++n) {
                const f32x4 gs = *(const f32x4*)(g_sgu + g * 128 + n * 16 + 4 * fq);
                const float o0 = bflo(uu[n].x) * (acc[n][0] * gs[0] + bias), o1 = bfhi(uu[n].x) * (acc[n][1] * gs[1] + bias);
                const float o2 = bflo(uu[n].y) * (acc[n][2] * gs[2] + bias), o3 = bfhi(uu[n].y) * (acc[n][3] * gs[3] + bias);
                u32x2 w; w.x = pk(o0, o1); w.y = pk(o2, o3);
                *(u32x2*)(yp + n * 16) = w;
            }
        }
        __syncthreads();
    }
}

__device__ __forceinline__ void ffn_fixup_phase(const Params& p, int l) {
    const bf16_t* zs = (const bf16_t*)(p.ws + WS_B2);
    bf16_t* act = (bf16_t*)(p.ws + WS_B1);
    const float* cw = p.in[15] + (size_t)l * 3 * NUP; const float* cb = p.in[16] + (size_t)l * NUP;
    constexpr int NCG = DFF / 8, NU = (MTOK / 64) * NCG;
    for (int u = obid() * 512 + otid(); u < NU; u += gridDim.x * 512) {
        const int blk = u / NCG, c8 = (u - blk * NCG) * 8;
        const bool first = ((blk * 64) & (SEQ - 1)) == 0;
        float g2[8], g1[8], ga[8], gb2[8], v2[8], v1[8], va[8], vb2[8];
#pragma unroll
        for (int j = 0; j < 8; ++j) { g2[j] = g1[j] = v2[j] = v1[j] = 0.f; }
        const bf16_t* own = zs + (size_t)blk * 4 * NUP + c8;
        if (!first) { const bf16_t* prv = own - 4 * (ptrdiff_t)NUP; ld8(prv, g2); ld8(prv + NUP, g1); ld8(prv + DFF, v2); ld8(prv + NUP + DFF, v1); }
        ld8(own + 2 * NUP, ga); ld8(own + 3 * NUP, gb2); ld8(own + 2 * NUP + DFF, va); ld8(own + 3 * NUP + DFF, vb2);
        float o0[8], o1[8];
#pragma unroll
        for (int j = 0; j < 8; ++j) {
            const float w0 = cw[c8 + j], w1 = cw[NUP + c8 + j], w2 = cw[2 * NUP + c8 + j], bb = cb[c8 + j];
            const float x0 = cw[DFF + c8 + j], x1 = cw[NUP + DFF + c8 + j], x2 = cw[2 * NUP + DFF + c8 + j], xb_ = cb[DFF + c8 + j];
            const float gg0 = w0 * g2[j] + w1 * g1[j] + w2 * ga[j] + bb, vv0 = x0 * v2[j] + x1 * v1[j] + x2 * va[j] + xb_;
            const float gg1 = w0 * g1[j] + w1 * ga[j] + w2 * gb2[j] + bb, vv1 = x0 * v1[j] + x1 * va[j] + x2 * vb2[j] + xb_;
            o0[j] = silu_f(gg0) * vv0; o1[j] = silu_f(gg1) * vv1;
        }
        st8(act + (size_t)(blk * 64) * DFF + c8, o0); st8(act + (size_t)(blk * 64 + 1) * DFF + c8, o1);
    }
}

__device__ __forceinline__ void final_norm_phase(const Params& p) {
    const float* gf = p.in[18]; const float* ssq = (const float*)(p.ws + WS_SSQ); const bf16_t* xb = (const bf16_t*)(p.ws + WS_XB); float* out = p.out;
    const int tid = otid(), lane = tid & 63, wave = tid >> 6;
    for (int r0 = (obid() * 8 + wave) * 2; r0 < MTOK; r0 += gridDim.x * 16) {
        u32x4 xv[2][2]; float rs[2];
#pragma unroll
        for (int rr = 0; rr < 2; ++rr) {
            rs[rr] = row_rstd(ssq, r0 + rr);
#pragma unroll
            for (int i = 0; i < 2; ++i) xv[rr][i] = *(const u32x4*)(xb + (size_t)(r0 + rr) * DM + i * 512 + lane * 8);
        }
#pragma unroll
        for (int rr = 0; rr < 2; ++rr)
#pragma unroll
            for (int i = 0; i < 2; ++i) {
                const int cc = i * 512 + lane * 8;
                const u32x4 q = xv[rr][i];
                const float v[8] = {bflo(q.x), bfhi(q.x), bflo(q.y), bfhi(q.y), bflo(q.z), bfhi(q.z), bflo(q.w), bfhi(q.w)};
                const f32x4 g0 = *(const f32x4*)(gf + cc), g1 = *(const f32x4*)(gf + cc + 4);
                f32x4 o0, o1;
#pragma unroll
                for (int j = 0; j < 4; ++j) { o0[j] = v[j] * rs[rr] * g0[j]; o1[j] = v[4 + j] * rs[rr] * g1[j]; }
                float* qo = out + (size_t)(r0 + rr) * DM + cc;
                __builtin_nontemporal_store(o0, (f32x4*)qo); __builtin_nontemporal_store(o1, (f32x4*)(qo + 4));
            }
    }
}

template <class Epi> __device__ __forceinline__ void run_gemm(unsigned char* lds, const bf16_t* A, const bf16_t* Bt, int M, int N, int K, const Epi& E, int stagger_step = 0) {
    pg8::Gemm g{A, Bt, M, N, K}; pg8::StaticOrder S; S.init(M, N, (int)gridDim.x, obid());
    if (stagger_step) {
        const unsigned long long t0 = wall_clock64(), d = (unsigned long long)(((obid() >> 3) & 7) * stagger_step);
        while (wall_clock64() - t0 < d) __builtin_amdgcn_s_sleep(16);
    }
    pg8::gemm_phase<Epi, pg8::StaticOrder, false>((PG8_LAS unsigned char*)lds, g, S, E, nullptr);
}

#define XB_TMO      128
#define XB_XCNT(j)  (256  + 64 * (j))
#define XB_XSUB(j)  (1280 + 64 * (j))
#define XB_XGEN(j)  (2304 + 64 * (j))
#define XB_TOP      3328
#define XB_TOPGEN   3392
#define XCD_BAR_WORDS 3456
#define XB_SPIN_CAP (1u << 18)

__device__ __forceinline__ unsigned xb_ld(unsigned* p)              { return __hip_atomic_load(p, __ATOMIC_RELAXED, __HIP_MEMORY_SCOPE_AGENT); }
__device__ __forceinline__ unsigned xb_add(unsigned* p, unsigned v) { return __hip_atomic_fetch_add(p, v, __ATOMIC_RELAXED, __HIP_MEMORY_SCOPE_AGENT); }
__device__ __forceinline__ unsigned xb_xcc_id() { return (unsigned)__builtin_amdgcn_s_getreg((3 << 11) | 20) & 0xFu; }
#define XB_SPIN(cond, bar) do { unsigned _sp = 0; while (cond) { __builtin_amdgcn_s_sleep(1); \
    if ((++_sp & 255u) == 0u) { if (xb_ld(&(bar)[XB_TMO])) break; if (_sp > XB_SPIN_CAP) { atomicAdd(&(bar)[XB_TMO], 1u); break; } } } } while (0)

struct XcdBarrier {
    unsigned* bar; unsigned x;
    volatile LAS unsigned* st;
};

__device__ __forceinline__ XcdBarrier xcd_barrier_post(unsigned* bar, volatile LAS unsigned* st) {
    XcdBarrier b; b.bar = bar; b.x = xb_xcc_id(); b.st = st;
    if (threadIdx.x == 0) (void)xb_add(&bar[XB_XCNT(b.x)], 1u);
    return b;
}
__device__ __forceinline__ void xcd_barrier_complete(unsigned* bar, unsigned x, unsigned& nloc, unsigned& nx) {
    const unsigned G = gridDim.x * gridDim.y * gridDim.z;
    unsigned sum, cnt, mine, sp = 0u;
    for (;;) {
        sum = 0u; cnt = 0u; mine = 0u;
#pragma unroll
        for (unsigned j = 0; j < 16; ++j) { const unsigned c = xb_ld(&bar[XB_XCNT(j)]); sum += c; cnt += (c > 0u) ? 1u : 0u; mine = (j == x) ? c : mine; }
        if (sum == G) break;
        __builtin_amdgcn_s_sleep(1);
        if ((++sp & 255u) == 0u) { if (xb_ld(&bar[XB_TMO])) break; if (sp > XB_SPIN_CAP) { atomicAdd(&bar[XB_TMO], 1u); break; } }
    }
    nloc = mine > 0u ? mine : 1u; nx = cnt > 0u ? cnt : 1u;
}

__device__ __forceinline__ void xcd_barrier(const XcdBarrier& b) {
    asm volatile("s_waitcnt vmcnt(0)" ::: "memory");
    __syncthreads();
    if (threadIdx.x == 0) {
        unsigned* bar = b.bar;
        __builtin_amdgcn_s_waitcnt(0);
        unsigned nloc = b.st[0], nx = b.st[1];
        if (nloc == 0u) { xcd_barrier_complete(bar, b.x, nloc, nx); b.st[0] = nloc; b.st[1] = nx; }
        const unsigned old = xb_add(&bar[XB_XSUB(b.x)], 1u);
        const unsigned gen = old / nloc;
        if (old + 1u == (gen + 1u) * nloc) {
            __builtin_amdgcn_fence(__ATOMIC_RELEASE, "agent");
            asm volatile("s_waitcnt vmcnt(0)" ::: "memory");
            const unsigned og = xb_add(&bar[XB_TOP], 1u);
            const unsigned tg = og / nx;
            if (og + 1u == (tg + 1u) * nx) xb_add(&bar[XB_TOPGEN], 1u);
            else XB_SPIN(xb_ld(&bar[XB_TOPGEN]) == tg, bar);
            __builtin_amdgcn_fence(__ATOMIC_ACQUIRE, "agent");
            xb_add(&bar[XB_XGEN(b.x)], 1u);
            asm volatile("s_waitcnt vmcnt(0)" ::: "memory");
        } else {
            XB_SPIN(xb_ld(&bar[XB_XGEN(b.x)]) == gen, bar);
            __builtin_amdgcn_fence(__ATOMIC_ACQUIRE, "agent");
            asm volatile("s_waitcnt vmcnt(0)" ::: "memory");
        }
    }
    __syncthreads();
}

typedef const Params __attribute__((address_space(4)))* ParamsK;
__device__ __forceinline__ Params fresh_params() {
    ParamsK q = (ParamsK)__builtin_amdgcn_kernarg_segment_ptr();
    asm volatile("" : "+s"(q));
    Params r;
#pragma unroll
    for (int i = 0; i < 19; ++i) r.in[i] = q->in[i];
    r.out = q->out; r.ws = q->ws;
    return r;
}
constexpr int LDS_TOTAL = pg8::STAGE_BYTES + 256;
__global__ void __launch_bounds__(512, 2) fwd_megakernel(Params p_unused) {
    extern __shared__ __attribute__((aligned(16))) unsigned char lds[];
    cg::grid_group grid = cg::this_grid();
    volatile LAS unsigned* st = (volatile LAS unsigned*)((LAS unsigned char*)lds + pg8::STAGE_BYTES);
    unsigned* bar;
    {
        const Params p = fresh_params(); bar = (unsigned*)(p.ws + WS_BAR);
        if (threadIdx.x < 4) st[threadIdx.x] = 0u;
        if (blockIdx.x == 0) for (int i = threadIdx.x; i < XCD_BAR_WORDS; i += 512) bar[i] = 0u;
        __syncthreads();
    }
#define WSP(off) ((bf16_t*)(p.ws + (off)))
#define GRID_BAR() do { XcdBarrier b_; b_.bar = (unsigned*)(fresh_params().ws + WS_BAR); b_.x = xb_xcc_id(); b_.st = (volatile LAS unsigned*)((LAS unsigned char*)lds + pg8::STAGE_BYTES); xcd_barrier(b_); } while (0)
    for (int l = 0; l < 2; ++l) {
        { const Params p = fresh_params(); prep_phase(p, l, (float*)lds); }
        if (l == 0) { grid.sync(); (void)xcd_barrier_post((unsigned*)(fresh_params().ws + WS_BAR), (volatile LAS unsigned*)((LAS unsigned char*)lds + pg8::STAGE_BYTES)); }
        else GRID_BAR();
        { const Params p = fresh_params(); EpiIn E{WSP(WS_B1), WSP(WS_B2), (const float*)(p.ws + WS_SSQ), (bf16_t*)p.out, WSP(WS_SC), WSP(WS_SCB), p.in[8] + (size_t)l * 3 * 512}; run_gemm(lds, WSP(WS_XB), WSP(WS_WIN), MTOK, NIN, DM, E); }
        GRID_BAR();
        { const Params p = fresh_params(); mixer_phase(p, l, lds); }
        GRID_BAR();
        { const Params p = fresh_params(); EpiBr E{WSP(WS_B2), WSP(WS_B1)}; run_gemm(lds, (const bf16_t*)p.out  , WSP(WS_WBR), MTOK, DM, NBR, E); }
        GRID_BAR();
        { const Params p = fresh_params(); EpiRes E{WSP(WS_XB), (float*)(p.ws + WS_SSQ)}; run_gemm(lds, WSP(WS_B1), WSP(WS_WO), MTOK, DM, DM, E); }
        GRID_BAR();
        { const Params p = fresh_params(); EpiUp E{WSP(WS_B1), WSP(WS_B2), (const float*)(p.ws + WS_SSQ), p.in[15] + (size_t)l * 3 * NUP, p.in[16] + (size_t)l * NUP}; run_gemm(lds, WSP(WS_XB), WSP(WS_WUP), MTOK, NUP, DM, E); }
        GRID_BAR();
        { const Params p = fresh_params(); ffn_fixup_phase(p, l); }
        GRID_BAR();
        { const Params p = fresh_params(); EpiRes E{WSP(WS_XB), (float*)(p.ws + WS_SSQ)}; run_gemm(lds, WSP(WS_B1), WSP(WS_WDN), MTOK, DM, DFF, E); }
        GRID_BAR();
    }
    { const Params p = fresh_params(); final_norm_phase(p); }
#undef WSP
#undef GRID_BAR
}

extern "C" void kernel_launch(void* const* d_in, const int* in_sizes, int n_in, void* d_out, int out_size, void* d_ws, size_t ws_size, hipStream_t stream) {
    constexpr size_t kLds = LDS_TOTAL;
    static int grid_blocks = 0;
    if (!grid_blocks) {
        int dev = 0, cus = 0, per_cu = 0;
        (void)hipGetDevice(&dev);
        (void)hipDeviceGetAttribute(&cus, hipDeviceAttributeMultiprocessorCount, dev);
        (void)hipFuncSetAttribute((const void*)fwd_megakernel, hipFuncAttributeMaxDynamicSharedMemorySize, (int)kLds);
        (void)hipOccupancyMaxActiveBlocksPerMultiprocessor(&per_cu, (const void*)fwd_megakernel, 512, kLds);
        if (per_cu < 1) per_cu = 1;
        grid_blocks = cus;
        if (ws_size < WS_TOTAL || n_in != 19 || out_size != MTOK * DM) { fprintf(stderr, "kernel_launch: unexpected sizes: ws %zu (need %zu), n_in %d, out %d\n", ws_size, (size_t)WS_END, n_in, out_size); }
    }
    Params p{};
    for (int i = 0; i < 19; ++i) p.in[i] = (const float*)d_in[i];
    p.out = (float*)d_out; p.ws = (unsigned char*)d_ws;
    void* args[] = {&p};
    hipError_t e = hipLaunchCooperativeKernel((void*)fwd_megakernel, dim3(grid_blocks), dim3(512), args, kLds, stream);
    if (e != hipSuccess) fprintf(stderr, "cooperative launch failed: %s (grid %d)\n", hipGetErrorString(e), grid_blocks);
}
```

```cpp
#include <hip/hip_runtime.h>
#include <hip/hip_cooperative_groups.h>
#include <cstdio>
namespace cg = cooperative_groups;
namespace pg8 {
#define PG8_LAS __attribute__((address_space(3)))
typedef unsigned short bf16_t;
typedef short bf16x8 __attribute__((ext_vector_type(8)));
typedef float f32x4 __attribute__((ext_vector_type(4)));
typedef unsigned u32x4 __attribute__((ext_vector_type(4)));
constexpr int BM = 256, BK = 64, HALF = 128, HTB = HALF * BK * 2  , STAGE_BYTES = 8 * HTB, NXCD = 8, WGM = 8;

__host__ __device__ __forceinline__ int lds_byte(int r, int c) { const int st = (r >> 4) * 2 + (c >> 5), rr = r & 15, cc = c & 31, ob = rr * 64 + cc * 2; return st * 1024 + (ob ^ (((ob >> 9) & 1) << 5)); }
__host__ __device__ __forceinline__ void stage_rc(int b, int& R, int& C) { const int st = b / 1024, sb = b % 1024, swz = sb ^ (((sb >> 9) & 1) << 5); R = (st >> 1) * 16 + swz / 64; C = (st & 1) * 32 + (swz % 64) / 2; }
__host__ __device__ __forceinline__ int perm32(int rho) { const int n = rho >> 4, i = rho & 15; return 8 * (i >> 2) + 4 * n + (i & 3); }

struct Unit { int pm, pn; };
struct Gemm { const bf16_t* A; const bf16_t* Bt; int M, N, K; };

struct StaticOrder {
    int nM, nN, nwg, G, c;
    __host__ __device__ void init(int M, int N, int G_, int c_) { nM = M / BM; nN = N / BM; nwg = nM * nN; G = G_; c = c_; }
    __host__ __device__ bool next(int i, Unit& u) const {
        const long L = (long)i * G + c; if (L >= nwg) return false;
        int wgid = (int)L; { const int q = nwg / NXCD, r = nwg % NXCD, xcd = wgid % NXCD, off = wgid / NXCD; wgid = (xcd < r ? xcd * (q + 1) : r * (q + 1) + (xcd - r) * q) + off; }
        const int nig = WGM * nN, gid = wgid / nig, fm = gid * WGM, gsz = (nM - fm) < WGM ? (nM - fm) : WGM;
        u.pm = fm + ((wgid % nig) % gsz); u.pn = (wgid % nig) / gsz; return true;
    }
    __device__ __forceinline__ void a_ready(const Unit&) const {}
    __device__ __forceinline__ void done(const Unit&) const {}
};
__device__ __forceinline__ unsigned cvt_pk_bf16(float lo, float hi) { unsigned r; asm volatile("v_cvt_pk_bf16_f32 %0, %1, %2" : "=v"(r) : "v"(lo), "v"(hi)); return r; }

template <class Epi, class Sched, bool STAMP = false>
__device__ __forceinline__ void gemm_phase(PG8_LAS unsigned char* lds, const Gemm g, const Sched& S, const Epi& E, unsigned long long* stamps) {
    int tid_ = threadIdx.x; asm volatile("" : "+v"(tid_));
    const int tid = tid_, wid = __builtin_amdgcn_readfirstlane(tid >> 6), lane = tid & 63, wr = wid >> 2, wc = wid & 3, fr = lane & 15, fq = lane >> 4;
    const int K = g.K, nt = K / BK;
    int ts_lo = 0, ts_hi = 0, nts = 0; const unsigned long long rt_entry = STAMP ? (unsigned long long)wall_clock64() : 0ull;
#define PG8_STAMP() do { if (STAMP && wid == 0 && nts < 64) { const unsigned long long _c = (unsigned long long)clock64(); \
        ts_lo = (lane == nts) ? (int)(unsigned)_c : ts_lo; ts_hi = (lane == nts) ? (int)(unsigned)(_c >> 32) : ts_hi; ++nts; } } while (0)
    PG8_STAMP();
    unsigned voffA[2], voffB[2];
#pragma unroll
    for (int i = 0; i < 2; ++i) { int R, C; stage_rc(tid * 16 + i * 8192, R, C); const int Rb = Epi::PERM ? ((R & ~31) + perm32(R & 31)) : R;
        voffA[i] = (unsigned)(R * K + C) * 2u; voffB[i] = (unsigned)(Rb * K + C) * 2u; }
    const size_t kstep = (size_t)(BK * 2);
    const size_t hstep = (size_t)HALF * K * 2;
    const size_t tstep = 2 * hstep;
    const unsigned ldsw = (unsigned)wid * 1024u;
    const int aoff = lds_byte(wr * 64 + fr, fq * 8), boff = lds_byte(wc * 32 + fr, fq * 8);
#define PG8_SA(b, h) (((b) * 2 + (h)) * HTB)
#define PG8_SB(b, h) ((4 + (b) * 2 + (h)) * HTB)
#define PG8_STAGE(bufoff, gbase, voff) do { _Pragma("unroll") for (int _i = 0; _i < 2; ++_i) \
        __builtin_amdgcn_global_load_lds((const unsigned*)((const char*)(gbase) + (voff)[_i]), (PG8_LAS unsigned*)(lds + (bufoff) + ldsw + _i * 8192), 16, 0, 0); } while (0)
#define PG8_LDA(dst, b, h) do { _Pragma("unroll") for (int m = 0; m < 4; ++m) _Pragma("unroll") for (int k = 0; k < 2; ++k) dst[m][k] = *(const PG8_LAS bf16x8*)(lds + PG8_SA(b, h) + aoff + m * 2048 + k * 1024); } while (0)
#define PG8_LDB(dst, b, h) do { _Pragma("unroll") for (int n = 0; n < 2; ++n) _Pragma("unroll") for (int k = 0; k < 2; ++k) dst[n][k] = *(const PG8_LAS bf16x8*)(lds + PG8_SB(b, h) + boff + n * 2048 + k * 1024); } while (0)
#define PG8_MMA(ai, bj, At, Bt) do { __builtin_amdgcn_s_setprio(1); _Pragma("unroll") for (int m = 0; m < 4; ++m) _Pragma("unroll") for (int n = 0; n < 2; ++n) _Pragma("unroll") for (int k = 0; k < 2; ++k) \
        acc[ai][bj][m][n] = __builtin_amdgcn_mfma_f32_16x16x32_bf16(Bt[n][k], At[m][k], acc[ai][bj][m][n], 0, 0, 0); __builtin_amdgcn_s_setprio(0); } while (0)
#define PG8_WAIT_V(n) asm volatile("s_waitcnt vmcnt(" #n ")" ::: "memory")
#define PG8_WAIT_L(n) asm volatile("s_waitcnt lgkmcnt(" #n ")" ::: "memory")
#define PG8_BAR __builtin_amdgcn_s_barrier()
#define PG8_SCHED __builtin_amdgcn_sched_barrier(0)
    Unit cur, nxt; int ui = 0;
    if (!S.next(0, cur)) return;
    f32x4 acc[2][2][4][2];
#pragma unroll
    for (int a = 0; a < 2; ++a)
#pragma unroll
        for (int b = 0; b < 2; ++b)
#pragma unroll
            for (int m = 0; m < 4; ++m)
#pragma unroll
                for (int n = 0; n < 2; ++n) acc[a][b][m][n] = (f32x4){0.f, 0.f, 0.f, 0.f};
    bf16x8 At[4][2], B0[2][2], B1[2][2];
    const char* cA = (const char*)g.A + (size_t)cur.pm * tstep; const char* cB = (const char*)g.Bt + (size_t)cur.pn * tstep;
    S.a_ready(cur);
    PG8_STAGE(PG8_SB(0, 0), cB, voffB); PG8_STAGE(PG8_SA(0, 0), cA, voffA); PG8_STAGE(PG8_SB(0, 1), cB + hstep, voffB); PG8_STAGE(PG8_SA(0, 1), cA + hstep, voffA);
    if (wr == 1) PG8_BAR;
    PG8_WAIT_V(4); PG8_BAR;
    PG8_STAGE(PG8_SB(1, 0), cB + kstep, voffB); PG8_STAGE(PG8_SA(1, 0), cA + kstep, voffA); PG8_STAGE(PG8_SB(1, 1), cB + hstep + kstep, voffB);
    PG8_WAIT_V(6); PG8_BAR;
    PG8_STAMP();
    for (;;) {
        const bool has_next = S.next(ui + 1, nxt);
        const char* nA = has_next ? (const char*)g.A + (size_t)nxt.pm * tstep : cA; const char* nB = has_next ? (const char*)g.Bt + (size_t)nxt.pn * tstep : cB;
        for (int t = 0; t < nt; t += 2) {
            if constexpr (Epi::MIDK) { if (t == 8 || t == 16) E.mid(acc, cur, t, wr, wc, fr, fq); }
            const bool last = (t == nt - 2);
            const char* a1 = cA + (size_t)(t + 1) * kstep;
            const char* a2 = last ? nA : cA + (size_t)(t + 2) * kstep; const char* b2 = last ? nB : cB + (size_t)(t + 2) * kstep;
            const char* a3 = a2 + kstep; const char* b3 = b2 + kstep;
            if (last && has_next) S.a_ready(nxt);
            PG8_LDB(B0, 0, 0); PG8_SCHED; PG8_LDA(At, 0, 0); PG8_STAGE(PG8_SA(1, 1), a1 + hstep, voffA);
            PG8_WAIT_L(8); PG8_BAR; PG8_WAIT_L(0); PG8_MMA(0, 0, At, B0); PG8_BAR; PG8_SCHED;
            PG8_LDB(B1, 0, 1); PG8_STAGE(PG8_SB(0, 0), b2, voffB);
            PG8_BAR; PG8_WAIT_L(0); PG8_MMA(0, 1, At, B1); PG8_BAR;
            PG8_LDA(At, 0, 1); PG8_STAGE(PG8_SA(0, 0), a2, voffA);
            PG8_BAR; PG8_WAIT_L(0); PG8_MMA(1, 0, At, B0); PG8_BAR; PG8_SCHED;
            PG8_STAGE(PG8_SB(0, 1), b2 + hstep, voffB);
            PG8_WAIT_V(6); PG8_BAR; PG8_MMA(1, 1, At, B1); PG8_BAR;
            PG8_LDB(B0, 1, 0); PG8_SCHED; PG8_LDA(At, 1, 0); PG8_STAGE(PG8_SA(0, 1), a2 + hstep, voffA);
            PG8_WAIT_L(8); PG8_BAR; PG8_WAIT_L(0); PG8_MMA(0, 0, At, B0); PG8_BAR; PG8_SCHED;
            PG8_LDB(B1, 1, 1); PG8_STAGE(PG8_SB(1, 0), b3, voffB);
            PG8_BAR; PG8_WAIT_L(0); PG8_MMA(0, 1, At, B1); PG8_BAR;
            PG8_LDA(At, 1, 1); PG8_STAGE(PG8_SA(1, 0), a3, voffA);
            PG8_BAR; PG8_WAIT_L(0); PG8_MMA(1, 0, At, B0); PG8_BAR; PG8_SCHED;
            PG8_STAGE(PG8_SB(1, 1), b3 + hstep, voffB);
            PG8_WAIT_V(6); PG8_BAR; PG8_MMA(1, 1, At, B1); PG8_BAR;
        }
        PG8_STAMP();
        if constexpr (!Epi::AFTER_DRAIN) { E(acc, cur, wr, wc, fr, fq); S.done(cur); }
        PG8_STAMP();
        if (!has_next) break;
#pragma unroll
        for (int a = 0; a < 2; ++a)
#pragma unroll
            for (int b = 0; b < 2; ++b)
#pragma unroll
                for (int m = 0; m < 4; ++m)
#pragma unroll
                    for (int n = 0; n < 2; ++n) acc[a][b][m][n] = (f32x4){0.f, 0.f, 0.f, 0.f};
        cur = nxt; cA = nA; cB = nB; ++ui;
    }
    PG8_WAIT_V(0);
    if (wr == 0) PG8_BAR;
    PG8_BAR;
    if constexpr (Epi::AFTER_DRAIN) { E.fused(acc, cur, wr, wc, fr, fq, lds, wid, lane); S.done(cur); }
    PG8_STAMP();
    if (STAMP && wid == 0) { stamps[lane] = lane < nts ? (((unsigned long long)(unsigned)ts_hi << 32) | (unsigned)ts_lo) : 0ull;
        if (lane == 62) stamps[62] = rt_entry; if (lane == 63) stamps[63] = (unsigned long long)wall_clock64(); }
#undef PG8_STAMP
#undef PG8_SA
#undef PG8_SB
#undef PG8_STAGE
#undef PG8_LDA
#undef PG8_LDB
#undef PG8_MMA
#undef PG8_WAIT_V
#undef PG8_WAIT_L
#undef PG8_BAR
#undef PG8_SCHED
}
}
typedef pg8::bf16_t bf16_t;
typedef pg8::f32x4 f32x4;
typedef pg8::u32x4 u32x4;
typedef pg8::bf16x8 bf16x8;
typedef unsigned u32x2 __attribute__((ext_vector_type(2)));
#define LAS __attribute__((address_space(3)))
constexpr int MTOK = 65536, DM = 1024, NIN = 6144, DFF = 2816, NUP = 5632, SEQ = 8192, NBR = 1536, NPA = 3072;
constexpr int NPA2 = 1536;
constexpr int MH = MTOK / 2;
constexpr float EPS = 1e-6f;
constexpr size_t WS_WIN = 0;
constexpr size_t WS_WBR = WS_WIN + (size_t)NIN * DM * 2;
constexpr size_t WS_WO = WS_WBR + (size_t)DM * NBR * 2;
constexpr size_t WS_WUP = WS_WO + (size_t)DM * DM * 2;
constexpr size_t WS_WDN = WS_WUP + (size_t)NUP * DM * 2;
constexpr size_t WS_SSQ = WS_WDN + (size_t)DM * DFF * 2;
constexpr size_t WS_XB = WS_SSQ + (size_t)MTOK * 16 * 4;
constexpr size_t WS_B1 = WS_XB + (size_t)MTOK * NBR * 2;
constexpr size_t WS_B2 = WS_B1 + (size_t)MTOK * NPA * 2;
constexpr size_t WS_END = WS_B2 + (size_t)MTOK * NPA * 2;
constexpr size_t WS_BAR = WS_END;
constexpr size_t WS_SC = WS_BAR + 16384;
constexpr size_t WS_SCB = WS_SC + (size_t)(MTOK / 64) * 4 * 512 * 2;
constexpr size_t WS_TOTAL = WS_SCB + (size_t)(MTOK / 64) * 2 * 512 * 2;

__device__ __forceinline__ int otid() { int t = threadIdx.x; asm volatile("" : "+v"(t)); return t; }
__device__ __forceinline__ int obid() { int b = blockIdx.x; asm volatile("" : "+s"(b)); return b; }
struct Params {
    const float* in[19];
    float* out; unsigned char* ws;
};

__device__ __forceinline__ void st_nt16(void* p, u32x4 w) { __builtin_nontemporal_store(w, (u32x4*)p); }
__device__ __forceinline__ float bflo(unsigned w) { return __uint_as_float(w << 16); }
__device__ __forceinline__ float bfhi(unsigned w) { return __uint_as_float(w & 0xffff0000u); }
__device__ __forceinline__ unsigned pk(float a, float b) { return pg8::cvt_pk_bf16(a, b); }
__device__ __forceinline__ float fast_rcp(float x) { return __builtin_amdgcn_rcpf(x); }
__device__ __forceinline__ float gate_t2(float y) { return 1.0f + __builtin_amdgcn_exp2f(fminf(y, 43.28f)); }
__device__ __forceinline__ float gelu_tanh_f(float x) {
    const float z2 = 1.5957691216f * (x + 0.044715f * x * x * x);
    return x * fast_rcp(1.0f + __expf(-z2));
}
__device__ __forceinline__ float silu_f(float x) { return x * fast_rcp(1.0f + __expf(-x)); }
__device__ __forceinline__ float row_rstd(const float* ssq, int r) {
    const f32x4* p = (const f32x4*)(ssq + (size_t)r * 16);
    const f32x4 a = p[0], b = p[1], c = p[2], d = p[3];
    const float s = ((a[0] + a[1]) + (a[2] + a[3])) + ((b[0] + b[1]) + (b[2] + b[3])) + ((c[0] + c[1]) + (c[2] + c[3])) + ((d[0] + d[1]) + (d[2] + d[3]));
    return rsqrtf(s * (1.0f / 1024.0f) + EPS);
}

__device__ __forceinline__ void rows_rstd8(const float* ssq, int row0, int fq, float (&rs)[8]) {
    f32x4 v[8];
#pragma unroll
    for (int i = 0; i < 8; ++i) v[i] = *(const f32x4*)(ssq + (size_t)(row0 + (i >> 2) * 128 + (i & 3) * 16) * 16 + fq * 4);
#pragma unroll
    for (int i = 0; i < 8; ++i) {
        float s = (v[i][0] + v[i][1]) + (v[i][2] + v[i][3]);
        s += __shfl_xor(s, 16); s += __shfl_xor(s, 32);
        rs[i] = rsqrtf(s * (1.0f / 1024.0f) + EPS);
    }
}
__device__ __forceinline__ float dpp_ror1(float x) { return __int_as_float(__builtin_amdgcn_mov_dpp(__float_as_int(x), 0x121, 0xf, 0xf, true)); }
__device__ __forceinline__ float dpp_ror2(float x) { return __int_as_float(__builtin_amdgcn_mov_dpp(__float_as_int(x), 0x122, 0xf, 0xf, true)); }
__device__ __forceinline__ float dpp_shr1(float old, float x) { return __int_as_float(__builtin_amdgcn_update_dpp(__float_as_int(old), __float_as_int(x), 0x111, 0xf, 0xf, false)); }
__device__ __forceinline__ float dpp_shr2(float old, float x) { return __int_as_float(__builtin_amdgcn_update_dpp(__float_as_int(old), __float_as_int(x), 0x112, 0xf, 0xf, false)); }
struct EpiIn {
    static constexpr bool PERM = true, AFTER_DRAIN = false, MIDK = false;
    bf16_t* PA; bf16_t* G; const float* ssq; bf16_t* Y; bf16_t* sc; bf16_t* scb; const float* cw;
    __device__ __forceinline__ void operator()(const f32x4 (&acc)[2][2][4][2], const pg8::Unit& u, int wr, int wc, int fr, int fq) const {
        const int row0 = u.pm * 256 + wr * 64 + fr;
        float rs8[8]; rows_rstd8(ssq, row0, fq, rs8);
        if (u.pn >= 16) {
            const int q0 = (u.pn - 16) * 64 + wc * 16 + fq * 4;
            const f32x4 w0 = *(const f32x4*)(cw + q0), w1 = *(const f32x4*)(cw + 512 + q0), w2 = *(const f32x4*)(cw + 1024 + q0);
#pragma unroll
            for (int ai = 0; ai < 2; ++ai) {
                f32x4 pz = {0.f, 0.f, 0.f, 0.f};
                const int blk = u.pm * 4 + ai * 2 + wr;
#pragma unroll
                for (int m = 0; m < 4; ++m) {
                    const float rs = rs8[ai * 4 + m];
                    const f32x4 cb = acc[ai][0][m][0] * rs, cc = acc[ai][0][m][1] * rs, cx = acc[ai][1][m][0] * rs, av = acc[ai][1][m][1] * rs;
                    const f32x4 z = cc * cx;
                    float y[4];
#pragma unroll
                    for (int j = 0; j < 4; ++j) {
                        const float z1 = dpp_shr1(dpp_ror1(pz[j]), z[j]), z2 = dpp_shr2(dpp_ror2(pz[j]), z[j]);
                        y[j] = cb[j] * (w0[j] * z2 + w1[j] * z1 + w2[j] * z[j]);
                        asm volatile("" : "+v"(y[j]));
                    }
                    const int r = row0 + ai * 128 + m * 16;
                    u32x2 w;
                    w.x = pk(av[0], av[1]); w.y = pk(av[2], av[3]); *(u32x2*)(PA + (size_t)r * NPA2 + q0) = w;
                    if (!(m == 0 && fr < 2)) { w.x = pk(y[0], y[1]); w.y = pk(y[2], y[3]); *(u32x2*)(Y + (size_t)r * NBR + 1024 + q0) = w; }
                    if (m == 0 && fr < 2) {
                        w.x = pk(z[0], z[1]); w.y = pk(z[2], z[3]); *(u32x2*)(sc + ((size_t)blk * 4 + 2 + fr) * 512 + q0) = w;
                        w.x = pk(cb[0], cb[1]); w.y = pk(cb[2], cb[3]); *(u32x2*)(scb + ((size_t)blk * 2 + fr) * 512 + q0) = w;
                    }
                    if (m == 3 && fr >= 14) { w.x = pk(z[0], z[1]); w.y = pk(z[2], z[3]); *(u32x2*)(sc + ((size_t)blk * 4 + (fr - 14)) * 512 + q0) = w; }
                    pz = z;
                }
            }
        } else {
            const int q0 = u.pn * 64 + wc * 16 + fq * 4;
#pragma unroll
            for (int ai = 0; ai < 2; ++ai)
#pragma unroll
                for (int m = 0; m < 4; ++m) {
                    const float rs = rs8[ai * 4 + m], rsn = rs * -1.44269504f;
                    const f32x4 ga = acc[ai][0][m][0] * rsn, gb = acc[ai][0][m][1] * rsn, gc = acc[ai][1][m][0] * rsn, uv = acc[ai][1][m][1] * rs;
                    float r1[4], r2[4], s3[4], ug[4];
#pragma unroll
                    for (int j = 0; j < 4; ++j) {
                        const float ta = gate_t2(ga[j]), tb = gate_t2(gb[j]), tc = gate_t2(gc[j]);
                        r1[j] = tb * fast_rcp(ta); r2[j] = tc * fast_rcp(tb); s3[j] = fast_rcp(tc);
                        ug[j] = gelu_tanh_f(uv[j]);
                    }
                    const size_t ro = (size_t)(row0 + ai * 128 + m * 16) * NPA, rp = (size_t)(row0 + ai * 128 + m * 16) * NPA2;
                    u32x2 w;
                    w.x = pk(r1[0], r1[1]); w.y = pk(r1[2], r1[3]); *(u32x2*)(G + ro + q0) = w;
                    w.x = pk(r2[0], r2[1]); w.y = pk(r2[2], r2[3]); *(u32x2*)(G + ro + 1024 + q0) = w;
                    w.x = pk(s3[0], s3[1]); w.y = pk(s3[2], s3[3]); *(u32x2*)(G + ro + 2048 + q0) = w;
                    w.x = pk(ug[0], ug[1]); w.y = pk(ug[2], ug[3]); *(u32x2*)(PA + rp + 512 + q0) = w;
                }
        }
    }
};
struct EpiBr {
    static constexpr bool PERM = true, AFTER_DRAIN = false, MIDK = true;
    const bf16_t* G; bf16_t* out;
    __device__ __forceinline__ void mid(f32x4 (&acc)[2][2][4][2], const pg8::Unit& u, int t, int wr, int wc, int fr, int fq) const {
        const int seg = (t == 8) ? 0 : 1024;
        int col0 = u.pn * 256 + wc * 32 + 8 * fq + seg;
        int row0 = u.pm * 256 + wr * 64 + fr;
        asm volatile("" : "+v"(col0), "+v"(row0));
#pragma unroll
        for (int ai = 0; ai < 2; ++ai) {
            u32x4 nu[4][2];
#pragma unroll
            for (int m = 0; m < 4; ++m)
#pragma unroll
                for (int bj = 0; bj < 2; ++bj) nu[m][bj] = *(const u32x4*)(G + (size_t)(row0 + ai * 128 + m * 16) * NPA + col0 + bj * 128);
            asm volatile("" ::: "memory");
#pragma unroll
            for (int m = 0; m < 4; ++m)
#pragma unroll
                for (int bj = 0; bj < 2; ++bj) {
                    const unsigned nw[4] = {nu[m][bj].x, nu[m][bj].y, nu[m][bj].z, nu[m][bj].w};
#pragma unroll
                    for (int q = 0; q < 4; ++q) { acc[ai][bj][m][q >> 1][(q & 1) * 2] *= bflo(nw[q]); acc[ai][bj][m][q >> 1][(q & 1) * 2 + 1] *= bfhi(nw[q]); }
                }
            asm volatile("" ::: "memory");
        }
    }
    __device__ __forceinline__ void operator()(const f32x4 (&acc)[2][2][4][2], const pg8::Unit& u, int wr, int wc, int fr, int fq) const {
        const int col0 = u.pn * 256 + wc * 32 + 8 * fq;
        const int row0 = u.pm * 256 + wr * 64 + fr;
        u32x4 sg[2][4][2];
#pragma unroll
        for (int ai = 0; ai < 2; ++ai)
#pragma unroll
            for (int m = 0; m < 4; ++m)
#pragma unroll
                for (int bj = 0; bj < 2; ++bj) sg[ai][m][bj] = *(const u32x4*)(G + (size_t)(row0 + ai * 128 + m * 16) * NPA + 2048 + col0 + bj * 128);
#pragma unroll
        for (int ai = 0; ai < 2; ++ai)
#pragma unroll
            for (int m = 0; m < 4; ++m) {
                const int r = row0 + ai * 128 + m * 16;
                bf16_t* op = out + (size_t)r * DM + col0;
#pragma unroll
                for (int bj = 0; bj < 2; ++bj) {
                    const u32x4 s = sg[ai][m][bj];
                    const f32x4 a0 = acc[ai][bj][m][0], a1 = acc[ai][bj][m][1];
                    u32x4 w;
                    w.x = pk(a0[0] * bflo(s.x), a0[1] * bfhi(s.x)); w.y = pk(a0[2] * bflo(s.y), a0[3] * bfhi(s.y));
                    w.z = pk(a1[0] * bflo(s.z), a1[1] * bfhi(s.z)); w.w = pk(a1[2] * bflo(s.w), a1[3] * bfhi(s.w));
                    *(u32x4*)(op + bj * 128) = w;
                }
            }
    }
};
struct EpiRes {
    static constexpr bool PERM = true, AFTER_DRAIN = false, MIDK = false;
    bf16_t* xb; float* ssq;
    __device__ __forceinline__ void operator()(const f32x4 (&acc)[2][2][4][2], const pg8::Unit& u, int wr, int wc, int fr, int fq) const {
        const int col0 = u.pn * 256 + wc * 32 + 8 * fq;
        const int row0 = u.pm * 256 + wr * 64 + fr;
        u32x4 bb[2][4][2];
#pragma unroll
        for (int ai = 0; ai < 2; ++ai)
#pragma unroll
            for (int m = 0; m < 4; ++m)
#pragma unroll
                for (int bj = 0; bj < 2; ++bj) bb[ai][m][bj] = *(const u32x4*)(xb + (size_t)(row0 + ai * 128 + m * 16) * DM + col0 + bj * 128);
        asm volatile("" ::: "memory");
#pragma unroll
        for (int ai = 0; ai < 2; ++ai) {
#pragma unroll
            for (int m = 0; m < 4; ++m) {
                const int r = row0 + ai * 128 + m * 16;
                float sq = 0.f;
#pragma unroll
                for (int bj = 0; bj < 2; ++bj) {
                    const u32x4 s = bb[ai][m][bj];
                    const f32x4 a0 = acc[ai][bj][m][0], a1 = acc[ai][bj][m][1];
                    const float o0 = bflo(s.x) + a0[0], o1 = bfhi(s.x) + a0[1], o2 = bflo(s.y) + a0[2], o3 = bfhi(s.y) + a0[3];
                    const float o4 = bflo(s.z) + a1[0], o5 = bfhi(s.z) + a1[1], o6 = bflo(s.w) + a1[2], o7 = bfhi(s.w) + a1[3];
                    u32x4 w; w.x = pk(o0, o1); w.y = pk(o2, o3); w.z = pk(o4, o5); w.w = pk(o6, o7);
                    *(u32x4*)(xb + (size_t)r * DM + col0 + bj * 128) = w;
                    sq += (o0 * o0 + o1 * o1) + (o2 * o2 + o3 * o3) + (o4 * o4 + o5 * o5) + (o6 * o6 + o7 * o7);
                }
                sq += __shfl_xor(sq, 16); sq += __shfl_xor(sq, 32);
                if (fq == 0) ssq[(size_t)r * 16 + u.pn * 4 + wc] = sq;
            }
            asm volatile("" ::: "memory");
        }
    }
};
struct EpiUp {
    static constexpr bool PERM = true, AFTER_DRAIN = false, MIDK = false;
    bf16_t* act; bf16_t* zs; const float* ssq; const float* cw; const float* cb;
    __device__ __forceinline__ void operator()(const f32x4 (&acc)[2][2][4][2], const pg8::Unit& u, int wr, int wc, int fr, int fq) const {
        const int c0 = u.pn * 128 + wc * 32 + 8 * fq;
        const int row0 = u.pm * 256 + wr * 64 + fr;
        float rs8[8]; rows_rstd8(ssq, row0, fq, rs8);
        u32x2 keep[2][4];
#pragma unroll
        for (int n = 0; n < 2; ++n) {
            const int c = c0 + 4 * n;
            const f32x4 gw0 = *(const f32x4*)(cw + c), gw1 = *(const f32x4*)(cw + NUP + c), gw2 = *(const f32x4*)(cw + 2 * NUP + c), gb = *(const f32x4*)(cb + c);
            const f32x4 vw0 = *(const f32x4*)(cw + DFF + c), vw1 = *(const f32x4*)(cw + NUP + DFF + c), vw2 = *(const f32x4*)(cw + 2 * NUP + DFF + c), vb = *(const f32x4*)(cb + DFF + c);
#pragma unroll
            for (int ai = 0; ai < 2; ++ai) {
                f32x4 pg = {0.f, 0.f, 0.f, 0.f}, pv = {0.f, 0.f, 0.f, 0.f};
                const int blk = u.pm * 4 + ai * 2 + wr;
#pragma unroll
                for (int m = 0; m < 4; ++m) {
                    const float rs = rs8[ai * 4 + m];
                    const f32x4 zg = acc[ai][0][m][n] * rs, zv = acc[ai][1][m][n] * rs;
                    float o[4];
#pragma unroll
                    for (int j = 0; j < 4; ++j) {
                        const float g1 = dpp_shr1(dpp_ror1(pg[j]), zg[j]), g2 = dpp_shr2(dpp_ror2(pg[j]), zg[j]);
                        const float v1 = dpp_shr1(dpp_ror1(pv[j]), zv[j]), v2 = dpp_shr2(dpp_ror2(pv[j]), zv[j]);
                        const float gg = gw2[j] * zg[j] + gw1[j] * g1 + gw0[j] * g2 + gb[j];
                        const float vv = vw2[j] * zv[j] + vw1[j] * v1 + vw0[j] * v2 + vb[j];
                        o[j] = silu_f(gg) * vv;
                    }
                    u32x2 w; w.x = pk(o[0], o[1]); w.y = pk(o[2], o[3]);
                    const int r = row0 + ai * 128 + m * 16;
                    if (n == 0) keep[ai][m] = w;
                    else if (!(m == 0 && fr < 2)) { u32x4 ww; ww.x = keep[ai][m].x; ww.y = keep[ai][m].y; ww.z = w.x; ww.w = w.y; st_nt16(act + (size_t)r * DFF + c0, ww); }
                    if (m == 0 && fr < 2) {
                        bf16_t* zp = zs + ((size_t)blk * 4 + 2 + fr) * NUP + c;
                        u32x2 a; a.x = pk(zg[0], zg[1]); a.y = pk(zg[2], zg[3]); *(u32x2*)zp = a;
                        u32x2 d; d.x = pk(zv[0], zv[1]); d.y = pk(zv[2], zv[3]); *(u32x2*)(zp + DFF) = d;
                    }
                    if (m == 3 && fr >= 14) {
                        bf16_t* zp = zs + ((size_t)blk * 4 + (fr - 14)) * NUP + c;
                        u32x2 a; a.x = pk(zg[0], zg[1]); a.y = pk(zg[2], zg[3]); *(u32x2*)zp = a;
                        u32x2 d; d.x = pk(zv[0], zv[1]); d.y = pk(zv[2], zv[3]); *(u32x2*)(zp + DFF) = d;
                    }
                    pg = zg; pv = zv;
                }
            }
        }
    }
};

__device__ __forceinline__ int win_dest_row(int col) {
    int ch, bj, n, t0;
    if (col < 512) { ch = col; bj = 1; n = 1; t0 = 16; }
    else if (col < 1536) { ch = col - 512; bj = 1; n = 1; t0 = 0; }
    else if (col < 3072) { const int s = (col - 1536) >> 9; ch = (col - 1536) & 511; bj = s >> 1; n = s & 1; t0 = 16; }
    else { const int gi = (col - 3072) >> 10; ch = (col - 3072) & 1023; bj = gi >> 1; n = gi & 1; t0 = 0; }
    const int k = t0 + (ch >> 6), r = ch & 63;
    return 256 * k + 128 * bj + 32 * (r >> 4) + 8 * ((r >> 2) & 3) + 4 * n + (r & 3);
}
__device__ __forceinline__ void transpose_tile(const float* __restrict__ W, int N, const float* __restrict__ g, bf16_t* __restrict__ Wt, int ldt, int koff, int k0, int n0, int nd0, float* tile, int tid, bool winmap = false) {
    {
        const int kk = tid >> 4, nn = (tid & 15) * 4;
        f32x4 v[2][2]; float s[2];
#pragma unroll
        for (int h = 0; h < 2; ++h) { s[h] = g ? g[k0 + kk + h * 32] : 1.0f;
#pragma unroll
            for (int h2 = 0; h2 < 2; ++h2) v[h2][h] = *(const f32x4*)(W + (size_t)(k0 + kk + h * 32) * N + n0 + h2 * 64 + nn); }
#pragma unroll
        for (int h2 = 0; h2 < 2; ++h2)
#pragma unroll
            for (int h = 0; h < 2; ++h) { float* tp = tile + h2 * (64 * 65) + (kk + h * 32) * 65 + nn;
                tp[0] = v[h2][h][0] * s[h]; tp[1] = v[h2][h][1] * s[h]; tp[2] = v[h2][h][2] * s[h]; tp[3] = v[h2][h][3] * s[h]; }
    }
    __syncthreads();
    {
        const int n = tid >> 3, kq = (tid & 7) * 8;
#pragma unroll
        for (int h2 = 0; h2 < 2; ++h2) {
            float v[8];
#pragma unroll
            for (int j = 0; j < 8; ++j) v[j] = tile[h2 * (64 * 65) + (kq + j) * 65 + n];
            u32x4 w; w.x = pk(v[0], v[1]); w.y = pk(v[2], v[3]); w.z = pk(v[4], v[5]); w.w = pk(v[6], v[7]);
            *(u32x4*)(Wt + (size_t)(winmap ? win_dest_row(n0 + h2 * 64 + n) : nd0 + h2 * 64 + n) * ldt + koff + k0 + kq) = w;
        }
    }
    __syncthreads();
}

__device__ __forceinline__ void prep_phase(const Params& p, int l, float* ldsf) {
    unsigned char* ws = p.ws;
    bf16_t* wt_in = (bf16_t*)(ws + WS_WIN); bf16_t* wt_br = (bf16_t*)(ws + WS_WBR); bf16_t* wt_o = (bf16_t*)(ws + WS_WO);
    bf16_t* wt_up = (bf16_t*)(ws + WS_WUP); bf16_t* wt_dn = (bf16_t*)(ws + WS_WDN);
    const float* g_mix = p.in[1] + (size_t)l * DM; const float* w_in = p.in[2] + (size_t)l * DM * NIN;
    const float* w_pool = p.in[3] + (size_t)l * 4 * 128 * 128; const float* pscale = p.in[4] + (size_t)l * 512;
    const float* w_ba = p.in[9] + (size_t)l * 512 * DM; const float* w_bb = p.in[10] + (size_t)l * 512 * DM; const float* w_bc = p.in[11] + (size_t)l * 512 * DM;
    const float* w_o = p.in[12] + (size_t)l * DM * DM; const float* g_ffn = p.in[13] + (size_t)l * DM;
    const float* w_up = p.in[14] + (size_t)l * DM * NUP; const float* w_dn = p.in[17] + (size_t)l * DFF * DM;
    const int tid = otid(), bid = obid();
    constexpr int T0 = 16 * 48, T1 = T0 + 64, T2 = T1 + 64, T3 = T2 + 128, T4 = T3 + 16 * 44, T5 = T4 + 44 * 8;
    for (int i = bid; i < T5; i += gridDim.x) {
        if (i < T0) { const int kt = i & 15, nt = i >> 4; transpose_tile(w_in, NIN, g_mix, wt_in, DM, 0, kt * 64, nt * 128, nt * 128, ldsf, tid, true); }
        else if (i < T1) { const int j = i - T0, kt = j & 7, nt = j >> 3; transpose_tile(w_bb, DM, nullptr, wt_br, NBR, 512, kt * 64, nt * 128, nt * 128, ldsf, tid); }
        else if (i < T2) { const int j = i - T1, kt = j & 7, nt = j >> 3; transpose_tile(w_bc, DM, nullptr, wt_br, NBR, 1024, kt * 64, nt * 128, nt * 128, ldsf, tid); }
        else if (i < T3) { const int j = i - T2, kt = j & 15, nt = j >> 4; transpose_tile(w_o, DM, nullptr, wt_o, DM, 0, kt * 64, nt * 128, nt * 128, ldsf, tid); }
        else if (i < T4) { const int j = i - T3, kt = j & 15, nt = j >> 4; const int n0 = nt * 128, bj = n0 / DFF, q0 = n0 - bj * DFF; transpose_tile(w_up, NUP, g_ffn, wt_up, DM, 0, kt * 64, n0, (q0 >> 7) * 256 + bj * 128, ldsf, tid);   }
        else { const int j = i - T4, kt = j % 44, nt = j / 44; transpose_tile(w_dn, DM, nullptr, wt_dn, DFF, 0, kt * 64, nt * 128, nt * 128, ldsf, tid); }
    }
    {
        float* wpT = ldsf;
        float* wa = ldsf + 128 * 128;
        for (int it = (int)gridDim.x - 1 - bid; it < 64; it += gridDim.x) {
            const int g = it >> 4, n0 = (it & 15) * 64;
            for (int q = tid; q < 128 * 32; q += 512) {
                const int d = q >> 5, e4 = (q & 31) * 4;
                const f32x4 v = *(const f32x4*)(w_pool + ((size_t)g * 128 + d) * 128 + e4);
                const f32x4 s = *(const f32x4*)(pscale + g * 128 + e4);
                wpT[(e4 + 0) * 128 + d] = v[0] * s[0]; wpT[(e4 + 1) * 128 + d] = v[1] * s[1]; wpT[(e4 + 2) * 128 + d] = v[2] * s[2]; wpT[(e4 + 3) * 128 + d] = v[3] * s[3];
            }
            for (int q = tid; q < 128 * 16; q += 512) {
                const int e = q >> 4, c4 = (q & 15) * 4;
                *(f32x4*)(wa + e * 64 + c4) = *(const f32x4*)(w_ba + (size_t)(g * 128 + e) * DM + n0 + c4);
            }
            __syncthreads();
            const int d = tid & 127, ns = tid >> 7;
            float acc[16];
#pragma unroll
            for (int i = 0; i < 16; ++i) acc[i] = 0.f;
            for (int e = 0; e < 128; ++e) {
                const float w = wpT[e * 128 + d];
                const f32x4* wr4 = (const f32x4*)(wa + e * 64 + ns * 16);
#pragma unroll
                for (int c = 0; c < 4; ++c) { const f32x4 b = wr4[c]; acc[c * 4 + 0] += w * b[0]; acc[c * 4 + 1] += w * b[1]; acc[c * 4 + 2] += w * b[2]; acc[c * 4 + 3] += w * b[3]; }
            }
#pragma unroll
            for (int i = 0; i < 16; ++i) wt_br[(size_t)(n0 + ns * 16 + i) * NBR + g * 128 + d] = (bf16_t)(pk(acc[i], 0.f) & 0xffffu);
            __syncthreads();
        }
    }
    if (l == 0) {
        const float* x = p.in[0]; bf16_t* xb = (bf16_t*)(ws + WS_XB); float* ssq = (float*)(ws + WS_SSQ);
        const int lane = tid & 63, wave = tid >> 6;
        for (int r0 = (bid * 8 + wave) * 2; r0 < MTOK; r0 += gridDim.x * 16) {
            f32x4 v[2][4];
#pragma unroll
            for (int rr = 0; rr < 2; ++rr)
#pragma unroll
                for (int i = 0; i < 4; ++i) v[rr][i] = *(const f32x4*)(x + (size_t)(r0 + rr) * DM + i * 256 + lane * 4);
#pragma unroll
            for (int rr = 0; rr < 2; ++rr) {
                const int r = r0 + rr;
                float sq = 0.f;
#pragma unroll
                for (int i = 0; i < 4; ++i) {
                    const f32x4 t = v[rr][i];
                    sq += (t[0] * t[0] + t[1] * t[1]) + (t[2] * t[2] + t[3] * t[3]);
                    u32x2 w; w.x = pk(t[0], t[1]); w.y = pk(t[2], t[3]);
                    *(u32x2*)(xb + (size_t)r * DM + i * 256 + lane * 4) = w;
                }
#pragma unroll
                for (int o = 32; o >= 1; o >>= 1) sq += __shfl_xor(sq, o);
                if (lane < 16) ssq[(size_t)r * 16 + lane] = (lane == 0) ? sq : 0.f;
            }
        }
    }
}
__device__ __forceinline__ void ld8(const bf16_t* p, float (&v)[8]) {
    const u32x4 w = *(const u32x4*)p;
    v[0] = bflo(w.x); v[1] = bfhi(w.x); v[2] = bflo(w.y); v[3] = bfhi(w.y); v[4] = bflo(w.z); v[5] = bfhi(w.z); v[6] = bflo(w.w); v[7] = bfhi(w.w);
}
__device__ __forceinline__ void st8(bf16_t* p, const float (&v)[8]) {
    u32x4 w; w.x = pk(v[0], v[1]); w.y = pk(v[2], v[3]); w.z = pk(v[4], v[5]); w.w = pk(v[6], v[7]);
    *(u32x4*)p = w;
}
template <int W> __device__ __forceinline__ void pool_rows(const bf16_t* __restrict__ ap, bf16_t* __restrict__ yp, int r0, int pos0) {
#pragma unroll
    for (int b = 0; b < 4; ++b) {
        const int base = r0 + 4 * b;
        u32x4 h[W + 3];
#pragma unroll
        for (int i = 0; i < W + 3; ++i) { const int rr = base - (W - 1) + i; h[i] = (pos0 + rr >= 0) ? *(const u32x4*)(ap + (ptrdiff_t)rr * NPA2) : (u32x4){0u, 0u, 0u, 0u}; }
        float s[8];
#pragma unroll
        for (int j = 0; j < 8; ++j) s[j] = 0.f;
#pragma unroll
        for (int i = 0; i < W - 1; ++i) { const u32x4 q = h[i];
            s[0] += bflo(q.x); s[1] += bfhi(q.x); s[2] += bflo(q.y); s[3] += bfhi(q.y); s[4] += bflo(q.z); s[5] += bfhi(q.z); s[6] += bflo(q.w); s[7] += bfhi(q.w); }
#pragma unroll
        for (int i = 0; i < 4; ++i) {
            const int rr = base + i, pos = pos0 + rr; const float inv = 1.0f / (float)(pos + 1 < W ? pos + 1 : W);
            const u32x4 q = h[W - 1 + i], od = h[i];
            const float v[8] = {bflo(q.x), bfhi(q.x), bflo(q.y), bfhi(q.y), bflo(q.z), bfhi(q.z), bflo(q.w), bfhi(q.w)};
            float o[8];
#pragma unroll
            for (int j = 0; j < 8; ++j) { s[j] += v[j]; o[j] = s[j] * inv - v[j]; }
            st8(yp + (size_t)rr * NBR, o);
            s[0] -= bflo(od.x); s[1] -= bfhi(od.x); s[2] -= bflo(od.y); s[3] -= bfhi(od.y); s[4] -= bflo(od.z); s[5] -= bfhi(od.z); s[6] -= bflo(od.w); s[7] -= bfhi(od.w);
        }
        asm volatile("" ::: "memory");
    }
}
constexpr int VT_PITCH = 136;
__device__ __forceinline__ void mixer_phase(const Params& p, int l, unsigned char* lds) {
    const bf16_t* PA = (const bf16_t*)(p.ws + WS_B1);
    bf16_t* Y = (bf16_t*)p.out;
    const float* g_sgu = p.in[5] + (size_t)l * 512;
    const float* w_sp = p.in[6] + (size_t)l * 4 * 128 * 128;
    const float* b_sp = p.in[7] + (size_t)l * 4 * 128;
    const float* conv_c = p.in[8] + (size_t)l * 3 * 512;
    float* rs = (float*)lds;
    bf16_t* vT = (bf16_t*)(lds + 1024);
    const int tid = otid(), lane = tid & 63, wave = __builtin_amdgcn_readfirstlane(tid >> 6), fr = lane & 15, fq = lane >> 4;
    for (int item = obid(); item < MTOK / 128; item += gridDim.x) {
        const int t0 = item * 128, pos0 = t0 & (SEQ - 1);
        {
            const int row = tid >> 2, q = tid & 3;
            const bf16_t* vp = PA + (size_t)(t0 + row) * NPA2 + 1024 + q * 128;
            float sq = 0.f;
#pragma unroll
            for (int i = 0; i < 16; ++i) { float v[8]; ld8(vp + i * 8, v);
#pragma unroll
                for (int j = 0; j < 8; ++j) sq += v[j] * v[j]; }
            sq += __shfl_xor(sq, 1); sq += __shfl_xor(sq, 2);
            if (q == 0) rs[row] = rsqrtf(sq * (1.0f / 512.0f) + EPS);
        }
        {
            const int grp = wave & 3;
            const int c8 = (grp * 16 + (lane & 15)) * 8; int r0 = ((wave >> 2) * 4 + (lane >> 4)) * 16;
            asm volatile("" : "+v"(r0));
            {
                const bf16_t* ap = PA + (size_t)t0 * NPA2 + c8;
                bf16_t* yp = Y + (size_t)t0 * NBR + c8;
                if (grp == 0) pool_rows<2>(ap, yp, r0, pos0); else if (grp == 1) pool_rows<4>(ap, yp, r0, pos0); else if (grp == 2) pool_rows<8>(ap, yp, r0, pos0); else pool_rows<16>(ap, yp, r0, pos0);
            }
        }
        if (tid < 256) {
            const bf16_t* sc = (const bf16_t*)(p.ws + WS_SC); const bf16_t* scb = (const bf16_t*)(p.ws + WS_SCB);
            const int b_ = tid >> 7, ri = (tid >> 6) & 1, c8 = (tid & 63) * 8;
            const int blk = (t0 >> 6) + b_;
            const bool first = ((blk * 64) & (SEQ - 1)) == 0;
            float z2[8], z1[8], z0[8], cbv[8], o[8];
#pragma unroll
            for (int j = 0; j < 8; ++j) { z2[j] = 0.f; z1[j] = 0.f; }
            const bf16_t* own = sc + (size_t)blk * 4 * 512 + c8;
            if (ri == 0) { if (!first) { ld8(own - 4 * 512, z2); ld8(own - 3 * 512, z1); } ld8(own + 2 * 512, z0); }
            else { if (!first) ld8(own - 3 * 512, z2); ld8(own + 2 * 512, z1); ld8(own + 3 * 512, z0); }
            ld8(scb + ((size_t)blk * 2 + ri) * 512 + c8, cbv);
#pragma unroll
            for (int j = 0; j < 8; ++j) o[j] = cbv[j] * (conv_c[c8 + j] * z2[j] + conv_c[512 + c8 + j] * z1[j] + conv_c[1024 + c8 + j] * z0[j]);
            st8(Y + (size_t)(blk * 64 + ri) * NBR + 1024 + c8, o);
        }
#pragma unroll 1
        for (int g = 0; g < 4; ++g) {
            const int t = wave * 16 + fr;
            const int nk = (wave >> 1) + 1;
            f32x4 wq[4][2];
#pragma unroll
            for (int k = 0; k < 4; ++k) { const float* wp = w_sp + ((size_t)g * 128 + t) * 128 + k * 32 + fq * 8; wq[k][0] = *(const f32x4*)wp; wq[k][1] = *(const f32x4*)(wp + 4); }
            const bf16_t* up = PA + (size_t)(t0 + t) * NPA2 + 512 + g * 128 + 4 * fq;
            u32x2 uu[8];
#pragma unroll
            for (int n = 0; n < 8; ++n) uu[n] = *(const u32x2*)(up + n * 16);
            const float bias = b_sp[g * 128 + t];
            u32x4 vq[4];
            const int s_ = tid >> 2, dq = (tid & 3) * 32;
            {
                const bf16_t* vp = PA + (size_t)(t0 + s_) * NPA2 + 1024 + g * 128 + dq;
#pragma unroll
                for (int i = 0; i < 4; ++i) vq[i] = *(const u32x4*)(vp + i * 8);
            }
            __syncthreads();
#pragma unroll
            for (int i = 0; i < 4; ++i) {
                const unsigned ww[4] = {vq[i].x, vq[i].y, vq[i].z, vq[i].w};
#pragma unroll
                for (int q = 0; q < 4; ++q) { vT[(dq + i * 8 + q * 2) * VT_PITCH + s_] = (bf16_t)(ww[q] & 0xffffu); vT[(dq + i * 8 + q * 2 + 1) * VT_PITCH + s_] = (bf16_t)(ww[q] >> 16); }
            }
            __syncthreads();
            f32x4 acc[8];
#pragma unroll
            for (int n = 0; n < 8; ++n) acc[n] = (f32x4){0.f, 0.f, 0.f, 0.f};
#pragma unroll
            for (int k = 0; k < 4; ++k) if (k < nk) {
                const int s0 = k * 32 + fq * 8;
                const f32x4 wa = wq[k][0], wb = wq[k][1];
                const f32x4 ra = *(const f32x4*)(rs + s0), rb = *(const f32x4*)(rs + s0 + 4);
                float a[8];
#pragma unroll
                for (int j = 0; j < 4; ++j) { a[j] = (s0 + j <= t) ? wa[j] * ra[j] : 0.f; a[4 + j] = (s0 + 4 + j <= t) ? wb[j] * rb[j] : 0.f; }
                union { u32x4 u; bf16x8 h; } af; af.u.x = pk(a[0], a[1]); af.u.y = pk(a[2], a[3]); af.u.z = pk(a[4], a[5]); af.u.w = pk(a[6], a[7]);
#pragma unroll
                for (int n = 0; n < 8; ++n) {
                    const bf16x8 bfrag = *(const bf16x8*)(vT + (n * 16 + fr) * VT_PITCH + s0);
                    acc[n] = __builtin_amdgcn_mfma_f32_16x16x32_bf16(bfrag, af.h, acc[n], 0, 0, 0);
                }
            }
            bf16_t* yp = Y + (size_t)(t0 + t) * NBR + 512 + g * 128 + 4 * fq;
#pragma unroll
            for (int n = 0; n < 8; ++n) {
                const f32x4 gs = *(const f32x4*)(g_sgu + g * 128 + n * 16 + 4 * fq);
                const float o0 = bflo(uu[n].x) * (acc[n][0] * gs[0] + bias), o1 = bfhi(uu[n].x) * (acc[n][1] * gs[1] + bias);
                const float o2 = bflo(uu[n].y) * (acc[n][2] * gs[2] + bias), o3 = bfhi(uu[n].y) * (acc[n][3] * gs[3] + bias);
                u32x2 w; w.x = pk(o0, o1); w.y = pk(o2, o3);
                *(u32x2*)(yp + n * 16) = w;
            }
        }
        __syncthreads();
    }
}

__device__ __forceinline__ void ffn_fixup_phase(const Params& p, int l) {
    const bf16_t* zs = (const bf16_t*)(p.ws + WS_B2);
    bf16_t* act = (bf16_t*)(p.ws + WS_B1);
    const float* cw = p.in[15] + (size_t)l * 3 * NUP; const float* cb = p.in[16] + (size_t)l * NUP;
    constexpr int NCG = DFF / 8, NU = (MTOK / 64) * NCG;
    for (int u = obid() * 512 + otid(); u < NU; u += gridDim.x * 512) {
        const int blk = u / NCG, c8 = (u - blk * NCG) * 8;
        const bool first = ((blk * 64) & (SEQ - 1)) == 0;
        float g2[8], g1[8], ga[8], gb2[8], v2[8], v1[8], va[8], vb2[8];
#pragma unroll
        for (int j = 0; j < 8; ++j) { g2[j] = g1[j] = v2[j] = v1[j] = 0.f; }
        const bf16_t* own = zs + (size_t)blk * 4 * NUP + c8;
        if (!first) { const bf16_t* prv = own - 4 * (ptrdiff_t)NUP; ld8(prv, g2); ld8(prv + NUP, g1); ld8(prv + DFF, v2); ld8(prv + NUP + DFF, v1); }
        ld8(own + 2 * NUP, ga); ld8(own + 3 * NUP, gb2); ld8(own + 2 * NUP + DFF, va); ld8(own + 3 * NUP + DFF, vb2);
        float o0[8], o1[8];
        float w0[8], w1[8], w2[8], bb[8], x0[8], x1[8], x2[8], xb_[8];
        { const f32x4* q;
#define LD8F(dst, ptr) q = (const f32x4*)(ptr); { const f32x4 a_ = q[0], b_ = q[1]; dst[0] = a_[0]; dst[1] = a_[1]; dst[2] = a_[2]; dst[3] = a_[3]; dst[4] = b_[0]; dst[5] = b_[1]; dst[6] = b_[2]; dst[7] = b_[3]; }
          LD8F(w0, cw + c8) LD8F(w1, cw + NUP + c8) LD8F(w2, cw + 2 * NUP + c8) LD8F(bb, cb + c8)
          LD8F(x0, cw + DFF + c8) LD8F(x1, cw + NUP + DFF + c8) LD8F(x2, cw + 2 * NUP + DFF + c8) LD8F(xb_, cb + DFF + c8)
#undef LD8F
        }
#pragma unroll
        for (int j = 0; j < 8; ++j) {
            const float gg0 = w0[j] * g2[j] + w1[j] * g1[j] + w2[j] * ga[j] + bb[j], vv0 = x0[j] * v2[j] + x1[j] * v1[j] + x2[j] * va[j] + xb_[j];
            const float gg1 = w0[j] * g1[j] + w1[j] * ga[j] + w2[j] * gb2[j] + bb[j], vv1 = x0[j] * v1[j] + x1[j] * va[j] + x2[j] * vb2[j] + xb_[j];
            o0[j] = silu_f(gg0) * vv0; o1[j] = silu_f(gg1) * vv1;
        }
        st8(act + (size_t)(blk * 64) * DFF + c8, o0); st8(act + (size_t)(blk * 64 + 1) * DFF + c8, o1);
    }
}

__device__ __forceinline__ void final_norm_phase(const Params& p) {
    const float* gf = p.in[18]; const float* ssq = (const float*)(p.ws + WS_SSQ); const bf16_t* xb = (const bf16_t*)(p.ws + WS_XB); float* out = p.out;
    const int tid = otid(), lane = tid & 63, wave = tid >> 6;
    for (int r0 = (obid() * 8 + wave) * 2; r0 < MTOK; r0 += gridDim.x * 16) {
        u32x4 xv[2][2]; float rs[2];
#pragma unroll
        for (int rr = 0; rr < 2; ++rr) {
            rs[rr] = row_rstd(ssq, r0 + rr);
#pragma unroll
            for (int i = 0; i < 2; ++i) xv[rr][i] = *(const u32x4*)(xb + (size_t)(r0 + rr) * DM + i * 512 + lane * 8);
        }
#pragma unroll
        for (int rr = 0; rr < 2; ++rr)
#pragma unroll
            for (int i = 0; i < 2; ++i) {
                const int cc = i * 512 + lane * 8;
                const u32x4 q = xv[rr][i];
                const float v[8] = {bflo(q.x), bfhi(q.x), bflo(q.y), bfhi(q.y), bflo(q.z), bfhi(q.z), bflo(q.w), bfhi(q.w)};
                const f32x4 g0 = *(const f32x4*)(gf + cc), g1 = *(const f32x4*)(gf + cc + 4);
                f32x4 o0, o1;
#pragma unroll
                for (int j = 0; j < 4; ++j) { o0[j] = v[j] * rs[rr] * g0[j]; o1[j] = v[4 + j] * rs[rr] * g1[j]; }
                float* qo = out + (size_t)(r0 + rr) * DM + cc;
                __builtin_nontemporal_store(o0, (f32x4*)qo); __builtin_nontemporal_store(o1, (f32x4*)(qo + 4));
            }
    }
}

template <class Epi> __device__ __forceinline__ void run_gemm(unsigned char* lds, const bf16_t* A, const bf16_t* Bt, int M, int N, int K, const Epi& E, int stagger_step = 0) {
    pg8::Gemm g{A, Bt, M, N, K}; pg8::StaticOrder S; S.init(M, N, (int)gridDim.x, obid());
    if (stagger_step) {
        const unsigned long long t0 = wall_clock64(), d = (unsigned long long)(((obid() >> 3) & 7) * stagger_step);
        while (wall_clock64() - t0 < d) __builtin_amdgcn_s_sleep(16);
    }
    pg8::gemm_phase<Epi, pg8::StaticOrder, false>((PG8_LAS unsigned char*)lds, g, S, E, nullptr);
}

#define XB_TMO      128
#define XB_XCNT(j)  (256  + 64 * (j))
#define XB_XSUB(j)  (1280 + 64 * (j))
#define XB_XGEN(j)  (2304 + 64 * (j))
#define XB_TOP      3328
#define XB_TOPGEN   3392
#define XCD_BAR_WORDS 3456
#define XB_SPIN_CAP (1u << 18)

__device__ __forceinline__ unsigned xb_ld(unsigned* p)              { return __hip_atomic_load(p, __ATOMIC_RELAXED, __HIP_MEMORY_SCOPE_AGENT); }
__device__ __forceinline__ unsigned xb_add(unsigned* p, unsigned v) { return __hip_atomic_fetch_add(p, v, __ATOMIC_RELAXED, __HIP_MEMORY_SCOPE_AGENT); }
__device__ __forceinline__ unsigned xb_xcc_id() { return (unsigned)__builtin_amdgcn_s_getreg((3 << 11) | 20) & 0xFu; }
#define XB_SPIN(cond, bar) do { unsigned _sp = 0; while (cond) { __builtin_amdgcn_s_sleep(1); \
    if ((++_sp & 255u) == 0u) { if (xb_ld(&(bar)[XB_TMO])) break; if (_sp > XB_SPIN_CAP) { atomicAdd(&(bar)[XB_TMO], 1u); break; } } } } while (0)

struct XcdBarrier {
    unsigned* bar; unsigned x;
    volatile LAS unsigned* st;
};

__device__ __forceinline__ XcdBarrier xcd_barrier_post(unsigned* bar, volatile LAS unsigned* st) {
    XcdBarrier b; b.bar = bar; b.x = xb_xcc_id(); b.st = st;
    if (threadIdx.x == 0) (void)xb_add(&bar[XB_XCNT(b.x)], 1u);
    return b;
}
__device__ __forceinline__ void xcd_barrier_complete(unsigned* bar, unsigned x, unsigned& nloc, unsigned& nx) {
    const unsigned G = gridDim.x * gridDim.y * gridDim.z;
    unsigned sum, cnt, mine, sp = 0u;
    for (;;) {
        sum = 0u; cnt = 0u; mine = 0u;
#pragma unroll
        for (unsigned j = 0; j < 16; ++j) { const unsigned c = xb_ld(&bar[XB_XCNT(j)]); sum += c; cnt += (c > 0u) ? 1u : 0u; mine = (j == x) ? c : mine; }
        if (sum == G) break;
        __builtin_amdgcn_s_sleep(1);
        if ((++sp & 255u) == 0u) { if (xb_ld(&bar[XB_TMO])) break; if (sp > XB_SPIN_CAP) { atomicAdd(&bar[XB_TMO], 1u); break; } }
    }
    nloc = mine > 0u ? mine : 1u; nx = cnt > 0u ? cnt : 1u;
}

__device__ __forceinline__ void xcd_barrier(const XcdBarrier& b) {
    asm volatile("s_waitcnt vmcnt(0)" ::: "memory");
    __syncthreads();
    if (threadIdx.x == 0) {
        unsigned* bar = b.bar;
        __builtin_amdgcn_s_waitcnt(0);
        unsigned nloc = b.st[0], nx = b.st[1];
        if (nloc == 0u) { xcd_barrier_complete(bar, b.x, nloc, nx); b.st[0] = nloc; b.st[1] = nx; }
        const unsigned old = xb_add(&bar[XB_XSUB(b.x)], 1u);
        const unsigned gen = old / nloc;
        if (old + 1u == (gen + 1u) * nloc) {
            __builtin_amdgcn_fence(__ATOMIC_RELEASE, "agent");
            asm volatile("s_waitcnt vmcnt(0)" ::: "memory");
            const unsigned og = xb_add(&bar[XB_TOP], 1u);
            const unsigned tg = og / nx;
            if (og + 1u == (tg + 1u) * nx) xb_add(&bar[XB_TOPGEN], 1u);
            else XB_SPIN(xb_ld(&bar[XB_TOPGEN]) == tg, bar);
            __builtin_amdgcn_fence(__ATOMIC_ACQUIRE, "agent");
            xb_add(&bar[XB_XGEN(b.x)], 1u);
            asm volatile("s_waitcnt vmcnt(0)" ::: "memory");
        } else {
            XB_SPIN(xb_ld(&bar[XB_XGEN(b.x)]) == gen, bar);
            __builtin_amdgcn_fence(__ATOMIC_ACQUIRE, "agent");
            asm volatile("s_waitcnt vmcnt(0)" ::: "memory");
        }
    }
    __syncthreads();
}

typedef const Params __attribute__((address_space(4)))* ParamsK;
__device__ __forceinline__ Params fresh_params() {
    ParamsK q = (ParamsK)__builtin_amdgcn_kernarg_segment_ptr();
    asm volatile("" : "+s"(q));
    Params r;
#pragma unroll
    for (int i = 0; i < 19; ++i) r.in[i] = q->in[i];
    r.out = q->out; r.ws = q->ws;
    return r;
}
constexpr int LDS_TOTAL = pg8::STAGE_BYTES + 256;
__global__ void __launch_bounds__(512, 2) fwd_megakernel(Params p_unused) {
    extern __shared__ __attribute__((aligned(16))) unsigned char lds[];
    cg::grid_group grid = cg::this_grid();
    volatile LAS unsigned* st = (volatile LAS unsigned*)((LAS unsigned char*)lds + pg8::STAGE_BYTES);
    unsigned* bar;
    {
        const Params p = fresh_params(); bar = (unsigned*)(p.ws + WS_BAR);
        if (threadIdx.x < 4) st[threadIdx.x] = 0u;
        if (blockIdx.x == 0) for (int i = threadIdx.x; i < XCD_BAR_WORDS; i += 512) bar[i] = 0u;
        __syncthreads();
    }
#define WSP(off) ((bf16_t*)(p.ws + (off)))
#define GRID_BAR() do { XcdBarrier b_; b_.bar = (unsigned*)(fresh_params().ws + WS_BAR); b_.x = xb_xcc_id(); b_.st = (volatile LAS unsigned*)((LAS unsigned char*)lds + pg8::STAGE_BYTES); xcd_barrier(b_); } while (0)
    for (int l = 0; l < 2; ++l) {
        { const Params p = fresh_params(); prep_phase(p, l, (float*)lds); }
        if (l == 0) { grid.sync(); (void)xcd_barrier_post((unsigned*)(fresh_params().ws + WS_BAR), (volatile LAS unsigned*)((LAS unsigned char*)lds + pg8::STAGE_BYTES)); }
        else GRID_BAR();
        { const Params p = fresh_params(); EpiIn E{WSP(WS_B1), WSP(WS_B2), (const float*)(p.ws + WS_SSQ), (bf16_t*)p.out, WSP(WS_SC), WSP(WS_SCB), p.in[8] + (size_t)l * 3 * 512}; run_gemm(lds, WSP(WS_XB), WSP(WS_WIN), MTOK, NIN, DM, E); }
        GRID_BAR();
        { const Params p = fresh_params(); mixer_phase(p, l, lds); }
        GRID_BAR();
        { const Params p = fresh_params(); EpiBr E{WSP(WS_B2), WSP(WS_B1)}; run_gemm(lds, (const bf16_t*)p.out  , WSP(WS_WBR), MTOK, DM, NBR, E); }
        GRID_BAR();
        { const Params p = fresh_params(); EpiRes E{WSP(WS_XB), (float*)(p.ws + WS_SSQ)}; run_gemm(lds, WSP(WS_B1), WSP(WS_WO), MTOK, DM, DM, E); }
        GRID_BAR();
        { const Params p = fresh_params(); EpiUp E{WSP(WS_B1), WSP(WS_B2), (const float*)(p.ws + WS_SSQ), p.in[15] + (size_t)l * 3 * NUP, p.in[16] + (size_t)l * NUP}; run_gemm(lds, WSP(WS_XB), WSP(WS_WUP), MTOK, NUP, DM, E); }
        GRID_BAR();
        { const Params p = fresh_params(); ffn_fixup_phase(p, l); }
        GRID_BAR();
        { const Params p = fresh_params(); EpiRes E{WSP(WS_XB), (float*)(p.ws + WS_SSQ)}; run_gemm(lds, WSP(WS_B1), WSP(WS_WDN), MTOK, DM, DFF, E); }
        GRID_BAR();
    }
    { const Params p = fresh_params(); final_norm_phase(p); }
#undef WSP
#undef GRID_BAR
}

extern "C" void kernel_launch(void* const* d_in, const int* in_sizes, int n_in, void* d_out, int out_size, void* d_ws, size_t ws_size, hipStream_t stream) {
    constexpr size_t kLds = LDS_TOTAL;
    static int grid_blocks = 0;
    if (!grid_blocks) {
        int dev = 0, cus = 0, per_cu = 0;
        (void)hipGetDevice(&dev);
        (void)hipDeviceGetAttribute(&cus, hipDeviceAttributeMultiprocessorCount, dev);
        (void)hipFuncSetAttribute((const void*)fwd_megakernel, hipFuncAttributeMaxDynamicSharedMemorySize, (int)kLds);
        (void)hipOccupancyMaxActiveBlocksPerMultiprocessor(&per_cu, (const void*)fwd_megakernel, 512, kLds);
        if (per_cu < 1) per_cu = 1;
        grid_blocks = cus;
        if (ws_size < WS_TOTAL || n_in != 19 || out_size != MTOK * DM) { fprintf(stderr, "kernel_launch: unexpected sizes: ws %zu (need %zu), n_in %d, out %d\n", ws_size, (size_t)WS_END, n_in, out_size); }
    }
    Params p{};
    for (int i = 0; i < 19; ++i) p.in[i] = (const float*)d_in[i];
    p.out = (float*)d_out; p.ws = (unsigned char*)d_ws;
    void* args[] = {&p};
    hipError_t e = hipLaunchCooperativeKernel((void*)fwd_megakernel, dim3(grid_blocks), dim3(512), args, kLds, stream);
    if (e != hipSuccess) fprintf(stderr, "cooperative launch failed: %s (grid %d)\n", hipGetErrorString(e), grid_blocks);
}
```

```cpp
#include <hip/hip_runtime.h>
#include <hip/hip_cooperative_groups.h>
#include <cstdio>
namespace cg = cooperative_groups;
namespace pg8 {
#define PG8_LAS __attribute__((address_space(3)))
typedef unsigned short bf16_t;
typedef short bf16x8 __attribute__((ext_vector_type(8)));
typedef float f32x4 __attribute__((ext_vector_type(4)));
typedef unsigned u32x4 __attribute__((ext_vector_type(4)));
constexpr int BM = 256, BK = 64, HALF = 128, HTB = HALF * BK * 2  , STAGE_BYTES = 8 * HTB, NXCD = 8, WGM = 8;

__host__ __device__ __forceinline__ int lds_byte(int r, int c) { const int st = (r >> 4) * 2 + (c >> 5), rr = r & 15, cc = c & 31, ob = rr * 64 + cc * 2; return st * 1024 + (ob ^ (((ob >> 9) & 1) << 5)); }
__host__ __device__ __forceinline__ void stage_rc(int b, int& R, int& C) { const int st = b / 1024, sb = b % 1024, swz = sb ^ (((sb >> 9) & 1) << 5); R = (st >> 1) * 16 + swz / 64; C = (st & 1) * 32 + (swz % 64) / 2; }
__host__ __device__ __forceinline__ int perm32(int rho) { const int n = rho >> 4, i = rho & 15; return 8 * (i >> 2) + 4 * n + (i & 3); }

struct Unit { int pm, pn; };
struct Gemm { const bf16_t* A; const bf16_t* Bt; int M, N, K; };

struct StaticOrder {
    int nM, nN, nwg, G, c;
    __host__ __device__ void init(int M, int N, int G_, int c_) { nM = M / BM; nN = N / BM; nwg = nM * nN; G = G_; c = c_; }
    __host__ __device__ bool next(int i, Unit& u) const {
        const long L = (long)i * G + c; if (L >= nwg) return false;
        int wgid = (int)L; { const int q = nwg / NXCD, r = nwg % NXCD, xcd = wgid % NXCD, off = wgid / NXCD; wgid = (xcd < r ? xcd * (q + 1) : r * (q + 1) + (xcd - r) * q) + off; }
        const int nig = WGM * nN, gid = wgid / nig, fm = gid * WGM, gsz = (nM - fm) < WGM ? (nM - fm) : WGM;
        u.pm = fm + ((wgid % nig) % gsz); u.pn = (wgid % nig) / gsz; return true;
    }
    __device__ __forceinline__ void a_ready(const Unit&) const {}
    __device__ __forceinline__ void done(const Unit&) const {}
};
__device__ __forceinline__ unsigned cvt_pk_bf16(float lo, float hi) { unsigned r; asm volatile("v_cvt_pk_bf16_f32 %0, %1, %2" : "=v"(r) : "v"(lo), "v"(hi)); return r; }

template <class Epi, class Sched, bool STAMP = false>
__device__ __forceinline__ void gemm_phase(PG8_LAS unsigned char* lds, const Gemm g, const Sched& S, const Epi& E, unsigned long long* stamps) {
    int tid_ = threadIdx.x; asm volatile("" : "+v"(tid_));
    const int tid = tid_, wid = __builtin_amdgcn_readfirstlane(tid >> 6), lane = tid & 63, wr = wid >> 2, wc = wid & 3, fr = lane & 15, fq = lane >> 4;
    const int K = g.K, nt = K / BK;
    int ts_lo = 0, ts_hi = 0, nts = 0; const unsigned long long rt_entry = STAMP ? (unsigned long long)wall_clock64() : 0ull;
#define PG8_STAMP() do { if (STAMP && wid == 0 && nts < 64) { const unsigned long long _c = (unsigned long long)clock64(); \
        ts_lo = (lane == nts) ? (int)(unsigned)_c : ts_lo; ts_hi = (lane == nts) ? (int)(unsigned)(_c >> 32) : ts_hi; ++nts; } } while (0)
    PG8_STAMP();
    unsigned voffA[2], voffB[2];
#pragma unroll
    for (int i = 0; i < 2; ++i) { int R, C; stage_rc(tid * 16 + i * 8192, R, C); const int Rb = Epi::PERM ? ((R & ~31) + perm32(R & 31)) : R;
        voffA[i] = (unsigned)(R * K + C) * 2u; voffB[i] = (unsigned)(Rb * K + C) * 2u; }
    const size_t kstep = (size_t)(BK * 2);
    const size_t hstep = (size_t)HALF * K * 2;
    const size_t tstep = 2 * hstep;
    const unsigned ldsw = (unsigned)wid * 1024u;
    const int aoff = lds_byte(wr * 64 + fr, fq * 8), boff = lds_byte(wc * 32 + fr, fq * 8);
#define PG8_SA(b, h) (((b) * 2 + (h)) * HTB)
#define PG8_SB(b, h) ((4 + (b) * 2 + (h)) * HTB)
#define PG8_STAGE(bufoff, gbase, voff) do { _Pragma("unroll") for (int _i = 0; _i < 2; ++_i) \
        __builtin_amdgcn_global_load_lds((const unsigned*)((const char*)(gbase) + (voff)[_i]), (PG8_LAS unsigned*)(lds + (bufoff) + ldsw + _i * 8192), 16, 0, 0); } while (0)
#define PG8_LDA(dst, b, h) do { _Pragma("unroll") for (int m = 0; m < 4; ++m) _Pragma("unroll") for (int k = 0; k < 2; ++k) dst[m][k] = *(const PG8_LAS bf16x8*)(lds + PG8_SA(b, h) + aoff + m * 2048 + k * 1024); } while (0)
#define PG8_LDB(dst, b, h) do { _Pragma("unroll") for (int n = 0; n < 2; ++n) _Pragma("unroll") for (int k = 0; k < 2; ++k) dst[n][k] = *(const PG8_LAS bf16x8*)(lds + PG8_SB(b, h) + boff + n * 2048 + k * 1024); } while (0)
#define PG8_MMA(ai, bj, At, Bt) do { __builtin_amdgcn_s_setprio(1); _Pragma("unroll") for (int m = 0; m < 4; ++m) _Pragma("unroll") for (int n = 0; n < 2; ++n) _Pragma("unroll") for (int k = 0; k < 2; ++k) \
        acc[ai][bj][m][n] = __builtin_amdgcn_mfma_f32_16x16x32_bf16(Bt[n][k], At[m][k], acc[ai][bj][m][n], 0, 0, 0); __builtin_amdgcn_s_setprio(0); } while (0)
#define PG8_WAIT_V(n) asm volatile("s_waitcnt vmcnt(" #n ")" ::: "memory")
#define PG8_WAIT_L(n) asm volatile("s_waitcnt lgkmcnt(" #n ")" ::: "memory")
#define PG8_BAR __builtin_amdgcn_s_barrier()
#define PG8_SCHED __builtin_amdgcn_sched_barrier(0)
    Unit cur, nxt; int ui = 0;
    if (!S.next(0, cur)) return;
    f32x4 acc[2][2][4][2];
#pragma unroll
    for (int a = 0; a < 2; ++a)
#pragma unroll
        for (int b = 0; b < 2; ++b)
#pragma unroll
            for (int m = 0; m < 4; ++m)
#pragma unroll
                for (int n = 0; n < 2; ++n) acc[a][b][m][n] = (f32x4){0.f, 0.f, 0.f, 0.f};
    bf16x8 At[4][2], B0[2][2], B1[2][2];
    const char* cA = (const char*)g.A + (size_t)cur.pm * tstep; const char* cB = (const char*)g.Bt + (size_t)cur.pn * tstep;
    S.a_ready(cur);
    PG8_STAGE(PG8_SB(0, 0), cB, voffB); PG8_STAGE(PG8_SA(0, 0), cA, voffA); PG8_STAGE(PG8_SB(0, 1), cB + hstep, voffB); PG8_STAGE(PG8_SA(0, 1), cA + hstep, voffA);
    if (wr == 1) PG8_BAR;
    PG8_WAIT_V(4); PG8_BAR;
    PG8_STAGE(PG8_SB(1, 0), cB + kstep, voffB); PG8_STAGE(PG8_SA(1, 0), cA + kstep, voffA); PG8_STAGE(PG8_SB(1, 1), cB + hstep + kstep, voffB);
    PG8_WAIT_V(6); PG8_BAR;
    PG8_STAMP();
    for (;;) {
        const bool has_next = S.next(ui + 1, nxt);
        const char* nA = has_next ? (const char*)g.A + (size_t)nxt.pm * tstep : cA; const char* nB = has_next ? (const char*)g.Bt + (size_t)nxt.pn * tstep : cB;
        for (int t = 0; t < nt; t += 2) {
            if constexpr (Epi::MIDK) { if (t == 8 || t == 16) E.mid(acc, cur, t, wr, wc, fr, fq); }
            const bool last = (t == nt - 2);
            const char* a1 = cA + (size_t)(t + 1) * kstep;
            const char* a2 = last ? nA : cA + (size_t)(t + 2) * kstep; const char* b2 = last ? nB : cB + (size_t)(t + 2) * kstep;
            const char* a3 = a2 + kstep; const char* b3 = b2 + kstep;
            if (last && has_next) S.a_ready(nxt);
            PG8_LDB(B0, 0, 0); PG8_SCHED; PG8_LDA(At, 0, 0); PG8_STAGE(PG8_SA(1, 1), a1 + hstep, voffA);
            PG8_WAIT_L(8); PG8_BAR; PG8_WAIT_L(0); PG8_MMA(0, 0, At, B0); PG8_BAR; PG8_SCHED;
            PG8_LDB(B1, 0, 1); PG8_STAGE(PG8_SB(0, 0), b2, voffB);
            PG8_BAR; PG8_WAIT_L(0); PG8_MMA(0, 1, At, B1); PG8_BAR;
            PG8_LDA(At, 0, 1); PG8_STAGE(PG8_SA(0, 0), a2, voffA);
            PG8_BAR; PG8_WAIT_L(0); PG8_MMA(1, 0, At, B0); PG8_BAR; PG8_SCHED;
            PG8_STAGE(PG8_SB(0, 1), b2 + hstep, voffB);
            PG8_WAIT_V(6); PG8_BAR; PG8_MMA(1, 1, At, B1); PG8_BAR;
            PG8_LDB(B0, 1, 0); PG8_SCHED; PG8_LDA(At, 1, 0); PG8_STAGE(PG8_SA(0, 1), a2 + hstep, voffA);
            PG8_WAIT_L(8); PG8_BAR; PG8_WAIT_L(0); PG8_MMA(0, 0, At, B0); PG8_BAR; PG8_SCHED;
            PG8_LDB(B1, 1, 1); PG8_STAGE(PG8_SB(1, 0), b3, voffB);
            PG8_BAR; PG8_WAIT_L(0); PG8_MMA(0, 1, At, B1); PG8_BAR;
            PG8_LDA(At, 1, 1); PG8_STAGE(PG8_SA(1, 0), a3, voffA);
            PG8_BAR; PG8_WAIT_L(0); PG8_MMA(1, 0, At, B0); PG8_BAR; PG8_SCHED;
            PG8_STAGE(PG8_SB(1, 1), b3 + hstep, voffB);
            PG8_WAIT_V(6); PG8_BAR; PG8_MMA(1, 1, At, B1); PG8_BAR;
        }
        PG8_STAMP();
        if constexpr (!Epi::AFTER_DRAIN) { E(acc, cur, wr, wc, fr, fq); S.done(cur); }
        PG8_STAMP();
        if (!has_next) break;
#pragma unroll
        for (int a = 0; a < 2; ++a)
#pragma unroll
            for (int b = 0; b < 2; ++b)
#pragma unroll
                for (int m = 0; m < 4; ++m)
#pragma unroll
                    for (int n = 0; n < 2; ++n) acc[a][b][m][n] = (f32x4){0.f, 0.f, 0.f, 0.f};
        cur = nxt; cA = nA; cB = nB; ++ui;
    }
    PG8_WAIT_V(0);
    if (wr == 0) PG8_BAR;
    PG8_BAR;
    if constexpr (Epi::AFTER_DRAIN) { E.fused(acc, cur, wr, wc, fr, fq, lds, wid, lane); S.done(cur); }
    PG8_STAMP();
    if (STAMP && wid == 0) { stamps[lane] = lane < nts ? (((unsigned long long)(unsigned)ts_hi << 32) | (unsigned)ts_lo) : 0ull;
        if (lane == 62) stamps[62] = rt_entry; if (lane == 63) stamps[63] = (unsigned long long)wall_clock64(); }
#undef PG8_STAMP
#undef PG8_SA
#undef PG8_SB
#undef PG8_STAGE
#undef PG8_LDA
#undef PG8_LDB
#undef PG8_MMA
#undef PG8_WAIT_V
#undef PG8_WAIT_L
#undef PG8_BAR
#undef PG8_SCHED
}
}
typedef pg8::bf16_t bf16_t;
typedef pg8::f32x4 f32x4;
typedef pg8::u32x4 u32x4;
typedef pg8::bf16x8 bf16x8;
typedef unsigned u32x2 __attribute__((ext_vector_type(2)));
#define LAS __attribute__((address_space(3)))
constexpr int MTOK = 65536, DM = 1024, NIN = 6144, DFF = 2816, NUP = 5632, SEQ = 8192, NBR = 1536, NPA = 3072;
constexpr int NPA2 = 1536;
constexpr int MH = MTOK / 2;
constexpr float EPS = 1e-6f;
constexpr size_t WS_WIN = 0;
constexpr size_t WS_WBR = WS_WIN + (size_t)NIN * DM * 2;
constexpr size_t WS_WO = WS_WBR + (size_t)DM * NBR * 2;
constexpr size_t WS_WUP = WS_WO + (size_t)DM * DM * 2;
constexpr size_t WS_WDN = WS_WUP + (size_t)NUP * DM * 2;
constexpr size_t WS_SSQ = WS_WDN + (size_t)DM * DFF * 2;
constexpr size_t WS_XB = WS_SSQ + (size_t)MTOK * 16 * 4;
constexpr size_t WS_B1 = WS_XB + (size_t)MTOK * NBR * 2;
constexpr size_t WS_B2 = WS_B1 + (size_t)MTOK * NPA * 2;
constexpr size_t WS_END = WS_B2 + (size_t)MTOK * NPA * 2;
constexpr size_t WS_BAR = WS_END;
constexpr size_t WS_SC = WS_BAR + 16384;
constexpr size_t WS_SCB = WS_SC + (size_t)(MTOK / 64) * 4 * 512 * 2;
constexpr size_t WS_TOTAL = WS_SCB + (size_t)(MTOK / 64) * 2 * 512 * 2;

__device__ __forceinline__ int otid() { int t = threadIdx.x; asm volatile("" : "+v"(t)); return t; }
__device__ __forceinline__ int obid() { int b = blockIdx.x; asm volatile("" : "+s"(b)); return b; }
struct Params {
    const float* in[19];
    float* out; unsigned char* ws;
};

__device__ __forceinline__ u32x4 ld_nt16(const void* p) { return __builtin_nontemporal_load((const u32x4*)p); }
__device__ __forceinline__ void st_nt16(void* p, u32x4 w) { __builtin_nontemporal_store(w, (u32x4*)p); }
__device__ __forceinline__ float bflo(unsigned w) { return __uint_as_float(w << 16); }
__device__ __forceinline__ float bfhi(unsigned w) { return __uint_as_float(w & 0xffff0000u); }
__device__ __forceinline__ unsigned pk(float a, float b) { return pg8::cvt_pk_bf16(a, b); }
__device__ __forceinline__ float fast_rcp(float x) { return __builtin_amdgcn_rcpf(x); }
__device__ __forceinline__ float gate_t2(float y) { return 1.0f + __builtin_amdgcn_exp2f(fminf(y, 43.28f)); }
__device__ __forceinline__ float gelu_tanh_f(float x) {
    const float z2 = 1.5957691216f * (x + 0.044715f * x * x * x);
    return x * fast_rcp(1.0f + __expf(-z2));
}
__device__ __forceinline__ float silu_f(float x) { return x * fast_rcp(1.0f + __expf(-x)); }
__device__ __forceinline__ float row_rstd(const float* ssq, int r) {
    const f32x4* p = (const f32x4*)(ssq + (size_t)r * 16);
    const f32x4 a = p[0], b = p[1], c = p[2], d = p[3];
    const float s = ((a[0] + a[1]) + (a[2] + a[3])) + ((b[0] + b[1]) + (b[2] + b[3])) + ((c[0] + c[1]) + (c[2] + c[3])) + ((d[0] + d[1]) + (d[2] + d[3]));
    return rsqrtf(s * (1.0f / 1024.0f) + EPS);
}

__device__ __forceinline__ void rows_rstd8(const float* ssq, int row0, int fq, float (&rs)[8]) {
    f32x4 v[8];
#pragma unroll
    for (int i = 0; i < 8; ++i) v[i] = *(const f32x4*)(ssq + (size_t)(row0 + (i >> 2) * 128 + (i & 3) * 16) * 16 + fq * 4);
#pragma unroll
    for (int i = 0; i < 8; ++i) {
        float s = (v[i][0] + v[i][1]) + (v[i][2] + v[i][3]);
        s += __shfl_xor(s, 16); s += __shfl_xor(s, 32);
        rs[i] = rsqrtf(s * (1.0f / 1024.0f) + EPS);
    }
}
__device__ __forceinline__ float dpp_ror1(float x) { return __int_as_float(__builtin_amdgcn_mov_dpp(__float_as_int(x), 0x121, 0xf, 0xf, true)); }
__device__ __forceinline__ float dpp_ror2(float x) { return __int_as_float(__builtin_amdgcn_mov_dpp(__float_as_int(x), 0x122, 0xf, 0xf, true)); }
__device__ __forceinline__ float dpp_shr1(float old, float x) { return __int_as_float(__builtin_amdgcn_update_dpp(__float_as_int(old), __float_as_int(x), 0x111, 0xf, 0xf, false)); }
__device__ __forceinline__ float dpp_shr2(float old, float x) { return __int_as_float(__builtin_amdgcn_update_dpp(__float_as_int(old), __float_as_int(x), 0x112, 0xf, 0xf, false)); }
struct EpiIn {
    static constexpr bool PERM = true, AFTER_DRAIN = false, MIDK = false;
    bf16_t* PA; bf16_t* G; const float* ssq; bf16_t* Y; bf16_t* sc; bf16_t* scb; const float* cw;
    __device__ __forceinline__ void operator()(const f32x4 (&acc)[2][2][4][2], const pg8::Unit& u, int wr, int wc, int fr, int fq) const {
        const int row0 = u.pm * 256 + wr * 64 + fr;
        float rs8[8]; rows_rstd8(ssq, row0, fq, rs8);
        if (u.pn >= 16) {
            const int q0 = (u.pn - 16) * 64 + wc * 16 + fq * 4;
            const f32x4 w0 = *(const f32x4*)(cw + q0), w1 = *(const f32x4*)(cw + 512 + q0), w2 = *(const f32x4*)(cw + 1024 + q0);
#pragma unroll
            for (int ai = 0; ai < 2; ++ai) {
                f32x4 pz = {0.f, 0.f, 0.f, 0.f};
                const int blk = u.pm * 4 + ai * 2 + wr;
#pragma unroll
                for (int m = 0; m < 4; ++m) {
                    const float rs = rs8[ai * 4 + m];
                    const f32x4 cb = acc[ai][0][m][0] * rs, cc = acc[ai][0][m][1] * rs, cx = acc[ai][1][m][0] * rs, av = acc[ai][1][m][1] * rs;
                    const f32x4 z = cc * cx;
                    float y[4];
#pragma unroll
                    for (int j = 0; j < 4; ++j) {
                        const float z1 = dpp_shr1(dpp_ror1(pz[j]), z[j]), z2 = dpp_shr2(dpp_ror2(pz[j]), z[j]);
                        y[j] = cb[j] * fmaf(w0[j], z2, fmaf(w1[j], z1, w2[j] * z[j]));
                        asm volatile("" : "+v"(y[j]));
                    }
                    const int r = row0 + ai * 128 + m * 16;
                    u32x2 w;
                    w.x = pk(av[0], av[1]); w.y = pk(av[2], av[3]); *(u32x2*)(PA + (size_t)r * NPA2 + q0) = w;
                    if (!(m == 0 && fr < 2)) { w.x = pk(y[0], y[1]); w.y = pk(y[2], y[3]); *(u32x2*)(Y + (size_t)r * NBR + 1024 + q0) = w; }
                    if (m == 0 && fr < 2) {
                        w.x = pk(z[0], z[1]); w.y = pk(z[2], z[3]); *(u32x2*)(sc + ((size_t)blk * 4 + 2 + fr) * 512 + q0) = w;
                        w.x = pk(cb[0], cb[1]); w.y = pk(cb[2], cb[3]); *(u32x2*)(scb + ((size_t)blk * 2 + fr) * 512 + q0) = w;
                    }
                    if (m == 3 && fr >= 14) { w.x = pk(z[0], z[1]); w.y = pk(z[2], z[3]); *(u32x2*)(sc + ((size_t)blk * 4 + (fr - 14)) * 512 + q0) = w; }
                    pz = z;
                }
            }
        } else {
            const int q0 = u.pn * 64 + wc * 16 + fq * 4;
#pragma unroll
            for (int ai = 0; ai < 2; ++ai)
#pragma unroll
                for (int m = 0; m < 4; ++m) {
                    const float rs = rs8[ai * 4 + m], rsn = rs * -1.44269504f;
                    const f32x4 ga = acc[ai][0][m][0] * rsn, gb = acc[ai][0][m][1] * rsn, gc = acc[ai][1][m][0] * rsn, uv = acc[ai][1][m][1] * rs;
                    float r1[4], r2[4], s3[4], ug[4];
#pragma unroll
                    for (int j = 0; j < 4; ++j) {
                        const float ta = gate_t2(ga[j]), tb = gate_t2(gb[j]), tc = gate_t2(gc[j]);
                        r1[j] = tb * fast_rcp(ta); r2[j] = tc * fast_rcp(tb); s3[j] = fast_rcp(tc);
                        ug[j] = gelu_tanh_f(uv[j]);
                    }
                    const size_t ro = (size_t)(row0 + ai * 128 + m * 16) * NPA, rp = (size_t)(row0 + ai * 128 + m * 16) * NPA2;
                    u32x2 w;
                    w.x = pk(r1[0], r1[1]); w.y = pk(r1[2], r1[3]); *(u32x2*)(G + ro + q0) = w;
                    w.x = pk(r2[0], r2[1]); w.y = pk(r2[2], r2[3]); *(u32x2*)(G + ro + 1024 + q0) = w;
                    w.x = pk(s3[0], s3[1]); w.y = pk(s3[2], s3[3]); *(u32x2*)(G + ro + 2048 + q0) = w;
                    w.x = pk(ug[0], ug[1]); w.y = pk(ug[2], ug[3]); *(u32x2*)(PA + rp + 512 + q0) = w;
                }
        }
    }
};
struct EpiBr {
    static constexpr bool PERM = true, AFTER_DRAIN = false, MIDK = true;
    const bf16_t* G; bf16_t* out;
    __device__ __forceinline__ void mid(f32x4 (&acc)[2][2][4][2], const pg8::Unit& u, int t, int wr, int wc, int fr, int fq) const {
        const int seg = (t == 8) ? 0 : 1024;
        int col0 = u.pn * 256 + wc * 32 + 8 * fq + seg;
        int row0 = u.pm * 256 + wr * 64 + fr;
        asm volatile("" : "+v"(col0), "+v"(row0));
#pragma unroll
        for (int ai = 0; ai < 2; ++ai) {
            u32x4 nu[4][2];
#pragma unroll
            for (int m = 0; m < 4; ++m)
#pragma unroll
                for (int bj = 0; bj < 2; ++bj) nu[m][bj] = ld_nt16(G + (size_t)(row0 + ai * 128 + m * 16) * NPA + col0 + bj * 128);
            asm volatile("" ::: "memory");
#pragma unroll
            for (int m = 0; m < 4; ++m)
#pragma unroll
                for (int bj = 0; bj < 2; ++bj) {
                    const unsigned nw[4] = {nu[m][bj].x, nu[m][bj].y, nu[m][bj].z, nu[m][bj].w};
#pragma unroll
                    for (int q = 0; q < 4; ++q) { acc[ai][bj][m][q >> 1][(q & 1) * 2] *= bflo(nw[q]); acc[ai][bj][m][q >> 1][(q & 1) * 2 + 1] *= bfhi(nw[q]); }
                }
            asm volatile("" ::: "memory");
        }
    }
    __device__ __forceinline__ void operator()(const f32x4 (&acc)[2][2][4][2], const pg8::Unit& u, int wr, int wc, int fr, int fq) const {
        const int col0 = u.pn * 256 + wc * 32 + 8 * fq;
        const int row0 = u.pm * 256 + wr * 64 + fr;
        u32x4 sg[2][4][2];
#pragma unroll
        for (int ai = 0; ai < 2; ++ai)
#pragma unroll
            for (int m = 0; m < 4; ++m)
#pragma unroll
                for (int bj = 0; bj < 2; ++bj) sg[ai][m][bj] = ld_nt16(G + (size_t)(row0 + ai * 128 + m * 16) * NPA + 2048 + col0 + bj * 128);
#pragma unroll
        for (int ai = 0; ai < 2; ++ai)
#pragma unroll
            for (int m = 0; m < 4; ++m) {
                const int r = row0 + ai * 128 + m * 16;
                bf16_t* op = out + (size_t)r * DM + col0;
#pragma unroll
                for (int bj = 0; bj < 2; ++bj) {
                    const u32x4 s = sg[ai][m][bj];
                    const f32x4 a0 = acc[ai][bj][m][0], a1 = acc[ai][bj][m][1];
                    u32x4 w;
                    w.x = pk(a0[0] * bflo(s.x), a0[1] * bfhi(s.x)); w.y = pk(a0[2] * bflo(s.y), a0[3] * bfhi(s.y));
                    w.z = pk(a1[0] * bflo(s.z), a1[1] * bfhi(s.z)); w.w = pk(a1[2] * bflo(s.w), a1[3] * bfhi(s.w));
                    *(u32x4*)(op + bj * 128) = w;
                }
            }
    }
};
struct EpiRes {
    static constexpr bool PERM = true, AFTER_DRAIN = false, MIDK = false;
    bf16_t* xb; float* ssq;
    __device__ __forceinline__ void operator()(const f32x4 (&acc)[2][2][4][2], const pg8::Unit& u, int wr, int wc, int fr, int fq) const {
        const int col0 = u.pn * 256 + wc * 32 + 8 * fq;
        const int row0 = u.pm * 256 + wr * 64 + fr;
        u32x4 bb[2][4][2];
#pragma unroll
        for (int ai = 0; ai < 2; ++ai)
#pragma unroll
            for (int m = 0; m < 4; ++m)
#pragma unroll
                for (int bj = 0; bj < 2; ++bj) bb[ai][m][bj] = *(const u32x4*)(xb + (size_t)(row0 + ai * 128 + m * 16) * DM + col0 + bj * 128);
        asm volatile("" ::: "memory");
#pragma unroll
        for (int ai = 0; ai < 2; ++ai) {
#pragma unroll
            for (int m = 0; m < 4; ++m) {
                const int r = row0 + ai * 128 + m * 16;
                float sq = 0.f;
#pragma unroll
                for (int bj = 0; bj < 2; ++bj) {
                    const u32x4 s = bb[ai][m][bj];
                    const f32x4 a0 = acc[ai][bj][m][0], a1 = acc[ai][bj][m][1];
                    const float o0 = bflo(s.x) + a0[0], o1 = bfhi(s.x) + a0[1], o2 = bflo(s.y) + a0[2], o3 = bfhi(s.y) + a0[3];
                    const float o4 = bflo(s.z) + a1[0], o5 = bfhi(s.z) + a1[1], o6 = bflo(s.w) + a1[2], o7 = bfhi(s.w) + a1[3];
                    u32x4 w; w.x = pk(o0, o1); w.y = pk(o2, o3); w.z = pk(o4, o5); w.w = pk(o6, o7);
                    *(u32x4*)(xb + (size_t)r * DM + col0 + bj * 128) = w;
                    sq += (o0 * o0 + o1 * o1) + (o2 * o2 + o3 * o3) + (o4 * o4 + o5 * o5) + (o6 * o6 + o7 * o7);
                }
                sq += __shfl_xor(sq, 16); sq += __shfl_xor(sq, 32);
                if (fq == 0) ssq[(size_t)r * 16 + u.pn * 4 + wc] = sq;
            }
            asm volatile("" ::: "memory");
        }
    }
};
struct EpiUp {
    static constexpr bool PERM = true, AFTER_DRAIN = false, MIDK = false;
    bf16_t* act; bf16_t* zs; const float* ssq; const float* cw; const float* cb;
    __device__ __forceinline__ void operator()(const f32x4 (&acc)[2][2][4][2], const pg8::Unit& u, int wr, int wc, int fr, int fq) const {
        const int c0 = u.pn * 128 + wc * 32 + 8 * fq;
        const int row0 = u.pm * 256 + wr * 64 + fr;
        float rs8[8]; rows_rstd8(ssq, row0, fq, rs8);
        u32x2 keep[2][4];
#pragma unroll
        for (int n = 0; n < 2; ++n) {
            const int c = c0 + 4 * n;
            const f32x4 gw0 = *(const f32x4*)(cw + c), gw1 = *(const f32x4*)(cw + NUP + c), gw2 = *(const f32x4*)(cw + 2 * NUP + c), gb = *(const f32x4*)(cb + c);
            const f32x4 vw0 = *(const f32x4*)(cw + DFF + c), vw1 = *(const f32x4*)(cw + NUP + DFF + c), vw2 = *(const f32x4*)(cw + 2 * NUP + DFF + c), vb = *(const f32x4*)(cb + DFF + c);
#pragma unroll
            for (int ai = 0; ai < 2; ++ai) {
                f32x4 pg = {0.f, 0.f, 0.f, 0.f}, pv = {0.f, 0.f, 0.f, 0.f};
                const int blk = u.pm * 4 + ai * 2 + wr;
#pragma unroll
                for (int m = 0; m < 4; ++m) {
                    const float rs = rs8[ai * 4 + m];
                    const f32x4 zg = acc[ai][0][m][n] * rs, zv = acc[ai][1][m][n] * rs;
                    float o[4];
#pragma unroll
                    for (int j = 0; j < 4; ++j) {
                        const float g1 = dpp_shr1(dpp_ror1(pg[j]), zg[j]), g2 = dpp_shr2(dpp_ror2(pg[j]), zg[j]);
                        const float v1 = dpp_shr1(dpp_ror1(pv[j]), zv[j]), v2 = dpp_shr2(dpp_ror2(pv[j]), zv[j]);
                        const float gg = fmaf(gw0[j], g2, fmaf(gw1[j], g1, fmaf(gw2[j], zg[j], gb[j])));
                        const float vv = fmaf(vw0[j], v2, fmaf(vw1[j], v1, fmaf(vw2[j], zv[j], vb[j])));
                        o[j] = silu_f(gg) * vv;
                    }
                    u32x2 w; w.x = pk(o[0], o[1]); w.y = pk(o[2], o[3]);
                    const int r = row0 + ai * 128 + m * 16;
                    if (n == 0) keep[ai][m] = w;
                    else if (!(m == 0 && fr < 2)) { u32x4 ww; ww.x = keep[ai][m].x; ww.y = keep[ai][m].y; ww.z = w.x; ww.w = w.y; st_nt16(act + (size_t)r * DFF + c0, ww); }
                    if (m == 0 && fr < 2) {
                        bf16_t* zp = zs + ((size_t)blk * 4 + 2 + fr) * NUP + c;
                        u32x2 a; a.x = pk(zg[0], zg[1]); a.y = pk(zg[2], zg[3]); *(u32x2*)zp = a;
                        u32x2 d; d.x = pk(zv[0], zv[1]); d.y = pk(zv[2], zv[3]); *(u32x2*)(zp + DFF) = d;
                    }
                    if (m == 3 && fr >= 14) {
                        bf16_t* zp = zs + ((size_t)blk * 4 + (fr - 14)) * NUP + c;
                        u32x2 a; a.x = pk(zg[0], zg[1]); a.y = pk(zg[2], zg[3]); *(u32x2*)zp = a;
                        u32x2 d; d.x = pk(zv[0], zv[1]); d.y = pk(zv[2], zv[3]); *(u32x2*)(zp + DFF) = d;
                    }
                    pg = zg; pv = zv;
                }
            }
        }
    }
};

__device__ __forceinline__ int win_dest_row(int col) {
    int ch, bj, n, t0;
    if (col < 512) { ch = col; bj = 1; n = 1; t0 = 16; }
    else if (col < 1536) { ch = col - 512; bj = 1; n = 1; t0 = 0; }
    else if (col < 3072) { const int s = (col - 1536) >> 9; ch = (col - 1536) & 511; bj = s >> 1; n = s & 1; t0 = 16; }
    else { const int gi = (col - 3072) >> 10; ch = (col - 3072) & 1023; bj = gi >> 1; n = gi & 1; t0 = 0; }
    const int k = t0 + (ch >> 6), r = ch & 63;
    return 256 * k + 128 * bj + 32 * (r >> 4) + 8 * ((r >> 2) & 3) + 4 * n + (r & 3);
}
__device__ __forceinline__ void transpose_tile(const float* __restrict__ W, int N, const float* __restrict__ g, bf16_t* __restrict__ Wt, int ldt, int koff, int k0, int n0, int nd0, float* tile, int tid, bool winmap = false) {
    {
        const int kk = tid >> 4, nn = (tid & 15) * 4;
        f32x4 v[2][2]; float s[2];
#pragma unroll
        for (int h = 0; h < 2; ++h) { s[h] = g ? g[k0 + kk + h * 32] : 1.0f;
#pragma unroll
            for (int h2 = 0; h2 < 2; ++h2) v[h2][h] = *(const f32x4*)(W + (size_t)(k0 + kk + h * 32) * N + n0 + h2 * 64 + nn); }
#pragma unroll
        for (int h2 = 0; h2 < 2; ++h2)
#pragma unroll
            for (int h = 0; h < 2; ++h) { float* tp = tile + h2 * (64 * 65) + (kk + h * 32) * 65 + nn;
                tp[0] = v[h2][h][0] * s[h]; tp[1] = v[h2][h][1] * s[h]; tp[2] = v[h2][h][2] * s[h]; tp[3] = v[h2][h][3] * s[h]; }
    }
    __syncthreads();
    {
        const int n = tid >> 3, kq = (tid & 7) * 8;
#pragma unroll
        for (int h2 = 0; h2 < 2; ++h2) {
            float v[8];
#pragma unroll
            for (int j = 0; j < 8; ++j) v[j] = tile[h2 * (64 * 65) + (kq + j) * 65 + n];
            u32x4 w; w.x = pk(v[0], v[1]); w.y = pk(v[2], v[3]); w.z = pk(v[4], v[5]); w.w = pk(v[6], v[7]);
            *(u32x4*)(Wt + (size_t)(winmap ? win_dest_row(n0 + h2 * 64 + n) : nd0 + h2 * 64 + n) * ldt + koff + k0 + kq) = w;
        }
    }
    __syncthreads();
}

__device__ __forceinline__ void prep_phase(const Params& p, int l, float* ldsf) {
    unsigned char* ws = p.ws;
    bf16_t* wt_in = (bf16_t*)(ws + WS_WIN); bf16_t* wt_br = (bf16_t*)(ws + WS_WBR); bf16_t* wt_o = (bf16_t*)(ws + WS_WO);
    bf16_t* wt_up = (bf16_t*)(ws + WS_WUP); bf16_t* wt_dn = (bf16_t*)(ws + WS_WDN);
    const float* g_mix = p.in[1] + (size_t)l * DM; const float* w_in = p.in[2] + (size_t)l * DM * NIN;
    const float* w_pool = p.in[3] + (size_t)l * 4 * 128 * 128; const float* pscale = p.in[4] + (size_t)l * 512;
    const float* w_ba = p.in[9] + (size_t)l * 512 * DM; const float* w_bb = p.in[10] + (size_t)l * 512 * DM; const float* w_bc = p.in[11] + (size_t)l * 512 * DM;
    const float* w_o = p.in[12] + (size_t)l * DM * DM; const float* g_ffn = p.in[13] + (size_t)l * DM;
    const float* w_up = p.in[14] + (size_t)l * DM * NUP; const float* w_dn = p.in[17] + (size_t)l * DFF * DM;
    const int tid = otid(), bid = obid();
    constexpr int T0 = 16 * 48, T1 = T0 + 64, T2 = T1 + 64, T3 = T2 + 128, T4 = T3 + 16 * 44, T5 = T4 + 44 * 8;
    for (int i = bid; i < T5; i += gridDim.x) {
        if (i < T0) { const int kt = i & 15, nt = i >> 4; transpose_tile(w_in, NIN, g_mix, wt_in, DM, 0, kt * 64, nt * 128, nt * 128, ldsf, tid, true); }
        else if (i < T1) { const int j = i - T0, kt = j & 7, nt = j >> 3; transpose_tile(w_bb, DM, nullptr, wt_br, NBR, 512, kt * 64, nt * 128, nt * 128, ldsf, tid); }
        else if (i < T2) { const int j = i - T1, kt = j & 7, nt = j >> 3; transpose_tile(w_bc, DM, nullptr, wt_br, NBR, 1024, kt * 64, nt * 128, nt * 128, ldsf, tid); }
        else if (i < T3) { const int j = i - T2, kt = j & 15, nt = j >> 4; transpose_tile(w_o, DM, nullptr, wt_o, DM, 0, kt * 64, nt * 128, nt * 128, ldsf, tid); }
        else if (i < T4) { const int j = i - T3, kt = j & 15, nt = j >> 4; const int n0 = nt * 128, bj = n0 / DFF, q0 = n0 - bj * DFF; transpose_tile(w_up, NUP, g_ffn, wt_up, DM, 0, kt * 64, n0, (q0 >> 7) * 256 + bj * 128, ldsf, tid);   }
        else { const int j = i - T4, kt = j % 44, nt = j / 44; transpose_tile(w_dn, DM, nullptr, wt_dn, DFF, 0, kt * 64, nt * 128, nt * 128, ldsf, tid); }
    }
    {
        float* wpT = ldsf;
        float* wa = ldsf + 128 * 128;
        for (int it = (int)gridDim.x - 1 - bid; it < 64; it += gridDim.x) {
            const int g = it >> 4, n0 = (it & 15) * 64;
            for (int q = tid; q < 128 * 32; q += 512) {
                const int d = q >> 5, e4 = (q & 31) * 4;
                const f32x4 v = *(const f32x4*)(w_pool + ((size_t)g * 128 + d) * 128 + e4);
                const f32x4 s = *(const f32x4*)(pscale + g * 128 + e4);
                wpT[(e4 + 0) * 128 + d] = v[0] * s[0]; wpT[(e4 + 1) * 128 + d] = v[1] * s[1]; wpT[(e4 + 2) * 128 + d] = v[2] * s[2]; wpT[(e4 + 3) * 128 + d] = v[3] * s[3];
            }
            for (int q = tid; q < 128 * 16; q += 512) {
                const int e = q >> 4, c4 = (q & 15) * 4;
                *(f32x4*)(wa + e * 64 + c4) = *(const f32x4*)(w_ba + (size_t)(g * 128 + e) * DM + n0 + c4);
            }
            __syncthreads();
            const int d = tid & 127, ns = tid >> 7;
            float acc[16];
#pragma unroll
            for (int i = 0; i < 16; ++i) acc[i] = 0.f;
            for (int e = 0; e < 128; ++e) {
                const float w = wpT[e * 128 + d];
                const f32x4* wr4 = (const f32x4*)(wa + e * 64 + ns * 16);
#pragma unroll
                for (int c = 0; c < 4; ++c) { const f32x4 b = wr4[c]; acc[c * 4 + 0] += w * b[0]; acc[c * 4 + 1] += w * b[1]; acc[c * 4 + 2] += w * b[2]; acc[c * 4 + 3] += w * b[3]; }
            }
#pragma unroll
            for (int i = 0; i < 16; ++i) wt_br[(size_t)(n0 + ns * 16 + i) * NBR + g * 128 + d] = (bf16_t)(pk(acc[i], 0.f) & 0xffffu);
            __syncthreads();
        }
    }
    if (l == 0) {
        const float* x = p.in[0]; bf16_t* xb = (bf16_t*)(ws + WS_XB); float* ssq = (float*)(ws + WS_SSQ);
        const int lane = tid & 63, wave = tid >> 6;
        for (int r0 = (bid * 8 + wave) * 2; r0 < MTOK; r0 += gridDim.x * 16) {
            f32x4 v[2][4];
#pragma unroll
            for (int rr = 0; rr < 2; ++rr)
#pragma unroll
                for (int i = 0; i < 4; ++i) v[rr][i] = *(const f32x4*)(x + (size_t)(r0 + rr) * DM + i * 256 + lane * 4);
#pragma unroll
            for (int rr = 0; rr < 2; ++rr) {
                const int r = r0 + rr;
                float sq = 0.f;
#pragma unroll
                for (int i = 0; i < 4; ++i) {
                    const f32x4 t = v[rr][i];
                    sq += (t[0] * t[0] + t[1] * t[1]) + (t[2] * t[2] + t[3] * t[3]);
                    u32x2 w; w.x = pk(t[0], t[1]); w.y = pk(t[2], t[3]);
                    *(u32x2*)(xb + (size_t)r * DM + i * 256 + lane * 4) = w;
                }
#pragma unroll
                for (int o = 32; o >= 1; o >>= 1) sq += __shfl_xor(sq, o);
                if (lane < 16) ssq[(size_t)r * 16 + lane] = (lane == 0) ? sq : 0.f;
            }
        }
    }
}
__device__ __forceinline__ void ld8(const bf16_t* p, float (&v)[8]) {
    const u32x4 w = *(const u32x4*)p;
    v[0] = bflo(w.x); v[1] = bfhi(w.x); v[2] = bflo(w.y); v[3] = bfhi(w.y); v[4] = bflo(w.z); v[5] = bfhi(w.z); v[6] = bflo(w.w); v[7] = bfhi(w.w);
}
__device__ __forceinline__ void st8(bf16_t* p, const float (&v)[8]) {
    u32x4 w; w.x = pk(v[0], v[1]); w.y = pk(v[2], v[3]); w.z = pk(v[4], v[5]); w.w = pk(v[6], v[7]);
    *(u32x4*)p = w;
}
template <int W> __device__ __forceinline__ void pool_rows(const bf16_t* __restrict__ ap, bf16_t* __restrict__ yp, int r0, int pos0) {
#pragma unroll
    for (int b = 0; b < 4; ++b) {
        const int base = r0 + 4 * b;
        u32x4 h[W + 3];
#pragma unroll
        for (int i = 0; i < W + 3; ++i) { const int rr = base - (W - 1) + i; h[i] = (pos0 + rr >= 0) ? *(const u32x4*)(ap + (ptrdiff_t)rr * NPA2) : (u32x4){0u, 0u, 0u, 0u}; }
        float s[8];
#pragma unroll
        for (int j = 0; j < 8; ++j) s[j] = 0.f;
#pragma unroll
        for (int i = 0; i < W - 1; ++i) { const u32x4 q = h[i];
            s[0] += bflo(q.x); s[1] += bfhi(q.x); s[2] += bflo(q.y); s[3] += bfhi(q.y); s[4] += bflo(q.z); s[5] += bfhi(q.z); s[6] += bflo(q.w); s[7] += bfhi(q.w); }
#pragma unroll
        for (int i = 0; i < 4; ++i) {
            const int rr = base + i, pos = pos0 + rr; const float inv = 1.0f / (float)(pos + 1 < W ? pos + 1 : W);
            const u32x4 q = h[W - 1 + i], od = h[i];
            const float v[8] = {bflo(q.x), bfhi(q.x), bflo(q.y), bfhi(q.y), bflo(q.z), bfhi(q.z), bflo(q.w), bfhi(q.w)};
            float o[8];
#pragma unroll
            for (int j = 0; j < 8; ++j) { s[j] += v[j]; o[j] = s[j] * inv - v[j]; }
            st8(yp + (size_t)rr * NBR, o);
            s[0] -= bflo(od.x); s[1] -= bfhi(od.x); s[2] -= bflo(od.y); s[3] -= bfhi(od.y); s[4] -= bflo(od.z); s[5] -= bfhi(od.z); s[6] -= bflo(od.w); s[7] -= bfhi(od.w);
        }
        asm volatile("" ::: "memory");
    }
}
constexpr int VT_PITCH = 136;
__device__ __forceinline__ void mixer_phase(const Params& p, int l, unsigned char* lds) {
    const bf16_t* PA = (const bf16_t*)(p.ws + WS_B1);
    bf16_t* Y = (bf16_t*)p.out;
    const float* g_sgu = p.in[5] + (size_t)l * 512;
    const float* w_sp = p.in[6] + (size_t)l * 4 * 128 * 128;
    const float* b_sp = p.in[7] + (size_t)l * 4 * 128;
    const float* conv_c = p.in[8] + (size_t)l * 3 * 512;
    float* rs = (float*)lds;
    bf16_t* vT = (bf16_t*)(lds + 1024);
    const int tid = otid(), lane = tid & 63, wave = __builtin_amdgcn_readfirstlane(tid >> 6), fr = lane & 15, fq = lane >> 4;
    for (int item = obid(); item < MTOK / 128; item += gridDim.x) {
        const int t0 = item * 128, pos0 = t0 & (SEQ - 1);
        {
            const int row = tid >> 2, q = tid & 3;
            const bf16_t* vp = PA + (size_t)(t0 + row) * NPA2 + 1024 + q * 128;
            float sq = 0.f;
#pragma unroll
            for (int i = 0; i < 16; ++i) { float v[8]; ld8(vp + i * 8, v);
#pragma unroll
                for (int j = 0; j < 8; ++j) sq += v[j] * v[j]; }
            sq += __shfl_xor(sq, 1); sq += __shfl_xor(sq, 2);
            if (q == 0) rs[row] = rsqrtf(sq * (1.0f / 512.0f) + EPS);
        }
        {
            const int grp = wave & 3;
            const int c8 = (grp * 16 + (lane & 15)) * 8; int r0 = ((wave >> 2) * 4 + (lane >> 4)) * 16;
            asm volatile("" : "+v"(r0));
            {
                const bf16_t* ap = PA + (size_t)t0 * NPA2 + c8;
                bf16_t* yp = Y + (size_t)t0 * NBR + c8;
                if (grp == 0) pool_rows<2>(ap, yp, r0, pos0); else if (grp == 1) pool_rows<4>(ap, yp, r0, pos0); else if (grp == 2) pool_rows<8>(ap, yp, r0, pos0); else pool_rows<16>(ap, yp, r0, pos0);
            }
        }
        if (tid < 256) {
            const bf16_t* sc = (const bf16_t*)(p.ws + WS_SC); const bf16_t* scb = (const bf16_t*)(p.ws + WS_SCB);
            const int b_ = tid >> 7, ri = (tid >> 6) & 1, c8 = (tid & 63) * 8;
            const int blk = (t0 >> 6) + b_;
            const bool first = ((blk * 64) & (SEQ - 1)) == 0;
            float z2[8], z1[8], z0[8], cbv[8], o[8];
#pragma unroll
            for (int j = 0; j < 8; ++j) { z2[j] = 0.f; z1[j] = 0.f; }
            const bf16_t* own = sc + (size_t)blk * 4 * 512 + c8;
            if (ri == 0) { if (!first) { ld8(own - 4 * 512, z2); ld8(own - 3 * 512, z1); } ld8(own + 2 * 512, z0); }
            else { if (!first) ld8(own - 3 * 512, z2); ld8(own + 2 * 512, z1); ld8(own + 3 * 512, z0); }
            ld8(scb + ((size_t)blk * 2 + ri) * 512 + c8, cbv);
#pragma unroll
            for (int j = 0; j < 8; ++j) o[j] = 0.f;
            { const f32x4 a0 = *(const f32x4*)(conv_c + c8), a1 = *(const f32x4*)(conv_c + c8 + 4), b0 = *(const f32x4*)(conv_c + 512 + c8), b1 = *(const f32x4*)(conv_c + 512 + c8 + 4), c0 = *(const f32x4*)(conv_c + 1024 + c8), c1 = *(const f32x4*)(conv_c + 1024 + c8 + 4);
#pragma unroll
              for (int j = 0; j < 4; ++j) { o[j] = cbv[j] * fmaf(a0[j], z2[j], fmaf(b0[j], z1[j], c0[j] * z0[j])); o[4 + j] = cbv[4 + j] * fmaf(a1[j], z2[4 + j], fmaf(b1[j], z1[4 + j], c1[j] * z0[4 + j])); } }
            st8(Y + (size_t)(blk * 64 + ri) * NBR + 1024 + c8, o);
        }
#pragma unroll 1
        for (int g = 0; g < 4; ++g) {
            const int t = wave * 16 + fr;
            const int nk = (wave >> 1) + 1;
            f32x4 wq[4][2];
#pragma unroll
            for (int k = 0; k < 4; ++k) { const float* wp = w_sp + ((size_t)g * 128 + t) * 128 + k * 32 + fq * 8; wq[k][0] = *(const f32x4*)wp; wq[k][1] = *(const f32x4*)(wp + 4); }
            const bf16_t* up = PA + (size_t)(t0 + t) * NPA2 + 512 + g * 128 + 4 * fq;
            u32x2 uu[8];
#pragma unroll
            for (int n = 0; n < 8; ++n) uu[n] = *(const u32x2*)(up + n * 16);
            const float bias = b_sp[g * 128 + t];
            u32x4 vq[4];
            const int s_ = tid >> 2, dq = (tid & 3) * 32;
            {
                const bf16_t* vp = PA + (size_t)(t0 + s_) * NPA2 + 1024 + g * 128 + dq;
#pragma unroll
                for (int i = 0; i < 4; ++i) vq[i] = *(const u32x4*)(vp + i * 8);
            }
            __syncthreads();
#pragma unroll
            for (int i = 0; i < 4; ++i) {
                const unsigned ww[4] = {vq[i].x, vq[i].y, vq[i].z, vq[i].w};
#pragma unroll
                for (int q = 0; q < 4; ++q) { vT[(dq + i * 8 + q * 2) * VT_PITCH + s_] = (bf16_t)(ww[q] & 0xffffu); vT[(dq + i * 8 + q * 2 + 1) * VT_PITCH + s_] = (bf16_t)(ww[q] >> 16); }
            }
            __syncthreads();
            f32x4 acc[8];
#pragma unroll
            for (int n = 0; n < 8; ++n) acc[n] = (f32x4){0.f, 0.f, 0.f, 0.f};
#pragma unroll
            for (int k = 0; k < 4; ++k) if (k < nk) {
                const int s0 = k * 32 + fq * 8;
                const f32x4 wa = wq[k][0], wb = wq[k][1];
                const f32x4 ra = *(const f32x4*)(rs + s0), rb = *(const f32x4*)(rs + s0 + 4);
                float a[8];
#pragma unroll
                for (int j = 0; j < 4; ++j) { a[j] = (s0 + j <= t) ? wa[j] * ra[j] : 0.f; a[4 + j] = (s0 + 4 + j <= t) ? wb[j] * rb[j] : 0.f; }
                union { u32x4 u; bf16x8 h; } af; af.u.x = pk(a[0], a[1]); af.u.y = pk(a[2], a[3]); af.u.z = pk(a[4], a[5]); af.u.w = pk(a[6], a[7]);
#pragma unroll
                for (int n = 0; n < 8; ++n) {
                    const bf16x8 bfrag = *(const bf16x8*)(vT + (n * 16 + fr) * VT_PITCH + s0);
                    acc[n] = __builtin_amdgcn_mfma_f32_16x16x32_bf16(bfrag, af.h, acc[n], 0, 0, 0);
                }
            }
            bf16_t* yp = Y + (size_t)(t0 + t) * NBR + 512 + g * 128 + 4 * fq;
#pragma unroll
            for (int n = 0; n < 8; ++n) {
                const f32x4 gs = *(const f32x4*)(g_sgu + g * 128 + n * 16 + 4 * fq);
                const float o0 = bflo(uu[n].x) * (acc[n][0] * gs[0] + bias), o1 = bfhi(uu[n].x) * (acc[n][1] * gs[1] + bias);
                const float o2 = bflo(uu[n].y) * (acc[n][2] * gs[2] + bias), o3 = bfhi(uu[n].y) * (acc[n][3] * gs[3] + bias);
                u32x2 w; w.x = pk(o0, o1); w.y = pk(o2, o3);
                *(u32x2*)(yp + n * 16) = w;
            }
        }
        __syncthreads();
    }
}

__device__ __forceinline__ void ffn_fixup_phase(const Params& p, int l) {
    const bf16_t* zs = (const bf16_t*)(p.ws + WS_B2);
    bf16_t* act = (bf16_t*)(p.ws + WS_B1);
    const float* cw = p.in[15] + (size_t)l * 3 * NUP; const float* cb = p.in[16] + (size_t)l * NUP;
    constexpr int NCG = DFF / 8, NU = (MTOK / 64) * NCG;
    for (int u = obid() * 512 + otid(); u < NU; u += gridDim.x * 512) {
        const int blk = u / NCG, c8 = (u - blk * NCG) * 8;
        const bool first = ((blk * 64) & (SEQ - 1)) == 0;
        float g2[8], g1[8], ga[8], gb2[8], v2[8], v1[8], va[8], vb2[8];
#pragma unroll
        for (int j = 0; j < 8; ++j) { g2[j] = g1[j] = v2[j] = v1[j] = 0.f; }
        const bf16_t* own = zs + (size_t)blk * 4 * NUP + c8;
        if (!first) { const bf16_t* prv = own - 4 * (ptrdiff_t)NUP; ld8(prv, g2); ld8(prv + NUP, g1); ld8(prv + DFF, v2); ld8(prv + NUP + DFF, v1); }
        ld8(own + 2 * NUP, ga); ld8(own + 3 * NUP, gb2); ld8(own + 2 * NUP + DFF, va); ld8(own + 3 * NUP + DFF, vb2);
        float o0[8], o1[8];
        float w0[8], w1[8], w2[8], bb[8], x0[8], x1[8], x2[8], xb_[8];
        { const f32x4* q;
#define LD8F(dst, ptr) q = (const f32x4*)(ptr); { const f32x4 a_ = q[0], b_ = q[1]; dst[0] = a_[0]; dst[1] = a_[1]; dst[2] = a_[2]; dst[3] = a_[3]; dst[4] = b_[0]; dst[5] = b_[1]; dst[6] = b_[2]; dst[7] = b_[3]; }
          LD8F(w0, cw + c8) LD8F(w1, cw + NUP + c8) LD8F(w2, cw + 2 * NUP + c8) LD8F(bb, cb + c8)
          LD8F(x0, cw + DFF + c8) LD8F(x1, cw + NUP + DFF + c8) LD8F(x2, cw + 2 * NUP + DFF + c8) LD8F(xb_, cb + DFF + c8)
#undef LD8F
        }
#pragma unroll
        for (int j = 0; j < 8; ++j) {
            const float gg0 = w0[j] * g2[j] + w1[j] * g1[j] + w2[j] * ga[j] + bb[j], vv0 = x0[j] * v2[j] + x1[j] * v1[j] + x2[j] * va[j] + xb_[j];
            const float gg1 = w0[j] * g1[j] + w1[j] * ga[j] + w2[j] * gb2[j] + bb[j], vv1 = x0[j] * v1[j] + x1[j] * va[j] + x2[j] * vb2[j] + xb_[j];
            o0[j] = silu_f(gg0) * vv0; o1[j] = silu_f(gg1) * vv1;
        }
        st8(act + (size_t)(blk * 64) * DFF + c8, o0); st8(act + (size_t)(blk * 64 + 1) * DFF + c8, o1);
    }
}

__device__ __forceinline__ void final_norm_phase(const Params& p) {
    const float* gf = p.in[18]; const float* ssq = (const float*)(p.ws + WS_SSQ); const bf16_t* xb = (const bf16_t*)(p.ws + WS_XB); float* out = p.out;
    const int tid = otid(), lane = tid & 63, wave = tid >> 6;
    for (int r0 = (obid() * 8 + wave) * 2; r0 < MTOK; r0 += gridDim.x * 16) {
        u32x4 xv[2][2]; float rs[2];
#pragma unroll
        for (int rr = 0; rr < 2; ++rr) {
            rs[rr] = row_rstd(ssq, r0 + rr);
#pragma unroll
            for (int i = 0; i < 2; ++i) xv[rr][i] = *(const u32x4*)(xb + (size_t)(r0 + rr) * DM + i * 512 + lane * 8);
        }
#pragma unroll
        for (int rr = 0; rr < 2; ++rr)
#pragma unroll
            for (int i = 0; i < 2; ++i) {
                const int cc = i * 512 + lane * 8;
                const u32x4 q = xv[rr][i];
                const float v[8] = {bflo(q.x), bfhi(q.x), bflo(q.y), bfhi(q.y), bflo(q.z), bfhi(q.z), bflo(q.w), bfhi(q.w)};
                const f32x4 g0 = *(const f32x4*)(gf + cc), g1 = *(const f32x4*)(gf + cc + 4);
                f32x4 o0, o1;
#pragma unroll
                for (int j = 0; j < 4; ++j) { o0[j] = v[j] * rs[rr] * g0[j]; o1[j] = v[4 + j] * rs[rr] * g1[j]; }
                float* qo = out + (size_t)(r0 + rr) * DM + cc;
                __builtin_nontemporal_store(o0, (f32x4*)qo); __builtin_nontemporal_store(o1, (f32x4*)(qo + 4));
            }
    }
}

template <class Epi> __device__ __forceinline__ void run_gemm(unsigned char* lds, const bf16_t* A, const bf16_t* Bt, int M, int N, int K, const Epi& E, int stagger_step = 0) {
    pg8::Gemm g{A, Bt, M, N, K}; pg8::StaticOrder S; S.init(M, N, (int)gridDim.x, obid());
    if (stagger_step) {
        const unsigned long long t0 = wall_clock64(), d = (unsigned long long)(((obid() >> 3) & 7) * stagger_step);
        while (wall_clock64() - t0 < d) __builtin_amdgcn_s_sleep(16);
    }
    pg8::gemm_phase<Epi, pg8::StaticOrder, false>((PG8_LAS unsigned char*)lds, g, S, E, nullptr);
}

#define XB_TMO      128
#define XB_XCNT(j)  (256  + 64 * (j))
#define XB_XSUB(j)  (1280 + 64 * (j))
#define XB_XGEN(j)  (2304 + 64 * (j))
#define XB_TOP      3328
#define XB_TOPGEN   3392
#define XCD_BAR_WORDS 3456
#define XB_SPIN_CAP (1u << 18)

__device__ __forceinline__ unsigned xb_ld(unsigned* p)              { return __hip_atomic_load(p, __ATOMIC_RELAXED, __HIP_MEMORY_SCOPE_AGENT); }
__device__ __forceinline__ unsigned xb_add(unsigned* p, unsigned v) { return __hip_atomic_fetch_add(p, v, __ATOMIC_RELAXED, __HIP_MEMORY_SCOPE_AGENT); }
__device__ __forceinline__ unsigned xb_xcc_id() { return (unsigned)__builtin_amdgcn_s_getreg((3 << 11) | 20) & 0xFu; }
#define XB_SPIN(cond, bar) do { unsigned _sp = 0; while (cond) { __builtin_amdgcn_s_sleep(1); \
    if ((++_sp & 255u) == 0u) { if (xb_ld(&(bar)[XB_TMO])) break; if (_sp > XB_SPIN_CAP) { atomicAdd(&(bar)[XB_TMO], 1u); break; } } } } while (0)

struct XcdBarrier {
    unsigned* bar; unsigned x;
    volatile LAS unsigned* st;
};

__device__ __forceinline__ XcdBarrier xcd_barrier_post(unsigned* bar, volatile LAS unsigned* st) {
    XcdBarrier b; b.bar = bar; b.x = xb_xcc_id(); b.st = st;
    if (threadIdx.x == 0) (void)xb_add(&bar[XB_XCNT(b.x)], 1u);
    return b;
}
__device__ __forceinline__ void xcd_barrier_complete(unsigned* bar, unsigned x, unsigned& nloc, unsigned& nx) {
    const unsigned G = gridDim.x * gridDim.y * gridDim.z;
    unsigned sum, cnt, mine, sp = 0u;
    for (;;) {
        sum = 0u; cnt = 0u; mine = 0u;
#pragma unroll
        for (unsigned j = 0; j < 16; ++j) { const unsigned c = xb_ld(&bar[XB_XCNT(j)]); sum += c; cnt += (c > 0u) ? 1u : 0u; mine = (j == x) ? c : mine; }
        if (sum == G) break;
        __builtin_amdgcn_s_sleep(1);
        if ((++sp & 255u) == 0u) { if (xb_ld(&bar[XB_TMO])) break; if (sp > XB_SPIN_CAP) { atomicAdd(&bar[XB_TMO], 1u); break; } }
    }
    nloc = mine > 0u ? mine : 1u; nx = cnt > 0u ? cnt : 1u;
}

__device__ __forceinline__ void xcd_barrier(const XcdBarrier& b) {
    asm volatile("s_waitcnt vmcnt(0)" ::: "memory");
    __syncthreads();
    if (threadIdx.x == 0) {
        unsigned* bar = b.bar;
        __builtin_amdgcn_s_waitcnt(0);
        unsigned nloc = b.st[0], nx = b.st[1];
        if (nloc == 0u) { xcd_barrier_complete(bar, b.x, nloc, nx); b.st[0] = nloc; b.st[1] = nx; }
        const unsigned old = xb_add(&bar[XB_XSUB(b.x)], 1u);
        const unsigned gen = old / nloc;
        if (old + 1u == (gen + 1u) * nloc) {
            __builtin_amdgcn_fence(__ATOMIC_RELEASE, "agent");
            asm volatile("s_waitcnt vmcnt(0)" ::: "memory");
            const unsigned og = xb_add(&bar[XB_TOP], 1u);
            const unsigned tg = og / nx;
            if (og + 1u == (tg + 1u) * nx) xb_add(&bar[XB_TOPGEN], 1u);
            else XB_SPIN(xb_ld(&bar[XB_TOPGEN]) == tg, bar);
            __builtin_amdgcn_fence(__ATOMIC_ACQUIRE, "agent");
            xb_add(&bar[XB_XGEN(b.x)], 1u);
            asm volatile("s_waitcnt vmcnt(0)" ::: "memory");
        } else {
            XB_SPIN(xb_ld(&bar[XB_XGEN(b.x)]) == gen, bar);
            __builtin_amdgcn_fence(__ATOMIC_ACQUIRE, "agent");
            asm volatile("s_waitcnt vmcnt(0)" ::: "memory");
        }
    }
    __syncthreads();
}

typedef const Params __attribute__((address_space(4)))* ParamsK;
__device__ __forceinline__ Params fresh_params() {
    ParamsK q = (ParamsK)__builtin_amdgcn_kernarg_segment_ptr();
    asm volatile("" : "+s"(q));
    Params r;
#pragma unroll
    for (int i = 0; i < 19; ++i) r.in[i] = q->in[i];
    r.out = q->out; r.ws = q->ws;
    return r;
}
constexpr int LDS_TOTAL = pg8::STAGE_BYTES + 256;
__global__ void __launch_bounds__(512, 2) fwd_megakernel(Params p_unused) {
    extern __shared__ __attribute__((aligned(16))) unsigned char lds[];
    cg::grid_group grid = cg::this_grid();
    volatile LAS unsigned* st = (volatile LAS unsigned*)((LAS unsigned char*)lds + pg8::STAGE_BYTES);
    unsigned* bar;
    {
        const Params p = fresh_params(); bar = (unsigned*)(p.ws + WS_BAR);
        if (threadIdx.x < 4) st[threadIdx.x] = 0u;
        if (blockIdx.x == 0) for (int i = threadIdx.x; i < XCD_BAR_WORDS; i += 512) bar[i] = 0u;
        __syncthreads();
    }
#define WSP(off) ((bf16_t*)(p.ws + (off)))
#define GRID_BAR() do { XcdBarrier b_; b_.bar = (unsigned*)(fresh_params().ws + WS_BAR); b_.x = xb_xcc_id(); b_.st = (volatile LAS unsigned*)((LAS unsigned char*)lds + pg8::STAGE_BYTES); xcd_barrier(b_); } while (0)
    for (int l = 0; l < 2; ++l) {
        { const Params p = fresh_params(); prep_phase(p, l, (float*)lds); }
        if (l == 0) { grid.sync(); (void)xcd_barrier_post((unsigned*)(fresh_params().ws + WS_BAR), (volatile LAS unsigned*)((LAS unsigned char*)lds + pg8::STAGE_BYTES)); }
        else GRID_BAR();
        { const Params p = fresh_params(); EpiIn E{WSP(WS_B1), WSP(WS_B2), (const float*)(p.ws + WS_SSQ), (bf16_t*)p.out, WSP(WS_SC), WSP(WS_SCB), p.in[8] + (size_t)l * 3 * 512}; run_gemm(lds, WSP(WS_XB), WSP(WS_WIN), MTOK, NIN, DM, E); }
        GRID_BAR();
        { const Params p = fresh_params(); mixer_phase(p, l, lds); }
        GRID_BAR();
        { const Params p = fresh_params(); EpiBr E{WSP(WS_B2), WSP(WS_B1)}; run_gemm(lds, (const bf16_t*)p.out  , WSP(WS_WBR), MTOK, DM, NBR, E); }
        GRID_BAR();
        { const Params p = fresh_params(); EpiRes E{WSP(WS_XB), (float*)(p.ws + WS_SSQ)}; run_gemm(lds, WSP(WS_B1), WSP(WS_WO), MTOK, DM, DM, E); }
        GRID_BAR();
        { const Params p = fresh_params(); EpiUp E{WSP(WS_B1), WSP(WS_B2), (const float*)(p.ws + WS_SSQ), p.in[15] + (size_t)l * 3 * NUP, p.in[16] + (size_t)l * NUP}; run_gemm(lds, WSP(WS_XB), WSP(WS_WUP), MTOK, NUP, DM, E); }
        GRID_BAR();
        { const Params p = fresh_params(); ffn_fixup_phase(p, l); }
        GRID_BAR();
        { const Params p = fresh_params(); EpiRes E{WSP(WS_XB), (float*)(p.ws + WS_SSQ)}; run_gemm(lds, WSP(WS_B1), WSP(WS_WDN), MTOK, DM, DFF, E); }
        GRID_BAR();
    }
    { const Params p = fresh_params(); final_norm_phase(p); }
#undef WSP
#undef GRID_BAR
}

extern "C" void kernel_launch(void* const* d_in, const int* in_sizes, int n_in, void* d_out, int out_size, void* d_ws, size_t ws_size, hipStream_t stream) {
    constexpr size_t kLds = LDS_TOTAL;
    static int grid_blocks = 0;
    if (!grid_blocks) {
        int dev = 0, cus = 0, per_cu = 0;
        (void)hipGetDevice(&dev);
        (void)hipDeviceGetAttribute(&cus, hipDeviceAttributeMultiprocessorCount, dev);
        (void)hipFuncSetAttribute((const void*)fwd_megakernel, hipFuncAttributeMaxDynamicSharedMemorySize, (int)kLds);
        (void)hipOccupancyMaxActiveBlocksPerMultiprocessor(&per_cu, (const void*)fwd_megakernel, 512, kLds);
        if (per_cu < 1) per_cu = 1;
        grid_blocks = cus;
        if (ws_size < WS_TOTAL || n_in != 19 || out_size != MTOK * DM) { fprintf(stderr, "kernel_launch: unexpected sizes: ws %zu (need %zu), n_in %d, out %d\n", ws_size, (size_t)WS_END, n_in, out_size); }
    }
    Params p{};
    for (int i = 0; i < 19; ++i) p.in[i] = (const float*)d_in[i];
    p.out = (float*)d_out; p.ws = (unsigned char*)d_ws;
    void* args[] = {&p};
    hipError_t e = hipLaunchCooperativeKernel((void*)fwd_megakernel, dim3(grid_blocks), dim3(512), args, kLds, stream);
    if (e != hipSuccess) fprintf(stderr, "cooperative launch failed: %s (grid %d)\n", hipGetErrorString(e), grid_blocks);
}
```

```cpp
#include <hip/hip_runtime.h>
#include <hip/hip_cooperative_groups.h>
#include <cstdio>
namespace cg = cooperative_groups;
namespace pg8 {
#define PG8_LAS __attribute__((address_space(3)))
typedef unsigned short bf16_t;
typedef short bf16x8 __attribute__((ext_vector_type(8)));
typedef float f32x4 __attribute__((ext_vector_type(4)));
typedef unsigned u32x4 __attribute__((ext_vector_type(4)));
constexpr int BM = 256, BK = 64, HALF = 128, HTB = HALF * BK * 2  , STAGE_BYTES = 8 * HTB, NXCD = 8, WGM = 8;

__host__ __device__ __forceinline__ int lds_byte(int r, int c) { const int st = (r >> 4) * 2 + (c >> 5), rr = r & 15, cc = c & 31, ob = rr * 64 + cc * 2; return st * 1024 + (ob ^ (((ob >> 9) & 1) << 5)); }
__host__ __device__ __forceinline__ void stage_rc(int b, int& R, int& C) { const int st = b / 1024, sb = b % 1024, swz = sb ^ (((sb >> 9) & 1) << 5); R = (st >> 1) * 16 + swz / 64; C = (st & 1) * 32 + (swz % 64) / 2; }
__host__ __device__ __forceinline__ int perm32(int rho) { const int n = rho >> 4, i = rho & 15; return 8 * (i >> 2) + 4 * n + (i & 3); }

struct Unit { int pm, pn; };
struct Gemm { const bf16_t* A; const bf16_t* Bt; int M, N, K; };

struct StaticOrder {
    int nM, nN, nwg, G, c;
    __host__ __device__ void init(int M, int N, int G_, int c_) { nM = M / BM; nN = N / BM; nwg = nM * nN; G = G_; c = c_; }
    __host__ __device__ bool next(int i, Unit& u) const {
        const long L = (long)i * G + c; if (L >= nwg) return false;
        int wgid = (int)L; { const int q = nwg / NXCD, r = nwg % NXCD, xcd = wgid % NXCD, off = wgid / NXCD; wgid = (xcd < r ? xcd * (q + 1) : r * (q + 1) + (xcd - r) * q) + off; }
        const int nig = WGM * nN, gid = wgid / nig, fm = gid * WGM, gsz = (nM - fm) < WGM ? (nM - fm) : WGM;
        u.pm = fm + ((wgid % nig) % gsz); u.pn = (wgid % nig) / gsz; return true;
    }
    __device__ __forceinline__ void a_ready(const Unit&) const {}
    __device__ __forceinline__ void done(const Unit&) const {}
};
__device__ __forceinline__ unsigned cvt_pk_bf16(float lo, float hi) { unsigned r; asm volatile("v_cvt_pk_bf16_f32 %0, %1, %2" : "=v"(r) : "v"(lo), "v"(hi)); return r; }

template <class Epi, class Sched, bool STAMP = false>
__device__ __forceinline__ void gemm_phase(PG8_LAS unsigned char* lds, const Gemm g, const Sched& S, const Epi& E, unsigned long long* stamps) {
    int tid_ = threadIdx.x; asm volatile("" : "+v"(tid_));
    const int tid = tid_, wid = __builtin_amdgcn_readfirstlane(tid >> 6), lane = tid & 63, wr = wid >> 2, wc = wid & 3, fr = lane & 15, fq = lane >> 4;
    const int K = g.K, nt = K / BK;
    int ts_lo = 0, ts_hi = 0, nts = 0; const unsigned long long rt_entry = STAMP ? (unsigned long long)wall_clock64() : 0ull;
#define PG8_STAMP() do { if (STAMP && wid == 0 && nts < 64) { const unsigned long long _c = (unsigned long long)clock64(); \
        ts_lo = (lane == nts) ? (int)(unsigned)_c : ts_lo; ts_hi = (lane == nts) ? (int)(unsigned)(_c >> 32) : ts_hi; ++nts; } } while (0)
    PG8_STAMP();
    unsigned voffA[2], voffB[2];
#pragma unroll
    for (int i = 0; i < 2; ++i) { int R, C; stage_rc(tid * 16 + i * 8192, R, C); const int Rb = Epi::PERM ? ((R & ~31) + perm32(R & 31)) : R;
        voffA[i] = (unsigned)(R * K + C) * 2u; voffB[i] = (unsigned)(Rb * K + C) * 2u; }
    const size_t kstep = (size_t)(BK * 2);
    const size_t hstep = (size_t)HALF * K * 2;
    const size_t tstep = 2 * hstep;
    const unsigned ldsw = (unsigned)wid * 1024u;
    const int aoff = lds_byte(wr * 64 + fr, fq * 8), boff = lds_byte(wc * 32 + fr, fq * 8);
#define PG8_SA(b, h) (((b) * 2 + (h)) * HTB)
#define PG8_SB(b, h) ((4 + (b) * 2 + (h)) * HTB)
#define PG8_STAGE(bufoff, gbase, voff) do { _Pragma("unroll") for (int _i = 0; _i < 2; ++_i) \
        __builtin_amdgcn_global_load_lds((const unsigned*)((const char*)(gbase) + (voff)[_i]), (PG8_LAS unsigned*)(lds + (bufoff) + ldsw + _i * 8192), 16, 0, 0); } while (0)
#define PG8_LDA(dst, b, h) do { _Pragma("unroll") for (int m = 0; m < 4; ++m) _Pragma("unroll") for (int k = 0; k < 2; ++k) dst[m][k] = *(const PG8_LAS bf16x8*)(lds + PG8_SA(b, h) + aoff + m * 2048 + k * 1024); } while (0)
#define PG8_LDB(dst, b, h) do { _Pragma("unroll") for (int n = 0; n < 2; ++n) _Pragma("unroll") for (int k = 0; k < 2; ++k) dst[n][k] = *(const PG8_LAS bf16x8*)(lds + PG8_SB(b, h) + boff + n * 2048 + k * 1024); } while (0)
#define PG8_MMA(ai, bj, At, Bt) do { __builtin_amdgcn_s_setprio(1); _Pragma("unroll") for (int m = 0; m < 4; ++m) _Pragma("unroll") for (int n = 0; n < 2; ++n) _Pragma("unroll") for (int k = 0; k < 2; ++k) \
        acc[ai][bj][m][n] = __builtin_amdgcn_mfma_f32_16x16x32_bf16(Bt[n][k], At[m][k], acc[ai][bj][m][n], 0, 0, 0); __builtin_amdgcn_s_setprio(0); } while (0)
#define PG8_WAIT_V(n) asm volatile("s_waitcnt vmcnt(" #n ")" ::: "memory")
#define PG8_WAIT_L(n) asm volatile("s_waitcnt lgkmcnt(" #n ")" ::: "memory")
#define PG8_BAR __builtin_amdgcn_s_barrier()
#define PG8_SCHED __builtin_amdgcn_sched_barrier(0)
    Unit cur, nxt; int ui = 0;
    if (!S.next(0, cur)) return;
    f32x4 acc[2][2][4][2];
#pragma unroll
    for (int a = 0; a < 2; ++a)
#pragma unroll
        for (int b = 0; b < 2; ++b)
#pragma unroll
            for (int m = 0; m < 4; ++m)
#pragma unroll
                for (int n = 0; n < 2; ++n) acc[a][b][m][n] = (f32x4){0.f, 0.f, 0.f, 0.f};
    bf16x8 At[4][2], B0[2][2], B1[2][2];
    const char* cA = (const char*)g.A + (size_t)cur.pm * tstep; const char* cB = (const char*)g.Bt + (size_t)cur.pn * tstep;
    S.a_ready(cur);
    PG8_STAGE(PG8_SB(0, 0), cB, voffB); PG8_STAGE(PG8_SA(0, 0), cA, voffA); PG8_STAGE(PG8_SB(0, 1), cB + hstep, voffB); PG8_STAGE(PG8_SA(0, 1), cA + hstep, voffA);
    if (wr == 1) PG8_BAR;
    PG8_WAIT_V(4); PG8_BAR;
    PG8_STAGE(PG8_SB(1, 0), cB + kstep, voffB); PG8_STAGE(PG8_SA(1, 0), cA + kstep, voffA); PG8_STAGE(PG8_SB(1, 1), cB + hstep + kstep, voffB);
    PG8_WAIT_V(6); PG8_BAR;
    PG8_STAMP();
    for (;;) {
        const bool has_next = S.next(ui + 1, nxt);
        const char* nA = has_next ? (const char*)g.A + (size_t)nxt.pm * tstep : cA; const char* nB = has_next ? (const char*)g.Bt + (size_t)nxt.pn * tstep : cB;
        for (int t = 0; t < nt; t += 2) {
            if constexpr (Epi::MIDK) { if (t == 8 || t == 16) E.mid(acc, cur, t, wr, wc, fr, fq); }
            const bool last = (t == nt - 2);
            const char* a1 = cA + (size_t)(t + 1) * kstep;
            const char* a2 = last ? nA : cA + (size_t)(t + 2) * kstep; const char* b2 = last ? nB : cB + (size_t)(t + 2) * kstep;
            const char* a3 = a2 + kstep; const char* b3 = b2 + kstep;
            if (last && has_next) S.a_ready(nxt);
            PG8_LDB(B0, 0, 0); PG8_SCHED; PG8_LDA(At, 0, 0); PG8_STAGE(PG8_SA(1, 1), a1 + hstep, voffA);
            PG8_WAIT_L(8); PG8_BAR; PG8_WAIT_L(0); PG8_MMA(0, 0, At, B0); PG8_BAR; PG8_SCHED;
            PG8_LDB(B1, 0, 1); PG8_STAGE(PG8_SB(0, 0), b2, voffB);
            PG8_BAR; PG8_WAIT_L(0); PG8_MMA(0, 1, At, B1); PG8_BAR;
            PG8_LDA(At, 0, 1); PG8_STAGE(PG8_SA(0, 0), a2, voffA);
            PG8_BAR; PG8_WAIT_L(0); PG8_MMA(1, 0, At, B0); PG8_BAR; PG8_SCHED;
            PG8_STAGE(PG8_SB(0, 1), b2 + hstep, voffB);
            PG8_WAIT_V(6); PG8_BAR; PG8_MMA(1, 1, At, B1); PG8_BAR;
            PG8_LDB(B0, 1, 0); PG8_SCHED; PG8_LDA(At, 1, 0); PG8_STAGE(PG8_SA(0, 1), a2 + hstep, voffA);
            PG8_WAIT_L(8); PG8_BAR; PG8_WAIT_L(0); PG8_MMA(0, 0, At, B0); PG8_BAR; PG8_SCHED;
            PG8_LDB(B1, 1, 1); PG8_STAGE(PG8_SB(1, 0), b3, voffB);
            PG8_BAR; PG8_WAIT_L(0); PG8_MMA(0, 1, At, B1); PG8_BAR;
            PG8_LDA(At, 1, 1); PG8_STAGE(PG8_SA(1, 0), a3, voffA);
            PG8_BAR; PG8_WAIT_L(0); PG8_MMA(1, 0, At, B0); PG8_BAR; PG8_SCHED;
            PG8_STAGE(PG8_SB(1, 1), b3 + hstep, voffB);
            PG8_WAIT_V(6); PG8_BAR; PG8_MMA(1, 1, At, B1); PG8_BAR;
        }
        PG8_STAMP();
        if constexpr (!Epi::AFTER_DRAIN) { E(acc, cur, wr, wc, fr, fq); S.done(cur); }
        PG8_STAMP();
        if (!has_next) break;
#pragma unroll
        for (int a = 0; a < 2; ++a)
#pragma unroll
            for (int b = 0; b < 2; ++b)
#pragma unroll
                for (int m = 0; m < 4; ++m)
#pragma unroll
                    for (int n = 0; n < 2; ++n) acc[a][b][m][n] = (f32x4){0.f, 0.f, 0.f, 0.f};
        cur = nxt; cA = nA; cB = nB; ++ui;
    }
    PG8_WAIT_V(0);
    if (wr == 0) PG8_BAR;
    PG8_BAR;
    if constexpr (Epi::AFTER_DRAIN) { E.fused(acc, cur, wr, wc, fr, fq, lds, wid, lane); S.done(cur); }
    PG8_STAMP();
    if (STAMP && wid == 0) { stamps[lane] = lane < nts ? (((unsigned long long)(unsigned)ts_hi << 32) | (unsigned)ts_lo) : 0ull;
        if (lane == 62) stamps[62] = rt_entry; if (lane == 63) stamps[63] = (unsigned long long)wall_clock64(); }
#undef PG8_STAMP
#undef PG8_SA
#undef PG8_SB
#undef PG8_STAGE
#undef PG8_LDA
#undef PG8_LDB
#undef PG8_MMA
#undef PG8_WAIT_V
#undef PG8_WAIT_L
#undef PG8_BAR
#undef PG8_SCHED
}
}
typedef pg8::bf16_t bf16_t;
typedef pg8::f32x4 f32x4;
typedef pg8::u32x4 u32x4;
typedef pg8::bf16x8 bf16x8;
typedef unsigned u32x2 __attribute__((ext_vector_type(2)));
#define LAS __attribute__((address_space(3)))
constexpr int MTOK = 65536, DM = 1024, NIN = 6144, DFF = 2816, NUP = 5632, SEQ = 8192, NBR = 1536, NPA = 3072;
constexpr int NPA2 = 1536;
constexpr int MH = MTOK / 2;
constexpr float EPS = 1e-6f;
constexpr size_t WS_WIN = 0;
constexpr size_t WS_WBR = WS_WIN + (size_t)NIN * DM * 2;
constexpr size_t WS_WO = WS_WBR + (size_t)DM * NBR * 2;
constexpr size_t WS_WUP = WS_WO + (size_t)DM * DM * 2;
constexpr size_t WS_WDN = WS_WUP + (size_t)NUP * DM * 2;
constexpr size_t WS_SSQ = WS_WDN + (size_t)DM * DFF * 2;
constexpr size_t WS_XB = WS_SSQ + (size_t)MTOK * 16 * 4;
constexpr size_t WS_B1 = WS_XB + (size_t)MTOK * NBR * 2;
constexpr size_t WS_B2 = WS_B1 + (size_t)MTOK * NPA * 2;
constexpr size_t WS_END = WS_B2 + (size_t)MTOK * NPA * 2;
constexpr size_t WS_BAR = WS_END;
constexpr size_t WS_SC = WS_BAR + 16384;
constexpr size_t WS_SCB = WS_SC + (size_t)(MTOK / 64) * 4 * 512 * 2;
constexpr size_t WS_TOTAL = WS_SCB + (size_t)(MTOK / 64) * 2 * 512 * 2;

__device__ __forceinline__ int otid() { int t = threadIdx.x; asm volatile("" : "+v"(t)); return t; }
__device__ __forceinline__ int obid() { int b = blockIdx.x; asm volatile("" : "+s"(b)); return b; }
struct Params {
    const float* in[19];
    float* out; unsigned char* ws;
};

__device__ __forceinline__ u32x4 ld_nt16(const void* p) { return __builtin_nontemporal_load((const u32x4*)p); }
__device__ __forceinline__ void st_nt16(void* p, u32x4 w) { __builtin_nontemporal_store(w, (u32x4*)p); }
__device__ __forceinline__ float bflo(unsigned w) { return __uint_as_float(w << 16); }
__device__ __forceinline__ float bfhi(unsigned w) { return __uint_as_float(w & 0xffff0000u); }
__device__ __forceinline__ unsigned pk(float a, float b) { return pg8::cvt_pk_bf16(a, b); }
__device__ __forceinline__ float fast_rcp(float x) { return __builtin_amdgcn_rcpf(x); }
__device__ __forceinline__ float gate_t2(float y) { return 1.0f + __builtin_amdgcn_exp2f(fminf(y, 43.28f)); }
__device__ __forceinline__ float gelu_tanh_f(float x) {
    const float z2 = 1.5957691216f * (x + 0.044715f * x * x * x);
    return x * fast_rcp(1.0f + __expf(-z2));
}
__device__ __forceinline__ float silu_f(float x) { return x * fast_rcp(1.0f + __expf(-x)); }
__device__ __forceinline__ float row_rstd(const float* ssq, int r) {
    const f32x4* p = (const f32x4*)(ssq + (size_t)r * 16);
    const f32x4 a = p[0], b = p[1], c = p[2], d = p[3];
    const float s = ((a[0] + a[1]) + (a[2] + a[3])) + ((b[0] + b[1]) + (b[2] + b[3])) + ((c[0] + c[1]) + (c[2] + c[3])) + ((d[0] + d[1]) + (d[2] + d[3]));
    return rsqrtf(s * (1.0f / 1024.0f) + EPS);
}

__device__ __forceinline__ void rows_rstd8(const float* ssq, int row0, int fq, float (&rs)[8]) {
    f32x4 v[8];
#pragma unroll
    for (int i = 0; i < 8; ++i) v[i] = *(const f32x4*)(ssq + (size_t)(row0 + (i >> 2) * 128 + (i & 3) * 16) * 16 + fq * 4);
#pragma unroll
    for (int i = 0; i < 8; ++i) {
        float s = (v[i][0] + v[i][1]) + (v[i][2] + v[i][3]);
        s += __shfl_xor(s, 16); s += __shfl_xor(s, 32);
        rs[i] = rsqrtf(s * (1.0f / 1024.0f) + EPS);
    }
}
__device__ __forceinline__ float dpp_ror1(float x) { return __int_as_float(__builtin_amdgcn_mov_dpp(__float_as_int(x), 0x121, 0xf, 0xf, true)); }
__device__ __forceinline__ float dpp_ror2(float x) { return __int_as_float(__builtin_amdgcn_mov_dpp(__float_as_int(x), 0x122, 0xf, 0xf, true)); }
__device__ __forceinline__ float dpp_shr1(float old, float x) { return __int_as_float(__builtin_amdgcn_update_dpp(__float_as_int(old), __float_as_int(x), 0x111, 0xf, 0xf, false)); }
__device__ __forceinline__ float dpp_shr2(float old, float x) { return __int_as_float(__builtin_amdgcn_update_dpp(__float_as_int(old), __float_as_int(x), 0x112, 0xf, 0xf, false)); }
__device__ __forceinline__ u32x4 widen_pair(u32x2 x, u32x2 y) {
    const auto s0 = __builtin_amdgcn_permlane32_swap(x.x, y.x, false, false);
    const auto s1 = __builtin_amdgcn_permlane32_swap(x.y, y.y, false, false);
    u32x4 w; w.x = s0[0]; w.y = s1[0]; w.z = s0[1]; w.w = s1[1];
    return w;
}
struct EpiIn {
    static constexpr bool PERM = true, AFTER_DRAIN = false, MIDK = false;
    bf16_t* PA; bf16_t* G; const float* ssq; bf16_t* Y; bf16_t* sc; bf16_t* scb; const float* cw;
    __device__ __forceinline__ void operator()(const f32x4 (&acc)[2][2][4][2], const pg8::Unit& u, int wr, int wc, int fr, int fq) const {
        const int row0 = u.pm * 256 + wr * 64 + fr;
        float rs8[8]; rows_rstd8(ssq, row0, fq, rs8);
        if (u.pn >= 16) {
            const int g4 = ((fq & 1) << 1) | (fq >> 1);
            const int q0 = (u.pn - 16) * 64 + wc * 16 + g4 * 4;
            const bool lower = fq < 2; const int qs = lower ? q0 : q0 - 4;
            const f32x4 w0 = *(const f32x4*)(cw + q0), w1 = *(const f32x4*)(cw + 512 + q0), w2 = *(const f32x4*)(cw + 1024 + q0);
#pragma unroll
            for (int ai = 0; ai < 2; ++ai) {
                f32x4 pz = {0.f, 0.f, 0.f, 0.f};
                const int blk = u.pm * 4 + ai * 2 + wr;
#pragma unroll
                for (int m = 0; m < 4; ++m) {
                    const float rs = rs8[ai * 4 + m];
                    const f32x4 cb = acc[ai][0][m][0] * rs, cc = acc[ai][0][m][1] * rs, cx = acc[ai][1][m][0] * rs, av = acc[ai][1][m][1] * rs;
                    const f32x4 z = cc * cx;
                    float y[4];
#pragma unroll
                    for (int j = 0; j < 4; ++j) {
                        const float z1 = dpp_shr1(dpp_ror1(pz[j]), z[j]), z2 = dpp_shr2(dpp_ror2(pz[j]), z[j]);
                        y[j] = cb[j] * fmaf(w0[j], z2, fmaf(w1[j], z1, w2[j] * z[j]));
                        asm volatile("" : "+v"(y[j]));
                    }
                    const int r = row0 + ai * 128 + m * 16;
                    u32x2 w;
                    {
                        u32x2 wa_, wy_; wa_.x = pk(av[0], av[1]); wa_.y = pk(av[2], av[3]); wy_.x = pk(y[0], y[1]); wy_.y = pk(y[2], y[3]);
                        const u32x4 ww = widen_pair(wa_, wy_);
                        bf16_t* dst = lower ? PA + (size_t)r * NPA2 + qs : Y + (size_t)r * NBR + 1024 + qs;
                        if (lower || !(m == 0 && fr < 2)) *(u32x4*)dst = ww;
                    }
                    if (m == 0 && fr < 2) {
                        w.x = pk(z[0], z[1]); w.y = pk(z[2], z[3]); *(u32x2*)(sc + ((size_t)blk * 4 + 2 + fr) * 512 + q0) = w;
                        w.x = pk(cb[0], cb[1]); w.y = pk(cb[2], cb[3]); *(u32x2*)(scb + ((size_t)blk * 2 + fr) * 512 + q0) = w;
                    }
                    if (m == 3 && fr >= 14) { w.x = pk(z[0], z[1]); w.y = pk(z[2], z[3]); *(u32x2*)(sc + ((size_t)blk * 4 + (fr - 14)) * 512 + q0) = w; }
                    pz = z;
                }
            }
        } else {
            const int g4 = ((fq & 1) << 1) | (fq >> 1);
            const int q0 = u.pn * 64 + wc * 16 + g4 * 4;
            const bool lower = fq < 2; const int qs = lower ? q0 : q0 - 4;
#pragma unroll
            for (int ai = 0; ai < 2; ++ai)
#pragma unroll
                for (int m = 0; m < 4; ++m) {
                    const float rs = rs8[ai * 4 + m], rsn = rs * -1.44269504f;
                    const f32x4 ga = acc[ai][0][m][0] * rsn, gb = acc[ai][0][m][1] * rsn, gc = acc[ai][1][m][0] * rsn, uv = acc[ai][1][m][1] * rs;
                    float r1[4], r2[4], s3[4], ug[4];
#pragma unroll
                    for (int j = 0; j < 4; ++j) {
                        const float ta = gate_t2(ga[j]), tb = gate_t2(gb[j]), tc = gate_t2(gc[j]);
                        r1[j] = tb * fast_rcp(ta); r2[j] = tc * fast_rcp(tb); s3[j] = fast_rcp(tc);
                        ug[j] = gelu_tanh_f(uv[j]);
                    }
                    const size_t ro = (size_t)(row0 + ai * 128 + m * 16) * NPA, rp = (size_t)(row0 + ai * 128 + m * 16) * NPA2;
                    u32x2 p1, p2, p3, p4;
                    p1.x = pk(r1[0], r1[1]); p1.y = pk(r1[2], r1[3]); p2.x = pk(r2[0], r2[1]); p2.y = pk(r2[2], r2[3]);
                    p3.x = pk(s3[0], s3[1]); p3.y = pk(s3[2], s3[3]); p4.x = pk(ug[0], ug[1]); p4.y = pk(ug[2], ug[3]);
                    const u32x4 wA = widen_pair(p1, p2), wB = widen_pair(p3, p4);
                    *(u32x4*)(G + ro + (lower ? 0 : 1024) + qs) = wA;
                    *(u32x4*)(lower ? G + ro + 2048 + qs : PA + rp + 512 + qs) = wB;
                }
        }
    }
};
struct EpiBr {
    static constexpr bool PERM = true, AFTER_DRAIN = false, MIDK = true;
    const bf16_t* G; bf16_t* out;
    __device__ __forceinline__ void mid(f32x4 (&acc)[2][2][4][2], const pg8::Unit& u, int t, int wr, int wc, int fr, int fq) const {
        const int seg = (t == 8) ? 0 : 1024;
        int col0 = u.pn * 256 + wc * 32 + 8 * fq + seg;
        int row0 = u.pm * 256 + wr * 64 + fr;
        asm volatile("" : "+v"(col0), "+v"(row0));
#pragma unroll
        for (int ai = 0; ai < 2; ++ai) {
            u32x4 nu[4][2];
#pragma unroll
            for (int m = 0; m < 4; ++m)
#pragma unroll
                for (int bj = 0; bj < 2; ++bj) nu[m][bj] = ld_nt16(G + (size_t)(row0 + ai * 128 + m * 16) * NPA + col0 + bj * 128);
            asm volatile("" ::: "memory");
#pragma unroll
            for (int m = 0; m < 4; ++m)
#pragma unroll
                for (int bj = 0; bj < 2; ++bj) {
                    const unsigned nw[4] = {nu[m][bj].x, nu[m][bj].y, nu[m][bj].z, nu[m][bj].w};
#pragma unroll
                    for (int q = 0; q < 4; ++q) { acc[ai][bj][m][q >> 1][(q & 1) * 2] *= bflo(nw[q]); acc[ai][bj][m][q >> 1][(q & 1) * 2 + 1] *= bfhi(nw[q]); }
                }
            asm volatile("" ::: "memory");
        }
    }
    __device__ __forceinline__ void operator()(const f32x4 (&acc)[2][2][4][2], const pg8::Unit& u, int wr, int wc, int fr, int fq) const {
        const int col0 = u.pn * 256 + wc * 32 + 8 * fq;
        const int row0 = u.pm * 256 + wr * 64 + fr;
        u32x4 sg[2][4][2];
#pragma unroll
        for (int ai = 0; ai < 2; ++ai)
#pragma unroll
            for (int m = 0; m < 4; ++m)
#pragma unroll
                for (int bj = 0; bj < 2; ++bj) sg[ai][m][bj] = ld_nt16(G + (size_t)(row0 + ai * 128 + m * 16) * NPA + 2048 + col0 + bj * 128);
#pragma unroll
        for (int ai = 0; ai < 2; ++ai)
#pragma unroll
            for (int m = 0; m < 4; ++m) {
                const int r = row0 + ai * 128 + m * 16;
                bf16_t* op = out + (size_t)r * DM + col0;
#pragma unroll
                for (int bj = 0; bj < 2; ++bj) {
                    const u32x4 s = sg[ai][m][bj];
                    const f32x4 a0 = acc[ai][bj][m][0], a1 = acc[ai][bj][m][1];
                    u32x4 w;
                    w.x = pk(a0[0] * bflo(s.x), a0[1] * bfhi(s.x)); w.y = pk(a0[2] * bflo(s.y), a0[3] * bfhi(s.y));
                    w.z = pk(a1[0] * bflo(s.z), a1[1] * bfhi(s.z)); w.w = pk(a1[2] * bflo(s.w), a1[3] * bfhi(s.w));
                    *(u32x4*)(op + bj * 128) = w;
                }
            }
    }
};
struct EpiRes {
    static constexpr bool PERM = true, AFTER_DRAIN = false, MIDK = false;
    bf16_t* xb; float* ssq;
    __device__ __forceinline__ void operator()(const f32x4 (&acc)[2][2][4][2], const pg8::Unit& u, int wr, int wc, int fr, int fq) const {
        const int col0 = u.pn * 256 + wc * 32 + 8 * fq;
        const int row0 = u.pm * 256 + wr * 64 + fr;
        u32x4 bb[2][4][2];
#pragma unroll
        for (int ai = 0; ai < 2; ++ai)
#pragma unroll
            for (int m = 0; m < 4; ++m)
#pragma unroll
                for (int bj = 0; bj < 2; ++bj) bb[ai][m][bj] = *(const u32x4*)(xb + (size_t)(row0 + ai * 128 + m * 16) * DM + col0 + bj * 128);
        asm volatile("" ::: "memory");
#pragma unroll
        for (int ai = 0; ai < 2; ++ai) {
#pragma unroll
            for (int m = 0; m < 4; ++m) {
                const int r = row0 + ai * 128 + m * 16;
                float sq = 0.f;
#pragma unroll
                for (int bj = 0; bj < 2; ++bj) {
                    const u32x4 s = bb[ai][m][bj];
                    const f32x4 a0 = acc[ai][bj][m][0], a1 = acc[ai][bj][m][1];
                    const float o0 = bflo(s.x) + a0[0], o1 = bfhi(s.x) + a0[1], o2 = bflo(s.y) + a0[2], o3 = bfhi(s.y) + a0[3];
                    const float o4 = bflo(s.z) + a1[0], o5 = bfhi(s.z) + a1[1], o6 = bflo(s.w) + a1[2], o7 = bfhi(s.w) + a1[3];
                    u32x4 w; w.x = pk(o0, o1); w.y = pk(o2, o3); w.z = pk(o4, o5); w.w = pk(o6, o7);
                    *(u32x4*)(xb + (size_t)r * DM + col0 + bj * 128) = w;
                    sq += (o0 * o0 + o1 * o1) + (o2 * o2 + o3 * o3) + (o4 * o4 + o5 * o5) + (o6 * o6 + o7 * o7);
                }
                sq += __shfl_xor(sq, 16); sq += __shfl_xor(sq, 32);
                if (fq == 0) ssq[(size_t)r * 16 + u.pn * 4 + wc] = sq;
            }
            asm volatile("" ::: "memory");
        }
    }
};
struct EpiUp {
    static constexpr bool PERM = true, AFTER_DRAIN = false, MIDK = false;
    bf16_t* act; bf16_t* zs; const float* ssq; const float* cw; const float* cb;
    __device__ __forceinline__ void operator()(const f32x4 (&acc)[2][2][4][2], const pg8::Unit& u, int wr, int wc, int fr, int fq) const {
        const int c0 = u.pn * 128 + wc * 32 + 8 * fq;
        const int row0 = u.pm * 256 + wr * 64 + fr;
        float rs8[8]; rows_rstd8(ssq, row0, fq, rs8);
        u32x2 keep[2][4];
#pragma unroll
        for (int n = 0; n < 2; ++n) {
            const int c = c0 + 4 * n;
            const f32x4 gw0 = *(const f32x4*)(cw + c), gw1 = *(const f32x4*)(cw + NUP + c), gw2 = *(const f32x4*)(cw + 2 * NUP + c), gb = *(const f32x4*)(cb + c);
            const f32x4 vw0 = *(const f32x4*)(cw + DFF + c), vw1 = *(const f32x4*)(cw + NUP + DFF + c), vw2 = *(const f32x4*)(cw + 2 * NUP + DFF + c), vb = *(const f32x4*)(cb + DFF + c);
#pragma unroll
            for (int ai = 0; ai < 2; ++ai) {
                f32x4 pg = {0.f, 0.f, 0.f, 0.f}, pv = {0.f, 0.f, 0.f, 0.f};
                const int blk = u.pm * 4 + ai * 2 + wr;
#pragma unroll
                for (int m = 0; m < 4; ++m) {
                    const float rs = rs8[ai * 4 + m];
                    const f32x4 zg = acc[ai][0][m][n] * rs, zv = acc[ai][1][m][n] * rs;
                    float o[4];
#pragma unroll
                    for (int j = 0; j < 4; ++j) {
                        const float g1 = dpp_shr1(dpp_ror1(pg[j]), zg[j]), g2 = dpp_shr2(dpp_ror2(pg[j]), zg[j]);
                        const float v1 = dpp_shr1(dpp_ror1(pv[j]), zv[j]), v2 = dpp_shr2(dpp_ror2(pv[j]), zv[j]);
                        const float gg = fmaf(gw0[j], g2, fmaf(gw1[j], g1, fmaf(gw2[j], zg[j], gb[j])));
                        const float vv = fmaf(vw0[j], v2, fmaf(vw1[j], v1, fmaf(vw2[j], zv[j], vb[j])));
                        o[j] = silu_f(gg) * vv;
                    }
                    u32x2 w; w.x = pk(o[0], o[1]); w.y = pk(o[2], o[3]);
                    const int r = row0 + ai * 128 + m * 16;
                    if (n == 0) keep[ai][m] = w;
                    else if (!(m == 0 && fr < 2)) { u32x4 ww; ww.x = keep[ai][m].x; ww.y = keep[ai][m].y; ww.z = w.x; ww.w = w.y; st_nt16(act + (size_t)r * DFF + c0, ww); }
                    if (m == 0 && fr < 2) {
                        bf16_t* zp = zs + ((size_t)blk * 4 + 2 + fr) * NUP + c;
                        u32x2 a; a.x = pk(zg[0], zg[1]); a.y = pk(zg[2], zg[3]); *(u32x2*)zp = a;
                        u32x2 d; d.x = pk(zv[0], zv[1]); d.y = pk(zv[2], zv[3]); *(u32x2*)(zp + DFF) = d;
                    }
                    if (m == 3 && fr >= 14) {
                        bf16_t* zp = zs + ((size_t)blk * 4 + (fr - 14)) * NUP + c;
                        u32x2 a; a.x = pk(zg[0], zg[1]); a.y = pk(zg[2], zg[3]); *(u32x2*)zp = a;
                        u32x2 d; d.x = pk(zv[0], zv[1]); d.y = pk(zv[2], zv[3]); *(u32x2*)(zp + DFF) = d;
                    }
                    pg = zg; pv = zv;
                }
            }
        }
    }
};

__device__ __forceinline__ int win_dest_row(int col) {
    int ch, bj, n, t0;
    if (col < 512) { ch = col; bj = 1; n = 1; t0 = 16; }
    else if (col < 1536) { ch = col - 512; bj = 1; n = 1; t0 = 0; }
    else if (col < 3072) { const int s = (col - 1536) >> 9; ch = (col - 1536) & 511; bj = s >> 1; n = s & 1; t0 = 16; }
    else { const int gi = (col - 3072) >> 10; ch = (col - 3072) & 1023; bj = gi >> 1; n = gi & 1; t0 = 0; }
    const int k = t0 + (ch >> 6), r = ch & 63;
    const int g4 = (r >> 2) & 3, fqh = ((g4 & 1) << 1) | (g4 >> 1);
    return 256 * k + 128 * bj + 32 * (r >> 4) + 8 * fqh + 4 * n + (r & 3);
}
__device__ __forceinline__ void transpose_tile(const float* __restrict__ W, int N, const float* __restrict__ g, bf16_t* __restrict__ Wt, int ldt, int koff, int k0, int n0, int nd0, float* tile, int tid, bool winmap = false) {
    {
        const int kk = tid >> 4, nn = (tid & 15) * 4;
        f32x4 v[2][2]; float s[2];
#pragma unroll
        for (int h = 0; h < 2; ++h) { s[h] = g ? g[k0 + kk + h * 32] : 1.0f;
#pragma unroll
            for (int h2 = 0; h2 < 2; ++h2) v[h2][h] = *(const f32x4*)(W + (size_t)(k0 + kk + h * 32) * N + n0 + h2 * 64 + nn); }
#pragma unroll
        for (int h2 = 0; h2 < 2; ++h2)
#pragma unroll
            for (int h = 0; h < 2; ++h) { float* tp = tile + h2 * (64 * 65) + (kk + h * 32) * 65 + nn;
                tp[0] = v[h2][h][0] * s[h]; tp[1] = v[h2][h][1] * s[h]; tp[2] = v[h2][h][2] * s[h]; tp[3] = v[h2][h][3] * s[h]; }
    }
    __syncthreads();
    {
        const int n = tid >> 3, kq = (tid & 7) * 8;
#pragma unroll
        for (int h2 = 0; h2 < 2; ++h2) {
            float v[8];
#pragma unroll
            for (int j = 0; j < 8; ++j) v[j] = tile[h2 * (64 * 65) + (kq + j) * 65 + n];
            u32x4 w; w.x = pk(v[0], v[1]); w.y = pk(v[2], v[3]); w.z = pk(v[4], v[5]); w.w = pk(v[6], v[7]);
            *(u32x4*)(Wt + (size_t)(winmap ? win_dest_row(n0 + h2 * 64 + n) : nd0 + h2 * 64 + n) * ldt + koff + k0 + kq) = w;
        }
    }
    __syncthreads();
}

__device__ __forceinline__ void prep_phase(const Params& p, int l, float* ldsf) {
    unsigned char* ws = p.ws;
    bf16_t* wt_in = (bf16_t*)(ws + WS_WIN); bf16_t* wt_br = (bf16_t*)(ws + WS_WBR); bf16_t* wt_o = (bf16_t*)(ws + WS_WO);
    bf16_t* wt_up = (bf16_t*)(ws + WS_WUP); bf16_t* wt_dn = (bf16_t*)(ws + WS_WDN);
    const float* g_mix = p.in[1] + (size_t)l * DM; const float* w_in = p.in[2] + (size_t)l * DM * NIN;
    const float* w_pool = p.in[3] + (size_t)l * 4 * 128 * 128; const float* pscale = p.in[4] + (size_t)l * 512;
    const float* w_ba = p.in[9] + (size_t)l * 512 * DM; const float* w_bb = p.in[10] + (size_t)l * 512 * DM; const float* w_bc = p.in[11] + (size_t)l * 512 * DM;
    const float* w_o = p.in[12] + (size_t)l * DM * DM; const float* g_ffn = p.in[13] + (size_t)l * DM;
    const float* w_up = p.in[14] + (size_t)l * DM * NUP; const float* w_dn = p.in[17] + (size_t)l * DFF * DM;
    const int tid = otid(), bid = obid();
    constexpr int T0 = 16 * 48, T1 = T0 + 64, T2 = T1 + 64, T3 = T2 + 128, T4 = T3 + 16 * 44, T5 = T4 + 44 * 8;
    for (int i = bid; i < T5; i += gridDim.x) {
        if (i < T0) { const int kt = i & 15, nt = i >> 4; transpose_tile(w_in, NIN, g_mix, wt_in, DM, 0, kt * 64, nt * 128, nt * 128, ldsf, tid, true); }
        else if (i < T1) { const int j = i - T0, kt = j & 7, nt = j >> 3; transpose_tile(w_bb, DM, nullptr, wt_br, NBR, 512, kt * 64, nt * 128, nt * 128, ldsf, tid); }
        else if (i < T2) { const int j = i - T1, kt = j & 7, nt = j >> 3; transpose_tile(w_bc, DM, nullptr, wt_br, NBR, 1024, kt * 64, nt * 128, nt * 128, ldsf, tid); }
        else if (i < T3) { const int j = i - T2, kt = j & 15, nt = j >> 4; transpose_tile(w_o, DM, nullptr, wt_o, DM, 0, kt * 64, nt * 128, nt * 128, ldsf, tid); }
        else if (i < T4) { const int j = i - T3, kt = j & 15, nt = j >> 4; const int n0 = nt * 128, bj = n0 / DFF, q0 = n0 - bj * DFF; transpose_tile(w_up, NUP, g_ffn, wt_up, DM, 0, kt * 64, n0, (q0 >> 7) * 256 + bj * 128, ldsf, tid);   }
        else { const int j = i - T4, kt = j % 44, nt = j / 44; transpose_tile(w_dn, DM, nullptr, wt_dn, DFF, 0, kt * 64, nt * 128, nt * 128, ldsf, tid); }
    }
    {
        float* wpT = ldsf;
        float* wa = ldsf + 128 * 128;
        for (int it = (int)gridDim.x - 1 - bid; it < 64; it += gridDim.x) {
            const int g = it >> 4, n0 = (it & 15) * 64;
            for (int q = tid; q < 128 * 32; q += 512) {
                const int d = q >> 5, e4 = (q & 31) * 4;
                const f32x4 v = *(const f32x4*)(w_pool + ((size_t)g * 128 + d) * 128 + e4);
                const f32x4 s = *(const f32x4*)(pscale + g * 128 + e4);
                wpT[(e4 + 0) * 128 + d] = v[0] * s[0]; wpT[(e4 + 1) * 128 + d] = v[1] * s[1]; wpT[(e4 + 2) * 128 + d] = v[2] * s[2]; wpT[(e4 + 3) * 128 + d] = v[3] * s[3];
            }
            for (int q = tid; q < 128 * 16; q += 512) {
                const int e = q >> 4, c4 = (q & 15) * 4;
                *(f32x4*)(wa + e * 64 + c4) = *(const f32x4*)(w_ba + (size_t)(g * 128 + e) * DM + n0 + c4);
            }
            __syncthreads();
            const int d = tid & 127, ns = tid >> 7;
            float acc[16];
#pragma unroll
            for (int i = 0; i < 16; ++i) acc[i] = 0.f;
            for (int e = 0; e < 128; ++e) {
                const float w = wpT[e * 128 + d];
                const f32x4* wr4 = (const f32x4*)(wa + e * 64 + ns * 16);
#pragma unroll
                for (int c = 0; c < 4; ++c) { const f32x4 b = wr4[c]; acc[c * 4 + 0] += w * b[0]; acc[c * 4 + 1] += w * b[1]; acc[c * 4 + 2] += w * b[2]; acc[c * 4 + 3] += w * b[3]; }
            }
#pragma unroll
            for (int i = 0; i < 16; ++i) wt_br[(size_t)(n0 + ns * 16 + i) * NBR + g * 128 + d] = (bf16_t)(pk(acc[i], 0.f) & 0xffffu);
            __syncthreads();
        }
    }
    if (l == 0) {
        const float* x = p.in[0]; bf16_t* xb = (bf16_t*)(ws + WS_XB); float* ssq = (float*)(ws + WS_SSQ);
        const int lane = tid & 63, wave = tid >> 6;
        for (int r0 = (bid * 8 + wave) * 2; r0 < MTOK; r0 += gridDim.x * 16) {
            f32x4 v[2][4];
#pragma unroll
            for (int rr = 0; rr < 2; ++rr)
#pragma unroll
                for (int i = 0; i < 4; ++i) v[rr][i] = *(const f32x4*)(x + (size_t)(r0 + rr) * DM + i * 256 + lane * 4);
#pragma unroll
            for (int rr = 0; rr < 2; ++rr) {
                const int r = r0 + rr;
                float sq = 0.f;
#pragma unroll
                for (int i = 0; i < 4; ++i) {
                    const f32x4 t = v[rr][i];
                    sq += (t[0] * t[0] + t[1] * t[1]) + (t[2] * t[2] + t[3] * t[3]);
                    u32x2 w; w.x = pk(t[0], t[1]); w.y = pk(t[2], t[3]);
                    *(u32x2*)(xb + (size_t)r * DM + i * 256 + lane * 4) = w;
                }
#pragma unroll
                for (int o = 32; o >= 1; o >>= 1) sq += __shfl_xor(sq, o);
                if (lane < 16) ssq[(size_t)r * 16 + lane] = (lane == 0) ? sq : 0.f;
            }
        }
    }
}
__device__ __forceinline__ void ld8(const bf16_t* p, float (&v)[8]) {
    const u32x4 w = *(const u32x4*)p;
    v[0] = bflo(w.x); v[1] = bfhi(w.x); v[2] = bflo(w.y); v[3] = bfhi(w.y); v[4] = bflo(w.z); v[5] = bfhi(w.z); v[6] = bflo(w.w); v[7] = bfhi(w.w);
}
__device__ __forceinline__ void st8(bf16_t* p, const float (&v)[8]) {
    u32x4 w; w.x = pk(v[0], v[1]); w.y = pk(v[2], v[3]); w.z = pk(v[4], v[5]); w.w = pk(v[6], v[7]);
    *(u32x4*)p = w;
}
template <int W> __device__ __forceinline__ void pool_rows(const bf16_t* __restrict__ ap, bf16_t* __restrict__ yp, int r0, int pos0) {
#pragma unroll
    for (int b = 0; b < 4; ++b) {
        const int base = r0 + 4 * b;
        u32x4 h[W + 3];
#pragma unroll
        for (int i = 0; i < W + 3; ++i) { const int rr = base - (W - 1) + i; h[i] = (pos0 + rr >= 0) ? *(const u32x4*)(ap + (ptrdiff_t)rr * NPA2) : (u32x4){0u, 0u, 0u, 0u}; }
        float s[8];
#pragma unroll
        for (int j = 0; j < 8; ++j) s[j] = 0.f;
#pragma unroll
        for (int i = 0; i < W - 1; ++i) { const u32x4 q = h[i];
            s[0] += bflo(q.x); s[1] += bfhi(q.x); s[2] += bflo(q.y); s[3] += bfhi(q.y); s[4] += bflo(q.z); s[5] += bfhi(q.z); s[6] += bflo(q.w); s[7] += bfhi(q.w); }
#pragma unroll
        for (int i = 0; i < 4; ++i) {
            const int rr = base + i, pos = pos0 + rr; const float inv = 1.0f / (float)(pos + 1 < W ? pos + 1 : W);
            const u32x4 q = h[W - 1 + i], od = h[i];
            const float v[8] = {bflo(q.x), bfhi(q.x), bflo(q.y), bfhi(q.y), bflo(q.z), bfhi(q.z), bflo(q.w), bfhi(q.w)};
            float o[8];
#pragma unroll
            for (int j = 0; j < 8; ++j) { s[j] += v[j]; o[j] = s[j] * inv - v[j]; }
            st8(yp + (size_t)rr * NBR, o);
            s[0] -= bflo(od.x); s[1] -= bfhi(od.x); s[2] -= bflo(od.y); s[3] -= bfhi(od.y); s[4] -= bflo(od.z); s[5] -= bfhi(od.z); s[6] -= bflo(od.w); s[7] -= bfhi(od.w);
        }
        asm volatile("" ::: "memory");
    }
}
constexpr int VT_PITCH = 136;
__device__ __forceinline__ void mixer_phase(const Params& p, int l, unsigned char* lds) {
    const bf16_t* PA = (const bf16_t*)(p.ws + WS_B1);
    bf16_t* Y = (bf16_t*)p.out;
    const float* g_sgu = p.in[5] + (size_t)l * 512;
    const float* w_sp = p.in[6] + (size_t)l * 4 * 128 * 128;
    const float* b_sp = p.in[7] + (size_t)l * 4 * 128;
    const float* conv_c = p.in[8] + (size_t)l * 3 * 512;
    float* rs = (float*)lds;
    bf16_t* vT = (bf16_t*)(lds + 1024);
    const int tid = otid(), lane = tid & 63, wave = __builtin_amdgcn_readfirstlane(tid >> 6), fr = lane & 15, fq = lane >> 4;
    for (int item = obid(); item < MTOK / 128; item += gridDim.x) {
        const int t0 = item * 128, pos0 = t0 & (SEQ - 1);
        {
            const int row = tid >> 2, q = tid & 3;
            const bf16_t* vp = PA + (size_t)(t0 + row) * NPA2 + 1024 + q * 128;
            float sq = 0.f;
#pragma unroll
            for (int i = 0; i < 16; ++i) { float v[8]; ld8(vp + i * 8, v);
#pragma unroll
                for (int j = 0; j < 8; ++j) sq += v[j] * v[j]; }
            sq += __shfl_xor(sq, 1); sq += __shfl_xor(sq, 2);
            if (q == 0) rs[row] = rsqrtf(sq * (1.0f / 512.0f) + EPS);
        }
        {
            const int grp = wave & 3;
            const int c8 = (grp * 16 + (lane & 15)) * 8; int r0 = ((wave >> 2) * 4 + (lane >> 4)) * 16;
            asm volatile("" : "+v"(r0));
            {
                const bf16_t* ap = PA + (size_t)t0 * NPA2 + c8;
                bf16_t* yp = Y + (size_t)t0 * NBR + c8;
                if (grp == 0) pool_rows<2>(ap, yp, r0, pos0); else if (grp == 1) pool_rows<4>(ap, yp, r0, pos0); else if (grp == 2) pool_rows<8>(ap, yp, r0, pos0); else pool_rows<16>(ap, yp, r0, pos0);
            }
        }
        if (tid < 256) {
            const bf16_t* sc = (const bf16_t*)(p.ws + WS_SC); const bf16_t* scb = (const bf16_t*)(p.ws + WS_SCB);
            const int b_ = tid >> 7, ri = (tid >> 6) & 1, c8 = (tid & 63) * 8;
            const int blk = (t0 >> 6) + b_;
            const bool first = ((blk * 64) & (SEQ - 1)) == 0;
            float z2[8], z1[8], z0[8], cbv[8], o[8];
#pragma unroll
            for (int j = 0; j < 8; ++j) { z2[j] = 0.f; z1[j] = 0.f; }
            const bf16_t* own = sc + (size_t)blk * 4 * 512 + c8;
            if (ri == 0) { if (!first) { ld8(own - 4 * 512, z2); ld8(own - 3 * 512, z1); } ld8(own + 2 * 512, z0); }
            else { if (!first) ld8(own - 3 * 512, z2); ld8(own + 2 * 512, z1); ld8(own + 3 * 512, z0); }
            ld8(scb + ((size_t)blk * 2 + ri) * 512 + c8, cbv);
#pragma unroll
            for (int j = 0; j < 8; ++j) o[j] = 0.f;
            { const f32x4 a0 = *(const f32x4*)(conv_c + c8), a1 = *(const f32x4*)(conv_c + c8 + 4), b0 = *(const f32x4*)(conv_c + 512 + c8), b1 = *(const f32x4*)(conv_c + 512 + c8 + 4), c0 = *(const f32x4*)(conv_c + 1024 + c8), c1 = *(const f32x4*)(conv_c + 1024 + c8 + 4);
#pragma unroll
              for (int j = 0; j < 4; ++j) { o[j] = cbv[j] * fmaf(a0[j], z2[j], fmaf(b0[j], z1[j], c0[j] * z0[j])); o[4 + j] = cbv[4 + j] * fmaf(a1[j], z2[4 + j], fmaf(b1[j], z1[4 + j], c1[j] * z0[4 + j])); } }
            st8(Y + (size_t)(blk * 64 + ri) * NBR + 1024 + c8, o);
        }
#pragma unroll 1
        for (int g = 0; g < 4; ++g) {
            const int t = wave * 16 + fr;
            const int nk = (wave >> 1) + 1;
            f32x4 wq[4][2];
#pragma unroll
            for (int k = 0; k < 4; ++k) { const float* wp = w_sp + ((size_t)g * 128 + t) * 128 + k * 32 + fq * 8; wq[k][0] = *(const f32x4*)wp; wq[k][1] = *(const f32x4*)(wp + 4); }
            const bf16_t* up = PA + (size_t)(t0 + t) * NPA2 + 512 + g * 128 + 4 * fq;
            u32x2 uu[8];
#pragma unroll
            for (int n = 0; n < 8; ++n) uu[n] = *(const u32x2*)(up + n * 16);
            const float bias = b_sp[g * 128 + t];
            u32x4 vq[4];
            const int s_ = tid >> 2, dq = (tid & 3) * 32;
            {
                const bf16_t* vp = PA + (size_t)(t0 + s_) * NPA2 + 1024 + g * 128 + dq;
#pragma unroll
                for (int i = 0; i < 4; ++i) vq[i] = *(const u32x4*)(vp + i * 8);
            }
            __syncthreads();
#pragma unroll
            for (int i = 0; i < 4; ++i) {
                const unsigned ww[4] = {vq[i].x, vq[i].y, vq[i].z, vq[i].w};
#pragma unroll
                for (int q = 0; q < 4; ++q) { vT[(dq + i * 8 + q * 2) * VT_PITCH + s_] = (bf16_t)(ww[q] & 0xffffu); vT[(dq + i * 8 + q * 2 + 1) * VT_PITCH + s_] = (bf16_t)(ww[q] >> 16); }
            }
            __syncthreads();
            f32x4 acc[8];
#pragma unroll
            for (int n = 0; n < 8; ++n) acc[n] = (f32x4){0.f, 0.f, 0.f, 0.f};
#pragma unroll
            for (int k = 0; k < 4; ++k) if (k < nk) {
                const int s0 = k * 32 + fq * 8;
                const f32x4 wa = wq[k][0], wb = wq[k][1];
                const f32x4 ra = *(const f32x4*)(rs + s0), rb = *(const f32x4*)(rs + s0 + 4);
                float a[8];
#pragma unroll
                for (int j = 0; j < 4; ++j) { a[j] = (s0 + j <= t) ? wa[j] * ra[j] : 0.f; a[4 + j] = (s0 + 4 + j <= t) ? wb[j] * rb[j] : 0.f; }
                union { u32x4 u; bf16x8 h; } af; af.u.x = pk(a[0], a[1]); af.u.y = pk(a[2], a[3]); af.u.z = pk(a[4], a[5]); af.u.w = pk(a[6], a[7]);
#pragma unroll
                for (int n = 0; n < 8; ++n) {
                    const bf16x8 bfrag = *(const bf16x8*)(vT + (n * 16 + fr) * VT_PITCH + s0);
                    acc[n] = __builtin_amdgcn_mfma_f32_16x16x32_bf16(bfrag, af.h, acc[n], 0, 0, 0);
                }
            }
            bf16_t* yp = Y + (size_t)(t0 + t) * NBR + 512 + g * 128 + 4 * fq;
#pragma unroll
            for (int n = 0; n < 8; ++n) {
                const f32x4 gs = *(const f32x4*)(g_sgu + g * 128 + n * 16 + 4 * fq);
                const float o0 = bflo(uu[n].x) * (acc[n][0] * gs[0] + bias), o1 = bfhi(uu[n].x) * (acc[n][1] * gs[1] + bias);
                const float o2 = bflo(uu[n].y) * (acc[n][2] * gs[2] + bias), o3 = bfhi(uu[n].y) * (acc[n][3] * gs[3] + bias);
                u32x2 w; w.x = pk(o0, o1); w.y = pk(o2, o3);
                *(u32x2*)(yp + n * 16) = w;
            }
        }
        __syncthreads();
    }
}

__device__ __forceinline__ void ffn_fixup_phase(const Params& p, int l) {
    const bf16_t* zs = (const bf16_t*)(p.ws + WS_B2);
    bf16_t* act = (bf16_t*)(p.ws + WS_B1);
    const float* cw = p.in[15] + (size_t)l * 3 * NUP; const float* cb = p.in[16] + (size_t)l * NUP;
    constexpr int NCG = DFF / 8, NU = (MTOK / 64) * NCG;
    for (int u = obid() * 512 + otid(); u < NU; u += gridDim.x * 512) {
        const int blk = u / NCG, c8 = (u - blk * NCG) * 8;
        const bool first = ((blk * 64) & (SEQ - 1)) == 0;
        float g2[8], g1[8], ga[8], gb2[8], v2[8], v1[8], va[8], vb2[8];
#pragma unroll
        for (int j = 0; j < 8; ++j) { g2[j] = g1[j] = v2[j] = v1[j] = 0.f; }
        const bf16_t* own = zs + (size_t)blk * 4 * NUP + c8;
        if (!first) { const bf16_t* prv = own - 4 * (ptrdiff_t)NUP; ld8(prv, g2); ld8(prv + NUP, g1); ld8(prv + DFF, v2); ld8(prv + NUP + DFF, v1); }
        ld8(own + 2 * NUP, ga); ld8(own + 3 * NUP, gb2); ld8(own + 2 * NUP + DFF, va); ld8(own + 3 * NUP + DFF, vb2);
        float o0[8], o1[8];
        float w0[8], w1[8], w2[8], bb[8], x0[8], x1[8], x2[8], xb_[8];
        { const f32x4* q;
#define LD8F(dst, ptr) q = (const f32x4*)(ptr); { const f32x4 a_ = q[0], b_ = q[1]; dst[0] = a_[0]; dst[1] = a_[1]; dst[2] = a_[2]; dst[3] = a_[3]; dst[4] = b_[0]; dst[5] = b_[1]; dst[6] = b_[2]; dst[7] = b_[3]; }
          LD8F(w0, cw + c8) LD8F(w1, cw + NUP + c8) LD8F(w2, cw + 2 * NUP + c8) LD8F(bb, cb + c8)
          LD8F(x0, cw + DFF + c8) LD8F(x1, cw + NUP + DFF + c8) LD8F(x2, cw + 2 * NUP + DFF + c8) LD8F(xb_, cb + DFF + c8)
#undef LD8F
        }
#pragma unroll
        for (int j = 0; j < 8; ++j) {
            const float gg0 = w0[j] * g2[j] + w1[j] * g1[j] + w2[j] * ga[j] + bb[j], vv0 = x0[j] * v2[j] + x1[j] * v1[j] + x2[j] * va[j] + xb_[j];
            const float gg1 = w0[j] * g1[j] + w1[j] * ga[j] + w2[j] * gb2[j] + bb[j], vv1 = x0[j] * v1[j] + x1[j] * va[j] + x2[j] * vb2[j] + xb_[j];
            o0[j] = silu_f(gg0) * vv0; o1[j] = silu_f(gg1) * vv1;
        }
        st8(act + (size_t)(blk * 64) * DFF + c8, o0); st8(act + (size_t)(blk * 64 + 1) * DFF + c8, o1);
    }
}

__device__ __forceinline__ void final_norm_phase(const Params& p) {
    const float* gf = p.in[18]; const float* ssq = (const float*)(p.ws + WS_SSQ); const bf16_t* xb = (const bf16_t*)(p.ws + WS_XB); float* out = p.out;
    const int tid = otid(), lane = tid & 63, wave = tid >> 6;
    for (int r0 = (obid() * 8 + wave) * 2; r0 < MTOK; r0 += gridDim.x * 16) {
        u32x4 xv[2][2]; float rs[2];
#pragma unroll
        for (int rr = 0; rr < 2; ++rr) {
            rs[rr] = row_rstd(ssq, r0 + rr);
#pragma unroll
            for (int i = 0; i < 2; ++i) xv[rr][i] = *(const u32x4*)(xb + (size_t)(r0 + rr) * DM + i * 512 + lane * 8);
        }
#pragma unroll
        for (int rr = 0; rr < 2; ++rr)
#pragma unroll
            for (int i = 0; i < 2; ++i) {
                const int cc = i * 512 + lane * 8;
                const u32x4 q = xv[rr][i];
                const float v[8] = {bflo(q.x), bfhi(q.x), bflo(q.y), bfhi(q.y), bflo(q.z), bfhi(q.z), bflo(q.w), bfhi(q.w)};
                const f32x4 g0 = *(const f32x4*)(gf + cc), g1 = *(const f32x4*)(gf + cc + 4);
                f32x4 o0, o1;
#pragma unroll
                for (int j = 0; j < 4; ++j) { o0[j] = v[j] * rs[rr] * g0[j]; o1[j] = v[4 + j] * rs[rr] * g1[j]; }
                float* qo = out + (size_t)(r0 + rr) * DM + cc;
                __builtin_nontemporal_store(o0, (f32x4*)qo); __builtin_nontemporal_store(o1, (f32x4*)(qo + 4));
            }
    }
}

template <class Epi> __device__ __forceinline__ void run_gemm(unsigned char* lds, const bf16_t* A, const bf16_t* Bt, int M, int N, int K, const Epi& E, int stagger_step = 0) {
    pg8::Gemm g{A, Bt, M, N, K}; pg8::StaticOrder S; S.init(M, N, (int)gridDim.x, obid());
    if (stagger_step) {
        const unsigned long long t0 = wall_clock64(), d = (unsigned long long)(((obid() >> 3) & 7) * stagger_step);
        while (wall_clock64() - t0 < d) __builtin_amdgcn_s_sleep(16);
    }
    pg8::gemm_phase<Epi, pg8::StaticOrder, false>((PG8_LAS unsigned char*)lds, g, S, E, nullptr);
}

#define XB_TMO      128
#define XB_XCNT(j)  (256  + 64 * (j))
#define XB_XSUB(j)  (1280 + 64 * (j))
#define XB_XGEN(j)  (2304 + 64 * (j))
#define XB_TOP      3328
#define XB_TOPGEN   3392
#define XCD_BAR_WORDS 3456
#define XB_SPIN_CAP (1u << 18)

__device__ __forceinline__ unsigned xb_ld(unsigned* p)              { return __hip_atomic_load(p, __ATOMIC_RELAXED, __HIP_MEMORY_SCOPE_AGENT); }
__device__ __forceinline__ unsigned xb_add(unsigned* p, unsigned v) { return __hip_atomic_fetch_add(p, v, __ATOMIC_RELAXED, __HIP_MEMORY_SCOPE_AGENT); }
__device__ __forceinline__ unsigned xb_xcc_id() { return (unsigned)__builtin_amdgcn_s_getreg((3 << 11) | 20) & 0xFu; }
#define XB_SPIN(cond, bar) do { unsigned _sp = 0; while (cond) { __builtin_amdgcn_s_sleep(1); \
    if ((++_sp & 255u) == 0u) { if (xb_ld(&(bar)[XB_TMO])) break; if (_sp > XB_SPIN_CAP) { atomicAdd(&(bar)[XB_TMO], 1u); break; } } } } while (0)

struct XcdBarrier {
    unsigned* bar; unsigned x;
    volatile LAS unsigned* st;
};

__device__ __forceinline__ XcdBarrier xcd_barrier_post(unsigned* bar, volatile LAS unsigned* st) {
    XcdBarrier b; b.bar = bar; b.x = xb_xcc_id(); b.st = st;
    if (threadIdx.x == 0) (void)xb_add(&bar[XB_XCNT(b.x)], 1u);
    return b;
}
__device__ __forceinline__ void xcd_barrier_complete(unsigned* bar, unsigned x, unsigned& nloc, unsigned& nx) {
    const unsigned G = gridDim.x * gridDim.y * gridDim.z;
    unsigned sum, cnt, mine, sp = 0u;
    for (;;) {
        sum = 0u; cnt = 0u; mine = 0u;
#pragma unroll
        for (unsigned j = 0; j < 16; ++j) { const unsigned c = xb_ld(&bar[XB_XCNT(j)]); sum += c; cnt += (c > 0u) ? 1u : 0u; mine = (j == x) ? c : mine; }
        if (sum == G) break;
        __builtin_amdgcn_s_sleep(1);
        if ((++sp & 255u) == 0u) { if (xb_ld(&bar[XB_TMO])) break; if (sp > XB_SPIN_CAP) { atomicAdd(&bar[XB_TMO], 1u); break; } }
    }
    nloc = mine > 0u ? mine : 1u; nx = cnt > 0u ? cnt : 1u;
}

__device__ __forceinline__ void xcd_barrier(const XcdBarrier& b) {
    asm volatile("s_waitcnt vmcnt(0)" ::: "memory");
    __syncthreads();
    if (threadIdx.x == 0) {
        unsigned* bar = b.bar;
        __builtin_amdgcn_s_waitcnt(0);
        unsigned nloc = b.st[0], nx = b.st[1];
        if (nloc == 0u) { xcd_barrier_complete(bar, b.x, nloc, nx); b.st[0] = nloc; b.st[1] = nx; }
        const unsigned old = xb_add(&bar[XB_XSUB(b.x)], 1u);
        const unsigned gen = old / nloc;
        if (old + 1u == (gen + 1u) * nloc) {
            __builtin_amdgcn_fence(__ATOMIC_RELEASE, "agent");
            asm volatile("s_waitcnt vmcnt(0)" ::: "memory");
            const unsigned og = xb_add(&bar[XB_TOP], 1u);
            const unsigned tg = og / nx;
            if (og + 1u == (tg + 1u) * nx) xb_add(&bar[XB_TOPGEN], 1u);
            else XB_SPIN(xb_ld(&bar[XB_TOPGEN]) == tg, bar);
            __builtin_amdgcn_fence(__ATOMIC_ACQUIRE, "agent");
            xb_add(&bar[XB_XGEN(b.x)], 1u);
            asm volatile("s_waitcnt vmcnt(0)" ::: "memory");
        } else {
            XB_SPIN(xb_ld(&bar[XB_XGEN(b.x)]) == gen, bar);
            __builtin_amdgcn_fence(__ATOMIC_ACQUIRE, "agent");
            asm volatile("s_waitcnt vmcnt(0)" ::: "memory");
        }
    }
    __syncthreads();
}

typedef const Params __attribute__((address_space(4)))* ParamsK;
__device__ __forceinline__ Params fresh_params() {
    ParamsK q = (ParamsK)__builtin_amdgcn_kernarg_segment_ptr();
    asm volatile("" : "+s"(q));
    Params r;
#pragma unroll
    for (int i = 0; i < 19; ++i) r.in[i] = q->in[i];
    r.out = q->out; r.ws = q->ws;
    return r;
}
constexpr int LDS_TOTAL = pg8::STAGE_BYTES + 256;
__global__ void __launch_bounds__(512, 2) fwd_megakernel(Params p_unused) {
    extern __shared__ __attribute__((aligned(16))) unsigned char lds[];
    cg::grid_group grid = cg::this_grid();
    volatile LAS unsigned* st = (volatile LAS unsigned*)((LAS unsigned char*)lds + pg8::STAGE_BYTES);
    unsigned* bar;
    {
        const Params p = fresh_params(); bar = (unsigned*)(p.ws + WS_BAR);
        if (threadIdx.x < 4) st[threadIdx.x] = 0u;
        if (blockIdx.x == 0) for (int i = threadIdx.x; i < XCD_BAR_WORDS; i += 512) bar[i] = 0u;
        __syncthreads();
    }
#define WSP(off) ((bf16_t*)(p.ws + (off)))
#define GRID_BAR() do { XcdBarrier b_; b_.bar = (unsigned*)(fresh_params().ws + WS_BAR); b_.x = xb_xcc_id(); b_.st = (volatile LAS unsigned*)((LAS unsigned char*)lds + pg8::STAGE_BYTES); xcd_barrier(b_); } while (0)
    for (int l = 0; l < 2; ++l) {
        { const Params p = fresh_params(); prep_phase(p, l, (float*)lds); }
        if (l == 0) { grid.sync(); (void)xcd_barrier_post((unsigned*)(fresh_params().ws + WS_BAR), (volatile LAS unsigned*)((LAS unsigned char*)lds + pg8::STAGE_BYTES)); }
        else GRID_BAR();
        { const Params p = fresh_params(); EpiIn E{WSP(WS_B1), WSP(WS_B2), (const float*)(p.ws + WS_SSQ), (bf16_t*)p.out, WSP(WS_SC), WSP(WS_SCB), p.in[8] + (size_t)l * 3 * 512}; run_gemm(lds, WSP(WS_XB), WSP(WS_WIN), MTOK, NIN, DM, E); }
        GRID_BAR();
        { const Params p = fresh_params(); mixer_phase(p, l, lds); }
        GRID_BAR();
        { const Params p = fresh_params(); EpiBr E{WSP(WS_B2), WSP(WS_B1)}; run_gemm(lds, (const bf16_t*)p.out  , WSP(WS_WBR), MTOK, DM, NBR, E); }
        GRID_BAR();
        { const Params p = fresh_params(); EpiRes E{WSP(WS_XB), (float*)(p.ws + WS_SSQ)}; run_gemm(lds, WSP(WS_B1), WSP(WS_WO), MTOK, DM, DM, E); }
        GRID_BAR();
        { const Params p = fresh_params(); EpiUp E{WSP(WS_B1), WSP(WS_B2), (const float*)(p.ws + WS_SSQ), p.in[15] + (size_t)l * 3 * NUP, p.in[16] + (size_t)l * NUP}; run_gemm(lds, WSP(WS_XB), WSP(WS_WUP), MTOK, NUP, DM, E); }
        GRID_BAR();
        { const Params p = fresh_params(); ffn_fixup_phase(p, l); }
        GRID_BAR();
        { const Params p = fresh_params(); EpiRes E{WSP(WS_XB), (float*)(p.ws + WS_SSQ)}; run_gemm(lds, WSP(WS_B1), WSP(WS_WDN), MTOK, DM, DFF, E); }
        GRID_BAR();
    }
    { const Params p = fresh_params(); final_norm_phase(p); }
#undef WSP
#undef GRID_BAR
}

extern "C" void kernel_launch(void* const* d_in, const int* in_sizes, int n_in, void* d_out, int out_size, void* d_ws, size_t ws_size, hipStream_t stream) {
    constexpr size_t kLds = LDS_TOTAL;
    static int grid_blocks = 0;
    if (!grid_blocks) {
        int dev = 0, cus = 0, per_cu = 0;
        (void)hipGetDevice(&dev);
        (void)hipDeviceGetAttribute(&cus, hipDeviceAttributeMultiprocessorCount, dev);
        (void)hipFuncSetAttribute((const void*)fwd_megakernel, hipFuncAttributeMaxDynamicSharedMemorySize, (int)kLds);
        (void)hipOccupancyMaxActiveBlocksPerMultiprocessor(&per_cu, (const void*)fwd_megakernel, 512, kLds);
        if (per_cu < 1) per_cu = 1;
        grid_blocks = cus;
        if (ws_size < WS_TOTAL || n_in != 19 || out_size != MTOK * DM) { fprintf(stderr, "kernel_launch: unexpected sizes: ws %zu (need %zu), n_in %d, out %d\n", ws_size, (size_t)WS_END, n_in, out_size); }
    }
    Params p{};
    for (int i = 0; i < 19; ++i) p.in[i] = (const float*)d_in[i];
    p.out = (float*)d_out; p.ws = (unsigned char*)d_ws;
    void* args[] = {&p};
    hipError_t e = hipLaunchCooperativeKernel((void*)fwd_megakernel, dim3(grid_blocks), dim3(512), args, kLds, stream);
    if (e != hipSuccess) fprintf(stderr, "cooperative launch failed: %s (grid %d)\n", hipGetErrorString(e), grid_blocks);
}
```

```cpp
#include <hip/hip_runtime.h>
#include <hip/hip_cooperative_groups.h>
#include <cstdio>
namespace cg = cooperative_groups;
namespace pg8 {
#define PG8_LAS __attribute__((address_space(3)))
typedef unsigned short bf16_t;
typedef short bf16x8 __attribute__((ext_vector_type(8)));
typedef float f32x4 __attribute__((ext_vector_type(4)));
typedef unsigned u32x4 __attribute__((ext_vector_type(4)));
constexpr int BM = 256, BK = 64, HALF = 128, HTB = HALF * BK * 2  , STAGE_BYTES = 8 * HTB, NXCD = 8, WGM = 8;

__host__ __device__ __forceinline__ int lds_byte(int r, int c) { const int st = (r >> 4) * 2 + (c >> 5), rr = r & 15, cc = c & 31, ob = rr * 64 + cc * 2; return st * 1024 + (ob ^ (((ob >> 9) & 1) << 5)); }
__host__ __device__ __forceinline__ void stage_rc(int b, int& R, int& C) { const int st = b / 1024, sb = b % 1024, swz = sb ^ (((sb >> 9) & 1) << 5); R = (st >> 1) * 16 + swz / 64; C = (st & 1) * 32 + (swz % 64) / 2; }
__host__ __device__ __forceinline__ int perm32(int rho) { const int n = rho >> 4, i = rho & 15; return 8 * (i >> 2) + 4 * n + (i & 3); }

struct Unit { int pm, pn; };
struct Gemm { const bf16_t* A; const bf16_t* Bt; int M, N, K; };

struct StaticOrder {
    int nM, nN, nwg, G, c;
    __host__ __device__ void init(int M, int N, int G_, int c_) { nM = M / BM; nN = N / BM; nwg = nM * nN; G = G_; c = c_; }
    __host__ __device__ bool next(int i, Unit& u) const {
        const long L = (long)i * G + c; if (L >= nwg) return false;
        int wgid = (int)L; { const int q = nwg / NXCD, r = nwg % NXCD, xcd = wgid % NXCD, off = wgid / NXCD; wgid = (xcd < r ? xcd * (q + 1) : r * (q + 1) + (xcd - r) * q) + off; }
        const int nig = WGM * nN, gid = wgid / nig, fm = gid * WGM, gsz = (nM - fm) < WGM ? (nM - fm) : WGM;
        u.pm = fm + ((wgid % nig) % gsz); u.pn = (wgid % nig) / gsz; return true;
    }
    __device__ __forceinline__ void a_ready(const Unit&) const {}
    __device__ __forceinline__ void done(const Unit&) const {}
};
__device__ __forceinline__ unsigned cvt_pk_bf16(float lo, float hi) { unsigned r; asm volatile("v_cvt_pk_bf16_f32 %0, %1, %2" : "=v"(r) : "v"(lo), "v"(hi)); return r; }

template <class Epi, class Sched, bool STAMP = false>
__device__ __forceinline__ void gemm_phase(PG8_LAS unsigned char* lds, const Gemm g, const Sched& S, const Epi& E, unsigned long long* stamps) {
    int tid_ = threadIdx.x; asm volatile("" : "+v"(tid_));
    const int tid = tid_, wid = __builtin_amdgcn_readfirstlane(tid >> 6), lane = tid & 63, wr = wid >> 2, wc = wid & 3, fr = lane & 15, fq = lane >> 4;
    const int K = g.K, nt = K / BK;
    int ts_lo = 0, ts_hi = 0, nts = 0; const unsigned long long rt_entry = STAMP ? (unsigned long long)wall_clock64() : 0ull;
#define PG8_STAMP() do { if (STAMP && wid == 0 && nts < 64) { const unsigned long long _c = (unsigned long long)clock64(); \
        ts_lo = (lane == nts) ? (int)(unsigned)_c : ts_lo; ts_hi = (lane == nts) ? (int)(unsigned)(_c >> 32) : ts_hi; ++nts; } } while (0)
    PG8_STAMP();
    unsigned voffA[2], voffB[2];
#pragma unroll
    for (int i = 0; i < 2; ++i) { int R, C; stage_rc(tid * 16 + i * 8192, R, C); const int Rb = Epi::PERM ? ((R & ~31) + perm32(R & 31)) : R;
        voffA[i] = (unsigned)(R * K + C) * 2u; voffB[i] = (unsigned)(Rb * K + C) * 2u; }
    const size_t kstep = (size_t)(BK * 2);
    const size_t hstep = (size_t)HALF * K * 2;
    const size_t tstep = 2 * hstep;
    const unsigned ldsw = (unsigned)wid * 1024u;
    const int aoff = lds_byte(wr * 64 + fr, fq * 8), boff = lds_byte(wc * 32 + fr, fq * 8);
#define PG8_SA(b, h) (((b) * 2 + (h)) * HTB)
#define PG8_SB(b, h) ((4 + (b) * 2 + (h)) * HTB)
#define PG8_STAGE(bufoff, gbase, voff) do { _Pragma("unroll") for (int _i = 0; _i < 2; ++_i) \
        __builtin_amdgcn_global_load_lds((const unsigned*)((const char*)(gbase) + (voff)[_i]), (PG8_LAS unsigned*)(lds + (bufoff) + ldsw + _i * 8192), 16, 0, 0); } while (0)
#define PG8_LDA(dst, b, h) do { _Pragma("unroll") for (int m = 0; m < 4; ++m) _Pragma("unroll") for (int k = 0; k < 2; ++k) dst[m][k] = *(const PG8_LAS bf16x8*)(lds + PG8_SA(b, h) + aoff + m * 2048 + k * 1024); } while (0)
#define PG8_LDB(dst, b, h) do { _Pragma("unroll") for (int n = 0; n < 2; ++n) _Pragma("unroll") for (int k = 0; k < 2; ++k) dst[n][k] = *(const PG8_LAS bf16x8*)(lds + PG8_SB(b, h) + boff + n * 2048 + k * 1024); } while (0)
#define PG8_MMA(ai, bj, At, Bt) do { __builtin_amdgcn_s_setprio(1); _Pragma("unroll") for (int m = 0; m < 4; ++m) _Pragma("unroll") for (int n = 0; n < 2; ++n) _Pragma("unroll") for (int k = 0; k < 2; ++k) \
        acc[ai][bj][m][n] = __builtin_amdgcn_mfma_f32_16x16x32_bf16(Bt[n][k], At[m][k], acc[ai][bj][m][n], 0, 0, 0); __builtin_amdgcn_s_setprio(0); } while (0)
#define PG8_WAIT_V(n) asm volatile("s_waitcnt vmcnt(" #n ")" ::: "memory")
#define PG8_WAIT_L(n) asm volatile("s_waitcnt lgkmcnt(" #n ")" ::: "memory")
#define PG8_BAR __builtin_amdgcn_s_barrier()
#define PG8_SCHED __builtin_amdgcn_sched_barrier(0)
    Unit cur, nxt; int ui = 0;
    if (!S.next(0, cur)) return;
    f32x4 acc[2][2][4][2];
#pragma unroll
    for (int a = 0; a < 2; ++a)
#pragma unroll
        for (int b = 0; b < 2; ++b)
#pragma unroll
            for (int m = 0; m < 4; ++m)
#pragma unroll
                for (int n = 0; n < 2; ++n) acc[a][b][m][n] = (f32x4){0.f, 0.f, 0.f, 0.f};
    bf16x8 At[4][2], B0[2][2], B1[2][2];
    const char* cA = (const char*)g.A + (size_t)cur.pm * tstep; const char* cB = (const char*)g.Bt + (size_t)cur.pn * tstep;
    S.a_ready(cur);
    PG8_STAGE(PG8_SB(0, 0), cB, voffB); PG8_STAGE(PG8_SA(0, 0), cA, voffA); PG8_STAGE(PG8_SB(0, 1), cB + hstep, voffB); PG8_STAGE(PG8_SA(0, 1), cA + hstep, voffA);
    if (wr == 1) PG8_BAR;
    PG8_WAIT_V(4); PG8_BAR;
    PG8_STAGE(PG8_SB(1, 0), cB + kstep, voffB); PG8_STAGE(PG8_SA(1, 0), cA + kstep, voffA); PG8_STAGE(PG8_SB(1, 1), cB + hstep + kstep, voffB);
    PG8_WAIT_V(6); PG8_BAR;
    PG8_STAMP();
    for (;;) {
        const bool has_next = S.next(ui + 1, nxt);
        const char* nA = has_next ? (const char*)g.A + (size_t)nxt.pm * tstep : cA; const char* nB = has_next ? (const char*)g.Bt + (size_t)nxt.pn * tstep : cB;
        for (int t = 0; t < nt; t += 2) {
            if constexpr (Epi::MIDK) { if (t == 8 || t == 16) E.mid(acc, cur, t, wr, wc, fr, fq); }
            const bool last = (t == nt - 2);
            const char* a1 = cA + (size_t)(t + 1) * kstep;
            const char* a2 = last ? nA : cA + (size_t)(t + 2) * kstep; const char* b2 = last ? nB : cB + (size_t)(t + 2) * kstep;
            const char* a3 = a2 + kstep; const char* b3 = b2 + kstep;
            if (last && has_next) S.a_ready(nxt);
            PG8_LDB(B0, 0, 0); PG8_SCHED; PG8_LDA(At, 0, 0); PG8_STAGE(PG8_SA(1, 1), a1 + hstep, voffA);
            PG8_WAIT_L(8); PG8_BAR; PG8_WAIT_L(0); PG8_MMA(0, 0, At, B0); PG8_BAR; PG8_SCHED;
            PG8_LDB(B1, 0, 1); PG8_STAGE(PG8_SB(0, 0), b2, voffB);
            PG8_BAR; PG8_WAIT_L(0); PG8_MMA(0, 1, At, B1); PG8_BAR;
            PG8_LDA(At, 0, 1); PG8_STAGE(PG8_SA(0, 0), a2, voffA);
            PG8_BAR; PG8_WAIT_L(0); PG8_MMA(1, 0, At, B0); PG8_BAR; PG8_SCHED;
            PG8_STAGE(PG8_SB(0, 1), b2 + hstep, voffB);
            PG8_WAIT_V(6); PG8_BAR; PG8_MMA(1, 1, At, B1); PG8_BAR;
            PG8_LDB(B0, 1, 0); PG8_SCHED; PG8_LDA(At, 1, 0); PG8_STAGE(PG8_SA(0, 1), a2 + hstep, voffA);
            PG8_WAIT_L(8); PG8_BAR; PG8_WAIT_L(0); PG8_MMA(0, 0, At, B0); PG8_BAR; PG8_SCHED;
            PG8_LDB(B1, 1, 1); PG8_STAGE(PG8_SB(1, 0), b3, voffB);
            PG8_BAR; PG8_WAIT_L(0); PG8_MMA(0, 1, At, B1); PG8_BAR;
            PG8_LDA(At, 1, 1); PG8_STAGE(PG8_SA(1, 0), a3, voffA);
            PG8_BAR; PG8_WAIT_L(0); PG8_MMA(1, 0, At, B0); PG8_BAR; PG8_SCHED;
            PG8_STAGE(PG8_SB(1, 1), b3 + hstep, voffB);
            PG8_WAIT_V(6); PG8_BAR; PG8_MMA(1, 1, At, B1); PG8_BAR;
        }
        PG8_STAMP();
        if constexpr (!Epi::AFTER_DRAIN) { E(acc, cur, wr, wc, fr, fq); S.done(cur); }
        PG8_STAMP();
        if (!has_next) break;
#pragma unroll
        for (int a = 0; a < 2; ++a)
#pragma unroll
            for (int b = 0; b < 2; ++b)
#pragma unroll
                for (int m = 0; m < 4; ++m)
#pragma unroll
                    for (int n = 0; n < 2; ++n) acc[a][b][m][n] = (f32x4){0.f, 0.f, 0.f, 0.f};
        cur = nxt; cA = nA; cB = nB; ++ui;
    }
    PG8_WAIT_V(0);
    if (wr == 0) PG8_BAR;
    PG8_BAR;
    if constexpr (Epi::AFTER_DRAIN) { E.fused(acc, cur, wr, wc, fr, fq, lds, wid, lane); S.done(cur); }
    PG8_STAMP();
    if (STAMP && wid == 0) { stamps[lane] = lane < nts ? (((unsigned long long)(unsigned)ts_hi << 32) | (unsigned)ts_lo) : 0ull;
        if (lane == 62) stamps[62] = rt_entry; if (lane == 63) stamps[63] = (unsigned long long)wall_clock64(); }
#undef PG8_STAMP
#undef PG8_SA
#undef PG8_SB
#undef PG8_STAGE
#undef PG8_LDA
#undef PG8_LDB
#undef PG8_MMA
#undef PG8_WAIT_V
#undef PG8_WAIT_L
#undef PG8_BAR
#undef PG8_SCHED
}
}
typedef pg8::bf16_t bf16_t;
typedef pg8::f32x4 f32x4;
typedef pg8::u32x4 u32x4;
typedef pg8::bf16x8 bf16x8;
typedef unsigned u32x2 __attribute__((ext_vector_type(2)));
#define LAS __attribute__((address_space(3)))
constexpr int MTOK = 65536, DM = 1024, NIN = 6144, DFF = 2816, NUP = 5632, SEQ = 8192, NBR = 1536, NPA = 3072;
constexpr int NPA2 = 1536;
constexpr int MH = MTOK / 2;
constexpr float EPS = 1e-6f;
constexpr size_t WS_WIN = 0;
constexpr size_t WS_WBR = WS_WIN + (size_t)NIN * DM * 2;
constexpr size_t WS_WO = WS_WBR + (size_t)DM * NBR * 2;
constexpr size_t WS_WUP = WS_WO + (size_t)DM * DM * 2;
constexpr size_t WS_WDN = WS_WUP + (size_t)NUP * DM * 2;
constexpr size_t WS_SSQ = WS_WDN + (size_t)DM * DFF * 2;
constexpr size_t WS_XB = WS_SSQ + (size_t)MTOK * 16 * 4;
constexpr size_t WS_B1 = WS_XB + (size_t)MTOK * NBR * 2;
constexpr size_t WS_B2 = WS_B1 + (size_t)MTOK * NPA * 2;
constexpr size_t WS_END = WS_B2 + (size_t)MTOK * NPA * 2;
constexpr size_t WS_BAR = WS_END;
constexpr size_t WS_SC = WS_BAR + 16384;
constexpr size_t WS_SCB = WS_SC + (size_t)(MTOK / 64) * 4 * 512 * 2;
constexpr size_t WS_RSTD = WS_SCB + (size_t)(MTOK / 64) * 2 * 512 * 2;
constexpr size_t WS_TOTAL = WS_RSTD + (size_t)MTOK * 4;

__device__ __forceinline__ int otid() { int t = threadIdx.x; asm volatile("" : "+v"(t)); return t; }
__device__ __forceinline__ int obid() { int b = blockIdx.x; asm volatile("" : "+s"(b)); return b; }
struct Params {
    const float* in[19];
    float* out; unsigned char* ws;
};

__device__ __forceinline__ u32x4 ld_nt16(const void* p) { return __builtin_nontemporal_load((const u32x4*)p); }
__device__ __forceinline__ void st_nt16(void* p, u32x4 w) { __builtin_nontemporal_store(w, (u32x4*)p); }
__device__ __forceinline__ float bflo(unsigned w) { return __uint_as_float(w << 16); }
__device__ __forceinline__ float bfhi(unsigned w) { return __uint_as_float(w & 0xffff0000u); }
__device__ __forceinline__ unsigned pk(float a, float b) { return pg8::cvt_pk_bf16(a, b); }
__device__ __forceinline__ float fast_rcp(float x) { return __builtin_amdgcn_rcpf(x); }
__device__ __forceinline__ float gate_t2(float y) { return 1.0f + __builtin_amdgcn_exp2f(fminf(y, 43.28f)); }
__device__ __forceinline__ float gelu_tanh_f(float x) {
    const float z2 = 1.5957691216f * (x + 0.044715f * x * x * x);
    return x * fast_rcp(1.0f + __expf(-z2));
}
__device__ __forceinline__ float silu_f(float x) { return x * fast_rcp(1.0f + __expf(-x)); }
__device__ __forceinline__ float row_rstd(const float* ssq, int r) {
    float s = 0.f;
#pragma unroll
    for (int k = 0; k < 16; ++k) s += ssq[(size_t)k * MTOK + r];
    return rsqrtf(s * (1.0f / 1024.0f) + EPS);
}
__device__ __forceinline__ void rows_rstd8(const float* ssq, int row0, int fq, float (&rs)[8]) {
    f32x4 v[8];
#pragma unroll
    for (int i = 0; i < 8; ++i) v[i] = *(const f32x4*)(ssq + (size_t)(row0 + (i >> 2) * 128 + (i & 3) * 16) * 16 + fq * 4);
#pragma unroll
    for (int i = 0; i < 8; ++i) {
        float s = (v[i][0] + v[i][1]) + (v[i][2] + v[i][3]);
        s += __shfl_xor(s, 16); s += __shfl_xor(s, 32);
        rs[i] = rsqrtf(s * (1.0f / 1024.0f) + EPS);
    }
}
__device__ __forceinline__ float dpp_ror1(float x) { return __int_as_float(__builtin_amdgcn_mov_dpp(__float_as_int(x), 0x121, 0xf, 0xf, true)); }
__device__ __forceinline__ float dpp_ror2(float x) { return __int_as_float(__builtin_amdgcn_mov_dpp(__float_as_int(x), 0x122, 0xf, 0xf, true)); }
__device__ __forceinline__ float dpp_shr1(float old, float x) { return __int_as_float(__builtin_amdgcn_update_dpp(__float_as_int(old), __float_as_int(x), 0x111, 0xf, 0xf, false)); }
__device__ __forceinline__ float dpp_shr2(float old, float x) { return __int_as_float(__builtin_amdgcn_update_dpp(__float_as_int(old), __float_as_int(x), 0x112, 0xf, 0xf, false)); }
__device__ __forceinline__ u32x4 widen_pair(u32x2 x, u32x2 y) {
    const auto s0 = __builtin_amdgcn_permlane32_swap(x.x, y.x, false, false);
    const auto s1 = __builtin_amdgcn_permlane32_swap(x.y, y.y, false, false);
    u32x4 w; w.x = s0[0]; w.y = s1[0]; w.z = s0[1]; w.w = s1[1];
    return w;
}
__device__ __forceinline__ size_t gidx(int a, int r, int ch) {
    return (size_t)a * ((size_t)MTOK * 1024) + ((((size_t)(r >> 4) * 64 + (ch >> 4)) * 16 + (r & 15)) * 16 + (ch & 15));
}
struct EpiIn {
    static constexpr bool PERM = true, AFTER_DRAIN = false, MIDK = false;
    bf16_t* PA; bf16_t* G; const float* ssq; bf16_t* Y; bf16_t* sc; bf16_t* scb; const float* cw;
    __device__ __forceinline__ void operator()(const f32x4 (&acc)[2][2][4][2], const pg8::Unit& u, int wr, int wc, int fr, int fq) const {
        const int row0 = u.pm * 256 + wr * 64 + fr;
        float rs8[8];
#pragma unroll
        for (int i = 0; i < 8; ++i) rs8[i] = ssq[row0 + (i >> 2) * 128 + (i & 3) * 16];
        if (u.pn >= 16) {
            const int g4 = ((fq & 1) << 1) | (fq >> 1);
            const int q0 = (u.pn - 16) * 64 + wc * 16 + g4 * 4;
            const bool lower = fq < 2; const int qs = lower ? q0 : q0 - 4;
            const f32x4 w0 = *(const f32x4*)(cw + q0), w1 = *(const f32x4*)(cw + 512 + q0), w2 = *(const f32x4*)(cw + 1024 + q0);
#pragma unroll
            for (int ai = 0; ai < 2; ++ai) {
                f32x4 pz = {0.f, 0.f, 0.f, 0.f};
                const int blk = u.pm * 4 + ai * 2 + wr;
#pragma unroll
                for (int m = 0; m < 4; ++m) {
                    const float rs = rs8[ai * 4 + m];
                    const f32x4 cb = acc[ai][0][m][0] * rs, cc = acc[ai][0][m][1] * rs, cx = acc[ai][1][m][0] * rs, av = acc[ai][1][m][1] * rs;
                    const f32x4 z = cc * cx;
                    float y[4];
#pragma unroll
                    for (int j = 0; j < 4; ++j) {
                        const float z1 = dpp_shr1(dpp_ror1(pz[j]), z[j]), z2 = dpp_shr2(dpp_ror2(pz[j]), z[j]);
                        y[j] = cb[j] * fmaf(w0[j], z2, fmaf(w1[j], z1, w2[j] * z[j]));
                        asm volatile("" : "+v"(y[j]));
                    }
                    const int r = row0 + ai * 128 + m * 16;
                    u32x2 w;
                    {
                        u32x2 wa_, wy_; wa_.x = pk(av[0], av[1]); wa_.y = pk(av[2], av[3]); wy_.x = pk(y[0], y[1]); wy_.y = pk(y[2], y[3]);
                        const u32x4 ww = widen_pair(wa_, wy_);
                        bf16_t* dst = lower ? PA + (size_t)r * NPA2 + qs : Y + (size_t)r * NBR + 1024 + qs;
                        if (lower || !(m == 0 && fr < 2)) *(u32x4*)dst = ww;
                    }
                    if (m == 0 && fr < 2) {
                        w.x = pk(z[0], z[1]); w.y = pk(z[2], z[3]); *(u32x2*)(sc + ((size_t)blk * 4 + 2 + fr) * 512 + q0) = w;
                        w.x = pk(cb[0], cb[1]); w.y = pk(cb[2], cb[3]); *(u32x2*)(scb + ((size_t)blk * 2 + fr) * 512 + q0) = w;
                    }
                    if (m == 3 && fr >= 14) { w.x = pk(z[0], z[1]); w.y = pk(z[2], z[3]); *(u32x2*)(sc + ((size_t)blk * 4 + (fr - 14)) * 512 + q0) = w; }
                    pz = z;
                }
            }
        } else {
            const int g4 = ((fq & 1) << 1) | (fq >> 1);
            const int q0 = u.pn * 64 + wc * 16 + g4 * 4;
            const bool lower = fq < 2; const int qs = lower ? q0 : q0 - 4;
#pragma unroll
            for (int ai = 0; ai < 2; ++ai)
#pragma unroll
                for (int m = 0; m < 4; ++m) {
                    const float rs = rs8[ai * 4 + m], rsn = rs * -1.44269504f;
                    const f32x4 ga = acc[ai][0][m][0] * rsn, gb = acc[ai][0][m][1] * rsn, gc = acc[ai][1][m][0] * rsn, uv = acc[ai][1][m][1] * rs;
                    float r1[4], r2[4], s3[4], ug[4];
#pragma unroll
                    for (int j = 0; j < 4; ++j) {
                        const float ta = gate_t2(ga[j]), tb = gate_t2(gb[j]), tc = gate_t2(gc[j]);
                        r1[j] = tb * fast_rcp(ta); r2[j] = tc * fast_rcp(tb); s3[j] = fast_rcp(tc);
                        ug[j] = gelu_tanh_f(uv[j]);
                    }
                    const size_t ro = (size_t)(row0 + ai * 128 + m * 16) * NPA, rp = (size_t)(row0 + ai * 128 + m * 16) * NPA2;
                    u32x2 p1, p2, p3, p4;
                    p1.x = pk(r1[0], r1[1]); p1.y = pk(r1[2], r1[3]); p2.x = pk(r2[0], r2[1]); p2.y = pk(r2[2], r2[3]);
                    p3.x = pk(s3[0], s3[1]); p3.y = pk(s3[2], s3[3]); p4.x = pk(ug[0], ug[1]); p4.y = pk(ug[2], ug[3]);
                    const u32x4 wA = widen_pair(p1, p2), wB = widen_pair(p3, p4);
                    const int rr_ = row0 + ai * 128 + m * 16;
                    *(u32x4*)(G + gidx(lower ? 0 : 1, rr_, qs)) = wA;
                    *(u32x4*)(lower ? G + gidx(2, rr_, qs) : PA + rp + 512 + qs) = wB;
                }
        }
    }
};
struct EpiBr {
    static constexpr bool PERM = true, AFTER_DRAIN = false, MIDK = true;
    const bf16_t* G; bf16_t* out;
    __device__ __forceinline__ void mid(f32x4 (&acc)[2][2][4][2], const pg8::Unit& u, int t, int wr, int wc, int fr, int fq) const {
        const int seg = (t == 8) ? 0 : 1;
        int col0 = u.pn * 256 + wc * 32 + 8 * fq;
        int row0 = u.pm * 256 + wr * 64 + fr;
        asm volatile("" : "+v"(col0), "+v"(row0));
#pragma unroll
        for (int ai = 0; ai < 2; ++ai) {
            u32x4 nu[4][2];
#pragma unroll
            for (int m = 0; m < 4; ++m)
#pragma unroll
                for (int bj = 0; bj < 2; ++bj) nu[m][bj] = ld_nt16(G + gidx(seg, row0 + ai * 128 + m * 16, col0 + bj * 128));
            asm volatile("" ::: "memory");
#pragma unroll
            for (int m = 0; m < 4; ++m)
#pragma unroll
                for (int bj = 0; bj < 2; ++bj) {
                    const unsigned nw[4] = {nu[m][bj].x, nu[m][bj].y, nu[m][bj].z, nu[m][bj].w};
#pragma unroll
                    for (int q = 0; q < 4; ++q) { acc[ai][bj][m][q >> 1][(q & 1) * 2] *= bflo(nw[q]); acc[ai][bj][m][q >> 1][(q & 1) * 2 + 1] *= bfhi(nw[q]); }
                }
            asm volatile("" ::: "memory");
        }
    }
    __device__ __forceinline__ void operator()(const f32x4 (&acc)[2][2][4][2], const pg8::Unit& u, int wr, int wc, int fr, int fq) const {
        const int col0 = u.pn * 256 + wc * 32 + 8 * fq;
        const int row0 = u.pm * 256 + wr * 64 + fr;
        u32x4 sg[2][4][2];
#pragma unroll
        for (int ai = 0; ai < 2; ++ai)
#pragma unroll
            for (int m = 0; m < 4; ++m)
#pragma unroll
                for (int bj = 0; bj < 2; ++bj) sg[ai][m][bj] = ld_nt16(G + gidx(2, row0 + ai * 128 + m * 16, col0 + bj * 128));
#pragma unroll
        for (int ai = 0; ai < 2; ++ai)
#pragma unroll
            for (int m = 0; m < 4; ++m) {
                const int r = row0 + ai * 128 + m * 16;
                bf16_t* op = out + (size_t)r * DM + col0;
#pragma unroll
                for (int bj = 0; bj < 2; ++bj) {
                    const u32x4 s = sg[ai][m][bj];
                    const f32x4 a0 = acc[ai][bj][m][0], a1 = acc[ai][bj][m][1];
                    u32x4 w;
                    w.x = pk(a0[0] * bflo(s.x), a0[1] * bfhi(s.x)); w.y = pk(a0[2] * bflo(s.y), a0[3] * bfhi(s.y));
                    w.z = pk(a1[0] * bflo(s.z), a1[1] * bfhi(s.z)); w.w = pk(a1[2] * bflo(s.w), a1[3] * bfhi(s.w));
                    *(u32x4*)(op + bj * 128) = w;
                }
            }
    }
};
struct EpiRes {
    static constexpr bool PERM = true, AFTER_DRAIN = false, MIDK = false;
    bf16_t* xb; float* ssq;
    __device__ __forceinline__ void operator()(const f32x4 (&acc)[2][2][4][2], const pg8::Unit& u, int wr, int wc, int fr, int fq) const {
        const int col0 = u.pn * 256 + wc * 32 + 8 * fq;
        const int row0 = u.pm * 256 + wr * 64 + fr;
        u32x4 bb[2][4][2];
#pragma unroll
        for (int ai = 0; ai < 2; ++ai)
#pragma unroll
            for (int m = 0; m < 4; ++m)
#pragma unroll
                for (int bj = 0; bj < 2; ++bj) bb[ai][m][bj] = *(const u32x4*)(xb + (size_t)(row0 + ai * 128 + m * 16) * DM + col0 + bj * 128);
        asm volatile("" ::: "memory");
#pragma unroll
        for (int ai = 0; ai < 2; ++ai) {
#pragma unroll
            for (int m = 0; m < 4; ++m) {
                const int r = row0 + ai * 128 + m * 16;
                float sq = 0.f;
#pragma unroll
                for (int bj = 0; bj < 2; ++bj) {
                    const u32x4 s = bb[ai][m][bj];
                    const f32x4 a0 = acc[ai][bj][m][0], a1 = acc[ai][bj][m][1];
                    const float o0 = bflo(s.x) + a0[0], o1 = bfhi(s.x) + a0[1], o2 = bflo(s.y) + a0[2], o3 = bfhi(s.y) + a0[3];
                    const float o4 = bflo(s.z) + a1[0], o5 = bfhi(s.z) + a1[1], o6 = bflo(s.w) + a1[2], o7 = bfhi(s.w) + a1[3];
                    u32x4 w; w.x = pk(o0, o1); w.y = pk(o2, o3); w.z = pk(o4, o5); w.w = pk(o6, o7);
                    *(u32x4*)(xb + (size_t)r * DM + col0 + bj * 128) = w;
                    sq += (o0 * o0 + o1 * o1) + (o2 * o2 + o3 * o3) + (o4 * o4 + o5 * o5) + (o6 * o6 + o7 * o7);
                }
                sq += __shfl_xor(sq, 16); sq += __shfl_xor(sq, 32);
                if (fq == 0) ssq[(size_t)(u.pn * 4 + wc) * MTOK + r] = sq;
            }
            asm volatile("" ::: "memory");
        }
    }
};
struct EpiUp {
    static constexpr bool PERM = true, AFTER_DRAIN = false, MIDK = false;
    bf16_t* act; bf16_t* zs; const float* ssq; const float* cw; const float* cb;
    __device__ __forceinline__ void operator()(const f32x4 (&acc)[2][2][4][2], const pg8::Unit& u, int wr, int wc, int fr, int fq) const {
        const int c0 = u.pn * 128 + wc * 32 + 8 * fq;
        const int row0 = u.pm * 256 + wr * 64 + fr;
        float rs8[8];
#pragma unroll
        for (int i = 0; i < 8; ++i) rs8[i] = ssq[row0 + (i >> 2) * 128 + (i & 3) * 16];
        u32x2 keep[2][4];
#pragma unroll
        for (int n = 0; n < 2; ++n) {
            const int c = c0 + 4 * n;
            const f32x4 gw0 = *(const f32x4*)(cw + c), gw1 = *(const f32x4*)(cw + NUP + c), gw2 = *(const f32x4*)(cw + 2 * NUP + c), gb = *(const f32x4*)(cb + c);
            const f32x4 vw0 = *(const f32x4*)(cw + DFF + c), vw1 = *(const f32x4*)(cw + NUP + DFF + c), vw2 = *(const f32x4*)(cw + 2 * NUP + DFF + c), vb = *(const f32x4*)(cb + DFF + c);
#pragma unroll
            for (int ai = 0; ai < 2; ++ai) {
                f32x4 pg = {0.f, 0.f, 0.f, 0.f}, pv = {0.f, 0.f, 0.f, 0.f};
                const int blk = u.pm * 4 + ai * 2 + wr;
#pragma unroll
                for (int m = 0; m < 4; ++m) {
                    const float rs = rs8[ai * 4 + m];
                    const f32x4 zg = acc[ai][0][m][n] * rs, zv = acc[ai][1][m][n] * rs;
                    float o[4];
#pragma unroll
                    for (int j = 0; j < 4; ++j) {
                        const float g1 = dpp_shr1(dpp_ror1(pg[j]), zg[j]), g2 = dpp_shr2(dpp_ror2(pg[j]), zg[j]);
                        const float v1 = dpp_shr1(dpp_ror1(pv[j]), zv[j]), v2 = dpp_shr2(dpp_ror2(pv[j]), zv[j]);
                        const float gg = fmaf(gw0[j], g2, fmaf(gw1[j], g1, fmaf(gw2[j], zg[j], gb[j])));
                        const float vv = fmaf(vw0[j], v2, fmaf(vw1[j], v1, fmaf(vw2[j], zv[j], vb[j])));
                        o[j] = silu_f(gg) * vv;
                    }
                    u32x2 w; w.x = pk(o[0], o[1]); w.y = pk(o[2], o[3]);
                    const int r = row0 + ai * 128 + m * 16;
                    if (n == 0) keep[ai][m] = w;
                    else if (!(m == 0 && fr < 2)) { u32x4 ww; ww.x = keep[ai][m].x; ww.y = keep[ai][m].y; ww.z = w.x; ww.w = w.y; st_nt16(act + (size_t)r * DFF + c0, ww); }
                    if (m == 0 && fr < 2) {
                        bf16_t* zp = zs + ((size_t)blk * 4 + 2 + fr) * NUP + c;
                        u32x2 a; a.x = pk(zg[0], zg[1]); a.y = pk(zg[2], zg[3]); *(u32x2*)zp = a;
                        u32x2 d; d.x = pk(zv[0], zv[1]); d.y = pk(zv[2], zv[3]); *(u32x2*)(zp + DFF) = d;
                    }
                    if (m == 3 && fr >= 14) {
                        bf16_t* zp = zs + ((size_t)blk * 4 + (fr - 14)) * NUP + c;
                        u32x2 a; a.x = pk(zg[0], zg[1]); a.y = pk(zg[2], zg[3]); *(u32x2*)zp = a;
                        u32x2 d; d.x = pk(zv[0], zv[1]); d.y = pk(zv[2], zv[3]); *(u32x2*)(zp + DFF) = d;
                    }
                    pg = zg; pv = zv;
                }
            }
        }
    }
};

__device__ __forceinline__ int win_dest_row(int col) {
    int ch, bj, n, t0;
    if (col < 512) { ch = col; bj = 1; n = 1; t0 = 16; }
    else if (col < 1536) { ch = col - 512; bj = 1; n = 1; t0 = 0; }
    else if (col < 3072) { const int s = (col - 1536) >> 9; ch = (col - 1536) & 511; bj = s >> 1; n = s & 1; t0 = 16; }
    else { const int gi = (col - 3072) >> 10; ch = (col - 3072) & 1023; bj = gi >> 1; n = gi & 1; t0 = 0; }
    const int k = t0 + (ch >> 6), r = ch & 63;
    const int g4 = (r >> 2) & 3, fqh = ((g4 & 1) << 1) | (g4 >> 1);
    return 256 * k + 128 * bj + 32 * (r >> 4) + 8 * fqh + 4 * n + (r & 3);
}
__device__ __forceinline__ void transpose_tile(const float* __restrict__ W, int N, const float* __restrict__ g, bf16_t* __restrict__ Wt, int ldt, int koff, int k0, int n0, int nd0, float* tile, int tid, bool winmap = false) {
    {
        const int kk = tid >> 4, nn = (tid & 15) * 4;
        f32x4 v[2][2]; float s[2];
#pragma unroll
        for (int h = 0; h < 2; ++h) { s[h] = g ? g[k0 + kk + h * 32] : 1.0f;
#pragma unroll
            for (int h2 = 0; h2 < 2; ++h2) v[h2][h] = *(const f32x4*)(W + (size_t)(k0 + kk + h * 32) * N + n0 + h2 * 64 + nn); }
#pragma unroll
        for (int h2 = 0; h2 < 2; ++h2)
#pragma unroll
            for (int h = 0; h < 2; ++h) { float* tp = tile + h2 * (64 * 65) + (kk + h * 32) * 65 + nn;
                tp[0] = v[h2][h][0] * s[h]; tp[1] = v[h2][h][1] * s[h]; tp[2] = v[h2][h][2] * s[h]; tp[3] = v[h2][h][3] * s[h]; }
    }
    __syncthreads();
    {
        const int n = tid >> 3, kq = (tid & 7) * 8;
#pragma unroll
        for (int h2 = 0; h2 < 2; ++h2) {
            float v[8];
#pragma unroll
            for (int j = 0; j < 8; ++j) v[j] = tile[h2 * (64 * 65) + (kq + j) * 65 + n];
            u32x4 w; w.x = pk(v[0], v[1]); w.y = pk(v[2], v[3]); w.z = pk(v[4], v[5]); w.w = pk(v[6], v[7]);
            *(u32x4*)(Wt + (size_t)(winmap ? win_dest_row(n0 + h2 * 64 + n) : nd0 + h2 * 64 + n) * ldt + koff + k0 + kq) = w;
        }
    }
    __syncthreads();
}

__device__ __forceinline__ void prep_phase(const Params& p, int l, float* ldsf) {
    unsigned char* ws = p.ws;
    bf16_t* wt_in = (bf16_t*)(ws + WS_WIN); bf16_t* wt_br = (bf16_t*)(ws + WS_WBR); bf16_t* wt_o = (bf16_t*)(ws + WS_WO);
    bf16_t* wt_up = (bf16_t*)(ws + WS_WUP); bf16_t* wt_dn = (bf16_t*)(ws + WS_WDN);
    const float* g_mix = p.in[1] + (size_t)l * DM; const float* w_in = p.in[2] + (size_t)l * DM * NIN;
    const float* w_pool = p.in[3] + (size_t)l * 4 * 128 * 128; const float* pscale = p.in[4] + (size_t)l * 512;
    const float* w_ba = p.in[9] + (size_t)l * 512 * DM; const float* w_bb = p.in[10] + (size_t)l * 512 * DM; const float* w_bc = p.in[11] + (size_t)l * 512 * DM;
    const float* w_o = p.in[12] + (size_t)l * DM * DM; const float* g_ffn = p.in[13] + (size_t)l * DM;
    const float* w_up = p.in[14] + (size_t)l * DM * NUP; const float* w_dn = p.in[17] + (size_t)l * DFF * DM;
    const int tid = otid(), bid = obid();
    constexpr int T0 = 16 * 48, T1 = T0 + 64, T2 = T1 + 64, T3 = T2 + 128, T4 = T3 + 16 * 44, T5 = T4 + 44 * 8;
    for (int i = bid; i < T5; i += gridDim.x) {
        if (i < T0) { const int kt = i & 15, nt = i >> 4; transpose_tile(w_in, NIN, g_mix, wt_in, DM, 0, kt * 64, nt * 128, nt * 128, ldsf, tid, true); }
        else if (i < T1) { const int j = i - T0, kt = j & 7, nt = j >> 3; transpose_tile(w_bb, DM, nullptr, wt_br, NBR, 512, kt * 64, nt * 128, nt * 128, ldsf, tid); }
        else if (i < T2) { const int j = i - T1, kt = j & 7, nt = j >> 3; transpose_tile(w_bc, DM, nullptr, wt_br, NBR, 1024, kt * 64, nt * 128, nt * 128, ldsf, tid); }
        else if (i < T3) { const int j = i - T2, kt = j & 15, nt = j >> 4; transpose_tile(w_o, DM, nullptr, wt_o, DM, 0, kt * 64, nt * 128, nt * 128, ldsf, tid); }
        else if (i < T4) { const int j = i - T3, kt = j & 15, nt = j >> 4; const int n0 = nt * 128, bj = n0 / DFF, q0 = n0 - bj * DFF; transpose_tile(w_up, NUP, g_ffn, wt_up, DM, 0, kt * 64, n0, (q0 >> 7) * 256 + bj * 128, ldsf, tid);   }
        else { const int j = i - T4, kt = j % 44, nt = j / 44; transpose_tile(w_dn, DM, nullptr, wt_dn, DFF, 0, kt * 64, nt * 128, nt * 128, ldsf, tid); }
    }
    {
        float* wpT = ldsf;
        float* wa = ldsf + 128 * 128;
        for (int it = (int)gridDim.x - 1 - bid; it < 64; it += gridDim.x) {
            const int g = it >> 4, n0 = (it & 15) * 64;
            for (int q = tid; q < 128 * 32; q += 512) {
                const int d = q >> 5, e4 = (q & 31) * 4;
                const f32x4 v = *(const f32x4*)(w_pool + ((size_t)g * 128 + d) * 128 + e4);
                const f32x4 s = *(const f32x4*)(pscale + g * 128 + e4);
                wpT[(e4 + 0) * 128 + d] = v[0] * s[0]; wpT[(e4 + 1) * 128 + d] = v[1] * s[1]; wpT[(e4 + 2) * 128 + d] = v[2] * s[2]; wpT[(e4 + 3) * 128 + d] = v[3] * s[3];
            }
            for (int q = tid; q < 128 * 16; q += 512) {
                const int e = q >> 4, c4 = (q & 15) * 4;
                *(f32x4*)(wa + e * 64 + c4) = *(const f32x4*)(w_ba + (size_t)(g * 128 + e) * DM + n0 + c4);
            }
            __syncthreads();
            const int d = tid & 127, ns = tid >> 7;
            float acc[16];
#pragma unroll
            for (int i = 0; i < 16; ++i) acc[i] = 0.f;
            for (int e = 0; e < 128; ++e) {
                const float w = wpT[e * 128 + d];
                const f32x4* wr4 = (const f32x4*)(wa + e * 64 + ns * 16);
#pragma unroll
                for (int c = 0; c < 4; ++c) { const f32x4 b = wr4[c]; acc[c * 4 + 0] += w * b[0]; acc[c * 4 + 1] += w * b[1]; acc[c * 4 + 2] += w * b[2]; acc[c * 4 + 3] += w * b[3]; }
            }
#pragma unroll
            for (int i = 0; i < 16; ++i) wt_br[(size_t)(n0 + ns * 16 + i) * NBR + g * 128 + d] = (bf16_t)(pk(acc[i], 0.f) & 0xffffu);
            __syncthreads();
        }
    }
    if (l != 0) {
        const float* ssq = (const float*)(ws + WS_SSQ); float* rstd1 = (float*)(ws + WS_RSTD);
        for (int r = bid * 512 + tid; r < MTOK; r += gridDim.x * 512) rstd1[r] = row_rstd(ssq, r);
    }
    if (l == 0) {
        const float* x = p.in[0]; bf16_t* xb = (bf16_t*)(ws + WS_XB); float* rstd1 = (float*)(ws + WS_RSTD);
        const int lane = tid & 63, wave = tid >> 6;
        for (int r0 = (bid * 8 + wave) * 2; r0 < MTOK; r0 += gridDim.x * 16) {
            f32x4 v[2][4];
#pragma unroll
            for (int rr = 0; rr < 2; ++rr)
#pragma unroll
                for (int i = 0; i < 4; ++i) v[rr][i] = *(const f32x4*)(x + (size_t)(r0 + rr) * DM + i * 256 + lane * 4);
#pragma unroll
            for (int rr = 0; rr < 2; ++rr) {
                const int r = r0 + rr;
                float sq = 0.f;
#pragma unroll
                for (int i = 0; i < 4; ++i) {
                    const f32x4 t = v[rr][i];
                    sq += (t[0] * t[0] + t[1] * t[1]) + (t[2] * t[2] + t[3] * t[3]);
                    u32x2 w; w.x = pk(t[0], t[1]); w.y = pk(t[2], t[3]);
                    *(u32x2*)(xb + (size_t)r * DM + i * 256 + lane * 4) = w;
                }
#pragma unroll
                for (int o = 32; o >= 1; o >>= 1) sq += __shfl_xor(sq, o);
                if (lane == 0) rstd1[r] = rsqrtf(sq * (1.0f / 1024.0f) + EPS);
            }
        }
    }
}
__device__ __forceinline__ void ld8(const bf16_t* p, float (&v)[8]) {
    const u32x4 w = *(const u32x4*)p;
    v[0] = bflo(w.x); v[1] = bfhi(w.x); v[2] = bflo(w.y); v[3] = bfhi(w.y); v[4] = bflo(w.z); v[5] = bfhi(w.z); v[6] = bflo(w.w); v[7] = bfhi(w.w);
}
__device__ __forceinline__ void st8(bf16_t* p, const float (&v)[8]) {
    u32x4 w; w.x = pk(v[0], v[1]); w.y = pk(v[2], v[3]); w.z = pk(v[4], v[5]); w.w = pk(v[6], v[7]);
    *(u32x4*)p = w;
}
template <int W> __device__ __forceinline__ void pool_rows(const bf16_t* __restrict__ ap, bf16_t* __restrict__ yp, int r0, int pos0) {
#pragma unroll
    for (int b = 0; b < 4; ++b) {
        const int base = r0 + 4 * b;
        u32x4 h[W + 3];
#pragma unroll
        for (int i = 0; i < W + 3; ++i) { const int rr = base - (W - 1) + i; h[i] = (pos0 + rr >= 0) ? *(const u32x4*)(ap + (ptrdiff_t)rr * NPA2) : (u32x4){0u, 0u, 0u, 0u}; }
        float s[8];
#pragma unroll
        for (int j = 0; j < 8; ++j) s[j] = 0.f;
#pragma unroll
        for (int i = 0; i < W - 1; ++i) { const u32x4 q = h[i];
            s[0] += bflo(q.x); s[1] += bfhi(q.x); s[2] += bflo(q.y); s[3] += bfhi(q.y); s[4] += bflo(q.z); s[5] += bfhi(q.z); s[6] += bflo(q.w); s[7] += bfhi(q.w); }
#pragma unroll
        for (int i = 0; i < 4; ++i) {
            const int rr = base + i, pos = pos0 + rr; const float inv = 1.0f / (float)(pos + 1 < W ? pos + 1 : W);
            const u32x4 q = h[W - 1 + i], od = h[i];
            const float v[8] = {bflo(q.x), bfhi(q.x), bflo(q.y), bfhi(q.y), bflo(q.z), bfhi(q.z), bflo(q.w), bfhi(q.w)};
            float o[8];
#pragma unroll
            for (int j = 0; j < 8; ++j) { s[j] += v[j]; o[j] = s[j] * inv - v[j]; }
            st8(yp + (size_t)rr * NBR, o);
            s[0] -= bflo(od.x); s[1] -= bfhi(od.x); s[2] -= bflo(od.y); s[3] -= bfhi(od.y); s[4] -= bflo(od.z); s[5] -= bfhi(od.z); s[6] -= bflo(od.w); s[7] -= bfhi(od.w);
        }
        asm volatile("" ::: "memory");
    }
}
constexpr int VT_PITCH = 136;
__device__ __forceinline__ void mixer_phase(const Params& p, int l, unsigned char* lds) {
    const bf16_t* PA = (const bf16_t*)(p.ws + WS_B1);
    bf16_t* Y = (bf16_t*)p.out;
    const float* g_sgu = p.in[5] + (size_t)l * 512;
    const float* w_sp = p.in[6] + (size_t)l * 4 * 128 * 128;
    const float* b_sp = p.in[7] + (size_t)l * 4 * 128;
    const float* conv_c = p.in[8] + (size_t)l * 3 * 512;
    float* rs = (float*)lds;
    bf16_t* vT = (bf16_t*)(lds + 1024);
    const int tid = otid(), lane = tid & 63, wave = __builtin_amdgcn_readfirstlane(tid >> 6), fr = lane & 15, fq = lane >> 4;
    for (int item = obid(); item < MTOK / 128; item += gridDim.x) {
        const int t0 = item * 128, pos0 = t0 & (SEQ - 1);
        {
            const int row = tid >> 2, q = tid & 3;
            const bf16_t* vp = PA + (size_t)(t0 + row) * NPA2 + 1024 + q * 128;
            float sq = 0.f;
#pragma unroll
            for (int i = 0; i < 16; ++i) { float v[8]; ld8(vp + i * 8, v);
#pragma unroll
                for (int j = 0; j < 8; ++j) sq += v[j] * v[j]; }
            sq += __shfl_xor(sq, 1); sq += __shfl_xor(sq, 2);
            if (q == 0) rs[row] = rsqrtf(sq * (1.0f / 512.0f) + EPS);
        }
        {
            const int grp = wave & 3;
            const int c8 = (grp * 16 + (lane & 15)) * 8; int r0 = ((wave >> 2) * 4 + (lane >> 4)) * 16;
            asm volatile("" : "+v"(r0));
            {
                const bf16_t* ap = PA + (size_t)t0 * NPA2 + c8;
                bf16_t* yp = Y + (size_t)t0 * NBR + c8;
                if (grp == 0) pool_rows<2>(ap, yp, r0, pos0); else if (grp == 1) pool_rows<4>(ap, yp, r0, pos0); else if (grp == 2) pool_rows<8>(ap, yp, r0, pos0); else pool_rows<16>(ap, yp, r0, pos0);
            }
        }
        if (tid < 256) {
            const bf16_t* sc = (const bf16_t*)(p.ws + WS_SC); const bf16_t* scb = (const bf16_t*)(p.ws + WS_SCB);
            const int b_ = tid >> 7, ri = (tid >> 6) & 1, c8 = (tid & 63) * 8;
            const int blk = (t0 >> 6) + b_;
            const bool first = ((blk * 64) & (SEQ - 1)) == 0;
            float z2[8], z1[8], z0[8], cbv[8], o[8];
#pragma unroll
            for (int j = 0; j < 8; ++j) { z2[j] = 0.f; z1[j] = 0.f; }
            const bf16_t* own = sc + (size_t)blk * 4 * 512 + c8;
            if (ri == 0) { if (!first) { ld8(own - 4 * 512, z2); ld8(own - 3 * 512, z1); } ld8(own + 2 * 512, z0); }
            else { if (!first) ld8(own - 3 * 512, z2); ld8(own + 2 * 512, z1); ld8(own + 3 * 512, z0); }
            ld8(scb + ((size_t)blk * 2 + ri) * 512 + c8, cbv);
#pragma unroll
            for (int j = 0; j < 8; ++j) o[j] = 0.f;
            { const f32x4 a0 = *(const f32x4*)(conv_c + c8), a1 = *(const f32x4*)(conv_c + c8 + 4), b0 = *(const f32x4*)(conv_c + 512 + c8), b1 = *(const f32x4*)(conv_c + 512 + c8 + 4), c0 = *(const f32x4*)(conv_c + 1024 + c8), c1 = *(const f32x4*)(conv_c + 1024 + c8 + 4);
#pragma unroll
              for (int j = 0; j < 4; ++j) { o[j] = cbv[j] * fmaf(a0[j], z2[j], fmaf(b0[j], z1[j], c0[j] * z0[j])); o[4 + j] = cbv[4 + j] * fmaf(a1[j], z2[4 + j], fmaf(b1[j], z1[4 + j], c1[j] * z0[4 + j])); } }
            st8(Y + (size_t)(blk * 64 + ri) * NBR + 1024 + c8, o);
        }
#pragma unroll 1
        for (int g = 0; g < 4; ++g) {
            const int t = wave * 16 + fr;
            const int nk = (wave >> 1) + 1;
            f32x4 wq[4][2];
#pragma unroll
            for (int k = 0; k < 4; ++k) { const float* wp = w_sp + ((size_t)g * 128 + t) * 128 + k * 32 + fq * 8; wq[k][0] = *(const f32x4*)wp; wq[k][1] = *(const f32x4*)(wp + 4); }
            const bf16_t* up = PA + (size_t)(t0 + t) * NPA2 + 512 + g * 128 + 4 * fq;
            u32x2 uu[8];
#pragma unroll
            for (int n = 0; n < 8; ++n) uu[n] = *(const u32x2*)(up + n * 16);
            const float bias = b_sp[g * 128 + t];
            u32x4 vq[4];
            const int s_ = tid >> 2, dq = (tid & 3) * 32;
            {
                const bf16_t* vp = PA + (size_t)(t0 + s_) * NPA2 + 1024 + g * 128 + dq;
#pragma unroll
                for (int i = 0; i < 4; ++i) vq[i] = *(const u32x4*)(vp + i * 8);
            }
            __syncthreads();
#pragma unroll
            for (int i = 0; i < 4; ++i) {
                const unsigned ww[4] = {vq[i].x, vq[i].y, vq[i].z, vq[i].w};
#pragma unroll
                for (int q = 0; q < 4; ++q) { vT[(dq + i * 8 + q * 2) * VT_PITCH + s_] = (bf16_t)(ww[q] & 0xffffu); vT[(dq + i * 8 + q * 2 + 1) * VT_PITCH + s_] = (bf16_t)(ww[q] >> 16); }
            }
            __syncthreads();
            f32x4 acc[8];
#pragma unroll
            for (int n = 0; n < 8; ++n) acc[n] = (f32x4){0.f, 0.f, 0.f, 0.f};
#pragma unroll
            for (int k = 0; k < 4; ++k) if (k < nk) {
                const int s0 = k * 32 + fq * 8;
                const f32x4 wa = wq[k][0], wb = wq[k][1];
                const f32x4 ra = *(const f32x4*)(rs + s0), rb = *(const f32x4*)(rs + s0 + 4);
                float a[8];
#pragma unroll
                for (int j = 0; j < 4; ++j) { a[j] = (s0 + j <= t) ? wa[j] * ra[j] : 0.f; a[4 + j] = (s0 + 4 + j <= t) ? wb[j] * rb[j] : 0.f; }
                union { u32x4 u; bf16x8 h; } af; af.u.x = pk(a[0], a[1]); af.u.y = pk(a[2], a[3]); af.u.z = pk(a[4], a[5]); af.u.w = pk(a[6], a[7]);
#pragma unroll
                for (int n = 0; n < 8; ++n) {
                    const bf16x8 bfrag = *(const bf16x8*)(vT + (n * 16 + fr) * VT_PITCH + s0);
                    acc[n] = __builtin_amdgcn_mfma_f32_16x16x32_bf16(bfrag, af.h, acc[n], 0, 0, 0);
                }
            }
            bf16_t* yp = Y + (size_t)(t0 + t) * NBR + 512 + g * 128 + 4 * fq;
#pragma unroll
            for (int n = 0; n < 8; ++n) {
                const f32x4 gs = *(const f32x4*)(g_sgu + g * 128 + n * 16 + 4 * fq);
                const float o0 = bflo(uu[n].x) * (acc[n][0] * gs[0] + bias), o1 = bfhi(uu[n].x) * (acc[n][1] * gs[1] + bias);
                const float o2 = bflo(uu[n].y) * (acc[n][2] * gs[2] + bias), o3 = bfhi(uu[n].y) * (acc[n][3] * gs[3] + bias);
                u32x2 w; w.x = pk(o0, o1); w.y = pk(o2, o3);
                *(u32x2*)(yp + n * 16) = w;
            }
        }
        __syncthreads();
    }
}

__device__ __forceinline__ void rstd_finalize_phase(const Params& p) {
    const float* ssq = (const float*)(p.ws + WS_SSQ); float* rstd = (float*)(p.ws + WS_RSTD);
    for (int r = obid() * 512 + otid(); r < MTOK; r += gridDim.x * 512) rstd[r] = row_rstd(ssq, r);
}

__device__ __forceinline__ void ffn_fixup_phase(const Params& p, int l) {
    const bf16_t* zs = (const bf16_t*)(p.ws + WS_B2);
    bf16_t* act = (bf16_t*)(p.ws + WS_B1);
    const float* cw = p.in[15] + (size_t)l * 3 * NUP; const float* cb = p.in[16] + (size_t)l * NUP;
    constexpr int NCG = DFF / 8, NU = (MTOK / 64) * NCG;
    for (int u = obid() * 512 + otid(); u < NU; u += gridDim.x * 512) {
        const int blk = u / NCG, c8 = (u - blk * NCG) * 8;
        const bool first = ((blk * 64) & (SEQ - 1)) == 0;
        float g2[8], g1[8], ga[8], gb2[8], v2[8], v1[8], va[8], vb2[8];
#pragma unroll
        for (int j = 0; j < 8; ++j) { g2[j] = g1[j] = v2[j] = v1[j] = 0.f; }
        const bf16_t* own = zs + (size_t)blk * 4 * NUP + c8;
        if (!first) { const bf16_t* prv = own - 4 * (ptrdiff_t)NUP; ld8(prv, g2); ld8(prv + NUP, g1); ld8(prv + DFF, v2); ld8(prv + NUP + DFF, v1); }
        ld8(own + 2 * NUP, ga); ld8(own + 3 * NUP, gb2); ld8(own + 2 * NUP + DFF, va); ld8(own + 3 * NUP + DFF, vb2);
        float o0[8], o1[8];
        float w0[8], w1[8], w2[8], bb[8], x0[8], x1[8], x2[8], xb_[8];
        { const f32x4* q;
#define LD8F(dst, ptr) q = (const f32x4*)(ptr); { const f32x4 a_ = q[0], b_ = q[1]; dst[0] = a_[0]; dst[1] = a_[1]; dst[2] = a_[2]; dst[3] = a_[3]; dst[4] = b_[0]; dst[5] = b_[1]; dst[6] = b_[2]; dst[7] = b_[3]; }
          LD8F(w0, cw + c8) LD8F(w1, cw + NUP + c8) LD8F(w2, cw + 2 * NUP + c8) LD8F(bb, cb + c8)
          LD8F(x0, cw + DFF + c8) LD8F(x1, cw + NUP + DFF + c8) LD8F(x2, cw + 2 * NUP + DFF + c8) LD8F(xb_, cb + DFF + c8)
#undef LD8F
        }
#pragma unroll
        for (int j = 0; j < 8; ++j) {
            const float gg0 = w0[j] * g2[j] + w1[j] * g1[j] + w2[j] * ga[j] + bb[j], vv0 = x0[j] * v2[j] + x1[j] * v1[j] + x2[j] * va[j] + xb_[j];
            const float gg1 = w0[j] * g1[j] + w1[j] * ga[j] + w2[j] * gb2[j] + bb[j], vv1 = x0[j] * v1[j] + x1[j] * va[j] + x2[j] * vb2[j] + xb_[j];
            o0[j] = silu_f(gg0) * vv0; o1[j] = silu_f(gg1) * vv1;
        }
        st8(act + (size_t)(blk * 64) * DFF + c8, o0); st8(act + (size_t)(blk * 64 + 1) * DFF + c8, o1);
    }
}

__device__ __forceinline__ void final_norm_phase(const Params& p) {
    const float* gf = p.in[18]; const float* ssq = (const float*)(p.ws + WS_SSQ); const bf16_t* xb = (const bf16_t*)(p.ws + WS_XB); float* out = p.out;
    const int tid = otid(), lane = tid & 63, wave = tid >> 6;
    for (int r0 = (obid() * 8 + wave) * 2; r0 < MTOK; r0 += gridDim.x * 16) {
        u32x4 xv[2][2]; float rs[2];
#pragma unroll
        for (int rr = 0; rr < 2; ++rr) {
            rs[rr] = row_rstd(ssq, r0 + rr);
#pragma unroll
            for (int i = 0; i < 2; ++i) xv[rr][i] = *(const u32x4*)(xb + (size_t)(r0 + rr) * DM + i * 512 + lane * 8);
        }
#pragma unroll
        for (int rr = 0; rr < 2; ++rr)
#pragma unroll
            for (int i = 0; i < 2; ++i) {
                const int cc = i * 512 + lane * 8;
                const u32x4 q = xv[rr][i];
                const float v[8] = {bflo(q.x), bfhi(q.x), bflo(q.y), bfhi(q.y), bflo(q.z), bfhi(q.z), bflo(q.w), bfhi(q.w)};
                const f32x4 g0 = *(const f32x4*)(gf + cc), g1 = *(const f32x4*)(gf + cc + 4);
                f32x4 o0, o1;
#pragma unroll
                for (int j = 0; j < 4; ++j) { o0[j] = v[j] * rs[rr] * g0[j]; o1[j] = v[4 + j] * rs[rr] * g1[j]; }
                float* qo = out + (size_t)(r0 + rr) * DM + cc;
                __builtin_nontemporal_store(o0, (f32x4*)qo); __builtin_nontemporal_store(o1, (f32x4*)(qo + 4));
            }
    }
}

template <class Epi> __device__ __forceinline__ void run_gemm(unsigned char* lds, const bf16_t* A, const bf16_t* Bt, int M, int N, int K, const Epi& E, int stagger_step = 0) {
    pg8::Gemm g{A, Bt, M, N, K}; pg8::StaticOrder S; S.init(M, N, (int)gridDim.x, obid());
    if (stagger_step) {
        const unsigned long long t0 = wall_clock64(), d = (unsigned long long)(((obid() >> 3) & 7) * stagger_step);
        while (wall_clock64() - t0 < d) __builtin_amdgcn_s_sleep(16);
    }
    pg8::gemm_phase<Epi, pg8::StaticOrder, false>((PG8_LAS unsigned char*)lds, g, S, E, nullptr);
}

#define XB_TMO      128
#define XB_XCNT(j)  (256  + 64 * (j))
#define XB_XSUB(j)  (1280 + 64 * (j))
#define XB_XGEN(j)  (2304 + 64 * (j))
#define XB_TOP      3328
#define XB_TOPGEN   3392
#define XCD_BAR_WORDS 3456
#define XB_SPIN_CAP (1u << 18)

__device__ __forceinline__ unsigned xb_ld(unsigned* p)              { return __hip_atomic_load(p, __ATOMIC_RELAXED, __HIP_MEMORY_SCOPE_AGENT); }
__device__ __forceinline__ unsigned xb_add(unsigned* p, unsigned v) { return __hip_atomic_fetch_add(p, v, __ATOMIC_RELAXED, __HIP_MEMORY_SCOPE_AGENT); }
__device__ __forceinline__ unsigned xb_xcc_id() { return (unsigned)__builtin_amdgcn_s_getreg((3 << 11) | 20) & 0xFu; }
#define XB_SPIN(cond, bar) do { unsigned _sp = 0; while (cond) { __builtin_amdgcn_s_sleep(1); \
    if ((++_sp & 255u) == 0u) { if (xb_ld(&(bar)[XB_TMO])) break; if (_sp > XB_SPIN_CAP) { atomicAdd(&(bar)[XB_TMO], 1u); break; } } } } while (0)

struct XcdBarrier {
    unsigned* bar; unsigned x;
    volatile LAS unsigned* st;
};

__device__ __forceinline__ XcdBarrier xcd_barrier_post(unsigned* bar, volatile LAS unsigned* st) {
    XcdBarrier b; b.bar = bar; b.x = xb_xcc_id(); b.st = st;
    if (threadIdx.x == 0) (void)xb_add(&bar[XB_XCNT(b.x)], 1u);
    return b;
}
__device__ __forceinline__ void xcd_barrier_complete(unsigned* bar, unsigned x, unsigned& nloc, unsigned& nx) {
    const unsigned G = gridDim.x * gridDim.y * gridDim.z;
    unsigned sum, cnt, mine, sp = 0u;
    for (;;) {
        sum = 0u; cnt = 0u; mine = 0u;
#pragma unroll
        for (unsigned j = 0; j < 16; ++j) { const unsigned c = xb_ld(&bar[XB_XCNT(j)]); sum += c; cnt += (c > 0u) ? 1u : 0u; mine = (j == x) ? c : mine; }
        if (sum == G) break;
        __builtin_amdgcn_s_sleep(1);
        if ((++sp & 255u) == 0u) { if (xb_ld(&bar[XB_TMO])) break; if (sp > XB_SPIN_CAP) { atomicAdd(&bar[XB_TMO], 1u); break; } }
    }
    nloc = mine > 0u ? mine : 1u; nx = cnt > 0u ? cnt : 1u;
}

__device__ __forceinline__ void xcd_barrier(const XcdBarrier& b) {
    asm volatile("s_waitcnt vmcnt(0)" ::: "memory");
    __syncthreads();
    if (threadIdx.x == 0) {
        unsigned* bar = b.bar;
        __builtin_amdgcn_s_waitcnt(0);
        unsigned nloc = b.st[0], nx = b.st[1];
        if (nloc == 0u) { xcd_barrier_complete(bar, b.x, nloc, nx); b.st[0] = nloc; b.st[1] = nx; }
        const unsigned old = xb_add(&bar[XB_XSUB(b.x)], 1u);
        const unsigned gen = old / nloc;
        if (old + 1u == (gen + 1u) * nloc) {
            __builtin_amdgcn_fence(__ATOMIC_RELEASE, "agent");
            asm volatile("s_waitcnt vmcnt(0)" ::: "memory");
            const unsigned og = xb_add(&bar[XB_TOP], 1u);
            const unsigned tg = og / nx;
            if (og + 1u == (tg + 1u) * nx) xb_add(&bar[XB_TOPGEN], 1u);
            else XB_SPIN(xb_ld(&bar[XB_TOPGEN]) == tg, bar);
            __builtin_amdgcn_fence(__ATOMIC_ACQUIRE, "agent");
            xb_add(&bar[XB_XGEN(b.x)], 1u);
            asm volatile("s_waitcnt vmcnt(0)" ::: "memory");
        } else {
            XB_SPIN(xb_ld(&bar[XB_XGEN(b.x)]) == gen, bar);
            __builtin_amdgcn_fence(__ATOMIC_ACQUIRE, "agent");
            asm volatile("s_waitcnt vmcnt(0)" ::: "memory");
        }
    }
    __syncthreads();
}

typedef const Params __attribute__((address_space(4)))* ParamsK;
__device__ __forceinline__ Params fresh_params() {
    ParamsK q = (ParamsK)__builtin_amdgcn_kernarg_segment_ptr();
    asm volatile("" : "+s"(q));
    Params r;
#pragma unroll
    for (int i = 0; i < 19; ++i) r.in[i] = q->in[i];
    r.out = q->out; r.ws = q->ws;
    return r;
}
constexpr int LDS_TOTAL = pg8::STAGE_BYTES + 256;
__global__ void __launch_bounds__(512, 2) fwd_megakernel(Params p_unused) {
    extern __shared__ __attribute__((aligned(16))) unsigned char lds[];
    cg::grid_group grid = cg::this_grid();
    volatile LAS unsigned* st = (volatile LAS unsigned*)((LAS unsigned char*)lds + pg8::STAGE_BYTES);
    unsigned* bar;
    {
        const Params p = fresh_params(); bar = (unsigned*)(p.ws + WS_BAR);
        if (threadIdx.x < 4) st[threadIdx.x] = 0u;
        if (blockIdx.x == 0) for (int i = threadIdx.x; i < XCD_BAR_WORDS; i += 512) bar[i] = 0u;
        __syncthreads();
    }
#define WSP(off) ((bf16_t*)(p.ws + (off)))
#define GRID_BAR() do { XcdBarrier b_; b_.bar = (unsigned*)(fresh_params().ws + WS_BAR); b_.x = xb_xcc_id(); b_.st = (volatile LAS unsigned*)((LAS unsigned char*)lds + pg8::STAGE_BYTES); xcd_barrier(b_); } while (0)
    for (int l = 0; l < 2; ++l) {
        { const Params p = fresh_params(); prep_phase(p, l, (float*)lds); }
        if (l == 0) { grid.sync(); (void)xcd_barrier_post((unsigned*)(fresh_params().ws + WS_BAR), (volatile LAS unsigned*)((LAS unsigned char*)lds + pg8::STAGE_BYTES)); }
        else GRID_BAR();
        { const Params p = fresh_params(); EpiIn E{WSP(WS_B1), WSP(WS_B2), (const float*)(p.ws + WS_RSTD), (bf16_t*)p.out, WSP(WS_SC), WSP(WS_SCB), p.in[8] + (size_t)l * 3 * 512}; run_gemm(lds, WSP(WS_XB), WSP(WS_WIN), MTOK, NIN, DM, E); }
        GRID_BAR();
        { const Params p = fresh_params(); mixer_phase(p, l, lds); }
        GRID_BAR();
        { const Params p = fresh_params(); EpiBr E{WSP(WS_B2), WSP(WS_B1)}; run_gemm(lds, (const bf16_t*)p.out  , WSP(WS_WBR), MTOK, DM, NBR, E); }
        GRID_BAR();
        { const Params p = fresh_params(); EpiRes E{WSP(WS_XB), (float*)(p.ws + WS_SSQ)}; run_gemm(lds, WSP(WS_B1), WSP(WS_WO), MTOK, DM, DM, E); }
        GRID_BAR();
        { const Params p = fresh_params(); rstd_finalize_phase(p); }
        GRID_BAR();
        { const Params p = fresh_params(); EpiUp E{WSP(WS_B1), WSP(WS_B2), (const float*)(p.ws + WS_RSTD), p.in[15] + (size_t)l * 3 * NUP, p.in[16] + (size_t)l * NUP}; run_gemm(lds, WSP(WS_XB), WSP(WS_WUP), MTOK, NUP, DM, E); }
        GRID_BAR();
        { const Params p = fresh_params(); ffn_fixup_phase(p, l); }
        GRID_BAR();
        { const Params p = fresh_params(); EpiRes E{WSP(WS_XB), (float*)(p.ws + WS_SSQ)}; run_gemm(lds, WSP(WS_B1), WSP(WS_WDN), MTOK, DM, DFF, E); }
        GRID_BAR();
    }
    { const Params p = fresh_params(); final_norm_phase(p); }
#undef WSP
#undef GRID_BAR
}

extern "C" void kernel_launch(void* const* d_in, const int* in_sizes, int n_in, void* d_out, int out_size, void* d_ws, size_t ws_size, hipStream_t stream) {
    constexpr size_t kLds = LDS_TOTAL;
    static int grid_blocks = 0;
    if (!grid_blocks) {
        int dev = 0, cus = 0, per_cu = 0;
        (void)hipGetDevice(&dev);
        (void)hipDeviceGetAttribute(&cus, hipDeviceAttributeMultiprocessorCount, dev);
        (void)hipFuncSetAttribute((const void*)fwd_megakernel, hipFuncAttributeMaxDynamicSharedMemorySize, (int)kLds);
        (void)hipOccupancyMaxActiveBlocksPerMultiprocessor(&per_cu, (const void*)fwd_megakernel, 512, kLds);
        if (per_cu < 1) per_cu = 1;
        grid_blocks = cus;
        if (ws_size < WS_TOTAL || n_in != 19 || out_size != MTOK * DM) { fprintf(stderr, "kernel_launch: unexpected sizes: ws %zu (need %zu), n_in %d, out %d\n", ws_size, (size_t)WS_END, n_in, out_size); }
    }
    Params p{};
    for (int i = 0; i < 19; ++i) p.in[i] = (const float*)d_in[i];
    p.out = (float*)d_out; p.ws = (unsigned char*)d_ws;
    void* args[] = {&p};
    hipError_t e = hipLaunchCooperativeKernel((void*)fwd_megakernel, dim3(grid_blocks), dim3(512), args, kLds, stream);
    if (e != hipSuccess) fprintf(stderr, "cooperative launch failed: %s (grid %d)\n", hipGetErrorString(e), grid_blocks);
}
```

```cpp
#include <hip/hip_runtime.h>
#include <hip/hip_cooperative_groups.h>
#include <cstdio>
namespace cg = cooperative_groups;
namespace pg8 {
#define PG8_LAS __attribute__((address_space(3)))
typedef unsigned short bf16_t;
typedef short bf16x8 __attribute__((ext_vector_type(8)));
typedef float f32x4 __attribute__((ext_vector_type(4)));
typedef unsigned u32x4 __attribute__((ext_vector_type(4)));
constexpr int BM = 256, BK = 64, HALF = 128, HTB = HALF * BK * 2  , STAGE_BYTES = 8 * HTB, NXCD = 8, WGM = 8;

__host__ __device__ __forceinline__ int lds_byte(int r, int c) { const int st = (r >> 4) * 2 + (c >> 5), rr = r & 15, cc = c & 31, ob = rr * 64 + cc * 2; return st * 1024 + (ob ^ (((ob >> 9) & 1) << 5)); }
__host__ __device__ __forceinline__ void stage_rc(int b, int& R, int& C) { const int st = b / 1024, sb = b % 1024, swz = sb ^ (((sb >> 9) & 1) << 5); R = (st >> 1) * 16 + swz / 64; C = (st & 1) * 32 + (swz % 64) / 2; }
__host__ __device__ __forceinline__ int perm32(int rho) { const int n = rho >> 4, i = rho & 15; return 8 * (i >> 2) + 4 * n + (i & 3); }

struct Unit { int pm, pn; };
struct Gemm { const bf16_t* A; const bf16_t* Bt; int M, N, K; };

struct StaticOrder {
    int nM, nN, nwg, G, c;
    __host__ __device__ void init(int M, int N, int G_, int c_) { nM = M / BM; nN = N / BM; nwg = nM * nN; G = G_; c = c_; }
    __host__ __device__ bool next(int i, Unit& u) const {
        const long L = (long)i * G + c; if (L >= nwg) return false;
        int wgid = (int)L; { const int q = nwg / NXCD, r = nwg % NXCD, xcd = wgid % NXCD, off = wgid / NXCD; wgid = (xcd < r ? xcd * (q + 1) : r * (q + 1) + (xcd - r) * q) + off; }
        const int nig = WGM * nN, gid = wgid / nig, fm = gid * WGM, gsz = (nM - fm) < WGM ? (nM - fm) : WGM;
        u.pm = fm + ((wgid % nig) % gsz); u.pn = (wgid % nig) / gsz; return true;
    }
    __device__ __forceinline__ void a_ready(const Unit&) const {}
    __device__ __forceinline__ void done(const Unit&) const {}
};
__device__ __forceinline__ unsigned cvt_pk_bf16(float lo, float hi) { unsigned r; asm volatile("v_cvt_pk_bf16_f32 %0, %1, %2" : "=v"(r) : "v"(lo), "v"(hi)); return r; }

template <class Epi, class Sched, bool STAMP = false>
__device__ __forceinline__ void gemm_phase(PG8_LAS unsigned char* lds, const Gemm g, const Sched& S, const Epi& E, unsigned long long* stamps) {
    int tid_ = threadIdx.x; asm volatile("" : "+v"(tid_));
    const int tid = tid_, wid = __builtin_amdgcn_readfirstlane(tid >> 6), lane = tid & 63, wr = wid >> 2, wc = wid & 3, fr = lane & 15, fq = lane >> 4;
    const int K = g.K, nt = K / BK;
    int ts_lo = 0, ts_hi = 0, nts = 0; const unsigned long long rt_entry = STAMP ? (unsigned long long)wall_clock64() : 0ull;
#define PG8_STAMP() do { if (STAMP && wid == 0 && nts < 64) { const unsigned long long _c = (unsigned long long)clock64(); \
        ts_lo = (lane == nts) ? (int)(unsigned)_c : ts_lo; ts_hi = (lane == nts) ? (int)(unsigned)(_c >> 32) : ts_hi; ++nts; } } while (0)
    PG8_STAMP();
    unsigned voffA[2], voffB[2];
#pragma unroll
    for (int i = 0; i < 2; ++i) { int R, C; stage_rc(tid * 16 + i * 8192, R, C); const int Rb = Epi::PERM ? ((R & ~31) + perm32(R & 31)) : R;
        voffA[i] = (unsigned)(R * K + C) * 2u; voffB[i] = (unsigned)(Rb * K + C) * 2u; }
    const size_t kstep = (size_t)(BK * 2);
    const size_t hstep = (size_t)HALF * K * 2;
    const size_t tstep = 2 * hstep;
    const unsigned ldsw = (unsigned)wid * 1024u;
    const int aoff = lds_byte(wr * 64 + fr, fq * 8), boff = lds_byte(wc * 32 + fr, fq * 8);
#define PG8_SA(b, h) (((b) * 2 + (h)) * HTB)
#define PG8_SB(b, h) ((4 + (b) * 2 + (h)) * HTB)
#define PG8_STAGE(bufoff, gbase, voff) do { _Pragma("unroll") for (int _i = 0; _i < 2; ++_i) \
        __builtin_amdgcn_global_load_lds((const unsigned*)((const char*)(gbase) + (voff)[_i]), (PG8_LAS unsigned*)(lds + (bufoff) + ldsw + _i * 8192), 16, 0, 0); } while (0)
#define PG8_LDA(dst, b, h) do { _Pragma("unroll") for (int m = 0; m < 4; ++m) _Pragma("unroll") for (int k = 0; k < 2; ++k) dst[m][k] = *(const PG8_LAS bf16x8*)(lds + PG8_SA(b, h) + aoff + m * 2048 + k * 1024); } while (0)
#define PG8_LDB(dst, b, h) do { _Pragma("unroll") for (int n = 0; n < 2; ++n) _Pragma("unroll") for (int k = 0; k < 2; ++k) dst[n][k] = *(const PG8_LAS bf16x8*)(lds + PG8_SB(b, h) + boff + n * 2048 + k * 1024); } while (0)
#define PG8_MMA(ai, bj, At, Bt) do { __builtin_amdgcn_s_setprio(1); _Pragma("unroll") for (int m = 0; m < 4; ++m) _Pragma("unroll") for (int n = 0; n < 2; ++n) _Pragma("unroll") for (int k = 0; k < 2; ++k) \
        acc[ai][bj][m][n] = __builtin_amdgcn_mfma_f32_16x16x32_bf16(Bt[n][k], At[m][k], acc[ai][bj][m][n], 0, 0, 0); __builtin_amdgcn_s_setprio(0); } while (0)
#define PG8_WAIT_V(n) asm volatile("s_waitcnt vmcnt(" #n ")" ::: "memory")
#define PG8_WAIT_L(n) asm volatile("s_waitcnt lgkmcnt(" #n ")" ::: "memory")
#define PG8_BAR __builtin_amdgcn_s_barrier()
#define PG8_SCHED __builtin_amdgcn_sched_barrier(0)
    Unit cur, nxt; int ui = 0;
    if (!S.next(0, cur)) return;
    f32x4 acc[2][2][4][2];
#pragma unroll
    for (int a = 0; a < 2; ++a)
#pragma unroll
        for (int b = 0; b < 2; ++b)
#pragma unroll
            for (int m = 0; m < 4; ++m)
#pragma unroll
                for (int n = 0; n < 2; ++n) acc[a][b][m][n] = (f32x4){0.f, 0.f, 0.f, 0.f};
    bf16x8 At[4][2], B0[2][2], B1[2][2];
    const char* cA = (const char*)g.A + (size_t)cur.pm * tstep; const char* cB = (const char*)g.Bt + (size_t)cur.pn * tstep;
    S.a_ready(cur);
    PG8_STAGE(PG8_SB(0, 0), cB, voffB); PG8_STAGE(PG8_SA(0, 0), cA, voffA); PG8_STAGE(PG8_SB(0, 1), cB + hstep, voffB); PG8_STAGE(PG8_SA(0, 1), cA + hstep, voffA);
    if (wr == 1) PG8_BAR;
    PG8_WAIT_V(4); PG8_BAR;
    PG8_STAGE(PG8_SB(1, 0), cB + kstep, voffB); PG8_STAGE(PG8_SA(1, 0), cA + kstep, voffA); PG8_STAGE(PG8_SB(1, 1), cB + hstep + kstep, voffB);
    PG8_WAIT_V(6); PG8_BAR;
    PG8_STAMP();
    for (;;) {
        const bool has_next = S.next(ui + 1, nxt);
        const char* nA = has_next ? (const char*)g.A + (size_t)nxt.pm * tstep : cA; const char* nB = has_next ? (const char*)g.Bt + (size_t)nxt.pn * tstep : cB;
        for (int t = 0; t < nt; t += 2) {
            if constexpr (Epi::MIDK) { if (t == 8 || t == 16) E.mid(acc, cur, t, wr, wc, fr, fq); }
            const bool last = (t == nt - 2);
            const char* a1 = cA + (size_t)(t + 1) * kstep;
            const char* a2 = last ? nA : cA + (size_t)(t + 2) * kstep; const char* b2 = last ? nB : cB + (size_t)(t + 2) * kstep;
            const char* a3 = a2 + kstep; const char* b3 = b2 + kstep;
            if (last && has_next) S.a_ready(nxt);
            PG8_LDB(B0, 0, 0); PG8_SCHED; PG8_LDA(At, 0, 0); PG8_STAGE(PG8_SA(1, 1), a1 + hstep, voffA);
            PG8_WAIT_L(8); PG8_BAR; PG8_WAIT_L(0); PG8_MMA(0, 0, At, B0); PG8_BAR; PG8_SCHED;
            PG8_LDB(B1, 0, 1); PG8_STAGE(PG8_SB(0, 0), b2, voffB);
            PG8_BAR; PG8_WAIT_L(0); PG8_MMA(0, 1, At, B1); PG8_BAR;
            PG8_LDA(At, 0, 1); PG8_STAGE(PG8_SA(0, 0), a2, voffA);
            PG8_BAR; PG8_WAIT_L(0); PG8_MMA(1, 0, At, B0); PG8_BAR; PG8_SCHED;
            PG8_STAGE(PG8_SB(0, 1), b2 + hstep, voffB);
            PG8_WAIT_V(6); PG8_BAR; PG8_MMA(1, 1, At, B1); PG8_BAR;
            PG8_LDB(B0, 1, 0); PG8_SCHED; PG8_LDA(At, 1, 0); PG8_STAGE(PG8_SA(0, 1), a2 + hstep, voffA);
            PG8_WAIT_L(8); PG8_BAR; PG8_WAIT_L(0); PG8_MMA(0, 0, At, B0); PG8_BAR; PG8_SCHED;
            PG8_LDB(B1, 1, 1); PG8_STAGE(PG8_SB(1, 0), b3, voffB);
            PG8_BAR; PG8_WAIT_L(0); PG8_MMA(0, 1, At, B1); PG8_BAR;
            PG8_LDA(At, 1, 1); PG8_STAGE(PG8_SA(1, 0), a3, voffA);
            PG8_BAR; PG8_WAIT_L(0); PG8_MMA(1, 0, At, B0); PG8_BAR; PG8_SCHED;
            PG8_STAGE(PG8_SB(1, 1), b3 + hstep, voffB);
            PG8_WAIT_V(6); PG8_BAR; PG8_MMA(1, 1, At, B1); PG8_BAR;
        }
        PG8_STAMP();
        if constexpr (!Epi::AFTER_DRAIN) { E(acc, cur, wr, wc, fr, fq); S.done(cur); }
        PG8_STAMP();
        if (!has_next) break;
#pragma unroll
        for (int a = 0; a < 2; ++a)
#pragma unroll
            for (int b = 0; b < 2; ++b)
#pragma unroll
                for (int m = 0; m < 4; ++m)
#pragma unroll
                    for (int n = 0; n < 2; ++n) acc[a][b][m][n] = (f32x4){0.f, 0.f, 0.f, 0.f};
        cur = nxt; cA = nA; cB = nB; ++ui;
    }
    PG8_WAIT_V(0);
    if (wr == 0) PG8_BAR;
    PG8_BAR;
    if constexpr (Epi::AFTER_DRAIN) { E.fused(acc, cur, wr, wc, fr, fq, lds, wid, lane); S.done(cur); }
    PG8_STAMP();
    if (STAMP && wid == 0) { stamps[lane] = lane < nts ? (((unsigned long long)(unsigned)ts_hi << 32) | (unsigned)ts_lo) : 0ull;
        if (lane == 62) stamps[62] = rt_entry; if (lane == 63) stamps[63] = (unsigned long long)wall_clock64(); }
#undef PG8_STAMP
#undef PG8_SA
#undef PG8_SB
#undef PG8_STAGE
#undef PG8_LDA
#undef PG8_LDB
#undef PG8_MMA
#undef PG8_WAIT_V
#undef PG8_WAIT_L
#undef PG8_BAR
#undef PG8_SCHED
}
}
typedef pg8::bf16_t bf16_t;
typedef pg8::f32x4 f32x4;
typedef pg8::u32x4 u32x4;
typedef pg8::bf16x8 bf16x8;
typedef unsigned u32x2 __attribute__((ext_vector_type(2)));
#define LAS __attribute__((address_space(3)))
constexpr int MTOK = 65536, DM = 1024, NIN = 6144, DFF = 2816, NUP = 5632, SEQ = 8192, NBR = 1536, NPA = 3072;
constexpr int NPA2 = 1536;
constexpr int MH = MTOK / 2;
constexpr float EPS = 1e-6f;
constexpr size_t WS_WIN = 0;
constexpr size_t WS_WBR = WS_WIN + (size_t)NIN * DM * 2;
constexpr size_t WS_WO = WS_WBR + (size_t)DM * NBR * 2;
constexpr size_t WS_WUP = WS_WO + (size_t)DM * DM * 2;
constexpr size_t WS_WDN = WS_WUP + (size_t)NUP * DM * 2;
constexpr size_t WS_SSQ = WS_WDN + (size_t)DM * DFF * 2;
constexpr size_t WS_XB = WS_SSQ + (size_t)MTOK * 16 * 4;
constexpr size_t WS_B1 = WS_XB + (size_t)MTOK * NBR * 2;
constexpr size_t WS_B2 = WS_B1 + (size_t)MTOK * NPA * 2;
constexpr size_t WS_END = WS_B2 + (size_t)MTOK * NPA * 2;
constexpr size_t WS_BAR = WS_END;
constexpr size_t WS_SC = WS_BAR + 16384;
constexpr size_t WS_SCB = WS_SC + (size_t)(MTOK / 64) * 4 * 512 * 2;
constexpr size_t WS_RSTD = WS_SCB + (size_t)(MTOK / 64) * 2 * 512 * 2;
constexpr size_t WS_TOTAL = WS_RSTD + (size_t)MTOK * 4;

__device__ __forceinline__ int otid() { int t = threadIdx.x; asm volatile("" : "+v"(t)); return t; }
__device__ __forceinline__ int obid() { int b = blockIdx.x; asm volatile("" : "+s"(b)); return b; }
struct Params {
    const float* in[19];
    float* out; unsigned char* ws;
};

__device__ __forceinline__ u32x4 ld_nt16(const void* p) { return __builtin_nontemporal_load((const u32x4*)p); }
__device__ __forceinline__ void st_nt16(void* p, u32x4 w) { __builtin_nontemporal_store(w, (u32x4*)p); }
__device__ __forceinline__ float bflo(unsigned w) { return __uint_as_float(w << 16); }
__device__ __forceinline__ float bfhi(unsigned w) { return __uint_as_float(w & 0xffff0000u); }
__device__ __forceinline__ unsigned pk(float a, float b) { return pg8::cvt_pk_bf16(a, b); }
__device__ __forceinline__ float fast_rcp(float x) { return __builtin_amdgcn_rcpf(x); }
__device__ __forceinline__ float gate_t2(float y) { return 1.0f + __builtin_amdgcn_exp2f(fminf(y, 43.28f)); }
__device__ __forceinline__ float gelu_tanh_f(float x) {
    const float z2 = 1.5957691216f * (x + 0.044715f * x * x * x);
    return x * fast_rcp(1.0f + __expf(-z2));
}
__device__ __forceinline__ float silu_f(float x) { return x * fast_rcp(1.0f + __expf(-x)); }
__device__ __forceinline__ float row_rstd(const float* ssq, int r) {
    const f32x4* p = (const f32x4*)(ssq + (size_t)r * 16);
    const f32x4 a = p[0], b = p[1], c = p[2], d = p[3];
    const float s = ((a[0] + a[1]) + (a[2] + a[3])) + ((b[0] + b[1]) + (b[2] + b[3])) + ((c[0] + c[1]) + (c[2] + c[3])) + ((d[0] + d[1]) + (d[2] + d[3]));
    return rsqrtf(s * (1.0f / 1024.0f) + EPS);
}

__device__ __forceinline__ void rows_rstd8(const float* ssq, int row0, int fq, float (&rs)[8]) {
    f32x4 v[8];
#pragma unroll
    for (int i = 0; i < 8; ++i) v[i] = *(const f32x4*)(ssq + (size_t)(row0 + (i >> 2) * 128 + (i & 3) * 16) * 16 + fq * 4);
#pragma unroll
    for (int i = 0; i < 8; ++i) {
        float s = (v[i][0] + v[i][1]) + (v[i][2] + v[i][3]);
        s += __shfl_xor(s, 16); s += __shfl_xor(s, 32);
        rs[i] = rsqrtf(s * (1.0f / 1024.0f) + EPS);
    }
}
__device__ __forceinline__ float dpp_ror1(float x) { return __int_as_float(__builtin_amdgcn_mov_dpp(__float_as_int(x), 0x121, 0xf, 0xf, true)); }
__device__ __forceinline__ float dpp_ror2(float x) { return __int_as_float(__builtin_amdgcn_mov_dpp(__float_as_int(x), 0x122, 0xf, 0xf, true)); }
__device__ __forceinline__ float dpp_shr1(float old, float x) { return __int_as_float(__builtin_amdgcn_update_dpp(__float_as_int(old), __float_as_int(x), 0x111, 0xf, 0xf, false)); }
__device__ __forceinline__ float dpp_shr2(float old, float x) { return __int_as_float(__builtin_amdgcn_update_dpp(__float_as_int(old), __float_as_int(x), 0x112, 0xf, 0xf, false)); }
__device__ __forceinline__ u32x4 widen_pair(u32x2 x, u32x2 y) {
    const auto s0 = __builtin_amdgcn_permlane32_swap(x.x, y.x, false, false);
    const auto s1 = __builtin_amdgcn_permlane32_swap(x.y, y.y, false, false);
    u32x4 w; w.x = s0[0]; w.y = s1[0]; w.z = s0[1]; w.w = s1[1];
    return w;
}
__device__ __forceinline__ size_t gidx(int a, int r, int ch) {
    return (size_t)a * ((size_t)MTOK * 1024) + ((((size_t)(r >> 4) * 64 + (ch >> 4)) * 16 + (r & 15)) * 16 + (ch & 15));
}
struct EpiIn {
    static constexpr bool PERM = true, AFTER_DRAIN = false, MIDK = false;
    bf16_t* PA; bf16_t* G; const float* ssq; bf16_t* Y; bf16_t* sc; bf16_t* scb; const float* cw;
    __device__ __forceinline__ void operator()(const f32x4 (&acc)[2][2][4][2], const pg8::Unit& u, int wr, int wc, int fr, int fq) const {
        const int row0 = u.pm * 256 + wr * 64 + fr;
        float rs8[8];
#pragma unroll
        for (int i = 0; i < 8; ++i) rs8[i] = ssq[row0 + (i >> 2) * 128 + (i & 3) * 16];
        if (u.pn >= 16) {
            const int g4 = ((fq & 1) << 1) | (fq >> 1);
            const int q0 = (u.pn - 16) * 64 + wc * 16 + g4 * 4;
            const bool lower = fq < 2; const int qs = lower ? q0 : q0 - 4;
            const f32x4 w0 = *(const f32x4*)(cw + q0), w1 = *(const f32x4*)(cw + 512 + q0), w2 = *(const f32x4*)(cw + 1024 + q0);
#pragma unroll
            for (int ai = 0; ai < 2; ++ai) {
                f32x4 pz = {0.f, 0.f, 0.f, 0.f};
                const int blk = u.pm * 4 + ai * 2 + wr;
#pragma unroll
                for (int m = 0; m < 4; ++m) {
                    const float rs = rs8[ai * 4 + m];
                    const f32x4 cb = acc[ai][0][m][0] * rs, cc = acc[ai][0][m][1] * rs, cx = acc[ai][1][m][0] * rs, av = acc[ai][1][m][1] * rs;
                    const f32x4 z = cc * cx;
                    float y[4];
#pragma unroll
                    for (int j = 0; j < 4; ++j) {
                        const float z1 = dpp_shr1(dpp_ror1(pz[j]), z[j]), z2 = dpp_shr2(dpp_ror2(pz[j]), z[j]);
                        y[j] = cb[j] * fmaf(w0[j], z2, fmaf(w1[j], z1, w2[j] * z[j]));
                        asm volatile("" : "+v"(y[j]));
                    }
                    const int r = row0 + ai * 128 + m * 16;
                    u32x2 w;
                    {
                        u32x2 wa_, wy_; wa_.x = pk(av[0], av[1]); wa_.y = pk(av[2], av[3]); wy_.x = pk(y[0], y[1]); wy_.y = pk(y[2], y[3]);
                        const u32x4 ww = widen_pair(wa_, wy_);
                        bf16_t* dst = lower ? PA + (size_t)r * NPA2 + qs : Y + (size_t)r * NBR + 1024 + qs;
                        if (lower || !(m == 0 && fr < 2)) *(u32x4*)dst = ww;
                    }
                    if (m == 0 && fr < 2) {
                        w.x = pk(z[0], z[1]); w.y = pk(z[2], z[3]); *(u32x2*)(sc + ((size_t)blk * 4 + 2 + fr) * 512 + q0) = w;
                        w.x = pk(cb[0], cb[1]); w.y = pk(cb[2], cb[3]); *(u32x2*)(scb + ((size_t)blk * 2 + fr) * 512 + q0) = w;
                    }
                    if (m == 3 && fr >= 14) { w.x = pk(z[0], z[1]); w.y = pk(z[2], z[3]); *(u32x2*)(sc + ((size_t)blk * 4 + (fr - 14)) * 512 + q0) = w; }
                    pz = z;
                }
            }
        } else {
            const int g4 = ((fq & 1) << 1) | (fq >> 1);
            const int q0 = u.pn * 64 + wc * 16 + g4 * 4;
            const bool lower = fq < 2; const int qs = lower ? q0 : q0 - 4;
#pragma unroll
            for (int ai = 0; ai < 2; ++ai)
#pragma unroll
                for (int m = 0; m < 4; ++m) {
                    const float rs = rs8[ai * 4 + m], rsn = rs * -1.44269504f;
                    const f32x4 ga = acc[ai][0][m][0] * rsn, gb = acc[ai][0][m][1] * rsn, gc = acc[ai][1][m][0] * rsn, uv = acc[ai][1][m][1] * rs;
                    float r1[4], r2[4], s3[4], ug[4];
#pragma unroll
                    for (int j = 0; j < 4; ++j) {
                        const float ta = gate_t2(ga[j]), tb = gate_t2(gb[j]), tc = gate_t2(gc[j]);
                        r1[j] = tb * fast_rcp(ta); r2[j] = tc * fast_rcp(tb); s3[j] = fast_rcp(tc);
                        ug[j] = gelu_tanh_f(uv[j]);
                    }
                    const size_t ro = (size_t)(row0 + ai * 128 + m * 16) * NPA, rp = (size_t)(row0 + ai * 128 + m * 16) * NPA2;
                    u32x2 p1, p2, p3, p4;
                    p1.x = pk(r1[0], r1[1]); p1.y = pk(r1[2], r1[3]); p2.x = pk(r2[0], r2[1]); p2.y = pk(r2[2], r2[3]);
                    p3.x = pk(s3[0], s3[1]); p3.y = pk(s3[2], s3[3]); p4.x = pk(ug[0], ug[1]); p4.y = pk(ug[2], ug[3]);
                    const u32x4 wA = widen_pair(p1, p2), wB = widen_pair(p3, p4);
                    const int rr_ = row0 + ai * 128 + m * 16;
                    *(u32x4*)(G + gidx(lower ? 0 : 1, rr_, qs)) = wA;
                    *(u32x4*)(lower ? G + gidx(2, rr_, qs) : PA + rp + 512 + qs) = wB;
                }
        }
    }
};
struct EpiBr {
    static constexpr bool PERM = true, AFTER_DRAIN = false, MIDK = true;
    const bf16_t* G; bf16_t* out;
    __device__ __forceinline__ void mid(f32x4 (&acc)[2][2][4][2], const pg8::Unit& u, int t, int wr, int wc, int fr, int fq) const {
        const int seg = (t == 8) ? 0 : 1;
        int col0 = u.pn * 256 + wc * 32 + 8 * fq;
        int row0 = u.pm * 256 + wr * 64 + fr;
        asm volatile("" : "+v"(col0), "+v"(row0));
#pragma unroll
        for (int ai = 0; ai < 2; ++ai) {
            u32x4 nu[4][2];
#pragma unroll
            for (int m = 0; m < 4; ++m)
#pragma unroll
                for (int bj = 0; bj < 2; ++bj) nu[m][bj] = ld_nt16(G + gidx(seg, row0 + ai * 128 + m * 16, col0 + bj * 128));
            asm volatile("" ::: "memory");
#pragma unroll
            for (int m = 0; m < 4; ++m)
#pragma unroll
                for (int bj = 0; bj < 2; ++bj) {
                    const unsigned nw[4] = {nu[m][bj].x, nu[m][bj].y, nu[m][bj].z, nu[m][bj].w};
#pragma unroll
                    for (int q = 0; q < 4; ++q) { acc[ai][bj][m][q >> 1][(q & 1) * 2] *= bflo(nw[q]); acc[ai][bj][m][q >> 1][(q & 1) * 2 + 1] *= bfhi(nw[q]); }
                }
            asm volatile("" ::: "memory");
        }
    }
    __device__ __forceinline__ void operator()(const f32x4 (&acc)[2][2][4][2], const pg8::Unit& u, int wr, int wc, int fr, int fq) const {
        const int col0 = u.pn * 256 + wc * 32 + 8 * fq;
        const int row0 = u.pm * 256 + wr * 64 + fr;
        u32x4 sg[2][4][2];
#pragma unroll
        for (int ai = 0; ai < 2; ++ai)
#pragma unroll
            for (int m = 0; m < 4; ++m)
#pragma unroll
                for (int bj = 0; bj < 2; ++bj) sg[ai][m][bj] = ld_nt16(G + gidx(2, row0 + ai * 128 + m * 16, col0 + bj * 128));
#pragma unroll
        for (int ai = 0; ai < 2; ++ai)
#pragma unroll
            for (int m = 0; m < 4; ++m) {
                const int r = row0 + ai * 128 + m * 16;
                bf16_t* op = out + (size_t)r * DM + col0;
#pragma unroll
                for (int bj = 0; bj < 2; ++bj) {
                    const u32x4 s = sg[ai][m][bj];
                    const f32x4 a0 = acc[ai][bj][m][0], a1 = acc[ai][bj][m][1];
                    u32x4 w;
                    w.x = pk(a0[0] * bflo(s.x), a0[1] * bfhi(s.x)); w.y = pk(a0[2] * bflo(s.y), a0[3] * bfhi(s.y));
                    w.z = pk(a1[0] * bflo(s.z), a1[1] * bfhi(s.z)); w.w = pk(a1[2] * bflo(s.w), a1[3] * bfhi(s.w));
                    *(u32x4*)(op + bj * 128) = w;
                }
            }
    }
};
struct EpiRes {
    static constexpr bool PERM = true, AFTER_DRAIN = false, MIDK = false;
    bf16_t* xb; float* ssq;
    __device__ __forceinline__ void operator()(const f32x4 (&acc)[2][2][4][2], const pg8::Unit& u, int wr, int wc, int fr, int fq) const {
        const int col0 = u.pn * 256 + wc * 32 + 8 * fq;
        const int row0 = u.pm * 256 + wr * 64 + fr;
        u32x4 bb[2][4][2];
#pragma unroll
        for (int ai = 0; ai < 2; ++ai)
#pragma unroll
            for (int m = 0; m < 4; ++m)
#pragma unroll
                for (int bj = 0; bj < 2; ++bj) bb[ai][m][bj] = *(const u32x4*)(xb + (size_t)(row0 + ai * 128 + m * 16) * DM + col0 + bj * 128);
        asm volatile("" ::: "memory");
#pragma unroll
        for (int ai = 0; ai < 2; ++ai) {
#pragma unroll
            for (int m = 0; m < 4; ++m) {
                const int r = row0 + ai * 128 + m * 16;
                float sq = 0.f;
#pragma unroll
                for (int bj = 0; bj < 2; ++bj) {
                    const u32x4 s = bb[ai][m][bj];
                    const f32x4 a0 = acc[ai][bj][m][0], a1 = acc[ai][bj][m][1];
                    const float o0 = bflo(s.x) + a0[0], o1 = bfhi(s.x) + a0[1], o2 = bflo(s.y) + a0[2], o3 = bfhi(s.y) + a0[3];
                    const float o4 = bflo(s.z) + a1[0], o5 = bfhi(s.z) + a1[1], o6 = bflo(s.w) + a1[2], o7 = bfhi(s.w) + a1[3];
                    u32x4 w; w.x = pk(o0, o1); w.y = pk(o2, o3); w.z = pk(o4, o5); w.w = pk(o6, o7);
                    *(u32x4*)(xb + (size_t)r * DM + col0 + bj * 128) = w;
                    sq += (o0 * o0 + o1 * o1) + (o2 * o2 + o3 * o3) + (o4 * o4 + o5 * o5) + (o6 * o6 + o7 * o7);
                }
                sq += __shfl_xor(sq, 16); sq += __shfl_xor(sq, 32);
                if (fq == 0) ssq[(size_t)r * 16 + u.pn * 4 + wc] = sq;
            }
            asm volatile("" ::: "memory");
        }
    }
};
struct EpiUp {
    static constexpr bool PERM = true, AFTER_DRAIN = false, MIDK = false;
    bf16_t* act; bf16_t* zs; const float* ssq; const float* cw; const float* cb;
    __device__ __forceinline__ void operator()(const f32x4 (&acc)[2][2][4][2], const pg8::Unit& u, int wr, int wc, int fr, int fq) const {
        const int c0 = u.pn * 128 + wc * 32 + 8 * fq;
        const int row0 = u.pm * 256 + wr * 64 + fr;
        float rs8[8];
#pragma unroll
        for (int i = 0; i < 8; ++i) rs8[i] = ssq[row0 + (i >> 2) * 128 + (i & 3) * 16];
        u32x2 keep[2][4];
#pragma unroll
        for (int n = 0; n < 2; ++n) {
            const int c = c0 + 4 * n;
            const f32x4 gw0 = *(const f32x4*)(cw + c), gw1 = *(const f32x4*)(cw + NUP + c), gw2 = *(const f32x4*)(cw + 2 * NUP + c), gb = *(const f32x4*)(cb + c);
            const f32x4 vw0 = *(const f32x4*)(cw + DFF + c), vw1 = *(const f32x4*)(cw + NUP + DFF + c), vw2 = *(const f32x4*)(cw + 2 * NUP + DFF + c), vb = *(const f32x4*)(cb + DFF + c);
#pragma unroll
            for (int ai = 0; ai < 2; ++ai) {
                f32x4 pg = {0.f, 0.f, 0.f, 0.f}, pv = {0.f, 0.f, 0.f, 0.f};
                const int blk = u.pm * 4 + ai * 2 + wr;
#pragma unroll
                for (int m = 0; m < 4; ++m) {
                    const float rs = rs8[ai * 4 + m];
                    const f32x4 zg = acc[ai][0][m][n] * rs, zv = acc[ai][1][m][n] * rs;
                    float o[4];
#pragma unroll
                    for (int j = 0; j < 4; ++j) {
                        const float g1 = dpp_shr1(dpp_ror1(pg[j]), zg[j]), g2 = dpp_shr2(dpp_ror2(pg[j]), zg[j]);
                        const float v1 = dpp_shr1(dpp_ror1(pv[j]), zv[j]), v2 = dpp_shr2(dpp_ror2(pv[j]), zv[j]);
                        const float gg = fmaf(gw0[j], g2, fmaf(gw1[j], g1, fmaf(gw2[j], zg[j], gb[j])));
                        const float vv = fmaf(vw0[j], v2, fmaf(vw1[j], v1, fmaf(vw2[j], zv[j], vb[j])));
                        o[j] = silu_f(gg) * vv;
                    }
                    u32x2 w; w.x = pk(o[0], o[1]); w.y = pk(o[2], o[3]);
                    const int r = row0 + ai * 128 + m * 16;
                    if (n == 0) keep[ai][m] = w;
                    else if (!(m == 0 && fr < 2)) { u32x4 ww; ww.x = keep[ai][m].x; ww.y = keep[ai][m].y; ww.z = w.x; ww.w = w.y; st_nt16(act + (size_t)r * DFF + c0, ww); }
                    if (m == 0 && fr < 2) {
                        bf16_t* zp = zs + ((size_t)blk * 4 + 2 + fr) * NUP + c;
                        u32x2 a; a.x = pk(zg[0], zg[1]); a.y = pk(zg[2], zg[3]); *(u32x2*)zp = a;
                        u32x2 d; d.x = pk(zv[0], zv[1]); d.y = pk(zv[2], zv[3]); *(u32x2*)(zp + DFF) = d;
                    }
                    if (m == 3 && fr >= 14) {
                        bf16_t* zp = zs + ((size_t)blk * 4 + (fr - 14)) * NUP + c;
                        u32x2 a; a.x = pk(zg[0], zg[1]); a.y = pk(zg[2], zg[3]); *(u32x2*)zp = a;
                        u32x2 d; d.x = pk(zv[0], zv[1]); d.y = pk(zv[2], zv[3]); *(u32x2*)(zp + DFF) = d;
                    }
                    pg = zg; pv = zv;
                }
            }
        }
    }
};

__device__ __forceinline__ int win_dest_row(int col) {
    int ch, bj, n, t0;
    if (col < 512) { ch = col; bj = 1; n = 1; t0 = 16; }
    else if (col < 1536) { ch = col - 512; bj = 1; n = 1; t0 = 0; }
    else if (col < 3072) { const int s = (col - 1536) >> 9; ch = (col - 1536) & 511; bj = s >> 1; n = s & 1; t0 = 16; }
    else { const int gi = (col - 3072) >> 10; ch = (col - 3072) & 1023; bj = gi >> 1; n = gi & 1; t0 = 0; }
    const int k = t0 + (ch >> 6), r = ch & 63;
    const int g4 = (r >> 2) & 3, fqh = ((g4 & 1) << 1) | (g4 >> 1);
    return 256 * k + 128 * bj + 32 * (r >> 4) + 8 * fqh + 4 * n + (r & 3);
}
__device__ __forceinline__ void transpose_tile(const float* __restrict__ W, int N, const float* __restrict__ g, bf16_t* __restrict__ Wt, int ldt, int koff, int k0, int n0, int nd0, float* tile, int tid, bool winmap = false) {
    {
        const int kk = tid >> 4, nn = (tid & 15) * 4;
        f32x4 v[2][2]; float s[2];
#pragma unroll
        for (int h = 0; h < 2; ++h) { s[h] = g ? g[k0 + kk + h * 32] : 1.0f;
#pragma unroll
            for (int h2 = 0; h2 < 2; ++h2) v[h2][h] = *(const f32x4*)(W + (size_t)(k0 + kk + h * 32) * N + n0 + h2 * 64 + nn); }
#pragma unroll
        for (int h2 = 0; h2 < 2; ++h2)
#pragma unroll
            for (int h = 0; h < 2; ++h) { float* tp = tile + h2 * (64 * 65) + (kk + h * 32) * 65 + nn;
                tp[0] = v[h2][h][0] * s[h]; tp[1] = v[h2][h][1] * s[h]; tp[2] = v[h2][h][2] * s[h]; tp[3] = v[h2][h][3] * s[h]; }
    }
    __syncthreads();
    {
        const int n = tid >> 3, kq = (tid & 7) * 8;
#pragma unroll
        for (int h2 = 0; h2 < 2; ++h2) {
            float v[8];
#pragma unroll
            for (int j = 0; j < 8; ++j) v[j] = tile[h2 * (64 * 65) + (kq + j) * 65 + n];
            u32x4 w; w.x = pk(v[0], v[1]); w.y = pk(v[2], v[3]); w.z = pk(v[4], v[5]); w.w = pk(v[6], v[7]);
            *(u32x4*)(Wt + (size_t)(winmap ? win_dest_row(n0 + h2 * 64 + n) : nd0 + h2 * 64 + n) * ldt + koff + k0 + kq) = w;
        }
    }
    __syncthreads();
}

__device__ __forceinline__ void prep_phase(const Params& p, int l, float* ldsf) {
    unsigned char* ws = p.ws;
    bf16_t* wt_in = (bf16_t*)(ws + WS_WIN); bf16_t* wt_br = (bf16_t*)(ws + WS_WBR); bf16_t* wt_o = (bf16_t*)(ws + WS_WO);
    bf16_t* wt_up = (bf16_t*)(ws + WS_WUP); bf16_t* wt_dn = (bf16_t*)(ws + WS_WDN);
    const float* g_mix = p.in[1] + (size_t)l * DM; const float* w_in = p.in[2] + (size_t)l * DM * NIN;
    const float* w_pool = p.in[3] + (size_t)l * 4 * 128 * 128; const float* pscale = p.in[4] + (size_t)l * 512;
    const float* w_ba = p.in[9] + (size_t)l * 512 * DM; const float* w_bb = p.in[10] + (size_t)l * 512 * DM; const float* w_bc = p.in[11] + (size_t)l * 512 * DM;
    const float* w_o = p.in[12] + (size_t)l * DM * DM; const float* g_ffn = p.in[13] + (size_t)l * DM;
    const float* w_up = p.in[14] + (size_t)l * DM * NUP; const float* w_dn = p.in[17] + (size_t)l * DFF * DM;
    const int tid = otid(), bid = obid();
    constexpr int T0 = 16 * 48, T1 = T0 + 64, T2 = T1 + 64, T3 = T2 + 128, T4 = T3 + 16 * 44, T5 = T4 + 44 * 8;
    for (int i = bid; i < T5; i += gridDim.x) {
        if (i < T0) { const int kt = i & 15, nt = i >> 4; transpose_tile(w_in, NIN, g_mix, wt_in, DM, 0, kt * 64, nt * 128, nt * 128, ldsf, tid, true); }
        else if (i < T1) { const int j = i - T0, kt = j & 7, nt = j >> 3; transpose_tile(w_bb, DM, nullptr, wt_br, NBR, 512, kt * 64, nt * 128, nt * 128, ldsf, tid); }
        else if (i < T2) { const int j = i - T1, kt = j & 7, nt = j >> 3; transpose_tile(w_bc, DM, nullptr, wt_br, NBR, 1024, kt * 64, nt * 128, nt * 128, ldsf, tid); }
        else if (i < T3) { const int j = i - T2, kt = j & 15, nt = j >> 4; transpose_tile(w_o, DM, nullptr, wt_o, DM, 0, kt * 64, nt * 128, nt * 128, ldsf, tid); }
        else if (i < T4) { const int j = i - T3, kt = j & 15, nt = j >> 4; const int n0 = nt * 128, bj = n0 / DFF, q0 = n0 - bj * DFF; transpose_tile(w_up, NUP, g_ffn, wt_up, DM, 0, kt * 64, n0, (q0 >> 7) * 256 + bj * 128, ldsf, tid);   }
        else { const int j = i - T4, kt = j % 44, nt = j / 44; transpose_tile(w_dn, DM, nullptr, wt_dn, DFF, 0, kt * 64, nt * 128, nt * 128, ldsf, tid); }
    }
    {
        float* wpT = ldsf;
        float* wa = ldsf + 128 * 128;
        for (int it = (int)gridDim.x - 1 - bid; it < 64; it += gridDim.x) {
            const int g = it >> 4, n0 = (it & 15) * 64;
            for (int q = tid; q < 128 * 32; q += 512) {
                const int d = q >> 5, e4 = (q & 31) * 4;
                const f32x4 v = *(const f32x4*)(w_pool + ((size_t)g * 128 + d) * 128 + e4);
                const f32x4 s = *(const f32x4*)(pscale + g * 128 + e4);
                wpT[(e4 + 0) * 128 + d] = v[0] * s[0]; wpT[(e4 + 1) * 128 + d] = v[1] * s[1]; wpT[(e4 + 2) * 128 + d] = v[2] * s[2]; wpT[(e4 + 3) * 128 + d] = v[3] * s[3];
            }
            for (int q = tid; q < 128 * 16; q += 512) {
                const int e = q >> 4, c4 = (q & 15) * 4;
                *(f32x4*)(wa + e * 64 + c4) = *(const f32x4*)(w_ba + (size_t)(g * 128 + e) * DM + n0 + c4);
            }
            __syncthreads();
            const int d = tid & 127, ns = tid >> 7;
            float acc[16];
#pragma unroll
            for (int i = 0; i < 16; ++i) acc[i] = 0.f;
            for (int e = 0; e < 128; ++e) {
                const float w = wpT[e * 128 + d];
                const f32x4* wr4 = (const f32x4*)(wa + e * 64 + ns * 16);
#pragma unroll
                for (int c = 0; c < 4; ++c) { const f32x4 b = wr4[c]; acc[c * 4 + 0] += w * b[0]; acc[c * 4 + 1] += w * b[1]; acc[c * 4 + 2] += w * b[2]; acc[c * 4 + 3] += w * b[3]; }
            }
#pragma unroll
            for (int i = 0; i < 16; ++i) wt_br[(size_t)(n0 + ns * 16 + i) * NBR + g * 128 + d] = (bf16_t)(pk(acc[i], 0.f) & 0xffffu);
            __syncthreads();
        }
    }
    if (l != 0) {
        const float* ssq = (const float*)(ws + WS_SSQ); float* rstd1 = (float*)(ws + WS_RSTD);
        for (int r = bid * 512 + tid; r < MTOK; r += gridDim.x * 512) rstd1[r] = row_rstd(ssq, r);
    }
    if (l == 0) {
        const float* x = p.in[0]; bf16_t* xb = (bf16_t*)(ws + WS_XB); float* rstd1 = (float*)(ws + WS_RSTD);
        const int lane = tid & 63, wave = tid >> 6;
        for (int r0 = (bid * 8 + wave) * 2; r0 < MTOK; r0 += gridDim.x * 16) {
            f32x4 v[2][4];
#pragma unroll
            for (int rr = 0; rr < 2; ++rr)
#pragma unroll
                for (int i = 0; i < 4; ++i) v[rr][i] = *(const f32x4*)(x + (size_t)(r0 + rr) * DM + i * 256 + lane * 4);
#pragma unroll
            for (int rr = 0; rr < 2; ++rr) {
                const int r = r0 + rr;
                float sq = 0.f;
#pragma unroll
                for (int i = 0; i < 4; ++i) {
                    const f32x4 t = v[rr][i];
                    sq += (t[0] * t[0] + t[1] * t[1]) + (t[2] * t[2] + t[3] * t[3]);
                    u32x2 w; w.x = pk(t[0], t[1]); w.y = pk(t[2], t[3]);
                    *(u32x2*)(xb + (size_t)r * DM + i * 256 + lane * 4) = w;
                }
#pragma unroll
                for (int o = 32; o >= 1; o >>= 1) sq += __shfl_xor(sq, o);
                if (lane == 0) rstd1[r] = rsqrtf(sq * (1.0f / 1024.0f) + EPS);
            }
        }
    }
}
__device__ __forceinline__ void ld8(const bf16_t* p, float (&v)[8]) {
    const u32x4 w = *(const u32x4*)p;
    v[0] = bflo(w.x); v[1] = bfhi(w.x); v[2] = bflo(w.y); v[3] = bfhi(w.y); v[4] = bflo(w.z); v[5] = bfhi(w.z); v[6] = bflo(w.w); v[7] = bfhi(w.w);
}
__device__ __forceinline__ void st8(bf16_t* p, const float (&v)[8]) {
    u32x4 w; w.x = pk(v[0], v[1]); w.y = pk(v[2], v[3]); w.z = pk(v[4], v[5]); w.w = pk(v[6], v[7]);
    *(u32x4*)p = w;
}
template <int W> __device__ __forceinline__ void pool_rows(const bf16_t* __restrict__ ap, bf16_t* __restrict__ yp, int r0, int pos0) {
#pragma unroll
    for (int b = 0; b < 4; ++b) {
        const int base = r0 + 4 * b;
        u32x4 h[W + 3];
#pragma unroll
        for (int i = 0; i < W + 3; ++i) { const int rr = base - (W - 1) + i; h[i] = (pos0 + rr >= 0) ? *(const u32x4*)(ap + (ptrdiff_t)rr * NPA2) : (u32x4){0u, 0u, 0u, 0u}; }
        float s[8];
#pragma unroll
        for (int j = 0; j < 8; ++j) s[j] = 0.f;
#pragma unroll
        for (int i = 0; i < W - 1; ++i) { const u32x4 q = h[i];
            s[0] += bflo(q.x); s[1] += bfhi(q.x); s[2] += bflo(q.y); s[3] += bfhi(q.y); s[4] += bflo(q.z); s[5] += bfhi(q.z); s[6] += bflo(q.w); s[7] += bfhi(q.w); }
#pragma unroll
        for (int i = 0; i < 4; ++i) {
            const int rr = base + i, pos = pos0 + rr; const float inv = 1.0f / (float)(pos + 1 < W ? pos + 1 : W);
            const u32x4 q = h[W - 1 + i], od = h[i];
            const float v[8] = {bflo(q.x), bfhi(q.x), bflo(q.y), bfhi(q.y), bflo(q.z), bfhi(q.z), bflo(q.w), bfhi(q.w)};
            float o[8];
#pragma unroll
            for (int j = 0; j < 8; ++j) { s[j] += v[j]; o[j] = s[j] * inv - v[j]; }
            st8(yp + (size_t)rr * NBR, o);
            s[0] -= bflo(od.x); s[1] -= bfhi(od.x); s[2] -= bflo(od.y); s[3] -= bfhi(od.y); s[4] -= bflo(od.z); s[5] -= bfhi(od.z); s[6] -= bflo(od.w); s[7] -= bfhi(od.w);
        }
        asm volatile("" ::: "memory");
    }
}
constexpr int VT_PITCH = 136;
__device__ __forceinline__ void mixer_phase(const Params& p, int l, unsigned char* lds) {
    const bf16_t* PA = (const bf16_t*)(p.ws + WS_B1);
    bf16_t* Y = (bf16_t*)p.out;
    const float* g_sgu = p.in[5] + (size_t)l * 512;
    const float* w_sp = p.in[6] + (size_t)l * 4 * 128 * 128;
    const float* b_sp = p.in[7] + (size_t)l * 4 * 128;
    const float* conv_c = p.in[8] + (size_t)l * 3 * 512;
    float* rs = (float*)lds;
    bf16_t* vT = (bf16_t*)(lds + 1024);
    const int tid = otid(), lane = tid & 63, wave = __builtin_amdgcn_readfirstlane(tid >> 6), fr = lane & 15, fq = lane >> 4;
    for (int item = obid(); item < MTOK / 128; item += gridDim.x) {
        const int t0 = item * 128, pos0 = t0 & (SEQ - 1);
        {
            const int row = tid >> 2, q = tid & 3;
            const bf16_t* vp = PA + (size_t)(t0 + row) * NPA2 + 1024 + q * 128;
            float sq = 0.f;
#pragma unroll
            for (int i = 0; i < 16; ++i) { float v[8]; ld8(vp + i * 8, v);
#pragma unroll
                for (int j = 0; j < 8; ++j) sq += v[j] * v[j]; }
            sq += __shfl_xor(sq, 1); sq += __shfl_xor(sq, 2);
            if (q == 0) rs[row] = rsqrtf(sq * (1.0f / 512.0f) + EPS);
        }
        {
            const int grp = wave & 3;
            const int c8 = (grp * 16 + (lane & 15)) * 8; int r0 = ((wave >> 2) * 4 + (lane >> 4)) * 16;
            asm volatile("" : "+v"(r0));
            {
                const bf16_t* ap = PA + (size_t)t0 * NPA2 + c8;
                bf16_t* yp = Y + (size_t)t0 * NBR + c8;
                if (grp == 0) pool_rows<2>(ap, yp, r0, pos0); else if (grp == 1) pool_rows<4>(ap, yp, r0, pos0); else if (grp == 2) pool_rows<8>(ap, yp, r0, pos0); else pool_rows<16>(ap, yp, r0, pos0);
            }
        }
        if (tid < 256) {
            const bf16_t* sc = (const bf16_t*)(p.ws + WS_SC); const bf16_t* scb = (const bf16_t*)(p.ws + WS_SCB);
            const int b_ = tid >> 7, ri = (tid >> 6) & 1, c8 = (tid & 63) * 8;
            const int blk = (t0 >> 6) + b_;
            const bool first = ((blk * 64) & (SEQ - 1)) == 0;
            float z2[8], z1[8], z0[8], cbv[8], o[8];
#pragma unroll
            for (int j = 0; j < 8; ++j) { z2[j] = 0.f; z1[j] = 0.f; }
            const bf16_t* own = sc + (size_t)blk * 4 * 512 + c8;
            if (ri == 0) { if (!first) { ld8(own - 4 * 512, z2); ld8(own - 3 * 512, z1); } ld8(own + 2 * 512, z0); }
            else { if (!first) ld8(own - 3 * 512, z2); ld8(own + 2 * 512, z1); ld8(own + 3 * 512, z0); }
            ld8(scb + ((size_t)blk * 2 + ri) * 512 + c8, cbv);
#pragma unroll
            for (int j = 0; j < 8; ++j) o[j] = 0.f;
            { const f32x4 a0 = *(const f32x4*)(conv_c + c8), a1 = *(const f32x4*)(conv_c + c8 + 4), b0 = *(const f32x4*)(conv_c + 512 + c8), b1 = *(const f32x4*)(conv_c + 512 + c8 + 4), c0 = *(const f32x4*)(conv_c + 1024 + c8), c1 = *(const f32x4*)(conv_c + 1024 + c8 + 4);
#pragma unroll
              for (int j = 0; j < 4; ++j) { o[j] = cbv[j] * fmaf(a0[j], z2[j], fmaf(b0[j], z1[j], c0[j] * z0[j])); o[4 + j] = cbv[4 + j] * fmaf(a1[j], z2[4 + j], fmaf(b1[j], z1[4 + j], c1[j] * z0[4 + j])); } }
            st8(Y + (size_t)(blk * 64 + ri) * NBR + 1024 + c8, o);
        }
#pragma unroll 1
        for (int g = 0; g < 4; ++g) {
            const int t = wave * 16 + fr;
            const int nk = (wave >> 1) + 1;
            f32x4 wq[4][2];
#pragma unroll
            for (int k = 0; k < 4; ++k) { const float* wp = w_sp + ((size_t)g * 128 + t) * 128 + k * 32 + fq * 8; wq[k][0] = *(const f32x4*)wp; wq[k][1] = *(const f32x4*)(wp + 4); }
            const bf16_t* up = PA + (size_t)(t0 + t) * NPA2 + 512 + g * 128 + 8 * fq;
            u32x4 uu[4];
#pragma unroll
            for (int pq = 0; pq < 4; ++pq) uu[pq] = *(const u32x4*)(up + pq * 32);
            const float bias = b_sp[g * 128 + t];
            u32x4 vq[4];
            const int s_ = tid >> 2, dq = (tid & 3) * 32;
            {
                const bf16_t* vp = PA + (size_t)(t0 + s_) * NPA2 + 1024 + g * 128 + dq;
#pragma unroll
                for (int i = 0; i < 4; ++i) vq[i] = *(const u32x4*)(vp + i * 8);
            }
            __syncthreads();
#pragma unroll
            for (int i = 0; i < 4; ++i) {
                const unsigned ww[4] = {vq[i].x, vq[i].y, vq[i].z, vq[i].w};
#pragma unroll
                for (int q = 0; q < 4; ++q) { vT[(dq + i * 8 + q * 2) * VT_PITCH + s_] = (bf16_t)(ww[q] & 0xffffu); vT[(dq + i * 8 + q * 2 + 1) * VT_PITCH + s_] = (bf16_t)(ww[q] >> 16); }
            }
            __syncthreads();
            f32x4 acc[8];
#pragma unroll
            for (int n = 0; n < 8; ++n) acc[n] = (f32x4){0.f, 0.f, 0.f, 0.f};
#pragma unroll
            for (int k = 0; k < 4; ++k) if (k < nk) {
                const int s0 = k * 32 + fq * 8;
                const f32x4 wa = wq[k][0], wb = wq[k][1];
                const f32x4 ra = *(const f32x4*)(rs + s0), rb = *(const f32x4*)(rs + s0 + 4);
                float a[8];
#pragma unroll
                for (int j = 0; j < 4; ++j) { a[j] = (s0 + j <= t) ? wa[j] * ra[j] : 0.f; a[4 + j] = (s0 + 4 + j <= t) ? wb[j] * rb[j] : 0.f; }
                union { u32x4 u; bf16x8 h; } af; af.u.x = pk(a[0], a[1]); af.u.y = pk(a[2], a[3]); af.u.z = pk(a[4], a[5]); af.u.w = pk(a[6], a[7]);
#pragma unroll
                for (int n = 0; n < 8; ++n) {
                    const bf16x8 bfrag = *(const bf16x8*)(vT + (32 * (n >> 1) + 8 * (fr >> 2) + 4 * (n & 1) + (fr & 3)) * VT_PITCH + s0);
                    acc[n] = __builtin_amdgcn_mfma_f32_16x16x32_bf16(bfrag, af.h, acc[n], 0, 0, 0);
                }
            }
            bf16_t* yp = Y + (size_t)(t0 + t) * NBR + 512 + g * 128 + 8 * fq;
#pragma unroll
            for (int pq = 0; pq < 4; ++pq) {
                const f32x4 gs0 = *(const f32x4*)(g_sgu + g * 128 + pq * 32 + 8 * fq), gs1 = *(const f32x4*)(g_sgu + g * 128 + pq * 32 + 8 * fq + 4);
                const f32x4 a0 = acc[2 * pq], a1 = acc[2 * pq + 1];
                const u32x4 uq = uu[pq];
                const float o0 = bflo(uq.x) * (a0[0] * gs0[0] + bias), o1 = bfhi(uq.x) * (a0[1] * gs0[1] + bias);
                const float o2 = bflo(uq.y) * (a0[2] * gs0[2] + bias), o3 = bfhi(uq.y) * (a0[3] * gs0[3] + bias);
                const float o4 = bflo(uq.z) * (a1[0] * gs1[0] + bias), o5 = bfhi(uq.z) * (a1[1] * gs1[1] + bias);
                const float o6 = bflo(uq.w) * (a1[2] * gs1[2] + bias), o7 = bfhi(uq.w) * (a1[3] * gs1[3] + bias);
                u32x4 w; w.x = pk(o0, o1); w.y = pk(o2, o3); w.z = pk(o4, o5); w.w = pk(o6, o7);
                *(u32x4*)(yp + pq * 32) = w;
            }
        }
        __syncthreads();
    }
}

__device__ __forceinline__ void rstd_finalize_phase(const Params& p) {
    const float* ssq = (const float*)(p.ws + WS_SSQ); float* rstd = (float*)(p.ws + WS_RSTD);
    for (int r = obid() * 512 + otid(); r < MTOK; r += gridDim.x * 512) rstd[r] = row_rstd(ssq, r);
}

__device__ __forceinline__ void ffn_fixup_phase(const Params& p, int l) {
    const bf16_t* zs = (const bf16_t*)(p.ws + WS_B2);
    bf16_t* act = (bf16_t*)(p.ws + WS_B1);
    const float* cw = p.in[15] + (size_t)l * 3 * NUP; const float* cb = p.in[16] + (size_t)l * NUP;
    constexpr int NCG = DFF / 8, NU = (MTOK / 64) * NCG;
    for (int u = obid() * 512 + otid(); u < NU; u += gridDim.x * 512) {
        const int blk = u / NCG, c8 = (u - blk * NCG) * 8;
        const bool first = ((blk * 64) & (SEQ - 1)) == 0;
        float g2[8], g1[8], ga[8], gb2[8], v2[8], v1[8], va[8], vb2[8];
#pragma unroll
        for (int j = 0; j < 8; ++j) { g2[j] = g1[j] = v2[j] = v1[j] = 0.f; }
        const bf16_t* own = zs + (size_t)blk * 4 * NUP + c8;
        if (!first) { const bf16_t* prv = own - 4 * (ptrdiff_t)NUP; ld8(prv, g2); ld8(prv + NUP, g1); ld8(prv + DFF, v2); ld8(prv + NUP + DFF, v1); }
        ld8(own + 2 * NUP, ga); ld8(own + 3 * NUP, gb2); ld8(own + 2 * NUP + DFF, va); ld8(own + 3 * NUP + DFF, vb2);
        float o0[8], o1[8];
        float w0[8], w1[8], w2[8], bb[8], x0[8], x1[8], x2[8], xb_[8];
        { const f32x4* q;
#define LD8F(dst, ptr) q = (const f32x4*)(ptr); { const f32x4 a_ = q[0], b_ = q[1]; dst[0] = a_[0]; dst[1] = a_[1]; dst[2] = a_[2]; dst[3] = a_[3]; dst[4] = b_[0]; dst[5] = b_[1]; dst[6] = b_[2]; dst[7] = b_[3]; }
          LD8F(w0, cw + c8) LD8F(w1, cw + NUP + c8) LD8F(w2, cw + 2 * NUP + c8) LD8F(bb, cb + c8)
          LD8F(x0, cw + DFF + c8) LD8F(x1, cw + NUP + DFF + c8) LD8F(x2, cw + 2 * NUP + DFF + c8) LD8F(xb_, cb + DFF + c8)
#undef LD8F
        }
#pragma unroll
        for (int j = 0; j < 8; ++j) {
            const float gg0 = w0[j] * g2[j] + w1[j] * g1[j] + w2[j] * ga[j] + bb[j], vv0 = x0[j] * v2[j] + x1[j] * v1[j] + x2[j] * va[j] + xb_[j];
            const float gg1 = w0[j] * g1[j] + w1[j] * ga[j] + w2[j] * gb2[j] + bb[j], vv1 = x0[j] * v1[j] + x1[j] * va[j] + x2[j] * vb2[j] + xb_[j];
            o0[j] = silu_f(gg0) * vv0; o1[j] = silu_f(gg1) * vv1;
        }
        st8(act + (size_t)(blk * 64) * DFF + c8, o0); st8(act + (size_t)(blk * 64 + 1) * DFF + c8, o1);
    }
}

__device__ __forceinline__ void final_norm_phase(const Params& p) {
    const float* gf = p.in[18]; const float* ssq = (const float*)(p.ws + WS_SSQ); const bf16_t* xb = (const bf16_t*)(p.ws + WS_XB); float* out = p.out;
    const int tid = otid(), lane = tid & 63, wave = tid >> 6;
    for (int r0 = (obid() * 8 + wave) * 2; r0 < MTOK; r0 += gridDim.x * 16) {
        u32x4 xv[2][2]; float rs[2];
#pragma unroll
        for (int rr = 0; rr < 2; ++rr) {
            rs[rr] = row_rstd(ssq, r0 + rr);
#pragma unroll
            for (int i = 0; i < 2; ++i) xv[rr][i] = *(const u32x4*)(xb + (size_t)(r0 + rr) * DM + i * 512 + lane * 8);
        }
#pragma unroll
        for (int rr = 0; rr < 2; ++rr)
#pragma unroll
            for (int i = 0; i < 2; ++i) {
                const int cc = i * 512 + lane * 8;
                const u32x4 q = xv[rr][i];
                const float v[8] = {bflo(q.x), bfhi(q.x), bflo(q.y), bfhi(q.y), bflo(q.z), bfhi(q.z), bflo(q.w), bfhi(q.w)};
                const f32x4 g0 = *(const f32x4*)(gf + cc), g1 = *(const f32x4*)(gf + cc + 4);
                f32x4 o0, o1;
#pragma unroll
                for (int j = 0; j < 4; ++j) { o0[j] = v[j] * rs[rr] * g0[j]; o1[j] = v[4 + j] * rs[rr] * g1[j]; }
                float* qo = out + (size_t)(r0 + rr) * DM + cc;
                __builtin_nontemporal_store(o0, (f32x4*)qo); __builtin_nontemporal_store(o1, (f32x4*)(qo + 4));
            }
    }
}

template <class Epi> __device__ __forceinline__ void run_gemm(unsigned char* lds, const bf16_t* A, const bf16_t* Bt, int M, int N, int K, const Epi& E, int stagger_step = 0) {
    pg8::Gemm g{A, Bt, M, N, K}; pg8::StaticOrder S; S.init(M, N, (int)gridDim.x, obid());
    if (stagger_step) {
        const unsigned long long t0 = wall_clock64(), d = (unsigned long long)(((obid() >> 3) & 7) * stagger_step);
        while (wall_clock64() - t0 < d) __builtin_amdgcn_s_sleep(16);
    }
    pg8::gemm_phase<Epi, pg8::StaticOrder, false>((PG8_LAS unsigned char*)lds, g, S, E, nullptr);
}

#define XB_TMO      128
#define XB_XCNT(j)  (256  + 64 * (j))
#define XB_XSUB(j)  (1280 + 64 * (j))
#define XB_XGEN(j)  (2304 + 64 * (j))
#define XB_TOP      3328
#define XB_TOPGEN   3392
#define XCD_BAR_WORDS 3456
#define XB_SPIN_CAP (1u << 18)

__device__ __forceinline__ unsigned xb_ld(unsigned* p)              { return __hip_atomic_load(p, __ATOMIC_RELAXED, __HIP_MEMORY_SCOPE_AGENT); }
__device__ __forceinline__ unsigned xb_add(unsigned* p, unsigned v) { return __hip_atomic_fetch_add(p, v, __ATOMIC_RELAXED, __HIP_MEMORY_SCOPE_AGENT); }
__device__ __forceinline__ unsigned xb_xcc_id() { return (unsigned)__builtin_amdgcn_s_getreg((3 << 11) | 20) & 0xFu; }
#define XB_SPIN(cond, bar) do { unsigned _sp = 0; while (cond) { __builtin_amdgcn_s_sleep(1); \
    if ((++_sp & 255u) == 0u) { if (xb_ld(&(bar)[XB_TMO])) break; if (_sp > XB_SPIN_CAP) { atomicAdd(&(bar)[XB_TMO], 1u); break; } } } } while (0)

struct XcdBarrier {
    unsigned* bar; unsigned x;
    volatile LAS unsigned* st;
};

__device__ __forceinline__ XcdBarrier xcd_barrier_post(unsigned* bar, volatile LAS unsigned* st) {
    XcdBarrier b; b.bar = bar; b.x = xb_xcc_id(); b.st = st;
    if (threadIdx.x == 0) (void)xb_add(&bar[XB_XCNT(b.x)], 1u);
    return b;
}
__device__ __forceinline__ void xcd_barrier_complete(unsigned* bar, unsigned x, unsigned& nloc, unsigned& nx) {
    const unsigned G = gridDim.x * gridDim.y * gridDim.z;
    unsigned sum, cnt, mine, sp = 0u;
    for (;;) {
        sum = 0u; cnt = 0u; mine = 0u;
#pragma unroll
        for (unsigned j = 0; j < 16; ++j) { const unsigned c = xb_ld(&bar[XB_XCNT(j)]); sum += c; cnt += (c > 0u) ? 1u : 0u; mine = (j == x) ? c : mine; }
        if (sum == G) break;
        __builtin_amdgcn_s_sleep(1);
        if ((++sp & 255u) == 0u) { if (xb_ld(&bar[XB_TMO])) break; if (sp > XB_SPIN_CAP) { atomicAdd(&bar[XB_TMO], 1u); break; } }
    }
    nloc = mine > 0u ? mine : 1u; nx = cnt > 0u ? cnt : 1u;
}

__device__ __forceinline__ void xcd_barrier(const XcdBarrier& b) {
    asm volatile("s_waitcnt vmcnt(0)" ::: "memory");
    __syncthreads();
    if (threadIdx.x == 0) {
        unsigned* bar = b.bar;
        __builtin_amdgcn_s_waitcnt(0);
        unsigned nloc = b.st[0], nx = b.st[1];
        if (nloc == 0u) { xcd_barrier_complete(bar, b.x, nloc, nx); b.st[0] = nloc; b.st[1] = nx; }
        const unsigned old = xb_add(&bar[XB_XSUB(b.x)], 1u);
        const unsigned gen = old / nloc;
        if (old + 1u == (gen + 1u) * nloc) {
            __builtin_amdgcn_fence(__ATOMIC_RELEASE, "agent");
            asm volatile("s_waitcnt vmcnt(0)" ::: "memory");
            const unsigned og = xb_add(&bar[XB_TOP], 1u);
            const unsigned tg = og / nx;
            if (og + 1u == (tg + 1u) * nx) xb_add(&bar[XB_TOPGEN], 1u);
            else XB_SPIN(xb_ld(&bar[XB_TOPGEN]) == tg, bar);
            __builtin_amdgcn_fence(__ATOMIC_ACQUIRE, "agent");
            xb_add(&bar[XB_XGEN(b.x)], 1u);
            asm volatile("s_waitcnt vmcnt(0)" ::: "memory");
        } else {
            XB_SPIN(xb_ld(&bar[XB_XGEN(b.x)]) == gen, bar);
            __builtin_amdgcn_fence(__ATOMIC_ACQUIRE, "agent");
            asm volatile("s_waitcnt vmcnt(0)" ::: "memory");
        }
    }
    __syncthreads();
}

typedef const Params __attribute__((address_space(4)))* ParamsK;
__device__ __forceinline__ Params fresh_params() {
    ParamsK q = (ParamsK)__builtin_amdgcn_kernarg_segment_ptr();
    asm volatile("" : "+s"(q));
    Params r;
#pragma unroll
    for (int i = 0; i < 19; ++i) r.in[i] = q->in[i];
    r.out = q->out; r.ws = q->ws;
    return r;
}
constexpr int LDS_TOTAL = pg8::STAGE_BYTES + 256;
__global__ void __launch_bounds__(512, 2) fwd_megakernel(Params p_unused) {
    extern __shared__ __attribute__((aligned(16))) unsigned char lds[];
    cg::grid_group grid = cg::this_grid();
    volatile LAS unsigned* st = (volatile LAS unsigned*)((LAS unsigned char*)lds + pg8::STAGE_BYTES);
    unsigned* bar;
    {
        const Params p = fresh_params(); bar = (unsigned*)(p.ws + WS_BAR);
        if (threadIdx.x < 4) st[threadIdx.x] = 0u;
        if (blockIdx.x == 0) for (int i = threadIdx.x; i < XCD_BAR_WORDS; i += 512) bar[i] = 0u;
        __syncthreads();
    }
#define WSP(off) ((bf16_t*)(p.ws + (off)))
#define GRID_BAR() do { XcdBarrier b_; b_.bar = (unsigned*)(fresh_params().ws + WS_BAR); b_.x = xb_xcc_id(); b_.st = (volatile LAS unsigned*)((LAS unsigned char*)lds + pg8::STAGE_BYTES); xcd_barrier(b_); } while (0)
    for (int l = 0; l < 2; ++l) {
        { const Params p = fresh_params(); prep_phase(p, l, (float*)lds); }
        if (l == 0) { grid.sync(); (void)xcd_barrier_post((unsigned*)(fresh_params().ws + WS_BAR), (volatile LAS unsigned*)((LAS unsigned char*)lds + pg8::STAGE_BYTES)); }
        else GRID_BAR();
        { const Params p = fresh_params(); EpiIn E{WSP(WS_B1), WSP(WS_B2), (const float*)(p.ws + WS_RSTD), (bf16_t*)p.out, WSP(WS_SC), WSP(WS_SCB), p.in[8] + (size_t)l * 3 * 512}; run_gemm(lds, WSP(WS_XB), WSP(WS_WIN), MTOK, NIN, DM, E); }
        GRID_BAR();
        { const Params p = fresh_params(); mixer_phase(p, l, lds); }
        GRID_BAR();
        { const Params p = fresh_params(); EpiBr E{WSP(WS_B2), WSP(WS_B1)}; run_gemm(lds, (const bf16_t*)p.out  , WSP(WS_WBR), MTOK, DM, NBR, E); }
        GRID_BAR();
        { const Params p = fresh_params(); EpiRes E{WSP(WS_XB), (float*)(p.ws + WS_SSQ)}; run_gemm(lds, WSP(WS_B1), WSP(WS_WO), MTOK, DM, DM, E); }
        GRID_BAR();
        { const Params p = fresh_params(); rstd_finalize_phase(p); }
        GRID_BAR();
        { const Params p = fresh_params(); EpiUp E{WSP(WS_B1), WSP(WS_B2), (const float*)(p.ws + WS_RSTD), p.in[15] + (size_t)l * 3 * NUP, p.in[16] + (size_t)l * NUP}; run_gemm(lds, WSP(WS_XB), WSP(WS_WUP), MTOK, NUP, DM, E); }
        GRID_BAR();
        { const Params p = fresh_params(); ffn_fixup_phase(p, l); }
        GRID_BAR();
        { const Params p = fresh_params(); EpiRes E{WSP(WS_XB), (float*)(p.ws + WS_SSQ)}; run_gemm(lds, WSP(WS_B1), WSP(WS_WDN), MTOK, DM, DFF, E); }
        GRID_BAR();
    }
    { const Params p = fresh_params(); final_norm_phase(p); }
#undef WSP
#undef GRID_BAR
}

extern "C" void kernel_launch(void* const* d_in, const int* in_sizes, int n_in, void* d_out, int out_size, void* d_ws, size_t ws_size, hipStream_t stream) {
    constexpr size_t kLds = LDS_TOTAL;
    static int grid_blocks = 0;
    if (!grid_blocks) {
        int dev = 0, cus = 0, per_cu = 0;
        (void)hipGetDevice(&dev);
        (void)hipDeviceGetAttribute(&cus, hipDeviceAttributeMultiprocessorCount, dev);
        (void)hipFuncSetAttribute((const void*)fwd_megakernel, hipFuncAttributeMaxDynamicSharedMemorySize, (int)kLds);
        (void)hipOccupancyMaxActiveBlocksPerMultiprocessor(&per_cu, (const void*)fwd_megakernel, 512, kLds);
        if (per_cu < 1) per_cu = 1;
        grid_blocks = cus;
        if (ws_size < WS_TOTAL || n_in != 19 || out_size != MTOK * DM) { fprintf(stderr, "kernel_launch: unexpected sizes: ws %zu (need %zu), n_in %d, out %d\n", ws_size, (size_t)WS_END, n_in, out_size); }
    }
    Params p{};
    for (int i = 0; i < 19; ++i) p.in[i] = (const float*)d_in[i];
    p.out = (float*)d_out; p.ws = (unsigned char*)d_ws;
    void* args[] = {&p};
    hipError_t e = hipLaunchCooperativeKernel((void*)fwd_megakernel, dim3(grid_blocks), dim3(512), args, kLds, stream);
    if (e != hipSuccess) fprintf(stderr, "cooperative launch failed: %s (grid %d)\n", hipGetErrorString(e), grid_blocks);
}
```

```cpp
#include <hip/hip_runtime.h>
#include <hip/hip_cooperative_groups.h>
#include <cstdio>
namespace cg = cooperative_groups;
namespace pg8 {
#define PG8_LAS __attribute__((address_space(3)))
typedef unsigned short bf16_t;
typedef short bf16x8 __attribute__((ext_vector_type(8)));
typedef float f32x4 __attribute__((ext_vector_type(4)));
typedef unsigned u32x4 __attribute__((ext_vector_type(4)));
constexpr int BM = 256, BK = 64, HALF = 128, HTB = HALF * BK * 2  , STAGE_BYTES = 8 * HTB, NXCD = 8, WGM = 8;

__host__ __device__ __forceinline__ int lds_byte(int r, int c) { const int st = (r >> 4) * 2 + (c >> 5), rr = r & 15, cc = c & 31, ob = rr * 64 + cc * 2; return st * 1024 + (ob ^ (((ob >> 9) & 1) << 5)); }
__host__ __device__ __forceinline__ void stage_rc(int b, int& R, int& C) { const int st = b / 1024, sb = b % 1024, swz = sb ^ (((sb >> 9) & 1) << 5); R = (st >> 1) * 16 + swz / 64; C = (st & 1) * 32 + (swz % 64) / 2; }
__host__ __device__ __forceinline__ int perm32(int rho) { const int n = rho >> 4, i = rho & 15; return 8 * (i >> 2) + 4 * n + (i & 3); }

struct Unit { int pm, pn; };
struct Gemm { const bf16_t* A; const bf16_t* Bt; int M, N, K; };

struct StaticOrder {
    int nM, nN, nwg, G, c;
    __host__ __device__ void init(int M, int N, int G_, int c_) { nM = M / BM; nN = N / BM; nwg = nM * nN; G = G_; c = c_; }
    __host__ __device__ bool next(int i, Unit& u) const {
        const long L = (long)i * G + c; if (L >= nwg) return false;
        int wgid = (int)L; { const int q = nwg / NXCD, r = nwg % NXCD, xcd = wgid % NXCD, off = wgid / NXCD; wgid = (xcd < r ? xcd * (q + 1) : r * (q + 1) + (xcd - r) * q) + off; }
        const int nig = WGM * nN, gid = wgid / nig, fm = gid * WGM, gsz = (nM - fm) < WGM ? (nM - fm) : WGM;
        u.pm = fm + ((wgid % nig) % gsz); u.pn = (wgid % nig) / gsz; return true;
    }
    __device__ __forceinline__ void a_ready(const Unit&) const {}
    __device__ __forceinline__ void done(const Unit&) const {}
};
__device__ __forceinline__ unsigned cvt_pk_bf16(float lo, float hi) { unsigned r; asm volatile("v_cvt_pk_bf16_f32 %0, %1, %2" : "=v"(r) : "v"(lo), "v"(hi)); return r; }

template <class Epi, class Sched, bool STAMP = false>
__device__ __forceinline__ void gemm_phase(PG8_LAS unsigned char* lds, const Gemm g, const Sched& S, const Epi& E, unsigned long long* stamps) {
    int tid_ = threadIdx.x; asm volatile("" : "+v"(tid_));
    const int tid = tid_, wid = __builtin_amdgcn_readfirstlane(tid >> 6), lane = tid & 63, wr = wid >> 2, wc = wid & 3, fr = lane & 15, fq = lane >> 4;
    const int K = g.K, nt = K / BK;
    int ts_lo = 0, ts_hi = 0, nts = 0; const unsigned long long rt_entry = STAMP ? (unsigned long long)wall_clock64() : 0ull;
#define PG8_STAMP() do { if (STAMP && wid == 0 && nts < 64) { const unsigned long long _c = (unsigned long long)clock64(); \
        ts_lo = (lane == nts) ? (int)(unsigned)_c : ts_lo; ts_hi = (lane == nts) ? (int)(unsigned)(_c >> 32) : ts_hi; ++nts; } } while (0)
    PG8_STAMP();
    unsigned voffA[2], voffB[2];
#pragma unroll
    for (int i = 0; i < 2; ++i) { int R, C; stage_rc(tid * 16 + i * 8192, R, C); const int Rb = Epi::PERM ? ((R & ~31) + perm32(R & 31)) : R;
        voffA[i] = (unsigned)(R * K + C) * 2u; voffB[i] = (unsigned)(Rb * K + C) * 2u; }
    const size_t kstep = (size_t)(BK * 2);
    const size_t hstep = (size_t)HALF * K * 2;
    const size_t tstep = 2 * hstep;
    const unsigned ldsw = (unsigned)wid * 1024u;
    const int aoff = lds_byte(wr * 64 + fr, fq * 8), boff = lds_byte(wc * 32 + fr, fq * 8);
#define PG8_SA(b, h) (((b) * 2 + (h)) * HTB)
#define PG8_SB(b, h) ((4 + (b) * 2 + (h)) * HTB)
#define PG8_STAGE(bufoff, gbase, voff) do { _Pragma("unroll") for (int _i = 0; _i < 2; ++_i) \
        __builtin_amdgcn_global_load_lds((const unsigned*)((const char*)(gbase) + (voff)[_i]), (PG8_LAS unsigned*)(lds + (bufoff) + ldsw + _i * 8192), 16, 0, 0); } while (0)
#define PG8_LDA(dst, b, h) do { _Pragma("unroll") for (int m = 0; m < 4; ++m) _Pragma("unroll") for (int k = 0; k < 2; ++k) dst[m][k] = *(const PG8_LAS bf16x8*)(lds + PG8_SA(b, h) + aoff + m * 2048 + k * 1024); } while (0)
#define PG8_LDB(dst, b, h) do { _Pragma("unroll") for (int n = 0; n < 2; ++n) _Pragma("unroll") for (int k = 0; k < 2; ++k) dst[n][k] = *(const PG8_LAS bf16x8*)(lds + PG8_SB(b, h) + boff + n * 2048 + k * 1024); } while (0)
#define PG8_MMA(ai, bj, At, Bt) do { __builtin_amdgcn_s_setprio(1); _Pragma("unroll") for (int m = 0; m < 4; ++m) _Pragma("unroll") for (int n = 0; n < 2; ++n) _Pragma("unroll") for (int k = 0; k < 2; ++k) \
        acc[ai][bj][m][n] = __builtin_amdgcn_mfma_f32_16x16x32_bf16(Bt[n][k], At[m][k], acc[ai][bj][m][n], 0, 0, 0); __builtin_amdgcn_s_setprio(0); } while (0)
#define PG8_WAIT_V(n) asm volatile("s_waitcnt vmcnt(" #n ")" ::: "memory")
#define PG8_WAIT_L(n) asm volatile("s_waitcnt lgkmcnt(" #n ")" ::: "memory")
#define PG8_BAR __builtin_amdgcn_s_barrier()
#define PG8_SCHED __builtin_amdgcn_sched_barrier(0)
    Unit cur, nxt; int ui = 0;
    if (!S.next(0, cur)) return;
    f32x4 acc[2][2][4][2];
#pragma unroll
    for (int a = 0; a < 2; ++a)
#pragma unroll
        for (int b = 0; b < 2; ++b)
#pragma unroll
            for (int m = 0; m < 4; ++m)
#pragma unroll
                for (int n = 0; n < 2; ++n) acc[a][b][m][n] = (f32x4){0.f, 0.f, 0.f, 0.f};
    bf16x8 At[4][2], B0[2][2], B1[2][2];
    const char* cA = (const char*)g.A + (size_t)cur.pm * tstep; const char* cB = (const char*)g.Bt + (size_t)cur.pn * tstep;
    S.a_ready(cur);
    PG8_STAGE(PG8_SB(0, 0), cB, voffB); PG8_STAGE(PG8_SA(0, 0), cA, voffA); PG8_STAGE(PG8_SB(0, 1), cB + hstep, voffB); PG8_STAGE(PG8_SA(0, 1), cA + hstep, voffA);
    if (wr == 1) PG8_BAR;
    PG8_WAIT_V(4); PG8_BAR;
    PG8_STAGE(PG8_SB(1, 0), cB + kstep, voffB); PG8_STAGE(PG8_SA(1, 0), cA + kstep, voffA); PG8_STAGE(PG8_SB(1, 1), cB + hstep + kstep, voffB);
    PG8_WAIT_V(6); PG8_BAR;
    PG8_STAMP();
    for (;;) {
        const bool has_next = S.next(ui + 1, nxt);
        const char* nA = has_next ? (const char*)g.A + (size_t)nxt.pm * tstep : cA; const char* nB = has_next ? (const char*)g.Bt + (size_t)nxt.pn * tstep : cB;
        for (int t = 0; t < nt; t += 2) {
            if constexpr (Epi::MIDK) { if (t == 8 || t == 16) E.mid(acc, cur, t, wr, wc, fr, fq); }
            const bool last = (t == nt - 2);
            const char* a1 = cA + (size_t)(t + 1) * kstep;
            const char* a2 = last ? nA : cA + (size_t)(t + 2) * kstep; const char* b2 = last ? nB : cB + (size_t)(t + 2) * kstep;
            const char* a3 = a2 + kstep; const char* b3 = b2 + kstep;
            if (last && has_next) S.a_ready(nxt);
            PG8_LDB(B0, 0, 0); PG8_SCHED; PG8_LDA(At, 0, 0); PG8_STAGE(PG8_SA(1, 1), a1 + hstep, voffA);
            PG8_WAIT_L(8); PG8_BAR; PG8_WAIT_L(0); PG8_MMA(0, 0, At, B0); PG8_BAR; PG8_SCHED;
            PG8_LDB(B1, 0, 1); PG8_STAGE(PG8_SB(0, 0), b2, voffB);
            PG8_BAR; PG8_WAIT_L(0); PG8_MMA(0, 1, At, B1); PG8_BAR;
            PG8_LDA(At, 0, 1); PG8_STAGE(PG8_SA(0, 0), a2, voffA);
            PG8_BAR; PG8_WAIT_L(0); PG8_MMA(1, 0, At, B0); PG8_BAR; PG8_SCHED;
            PG8_STAGE(PG8_SB(0, 1), b2 + hstep, voffB);
            PG8_WAIT_V(6); PG8_BAR; PG8_MMA(1, 1, At, B1); PG8_BAR;
            PG8_LDB(B0, 1, 0); PG8_SCHED; PG8_LDA(At, 1, 0); PG8_STAGE(PG8_SA(0, 1), a2 + hstep, voffA);
            PG8_WAIT_L(8); PG8_BAR; PG8_WAIT_L(0); PG8_MMA(0, 0, At, B0); PG8_BAR; PG8_SCHED;
            PG8_LDB(B1, 1, 1); PG8_STAGE(PG8_SB(1, 0), b3, voffB);
            PG8_BAR; PG8_WAIT_L(0); PG8_MMA(0, 1, At, B1); PG8_BAR;
            PG8_LDA(At, 1, 1); PG8_STAGE(PG8_SA(1, 0), a3, voffA);
            PG8_BAR; PG8_WAIT_L(0); PG8_MMA(1, 0, At, B0); PG8_BAR; PG8_SCHED;
            PG8_STAGE(PG8_SB(1, 1), b3 + hstep, voffB);
            PG8_WAIT_V(6); PG8_BAR; PG8_MMA(1, 1, At, B1); PG8_BAR;
        }
        PG8_STAMP();
        if constexpr (!Epi::AFTER_DRAIN) { E(acc, cur, wr, wc, fr, fq); S.done(cur); }
        PG8_STAMP();
        if (!has_next) break;
#pragma unroll
        for (int a = 0; a < 2; ++a)
#pragma unroll
            for (int b = 0; b < 2; ++b)
#pragma unroll
                for (int m = 0; m < 4; ++m)
#pragma unroll
                    for (int n = 0; n < 2; ++n) acc[a][b][m][n] = (f32x4){0.f, 0.f, 0.f, 0.f};
        cur = nxt; cA = nA; cB = nB; ++ui;
    }
    PG8_WAIT_V(0);
    if (wr == 0) PG8_BAR;
    PG8_BAR;
    if constexpr (Epi::AFTER_DRAIN) { E.fused(acc, cur, wr, wc, fr, fq, lds, wid, lane); S.done(cur); }
    PG8_STAMP();
    if (STAMP && wid == 0) { stamps[lane] = lane < nts ? (((unsigned long long)(unsigned)ts_hi << 32) | (unsigned)ts_lo) : 0ull;
        if (lane == 62) stamps[62] = rt_entry; if (lane == 63) stamps[63] = (unsigned long long)wall_clock64(); }
#undef PG8_STAMP
#undef PG8_SA
#undef PG8_SB
#undef PG8_STAGE
#undef PG8_LDA
#undef PG8_LDB
#undef PG8_MMA
#undef PG8_WAIT_V
#undef PG8_WAIT_L
#undef PG8_BAR
#undef PG8_SCHED
}
}
typedef pg8::bf16_t bf16_t;
typedef pg8::f32x4 f32x4;
typedef pg8::u32x4 u32x4;
typedef pg8::bf16x8 bf16x8;
typedef unsigned u32x2 __attribute__((ext_vector_type(2)));
#define LAS __attribute__((address_space(3)))
constexpr int MTOK = 65536, DM = 1024, NIN = 6144, DFF = 2816, NUP = 5632, SEQ = 8192, NBR = 1536, NPA = 3072;
constexpr int NPA2 = 1536;
constexpr int MH = MTOK / 2;
constexpr float EPS = 1e-6f;
constexpr size_t WS_WIN = 0;
constexpr size_t WS_WBR = WS_WIN + (size_t)NIN * DM * 2;
constexpr size_t WS_WO = WS_WBR + (size_t)DM * NBR * 2;
constexpr size_t WS_WUP = WS_WO + (size_t)DM * DM * 2;
constexpr size_t WS_WDN = WS_WUP + (size_t)NUP * DM * 2;
constexpr size_t WS_SSQ = WS_WDN + (size_t)DM * DFF * 2;
constexpr size_t WS_XB = WS_SSQ + (size_t)MTOK * 16 * 4;
constexpr size_t WS_B1 = WS_XB + (size_t)MTOK * NBR * 2;
constexpr size_t WS_B2 = WS_B1 + (size_t)MTOK * NPA * 2;
constexpr size_t WS_END = WS_B2 + (size_t)MTOK * NPA * 2;
constexpr size_t WS_BAR = WS_END;
constexpr size_t WS_SC = WS_BAR + 16384;
constexpr size_t WS_SCB = WS_SC + (size_t)(MTOK / 64) * 4 * 512 * 2;
constexpr size_t WS_RSTD = WS_SCB + (size_t)(MTOK / 64) * 2 * 512 * 2;
constexpr size_t WS_TOTAL = WS_RSTD + (size_t)MTOK * 4;

__device__ __forceinline__ int otid() { int t = threadIdx.x; asm volatile("" : "+v"(t)); return t; }
__device__ __forceinline__ int obid() { int b = blockIdx.x; asm volatile("" : "+s"(b)); return b; }
struct Params {
    const float* in[19];
    float* out; unsigned char* ws;
};

__device__ __forceinline__ u32x4 ld_nt16(const void* p) { return __builtin_nontemporal_load((const u32x4*)p); }
__device__ __forceinline__ void st_nt16(void* p, u32x4 w) { __builtin_nontemporal_store(w, (u32x4*)p); }
__device__ __forceinline__ float bflo(unsigned w) { return __uint_as_float(w << 16); }
__device__ __forceinline__ float bfhi(unsigned w) { return __uint_as_float(w & 0xffff0000u); }
__device__ __forceinline__ unsigned pk(float a, float b) { return pg8::cvt_pk_bf16(a, b); }
__device__ __forceinline__ float fast_rcp(float x) { return __builtin_amdgcn_rcpf(x); }
__device__ __forceinline__ float gate_t2(float y) { return 1.0f + __builtin_amdgcn_exp2f(fminf(y, 43.28f)); }
__device__ __forceinline__ float gelu_tanh_f(float x) {
    const float z2 = 1.5957691216f * (x + 0.044715f * x * x * x);
    return x * fast_rcp(1.0f + __expf(-z2));
}
__device__ __forceinline__ float silu_f(float x) { return x * fast_rcp(1.0f + __expf(-x)); }
__device__ __forceinline__ float row_rstd(const float* ssq, int r) {
    const f32x4* p = (const f32x4*)(ssq + (size_t)r * 16);
    const f32x4 a = p[0], b = p[1], c = p[2], d = p[3];
    const float s = ((a[0] + a[1]) + (a[2] + a[3])) + ((b[0] + b[1]) + (b[2] + b[3])) + ((c[0] + c[1]) + (c[2] + c[3])) + ((d[0] + d[1]) + (d[2] + d[3]));
    return rsqrtf(s * (1.0f / 1024.0f) + EPS);
}

__device__ __forceinline__ void rows_rstd8(const float* ssq, int row0, int fq, float (&rs)[8]) {
    f32x4 v[8];
#pragma unroll
    for (int i = 0; i < 8; ++i) v[i] = *(const f32x4*)(ssq + (size_t)(row0 + (i >> 2) * 128 + (i & 3) * 16) * 16 + fq * 4);
#pragma unroll
    for (int i = 0; i < 8; ++i) {
        float s = (v[i][0] + v[i][1]) + (v[i][2] + v[i][3]);
        s += __shfl_xor(s, 16); s += __shfl_xor(s, 32);
        rs[i] = rsqrtf(s * (1.0f / 1024.0f) + EPS);
    }
}
__device__ __forceinline__ float dpp_ror1(float x) { return __int_as_float(__builtin_amdgcn_mov_dpp(__float_as_int(x), 0x121, 0xf, 0xf, true)); }
__device__ __forceinline__ float dpp_ror2(float x) { return __int_as_float(__builtin_amdgcn_mov_dpp(__float_as_int(x), 0x122, 0xf, 0xf, true)); }
__device__ __forceinline__ float dpp_shr1(float old, float x) { return __int_as_float(__builtin_amdgcn_update_dpp(__float_as_int(old), __float_as_int(x), 0x111, 0xf, 0xf, false)); }
__device__ __forceinline__ float dpp_shr2(float old, float x) { return __int_as_float(__builtin_amdgcn_update_dpp(__float_as_int(old), __float_as_int(x), 0x112, 0xf, 0xf, false)); }
__device__ __forceinline__ u32x4 widen_pair(u32x2 x, u32x2 y) {
    const auto s0 = __builtin_amdgcn_permlane32_swap(x.x, y.x, false, false);
    const auto s1 = __builtin_amdgcn_permlane32_swap(x.y, y.y, false, false);
    u32x4 w; w.x = s0[0]; w.y = s1[0]; w.z = s0[1]; w.w = s1[1];
    return w;
}
__device__ __forceinline__ size_t gidx(int a, int r, int ch) {
    return (size_t)a * ((size_t)MTOK * 1024) + ((((size_t)(r >> 4) * 64 + (ch >> 4)) * 16 + (r & 15)) * 16 + (ch & 15));
}
struct EpiIn {
    static constexpr bool PERM = true, AFTER_DRAIN = false, MIDK = false;
    bf16_t* PA; bf16_t* G; const float* ssq; bf16_t* Y; bf16_t* sc; bf16_t* scb; const float* cw;
    __device__ __forceinline__ void operator()(const f32x4 (&acc)[2][2][4][2], const pg8::Unit& u, int wr, int wc, int fr, int fq) const {
        const int row0 = u.pm * 256 + wr * 64 + fr;
        float rs8[8];
#pragma unroll
        for (int i = 0; i < 8; ++i) rs8[i] = ssq[row0 + (i >> 2) * 128 + (i & 3) * 16];
        if (u.pn >= 16) {
            const int g4 = ((fq & 1) << 1) | (fq >> 1);
            const int q0 = (u.pn - 16) * 64 + wc * 16 + g4 * 4;
            const bool lower = fq < 2; const int qs = lower ? q0 : q0 - 4;
            const f32x4 w0 = *(const f32x4*)(cw + q0), w1 = *(const f32x4*)(cw + 512 + q0), w2 = *(const f32x4*)(cw + 1024 + q0);
#pragma unroll
            for (int ai = 0; ai < 2; ++ai) {
                f32x4 pz = {0.f, 0.f, 0.f, 0.f};
                const int blk = u.pm * 4 + ai * 2 + wr;
#pragma unroll
                for (int m = 0; m < 4; ++m) {
                    const float rs = rs8[ai * 4 + m];
                    const f32x4 cb = acc[ai][0][m][0] * rs, cc = acc[ai][0][m][1] * rs, cx = acc[ai][1][m][0] * rs, av = acc[ai][1][m][1] * rs;
                    const f32x4 z = cc * cx;
                    float y[4];
#pragma unroll
                    for (int j = 0; j < 4; ++j) {
                        const float z1 = dpp_shr1(dpp_ror1(pz[j]), z[j]), z2 = dpp_shr2(dpp_ror2(pz[j]), z[j]);
                        y[j] = cb[j] * fmaf(w0[j], z2, fmaf(w1[j], z1, w2[j] * z[j]));
                        asm volatile("" : "+v"(y[j]));
                    }
                    const int r = row0 + ai * 128 + m * 16;
                    u32x2 w;
                    {
                        u32x2 wa_, wy_; wa_.x = pk(av[0], av[1]); wa_.y = pk(av[2], av[3]); wy_.x = pk(y[0], y[1]); wy_.y = pk(y[2], y[3]);
                        const u32x4 ww = widen_pair(wa_, wy_);
                        bf16_t* dst = lower ? PA + (size_t)r * NPA2 + qs : Y + (size_t)r * NBR + 1024 + qs;
                        if (lower || !(m == 0 && fr < 2)) *(u32x4*)dst = ww;
                    }
                    if (m == 0 && fr < 2) {
                        w.x = pk(z[0], z[1]); w.y = pk(z[2], z[3]); *(u32x2*)(sc + ((size_t)blk * 4 + 2 + fr) * 512 + q0) = w;
                        w.x = pk(cb[0], cb[1]); w.y = pk(cb[2], cb[3]); *(u32x2*)(scb + ((size_t)blk * 2 + fr) * 512 + q0) = w;
                    }
                    if (m == 3 && fr >= 14) { w.x = pk(z[0], z[1]); w.y = pk(z[2], z[3]); *(u32x2*)(sc + ((size_t)blk * 4 + (fr - 14)) * 512 + q0) = w; }
                    pz = z;
                }
            }
        } else {
            const int g4 = ((fq & 1) << 1) | (fq >> 1);
            const int q0 = u.pn * 64 + wc * 16 + g4 * 4;
            const bool lower = fq < 2; const int qs = lower ? q0 : q0 - 4;
#pragma unroll
            for (int ai = 0; ai < 2; ++ai)
#pragma unroll
                for (int m = 0; m < 4; ++m) {
                    const float rs = rs8[ai * 4 + m], rsn = rs * -1.44269504f;
                    const f32x4 ga = acc[ai][0][m][0] * rsn, gb = acc[ai][0][m][1] * rsn, gc = acc[ai][1][m][0] * rsn, uv = acc[ai][1][m][1] * rs;
                    float r1[4], r2[4], s3[4], ug[4];
#pragma unroll
                    for (int j = 0; j < 4; ++j) {
                        const float ta = gate_t2(ga[j]), tb = gate_t2(gb[j]), tc = gate_t2(gc[j]);
                        r1[j] = tb * fast_rcp(ta); r2[j] = tc * fast_rcp(tb); s3[j] = fast_rcp(tc);
                        ug[j] = gelu_tanh_f(uv[j]);
                    }
                    const size_t ro = (size_t)(row0 + ai * 128 + m * 16) * NPA, rp = (size_t)(row0 + ai * 128 + m * 16) * NPA2;
                    u32x2 p1, p2, p3, p4;
                    p1.x = pk(r1[0], r1[1]); p1.y = pk(r1[2], r1[3]); p2.x = pk(r2[0], r2[1]); p2.y = pk(r2[2], r2[3]);
                    p3.x = pk(s3[0], s3[1]); p3.y = pk(s3[2], s3[3]); p4.x = pk(ug[0], ug[1]); p4.y = pk(ug[2], ug[3]);
                    const u32x4 wA = widen_pair(p1, p2), wB = widen_pair(p3, p4);
                    const int rr_ = row0 + ai * 128 + m * 16;
                    *(u32x4*)(G + gidx(lower ? 0 : 1, rr_, qs)) = wA;
                    *(u32x4*)(lower ? G + gidx(2, rr_, qs) : PA + rp + 512 + qs) = wB;
                }
        }
    }
};
struct EpiBr {
    static constexpr bool PERM = true, AFTER_DRAIN = false, MIDK = true;
    const bf16_t* G; bf16_t* out;
    __device__ __forceinline__ void mid(f32x4 (&acc)[2][2][4][2], const pg8::Unit& u, int t, int wr, int wc, int fr, int fq) const {
        const int seg = (t == 8) ? 0 : 1;
        int col0 = u.pn * 256 + wc * 32 + 8 * fq;
        int row0 = u.pm * 256 + wr * 64 + fr;
        asm volatile("" : "+v"(col0), "+v"(row0));
#pragma unroll
        for (int ai = 0; ai < 2; ++ai) {
            u32x4 nu[4][2];
#pragma unroll
            for (int m = 0; m < 4; ++m)
#pragma unroll
                for (int bj = 0; bj < 2; ++bj) nu[m][bj] = ld_nt16(G + gidx(seg, row0 + ai * 128 + m * 16, col0 + bj * 128));
            asm volatile("" ::: "memory");
#pragma unroll
            for (int m = 0; m < 4; ++m)
#pragma unroll
                for (int bj = 0; bj < 2; ++bj) {
                    const unsigned nw[4] = {nu[m][bj].x, nu[m][bj].y, nu[m][bj].z, nu[m][bj].w};
#pragma unroll
                    for (int q = 0; q < 4; ++q) { acc[ai][bj][m][q >> 1][(q & 1) * 2] *= bflo(nw[q]); acc[ai][bj][m][q >> 1][(q & 1) * 2 + 1] *= bfhi(nw[q]); }
                }
            asm volatile("" ::: "memory");
        }
    }
    __device__ __forceinline__ void operator()(const f32x4 (&acc)[2][2][4][2], const pg8::Unit& u, int wr, int wc, int fr, int fq) const {
        const int col0 = u.pn * 256 + wc * 32 + 8 * fq;
        const int row0 = u.pm * 256 + wr * 64 + fr;
        u32x4 sg[2][4][2];
#pragma unroll
        for (int ai = 0; ai < 2; ++ai)
#pragma unroll
            for (int m = 0; m < 4; ++m)
#pragma unroll
                for (int bj = 0; bj < 2; ++bj) sg[ai][m][bj] = ld_nt16(G + gidx(2, row0 + ai * 128 + m * 16, col0 + bj * 128));
#pragma unroll
        for (int ai = 0; ai < 2; ++ai)
#pragma unroll
            for (int m = 0; m < 4; ++m) {
                const int r = row0 + ai * 128 + m * 16;
                bf16_t* op = out + (size_t)r * DM + col0;
#pragma unroll
                for (int bj = 0; bj < 2; ++bj) {
                    const u32x4 s = sg[ai][m][bj];
                    const f32x4 a0 = acc[ai][bj][m][0], a1 = acc[ai][bj][m][1];
                    u32x4 w;
                    w.x = pk(a0[0] * bflo(s.x), a0[1] * bfhi(s.x)); w.y = pk(a0[2] * bflo(s.y), a0[3] * bfhi(s.y));
                    w.z = pk(a1[0] * bflo(s.z), a1[1] * bfhi(s.z)); w.w = pk(a1[2] * bflo(s.w), a1[3] * bfhi(s.w));
                    *(u32x4*)(op + bj * 128) = w;
                }
            }
    }
};
struct EpiRes {
    static constexpr bool PERM = true, AFTER_DRAIN = false, MIDK = false;
    bf16_t* xb; float* ssq;
    __device__ __forceinline__ void operator()(const f32x4 (&acc)[2][2][4][2], const pg8::Unit& u, int wr, int wc, int fr, int fq) const {
        const int col0 = u.pn * 256 + wc * 32 + 8 * fq;
        const int row0 = u.pm * 256 + wr * 64 + fr;
        u32x4 bb[2][4][2];
#pragma unroll
        for (int ai = 0; ai < 2; ++ai)
#pragma unroll
            for (int m = 0; m < 4; ++m)
#pragma unroll
                for (int bj = 0; bj < 2; ++bj) bb[ai][m][bj] = *(const u32x4*)(xb + (size_t)(row0 + ai * 128 + m * 16) * DM + col0 + bj * 128);
        asm volatile("" ::: "memory");
#pragma unroll
        for (int ai = 0; ai < 2; ++ai) {
#pragma unroll
            for (int m = 0; m < 4; ++m) {
                const int r = row0 + ai * 128 + m * 16;
                float sq = 0.f;
#pragma unroll
                for (int bj = 0; bj < 2; ++bj) {
                    const u32x4 s = bb[ai][m][bj];
                    const f32x4 a0 = acc[ai][bj][m][0], a1 = acc[ai][bj][m][1];
                    const float o0 = bflo(s.x) + a0[0], o1 = bfhi(s.x) + a0[1], o2 = bflo(s.y) + a0[2], o3 = bfhi(s.y) + a0[3];
                    const float o4 = bflo(s.z) + a1[0], o5 = bfhi(s.z) + a1[1], o6 = bflo(s.w) + a1[2], o7 = bfhi(s.w) + a1[3];
                    u32x4 w; w.x = pk(o0, o1); w.y = pk(o2, o3); w.z = pk(o4, o5); w.w = pk(o6, o7);
                    *(u32x4*)(xb + (size_t)r * DM + col0 + bj * 128) = w;
                    sq += (o0 * o0 + o1 * o1) + (o2 * o2 + o3 * o3) + (o4 * o4 + o5 * o5) + (o6 * o6 + o7 * o7);
                }
                sq += __shfl_xor(sq, 16); sq += __shfl_xor(sq, 32);
                if (fq == 0) ssq[(size_t)r * 16 + u.pn * 4 + wc] = sq;
            }
            asm volatile("" ::: "memory");
        }
    }
};
struct EpiUp {
    static constexpr bool PERM = true, AFTER_DRAIN = false, MIDK = false;
    bf16_t* act; bf16_t* zs; const float* ssq; const float* cw; const float* cb;
    __device__ __forceinline__ void operator()(const f32x4 (&acc)[2][2][4][2], const pg8::Unit& u, int wr, int wc, int fr, int fq) const {
        const int c0 = u.pn * 128 + wc * 32 + 8 * fq;
        const int row0 = u.pm * 256 + wr * 64 + fr;
        float rs8[8];
#pragma unroll
        for (int i = 0; i < 8; ++i) rs8[i] = ssq[row0 + (i >> 2) * 128 + (i & 3) * 16];
        u32x2 keep[2][4];
#pragma unroll
        for (int n = 0; n < 2; ++n) {
            const int c = c0 + 4 * n;
            const f32x4 gw0 = *(const f32x4*)(cw + c), gw1 = *(const f32x4*)(cw + NUP + c), gw2 = *(const f32x4*)(cw + 2 * NUP + c), gb = *(const f32x4*)(cb + c);
            const f32x4 vw0 = *(const f32x4*)(cw + DFF + c), vw1 = *(const f32x4*)(cw + NUP + DFF + c), vw2 = *(const f32x4*)(cw + 2 * NUP + DFF + c), vb = *(const f32x4*)(cb + DFF + c);
#pragma unroll
            for (int ai = 0; ai < 2; ++ai) {
                f32x4 pg = {0.f, 0.f, 0.f, 0.f}, pv = {0.f, 0.f, 0.f, 0.f};
                const int blk = u.pm * 4 + ai * 2 + wr;
#pragma unroll
                for (int m = 0; m < 4; ++m) {
                    const float rs = rs8[ai * 4 + m];
                    const f32x4 zg = acc[ai][0][m][n] * rs, zv = acc[ai][1][m][n] * rs;
                    float o[4];
#pragma unroll
                    for (int j = 0; j < 4; ++j) {
                        const float g1 = dpp_shr1(dpp_ror1(pg[j]), zg[j]), g2 = dpp_shr2(dpp_ror2(pg[j]), zg[j]);
                        const float v1 = dpp_shr1(dpp_ror1(pv[j]), zv[j]), v2 = dpp_shr2(dpp_ror2(pv[j]), zv[j]);
                        const float gg = fmaf(gw0[j], g2, fmaf(gw1[j], g1, fmaf(gw2[j], zg[j], gb[j])));
                        const float vv = fmaf(vw0[j], v2, fmaf(vw1[j], v1, fmaf(vw2[j], zv[j], vb[j])));
                        o[j] = silu_f(gg) * vv;
                    }
                    u32x2 w; w.x = pk(o[0], o[1]); w.y = pk(o[2], o[3]);
                    const int r = row0 + ai * 128 + m * 16;
                    if (n == 0) keep[ai][m] = w;
                    else if (!(m == 0 && fr < 2)) { u32x4 ww; ww.x = keep[ai][m].x; ww.y = keep[ai][m].y; ww.z = w.x; ww.w = w.y; st_nt16(act + (size_t)r * DFF + c0, ww); }
                    if (m == 0 && fr < 2) {
                        u32x4 sd; sd.x = pk(zg[0], zg[1]); sd.y = pk(zg[2], zg[3]); sd.z = pk(zv[0], zv[1]); sd.w = pk(zv[2], zv[3]);
                        *(u32x4*)(zs + ((size_t)blk * 4 + 2 + fr) * NUP + 2 * c) = sd;
                    }
                    if (m == 3 && fr >= 14) {
                        u32x4 sd; sd.x = pk(zg[0], zg[1]); sd.y = pk(zg[2], zg[3]); sd.z = pk(zv[0], zv[1]); sd.w = pk(zv[2], zv[3]);
                        *(u32x4*)(zs + ((size_t)blk * 4 + (fr - 14)) * NUP + 2 * c) = sd;
                    }
                    pg = zg; pv = zv;
                }
            }
        }
    }
};

__device__ __forceinline__ int win_dest_row(int col) {
    int ch, bj, n, t0;
    if (col < 512) { ch = col; bj = 1; n = 1; t0 = 16; }
    else if (col < 1536) { ch = col - 512; bj = 1; n = 1; t0 = 0; }
    else if (col < 3072) { const int s = (col - 1536) >> 9; ch = (col - 1536) & 511; bj = s >> 1; n = s & 1; t0 = 16; }
    else { const int gi = (col - 3072) >> 10; ch = (col - 3072) & 1023; bj = gi >> 1; n = gi & 1; t0 = 0; }
    const int k = t0 + (ch >> 6), r = ch & 63;
    const int g4 = (r >> 2) & 3, fqh = ((g4 & 1) << 1) | (g4 >> 1);
    return 256 * k + 128 * bj + 32 * (r >> 4) + 8 * fqh + 4 * n + (r & 3);
}
__device__ __forceinline__ void transpose_tile(const float* __restrict__ W, int N, const float* __restrict__ g, bf16_t* __restrict__ Wt, int ldt, int koff, int k0, int n0, int nd0, float* tile, int tid, bool winmap = false) {
    {
        const int kk = tid >> 4, nn = (tid & 15) * 4;
        f32x4 v[2][2]; float s[2];
#pragma unroll
        for (int h = 0; h < 2; ++h) { s[h] = g ? g[k0 + kk + h * 32] : 1.0f;
#pragma unroll
            for (int h2 = 0; h2 < 2; ++h2) v[h2][h] = *(const f32x4*)(W + (size_t)(k0 + kk + h * 32) * N + n0 + h2 * 64 + nn); }
#pragma unroll
        for (int h2 = 0; h2 < 2; ++h2)
#pragma unroll
            for (int h = 0; h < 2; ++h) { float* tp = tile + h2 * (64 * 65) + (kk + h * 32) * 65 + nn;
                tp[0] = v[h2][h][0] * s[h]; tp[1] = v[h2][h][1] * s[h]; tp[2] = v[h2][h][2] * s[h]; tp[3] = v[h2][h][3] * s[h]; }
    }
    __syncthreads();
    {
        const int n = tid >> 3, kq = (tid & 7) * 8;
#pragma unroll
        for (int h2 = 0; h2 < 2; ++h2) {
            float v[8];
#pragma unroll
            for (int j = 0; j < 8; ++j) v[j] = tile[h2 * (64 * 65) + (kq + j) * 65 + n];
            u32x4 w; w.x = pk(v[0], v[1]); w.y = pk(v[2], v[3]); w.z = pk(v[4], v[5]); w.w = pk(v[6], v[7]);
            *(u32x4*)(Wt + (size_t)(winmap ? win_dest_row(n0 + h2 * 64 + n) : nd0 + h2 * 64 + n) * ldt + koff + k0 + kq) = w;
        }
    }
    __syncthreads();
}

__device__ __forceinline__ void prep_phase(const Params& p, int l, float* ldsf) {
    unsigned char* ws = p.ws;
    bf16_t* wt_in = (bf16_t*)(ws + WS_WIN); bf16_t* wt_br = (bf16_t*)(ws + WS_WBR); bf16_t* wt_o = (bf16_t*)(ws + WS_WO);
    bf16_t* wt_up = (bf16_t*)(ws + WS_WUP); bf16_t* wt_dn = (bf16_t*)(ws + WS_WDN);
    const float* g_mix = p.in[1] + (size_t)l * DM; const float* w_in = p.in[2] + (size_t)l * DM * NIN;
    const float* w_pool = p.in[3] + (size_t)l * 4 * 128 * 128; const float* pscale = p.in[4] + (size_t)l * 512;
    const float* w_ba = p.in[9] + (size_t)l * 512 * DM; const float* w_bb = p.in[10] + (size_t)l * 512 * DM; const float* w_bc = p.in[11] + (size_t)l * 512 * DM;
    const float* w_o = p.in[12] + (size_t)l * DM * DM; const float* g_ffn = p.in[13] + (size_t)l * DM;
    const float* w_up = p.in[14] + (size_t)l * DM * NUP; const float* w_dn = p.in[17] + (size_t)l * DFF * DM;
    const int tid = otid(), bid = obid();
    constexpr int T0 = 16 * 48, T1 = T0 + 64, T2 = T1 + 64, T3 = T2 + 128, T4 = T3 + 16 * 44, T5 = T4 + 44 * 8;
    for (int i = bid; i < T5; i += gridDim.x) {
        if (i < T0) { const int kt = i & 15, nt = i >> 4; transpose_tile(w_in, NIN, g_mix, wt_in, DM, 0, kt * 64, nt * 128, nt * 128, ldsf, tid, true); }
        else if (i < T1) { const int j = i - T0, kt = j & 7, nt = j >> 3; transpose_tile(w_bb, DM, nullptr, wt_br, NBR, 512, kt * 64, nt * 128, nt * 128, ldsf, tid); }
        else if (i < T2) { const int j = i - T1, kt = j & 7, nt = j >> 3; transpose_tile(w_bc, DM, nullptr, wt_br, NBR, 1024, kt * 64, nt * 128, nt * 128, ldsf, tid); }
        else if (i < T3) { const int j = i - T2, kt = j & 15, nt = j >> 4; transpose_tile(w_o, DM, nullptr, wt_o, DM, 0, kt * 64, nt * 128, nt * 128, ldsf, tid); }
        else if (i < T4) { const int j = i - T3, kt = j & 15, nt = j >> 4; const int n0 = nt * 128, bj = n0 / DFF, q0 = n0 - bj * DFF; transpose_tile(w_up, NUP, g_ffn, wt_up, DM, 0, kt * 64, n0, (q0 >> 7) * 256 + bj * 128, ldsf, tid);   }
        else { const int j = i - T4, kt = j % 44, nt = j / 44; transpose_tile(w_dn, DM, nullptr, wt_dn, DFF, 0, kt * 64, nt * 128, nt * 128, ldsf, tid); }
    }
    {
        float* wpT = ldsf;
        float* wa = ldsf + 128 * 128;
        for (int it = (int)gridDim.x - 1 - bid; it < 64; it += gridDim.x) {
            const int g = it >> 4, n0 = (it & 15) * 64;
            for (int q = tid; q < 128 * 32; q += 512) {
                const int d = q >> 5, e4 = (q & 31) * 4;
                const f32x4 v = *(const f32x4*)(w_pool + ((size_t)g * 128 + d) * 128 + e4);
                const f32x4 s = *(const f32x4*)(pscale + g * 128 + e4);
                wpT[(e4 + 0) * 128 + d] = v[0] * s[0]; wpT[(e4 + 1) * 128 + d] = v[1] * s[1]; wpT[(e4 + 2) * 128 + d] = v[2] * s[2]; wpT[(e4 + 3) * 128 + d] = v[3] * s[3];
            }
            for (int q = tid; q < 128 * 16; q += 512) {
                const int e = q >> 4, c4 = (q & 15) * 4;
                *(f32x4*)(wa + e * 64 + c4) = *(const f32x4*)(w_ba + (size_t)(g * 128 + e) * DM + n0 + c4);
            }
            __syncthreads();
            const int d = tid & 127, ns = tid >> 7;
            float acc[16];
#pragma unroll
            for (int i = 0; i < 16; ++i) acc[i] = 0.f;
            for (int e = 0; e < 128; ++e) {
                const float w = wpT[e * 128 + d];
                const f32x4* wr4 = (const f32x4*)(wa + e * 64 + ns * 16);
#pragma unroll
                for (int c = 0; c < 4; ++c) { const f32x4 b = wr4[c]; acc[c * 4 + 0] += w * b[0]; acc[c * 4 + 1] += w * b[1]; acc[c * 4 + 2] += w * b[2]; acc[c * 4 + 3] += w * b[3]; }
            }
#pragma unroll
            for (int i = 0; i < 16; ++i) wt_br[(size_t)(n0 + ns * 16 + i) * NBR + g * 128 + d] = (bf16_t)(pk(acc[i], 0.f) & 0xffffu);
            __syncthreads();
        }
    }
    if (l != 0) {
        const float* ssq = (const float*)(ws + WS_SSQ); float* rstd1 = (float*)(ws + WS_RSTD);
        for (int r = bid * 512 + tid; r < MTOK; r += gridDim.x * 512) rstd1[r] = row_rstd(ssq, r);
    }
    if (l == 0) {
        const float* x = p.in[0]; bf16_t* xb = (bf16_t*)(ws + WS_XB); float* rstd1 = (float*)(ws + WS_RSTD);
        const int lane = tid & 63, wave = tid >> 6;
        for (int r0 = (bid * 8 + wave) * 2; r0 < MTOK; r0 += gridDim.x * 16) {
            f32x4 v[2][4];
#pragma unroll
            for (int rr = 0; rr < 2; ++rr)
#pragma unroll
                for (int i = 0; i < 4; ++i) v[rr][i] = *(const f32x4*)(x + (size_t)(r0 + rr) * DM + i * 256 + lane * 4);
#pragma unroll
            for (int rr = 0; rr < 2; ++rr) {
                const int r = r0 + rr;
                float sq = 0.f;
#pragma unroll
                for (int i = 0; i < 4; ++i) {
                    const f32x4 t = v[rr][i];
                    sq += (t[0] * t[0] + t[1] * t[1]) + (t[2] * t[2] + t[3] * t[3]);
                    u32x2 w; w.x = pk(t[0], t[1]); w.y = pk(t[2], t[3]);
                    *(u32x2*)(xb + (size_t)r * DM + i * 256 + lane * 4) = w;
                }
#pragma unroll
                for (int o = 32; o >= 1; o >>= 1) sq += __shfl_xor(sq, o);
                if (lane == 0) rstd1[r] = rsqrtf(sq * (1.0f / 1024.0f) + EPS);
            }
        }
    }
}
__device__ __forceinline__ void ld8(const bf16_t* p, float (&v)[8]) {
    const u32x4 w = *(const u32x4*)p;
    v[0] = bflo(w.x); v[1] = bfhi(w.x); v[2] = bflo(w.y); v[3] = bfhi(w.y); v[4] = bflo(w.z); v[5] = bfhi(w.z); v[6] = bflo(w.w); v[7] = bfhi(w.w);
}
__device__ __forceinline__ void st8(bf16_t* p, const float (&v)[8]) {
    u32x4 w; w.x = pk(v[0], v[1]); w.y = pk(v[2], v[3]); w.z = pk(v[4], v[5]); w.w = pk(v[6], v[7]);
    *(u32x4*)p = w;
}
template <int W> __device__ __forceinline__ void pool_rows(const bf16_t* __restrict__ ap, bf16_t* __restrict__ yp, int r0, int pos0) {
#pragma unroll
    for (int b = 0; b < 4; ++b) {
        const int base = r0 + 4 * b;
        u32x4 h[W + 3];
#pragma unroll
        for (int i = 0; i < W + 3; ++i) { const int rr = base - (W - 1) + i; h[i] = (pos0 + rr >= 0) ? *(const u32x4*)(ap + (ptrdiff_t)rr * NPA2) : (u32x4){0u, 0u, 0u, 0u}; }
        float s[8];
#pragma unroll
        for (int j = 0; j < 8; ++j) s[j] = 0.f;
#pragma unroll
        for (int i = 0; i < W - 1; ++i) { const u32x4 q = h[i];
            s[0] += bflo(q.x); s[1] += bfhi(q.x); s[2] += bflo(q.y); s[3] += bfhi(q.y); s[4] += bflo(q.z); s[5] += bfhi(q.z); s[6] += bflo(q.w); s[7] += bfhi(q.w); }
#pragma unroll
        for (int i = 0; i < 4; ++i) {
            const int rr = base + i, pos = pos0 + rr; const float inv = 1.0f / (float)(pos + 1 < W ? pos + 1 : W);
            const u32x4 q = h[W - 1 + i], od = h[i];
            const float v[8] = {bflo(q.x), bfhi(q.x), bflo(q.y), bfhi(q.y), bflo(q.z), bfhi(q.z), bflo(q.w), bfhi(q.w)};
            float o[8];
#pragma unroll
            for (int j = 0; j < 8; ++j) { s[j] += v[j]; o[j] = s[j] * inv - v[j]; }
            st8(yp + (size_t)rr * NBR, o);
            s[0] -= bflo(od.x); s[1] -= bfhi(od.x); s[2] -= bflo(od.y); s[3] -= bfhi(od.y); s[4] -= bflo(od.z); s[5] -= bfhi(od.z); s[6] -= bflo(od.w); s[7] -= bfhi(od.w);
        }
        asm volatile("" ::: "memory");
    }
}
constexpr int VT_PITCH = 136;
__device__ __forceinline__ void mixer_phase(const Params& p, int l, unsigned char* lds) {
    const bf16_t* PA = (const bf16_t*)(p.ws + WS_B1);
    bf16_t* Y = (bf16_t*)p.out;
    const float* g_sgu = p.in[5] + (size_t)l * 512;
    const float* w_sp = p.in[6] + (size_t)l * 4 * 128 * 128;
    const float* b_sp = p.in[7] + (size_t)l * 4 * 128;
    const float* conv_c = p.in[8] + (size_t)l * 3 * 512;
    float* rs = (float*)lds;
    bf16_t* vT = (bf16_t*)(lds + 1024);
    const int tid = otid(), lane = tid & 63, wave = __builtin_amdgcn_readfirstlane(tid >> 6), fr = lane & 15, fq = lane >> 4;
    for (int item = obid(); item < MTOK / 128; item += gridDim.x) {
        const int t0 = item * 128, pos0 = t0 & (SEQ - 1);
        {
            const int row = tid >> 2, q = tid & 3;
            const bf16_t* vp = PA + (size_t)(t0 + row) * NPA2 + 1024 + q * 128;
            float sq = 0.f;
#pragma unroll
            for (int i = 0; i < 16; ++i) { float v[8]; ld8(vp + i * 8, v);
#pragma unroll
                for (int j = 0; j < 8; ++j) sq += v[j] * v[j]; }
            sq += __shfl_xor(sq, 1); sq += __shfl_xor(sq, 2);
            if (q == 0) rs[row] = rsqrtf(sq * (1.0f / 512.0f) + EPS);
        }
        {
            const int grp = wave & 3;
            const int c8 = (grp * 16 + (lane & 15)) * 8; int r0 = ((wave >> 2) * 4 + (lane >> 4)) * 16;
            asm volatile("" : "+v"(r0));
            {
                const bf16_t* ap = PA + (size_t)t0 * NPA2 + c8;
                bf16_t* yp = Y + (size_t)t0 * NBR + c8;
                if (grp == 0) pool_rows<2>(ap, yp, r0, pos0); else if (grp == 1) pool_rows<4>(ap, yp, r0, pos0); else if (grp == 2) pool_rows<8>(ap, yp, r0, pos0); else pool_rows<16>(ap, yp, r0, pos0);
            }
        }
        if (tid < 256) {
            const bf16_t* sc = (const bf16_t*)(p.ws + WS_SC); const bf16_t* scb = (const bf16_t*)(p.ws + WS_SCB);
            const int b_ = tid >> 7, ri = (tid >> 6) & 1, c8 = (tid & 63) * 8;
            const int blk = (t0 >> 6) + b_;
            const bool first = ((blk * 64) & (SEQ - 1)) == 0;
            float z2[8], z1[8], z0[8], cbv[8], o[8];
#pragma unroll
            for (int j = 0; j < 8; ++j) { z2[j] = 0.f; z1[j] = 0.f; }
            const bf16_t* own = sc + (size_t)blk * 4 * 512 + c8;
            if (ri == 0) { if (!first) { ld8(own - 4 * 512, z2); ld8(own - 3 * 512, z1); } ld8(own + 2 * 512, z0); }
            else { if (!first) ld8(own - 3 * 512, z2); ld8(own + 2 * 512, z1); ld8(own + 3 * 512, z0); }
            ld8(scb + ((size_t)blk * 2 + ri) * 512 + c8, cbv);
#pragma unroll
            for (int j = 0; j < 8; ++j) o[j] = 0.f;
            { const f32x4 a0 = *(const f32x4*)(conv_c + c8), a1 = *(const f32x4*)(conv_c + c8 + 4), b0 = *(const f32x4*)(conv_c + 512 + c8), b1 = *(const f32x4*)(conv_c + 512 + c8 + 4), c0 = *(const f32x4*)(conv_c + 1024 + c8), c1 = *(const f32x4*)(conv_c + 1024 + c8 + 4);
#pragma unroll
              for (int j = 0; j < 4; ++j) { o[j] = cbv[j] * fmaf(a0[j], z2[j], fmaf(b0[j], z1[j], c0[j] * z0[j])); o[4 + j] = cbv[4 + j] * fmaf(a1[j], z2[4 + j], fmaf(b1[j], z1[4 + j], c1[j] * z0[4 + j])); } }
            st8(Y + (size_t)(blk * 64 + ri) * NBR + 1024 + c8, o);
        }
#pragma unroll 1
        for (int g = 0; g < 4; ++g) {
            const int t = wave * 16 + fr;
            const int nk = (wave >> 1) + 1;
            f32x4 wq[4][2];
#pragma unroll
            for (int k = 0; k < 4; ++k) { const float* wp = w_sp + ((size_t)g * 128 + t) * 128 + k * 32 + fq * 8; wq[k][0] = *(const f32x4*)wp; wq[k][1] = *(const f32x4*)(wp + 4); }
            const bf16_t* up = PA + (size_t)(t0 + t) * NPA2 + 512 + g * 128 + 8 * fq;
            u32x4 uu[4];
#pragma unroll
            for (int pq = 0; pq < 4; ++pq) uu[pq] = *(const u32x4*)(up + pq * 32);
            const float bias = b_sp[g * 128 + t];
            u32x4 vq[4];
            const int s_ = tid >> 2, dq = (tid & 3) * 32;
            {
                const bf16_t* vp = PA + (size_t)(t0 + s_) * NPA2 + 1024 + g * 128 + dq;
#pragma unroll
                for (int i = 0; i < 4; ++i) vq[i] = *(const u32x4*)(vp + i * 8);
            }
            __syncthreads();
#pragma unroll
            for (int i = 0; i < 4; ++i) {
                const unsigned ww[4] = {vq[i].x, vq[i].y, vq[i].z, vq[i].w};
#pragma unroll
                for (int q = 0; q < 4; ++q) { vT[(dq + i * 8 + q * 2) * VT_PITCH + s_] = (bf16_t)(ww[q] & 0xffffu); vT[(dq + i * 8 + q * 2 + 1) * VT_PITCH + s_] = (bf16_t)(ww[q] >> 16); }
            }
            __syncthreads();
            f32x4 acc[8];
#pragma unroll
            for (int n = 0; n < 8; ++n) acc[n] = (f32x4){0.f, 0.f, 0.f, 0.f};
#pragma unroll
            for (int k = 0; k < 4; ++k) if (k < nk) {
                const int s0 = k * 32 + fq * 8;
                const f32x4 wa = wq[k][0], wb = wq[k][1];
                const f32x4 ra = *(const f32x4*)(rs + s0), rb = *(const f32x4*)(rs + s0 + 4);
                float a[8];
#pragma unroll
                for (int j = 0; j < 4; ++j) { a[j] = (s0 + j <= t) ? wa[j] * ra[j] : 0.f; a[4 + j] = (s0 + 4 + j <= t) ? wb[j] * rb[j] : 0.f; }
                union { u32x4 u; bf16x8 h; } af; af.u.x = pk(a[0], a[1]); af.u.y = pk(a[2], a[3]); af.u.z = pk(a[4], a[5]); af.u.w = pk(a[6], a[7]);
#pragma unroll
                for (int n = 0; n < 8; ++n) {
                    const bf16x8 bfrag = *(const bf16x8*)(vT + (32 * (n >> 1) + 8 * (fr >> 2) + 4 * (n & 1) + (fr & 3)) * VT_PITCH + s0);
                    acc[n] = __builtin_amdgcn_mfma_f32_16x16x32_bf16(bfrag, af.h, acc[n], 0, 0, 0);
                }
            }
            bf16_t* yp = Y + (size_t)(t0 + t) * NBR + 512 + g * 128 + 8 * fq;
#pragma unroll
            for (int pq = 0; pq < 4; ++pq) {
                const f32x4 gs0 = *(const f32x4*)(g_sgu + g * 128 + pq * 32 + 8 * fq), gs1 = *(const f32x4*)(g_sgu + g * 128 + pq * 32 + 8 * fq + 4);
                const f32x4 a0 = acc[2 * pq], a1 = acc[2 * pq + 1];
                const u32x4 uq = uu[pq];
                const float o0 = bflo(uq.x) * (a0[0] * gs0[0] + bias), o1 = bfhi(uq.x) * (a0[1] * gs0[1] + bias);
                const float o2 = bflo(uq.y) * (a0[2] * gs0[2] + bias), o3 = bfhi(uq.y) * (a0[3] * gs0[3] + bias);
                const float o4 = bflo(uq.z) * (a1[0] * gs1[0] + bias), o5 = bfhi(uq.z) * (a1[1] * gs1[1] + bias);
                const float o6 = bflo(uq.w) * (a1[2] * gs1[2] + bias), o7 = bfhi(uq.w) * (a1[3] * gs1[3] + bias);
                u32x4 w; w.x = pk(o0, o1); w.y = pk(o2, o3); w.z = pk(o4, o5); w.w = pk(o6, o7);
                *(u32x4*)(yp + pq * 32) = w;
            }
        }
        __syncthreads();
    }
}

__device__ __forceinline__ void rstd_finalize_phase(const Params& p) {
    const float* ssq = (const float*)(p.ws + WS_SSQ); float* rstd = (float*)(p.ws + WS_RSTD);
    for (int r = obid() * 512 + otid(); r < MTOK; r += gridDim.x * 512) rstd[r] = row_rstd(ssq, r);
}

__device__ __forceinline__ void ffn_fixup_phase(const Params& p, int l) {
    const bf16_t* zs = (const bf16_t*)(p.ws + WS_B2);
    bf16_t* act = (bf16_t*)(p.ws + WS_B1);
    const float* cw = p.in[15] + (size_t)l * 3 * NUP; const float* cb = p.in[16] + (size_t)l * NUP;
    constexpr int NCG = DFF / 8, NU = (MTOK / 64) * NCG;
    for (int u = obid() * 512 + otid(); u < NU; u += gridDim.x * 512) {
        const int blk = u / NCG, c8 = (u - blk * NCG) * 8;
        const bool first = ((blk * 64) & (SEQ - 1)) == 0;
        float g2[8], g1[8], ga[8], gb2[8], v2[8], v1[8], va[8], vb2[8];
#pragma unroll
        for (int j = 0; j < 8; ++j) { g2[j] = g1[j] = v2[j] = v1[j] = 0.f; }
        const bf16_t* own = zs + (size_t)blk * 4 * NUP + 2 * c8;
#define LDGV(ptr, gd, vd) { const u32x4 a_ = *(const u32x4*)(ptr), b_ = *(const u32x4*)((ptr) + 8); \
            gd[0] = bflo(a_.x); gd[1] = bfhi(a_.x); gd[2] = bflo(a_.y); gd[3] = bfhi(a_.y); vd[0] = bflo(a_.z); vd[1] = bfhi(a_.z); vd[2] = bflo(a_.w); vd[3] = bfhi(a_.w); \
            gd[4] = bflo(b_.x); gd[5] = bfhi(b_.x); gd[6] = bflo(b_.y); gd[7] = bfhi(b_.y); vd[4] = bflo(b_.z); vd[5] = bfhi(b_.z); vd[6] = bflo(b_.w); vd[7] = bfhi(b_.w); }
        if (!first) { const bf16_t* prv = own - 4 * (ptrdiff_t)NUP; LDGV(prv, g2, v2) LDGV(prv + NUP, g1, v1) }
        LDGV(own + 2 * NUP, ga, va) LDGV(own + 3 * NUP, gb2, vb2)
#undef LDGV
        float o0[8], o1[8];
        float w0[8], w1[8], w2[8], bb[8], x0[8], x1[8], x2[8], xb_[8];
        { const f32x4* q;
#define LD8F(dst, ptr) q = (const f32x4*)(ptr); { const f32x4 a_ = q[0], b_ = q[1]; dst[0] = a_[0]; dst[1] = a_[1]; dst[2] = a_[2]; dst[3] = a_[3]; dst[4] = b_[0]; dst[5] = b_[1]; dst[6] = b_[2]; dst[7] = b_[3]; }
          LD8F(w0, cw + c8) LD8F(w1, cw + NUP + c8) LD8F(w2, cw + 2 * NUP + c8) LD8F(bb, cb + c8)
          LD8F(x0, cw + DFF + c8) LD8F(x1, cw + NUP + DFF + c8) LD8F(x2, cw + 2 * NUP + DFF + c8) LD8F(xb_, cb + DFF + c8)
#undef LD8F
        }
#pragma unroll
        for (int j = 0; j < 8; ++j) {
            const float gg0 = w0[j] * g2[j] + w1[j] * g1[j] + w2[j] * ga[j] + bb[j], vv0 = x0[j] * v2[j] + x1[j] * v1[j] + x2[j] * va[j] + xb_[j];
            const float gg1 = w0[j] * g1[j] + w1[j] * ga[j] + w2[j] * gb2[j] + bb[j], vv1 = x0[j] * v1[j] + x1[j] * va[j] + x2[j] * vb2[j] + xb_[j];
            o0[j] = silu_f(gg0) * vv0; o1[j] = silu_f(gg1) * vv1;
        }
        st8(act + (size_t)(blk * 64) * DFF + c8, o0); st8(act + (size_t)(blk * 64 + 1) * DFF + c8, o1);
    }
}

__device__ __forceinline__ void final_norm_phase(const Params& p) {
    const float* gf = p.in[18]; const float* ssq = (const float*)(p.ws + WS_SSQ); const bf16_t* xb = (const bf16_t*)(p.ws + WS_XB); float* out = p.out;
    const int tid = otid(), lane = tid & 63, wave = tid >> 6;
    for (int r0 = (obid() * 8 + wave) * 2; r0 < MTOK; r0 += gridDim.x * 16) {
        u32x4 xv[2][2]; float rs[2];
#pragma unroll
        for (int rr = 0; rr < 2; ++rr) {
            rs[rr] = row_rstd(ssq, r0 + rr);
#pragma unroll
            for (int i = 0; i < 2; ++i) xv[rr][i] = *(const u32x4*)(xb + (size_t)(r0 + rr) * DM + i * 512 + lane * 8);
        }
#pragma unroll
        for (int rr = 0; rr < 2; ++rr)
#pragma unroll
            for (int i = 0; i < 2; ++i) {
                const int cc = i * 512 + lane * 8;
                const u32x4 q = xv[rr][i];
                const float v[8] = {bflo(q.x), bfhi(q.x), bflo(q.y), bfhi(q.y), bflo(q.z), bfhi(q.z), bflo(q.w), bfhi(q.w)};
                const f32x4 g0 = *(const f32x4*)(gf + cc), g1 = *(const f32x4*)(gf + cc + 4);
                f32x4 o0, o1;
#pragma unroll
                for (int j = 0; j < 4; ++j) { o0[j] = v[j] * rs[rr] * g0[j]; o1[j] = v[4 + j] * rs[rr] * g1[j]; }
                float* qo = out + (size_t)(r0 + rr) * DM + cc;
                __builtin_nontemporal_store(o0, (f32x4*)qo); __builtin_nontemporal_store(o1, (f32x4*)(qo + 4));
            }
    }
}

template <class Epi> __device__ __forceinline__ void run_gemm(unsigned char* lds, const bf16_t* A, const bf16_t* Bt, int M, int N, int K, const Epi& E, int stagger_step = 0) {
    pg8::Gemm g{A, Bt, M, N, K}; pg8::StaticOrder S; S.init(M, N, (int)gridDim.x, obid());
    if (stagger_step) {
        const unsigned long long t0 = wall_clock64(), d = (unsigned long long)(((obid() >> 3) & 7) * stagger_step);
        while (wall_clock64() - t0 < d) __builtin_amdgcn_s_sleep(16);
    }
    pg8::gemm_phase<Epi, pg8::StaticOrder, false>((PG8_LAS unsigned char*)lds, g, S, E, nullptr);
}

#define XB_TMO      128
#define XB_XCNT(j)  (256  + 64 * (j))
#define XB_XSUB(j)  (1280 + 64 * (j))
#define XB_XGEN(j)  (2304 + 64 * (j))
#define XB_TOP      3328
#define XB_TOPGEN   3392
#define XCD_BAR_WORDS 3456
#define XB_SPIN_CAP (1u << 18)

__device__ __forceinline__ unsigned xb_ld(unsigned* p)              { return __hip_atomic_load(p, __ATOMIC_RELAXED, __HIP_MEMORY_SCOPE_AGENT); }
__device__ __forceinline__ unsigned xb_add(unsigned* p, unsigned v) { return __hip_atomic_fetch_add(p, v, __ATOMIC_RELAXED, __HIP_MEMORY_SCOPE_AGENT); }
__device__ __forceinline__ unsigned xb_xcc_id() { return (unsigned)__builtin_amdgcn_s_getreg((3 << 11) | 20) & 0xFu; }
#define XB_SPIN(cond, bar) do { unsigned _sp = 0; while (cond) { __builtin_amdgcn_s_sleep(1); \
    if ((++_sp & 255u) == 0u) { if (xb_ld(&(bar)[XB_TMO])) break; if (_sp > XB_SPIN_CAP) { atomicAdd(&(bar)[XB_TMO], 1u); break; } } } } while (0)

struct XcdBarrier {
    unsigned* bar; unsigned x;
    volatile LAS unsigned* st;
};

__device__ __forceinline__ XcdBarrier xcd_barrier_post(unsigned* bar, volatile LAS unsigned* st) {
    XcdBarrier b; b.bar = bar; b.x = xb_xcc_id(); b.st = st;
    if (threadIdx.x == 0) (void)xb_add(&bar[XB_XCNT(b.x)], 1u);
    return b;
}
__device__ __forceinline__ void xcd_barrier_complete(unsigned* bar, unsigned x, unsigned& nloc, unsigned& nx) {
    const unsigned G = gridDim.x * gridDim.y * gridDim.z;
    unsigned sum, cnt, mine, sp = 0u;
    for (;;) {
        sum = 0u; cnt = 0u; mine = 0u;
#pragma unroll
        for (unsigned j = 0; j < 16; ++j) { const unsigned c = xb_ld(&bar[XB_XCNT(j)]); sum += c; cnt += (c > 0u) ? 1u : 0u; mine = (j == x) ? c : mine; }
        if (sum == G) break;
        __builtin_amdgcn_s_sleep(1);
        if ((++sp & 255u) == 0u) { if (xb_ld(&bar[XB_TMO])) break; if (sp > XB_SPIN_CAP) { atomicAdd(&bar[XB_TMO], 1u); break; } }
    }
    nloc = mine > 0u ? mine : 1u; nx = cnt > 0u ? cnt : 1u;
}

__device__ __forceinline__ void xcd_barrier(const XcdBarrier& b) {
    asm volatile("s_waitcnt vmcnt(0)" ::: "memory");
    __syncthreads();
    if (threadIdx.x == 0) {
        unsigned* bar = b.bar;
        __builtin_amdgcn_s_waitcnt(0);
        unsigned nloc = b.st[0], nx = b.st[1];
        if (nloc == 0u) { xcd_barrier_complete(bar, b.x, nloc, nx); b.st[0] = nloc; b.st[1] = nx; }
        const unsigned old = xb_add(&bar[XB_XSUB(b.x)], 1u);
        const unsigned gen = old / nloc;
        if (old + 1u == (gen + 1u) * nloc) {
            __builtin_amdgcn_fence(__ATOMIC_RELEASE, "agent");
            asm volatile("s_waitcnt vmcnt(0)" ::: "memory");
            const unsigned og = xb_add(&bar[XB_TOP], 1u);
            const unsigned tg = og / nx;
            if (og + 1u == (tg + 1u) * nx) xb_add(&bar[XB_TOPGEN], 1u);
            else XB_SPIN(xb_ld(&bar[XB_TOPGEN]) == tg, bar);
            __builtin_amdgcn_fence(__ATOMIC_ACQUIRE, "agent");
            xb_add(&bar[XB_XGEN(b.x)], 1u);
            asm volatile("s_waitcnt vmcnt(0)" ::: "memory");
        } else {
            XB_SPIN(xb_ld(&bar[XB_XGEN(b.x)]) == gen, bar);
            __builtin_amdgcn_fence(__ATOMIC_ACQUIRE, "agent");
            asm volatile("s_waitcnt vmcnt(0)" ::: "memory");
        }
    }
    __syncthreads();
}

typedef const Params __attribute__((address_space(4)))* ParamsK;
__device__ __forceinline__ Params fresh_params() {
    ParamsK q = (ParamsK)__builtin_amdgcn_kernarg_segment_ptr();
    asm volatile("" : "+s"(q));
    Params r;
#pragma unroll
    for (int i = 0; i < 19; ++i) r.in[i] = q->in[i];
    r.out = q->out; r.ws = q->ws;
    return r;
}
constexpr int LDS_TOTAL = pg8::STAGE_BYTES + 256;
__global__ void __launch_bounds__(512, 2) fwd_megakernel(Params p_unused) {
    extern __shared__ __attribute__((aligned(16))) unsigned char lds[];
    cg::grid_group grid = cg::this_grid();
    volatile LAS unsigned* st = (volatile LAS unsigned*)((LAS unsigned char*)lds + pg8::STAGE_BYTES);
    unsigned* bar;
    {
        const Params p = fresh_params(); bar = (unsigned*)(p.ws + WS_BAR);
        if (threadIdx.x < 4) st[threadIdx.x] = 0u;
        if (blockIdx.x == 0) for (int i = threadIdx.x; i < XCD_BAR_WORDS; i += 512) bar[i] = 0u;
        __syncthreads();
    }
#define WSP(off) ((bf16_t*)(p.ws + (off)))
#define GRID_BAR() do { XcdBarrier b_; b_.bar = (unsigned*)(fresh_params().ws + WS_BAR); b_.x = xb_xcc_id(); b_.st = (volatile LAS unsigned*)((LAS unsigned char*)lds + pg8::STAGE_BYTES); xcd_barrier(b_); } while (0)
    for (int l = 0; l < 2; ++l) {
        { const Params p = fresh_params(); prep_phase(p, l, (float*)lds); }
        if (l == 0) { grid.sync(); (void)xcd_barrier_post((unsigned*)(fresh_params().ws + WS_BAR), (volatile LAS unsigned*)((LAS unsigned char*)lds + pg8::STAGE_BYTES)); }
        else GRID_BAR();
        { const Params p = fresh_params(); EpiIn E{WSP(WS_B1), WSP(WS_B2), (const float*)(p.ws + WS_RSTD), (bf16_t*)p.out, WSP(WS_SC), WSP(WS_SCB), p.in[8] + (size_t)l * 3 * 512}; run_gemm(lds, WSP(WS_XB), WSP(WS_WIN), MTOK, NIN, DM, E); }
        GRID_BAR();
        { const Params p = fresh_params(); mixer_phase(p, l, lds); }
        GRID_BAR();
        { const Params p = fresh_params(); EpiBr E{WSP(WS_B2), WSP(WS_B1)}; run_gemm(lds, (const bf16_t*)p.out  , WSP(WS_WBR), MTOK, DM, NBR, E); }
        GRID_BAR();
        { const Params p = fresh_params(); EpiRes E{WSP(WS_XB), (float*)(p.ws + WS_SSQ)}; run_gemm(lds, WSP(WS_B1), WSP(WS_WO), MTOK, DM, DM, E); }
        GRID_BAR();
        { const Params p = fresh_params(); rstd_finalize_phase(p); }
        GRID_BAR();
        { const Params p = fresh_params(); EpiUp E{WSP(WS_B1), WSP(WS_B2), (const float*)(p.ws + WS_RSTD), p.in[15] + (size_t)l * 3 * NUP, p.in[16] + (size_t)l * NUP}; run_gemm(lds, WSP(WS_XB), WSP(WS_WUP), MTOK, NUP, DM, E); }
        GRID_BAR();
        { const Params p = fresh_params(); ffn_fixup_phase(p, l); }
        GRID_BAR();
        { const Params p = fresh_params(); EpiRes E{WSP(WS_XB), (float*)(p.ws + WS_SSQ)}; run_gemm(lds, WSP(WS_B1), WSP(WS_WDN), MTOK, DM, DFF, E); }
        GRID_BAR();
    }
    { const Params p = fresh_params(); final_norm_phase(p); }
#undef WSP
#undef GRID_BAR
}

extern "C" void kernel_launch(void* const* d_in, const int* in_sizes, int n_in, void* d_out, int out_size, void* d_ws, size_t ws_size, hipStream_t stream) {
    constexpr size_t kLds = LDS_TOTAL;
    static int grid_blocks = 0;
    if (!grid_blocks) {
        int dev = 0, cus = 0, per_cu = 0;
        (void)hipGetDevice(&dev);
        (void)hipDeviceGetAttribute(&cus, hipDeviceAttributeMultiprocessorCount, dev);
        (void)hipFuncSetAttribute((const void*)fwd_megakernel, hipFuncAttributeMaxDynamicSharedMemorySize, (int)kLds);
        (void)hipOccupancyMaxActiveBlocksPerMultiprocessor(&per_cu, (const void*)fwd_megakernel, 512, kLds);
        if (per_cu < 1) per_cu = 1;
        grid_blocks = cus;
        if (ws_size < WS_TOTAL || n_in != 19 || out_size != MTOK * DM) { fprintf(stderr, "kernel_launch: unexpected sizes: ws %zu (need %zu), n_in %d, out %d\n", ws_size, (size_t)WS_END, n_in, out_size); }
    }
    Params p{};
    for (int i = 0; i < 19; ++i) p.in[i] = (const float*)d_in[i];
    p.out = (float*)d_out; p.ws = (unsigned char*)d_ws;
    void* args[] = {&p};
    hipError_t e = hipLaunchCooperativeKernel((void*)fwd_megakernel, dim3(grid_blocks), dim3(512), args, kLds, stream);
    if (e != hipSuccess) fprintf(stderr, "cooperative launch failed: %s (grid %d)\n", hipGetErrorString(e), grid_blocks);
}
```
